# Optimizing an MI355X kernel written in HIP

```python
import jax
import jax.numpy as jnp
from jax import lax
import numpy as np

D_MODEL = 1024
BATCH = 2
SEQ = 16384
DEPTH = 1
DEC_BATCH = 8
DEC_SEQ = 32
PAST_LEN = 1024

CHUNK = 64
N_HEADS_A = 8
HEAD_DIM_A = 64
WIDTH_A = N_HEADS_A * HEAD_DIM_A
N_GROUPS_B = 4
GROUP_DIM_B = 128
WIDTH_B = N_GROUPS_B * GROUP_DIM_B
GMLP_CHUNK = 128
D_FF = 2816
Q_BLOCK = 128
N_MOD = 9
EPS = 1e-6
ATTN_SCALE = HEAD_DIM_A ** -0.5
IN_COLS = 3 * WIDTH_A + N_HEADS_A + 2 * WIDTH_B + 2 * D_MODEL
IN_SPLITS = (WIDTH_A, 2 * WIDTH_A, 3 * WIDTH_A, 3 * WIDTH_A + N_HEADS_A,
             3 * WIDTH_A + N_HEADS_A + 2 * WIDTH_B,
             3 * WIDTH_A + N_HEADS_A + 2 * WIDTH_B + D_MODEL)

kernel_name = 'fox_gmlp_macaron_adaln_stream_step'


def rms_norm(x, g):
    xf = x.astype(jnp.float32)
    y = xf * lax.rsqrt(jnp.mean(xf * xf, axis=-1, keepdims=True) + EPS)
    return (y * g.astype(jnp.float32)).astype(x.dtype)


def modulate(x, shift, scale):
    return x * (1 + scale) + shift


def ada_modulation(c, w_ada, b_ada):
    m = jax.nn.silu(c) @ w_ada + b_ada
    return jnp.split(m[:, None, :], N_MOD, axis=-1)


def ffn_sublayer(x, shift, scale, gate, g, w_gate, w_up, w_down):
    h = modulate(rms_norm(x, g), shift, scale)
    return x + 0.5 * gate * ((jax.nn.silu(h @ w_gate) * (h @ w_up)) @ w_down)


def mixer_projections(n, w_in, b_forget, g_q, g_k, g_gmlp_v):
    B, T, _ = n.shape
    z = n @ w_in
    q, k, v, f, zb, ga, gb = jnp.split(z, IN_SPLITS, axis=-1)
    q = rms_norm(q.reshape(B, T, N_HEADS_A, HEAD_DIM_A), g_q)
    k = rms_norm(k.reshape(B, T, N_HEADS_A, HEAD_DIM_A), g_k)
    v = v.reshape(B, T, N_HEADS_A, HEAD_DIM_A)
    logf = jax.nn.log_sigmoid((f + b_forget).astype(jnp.float32))
    u, vb = jnp.split(jax.nn.gelu(zb), 2, axis=-1)
    vb = rms_norm(vb, g_gmlp_v)
    return q, k, v, logf, u, vb, ga, gb


def fox_prompt(q, k, v, logf):
    B, S, H, Dh = q.shape
    nb = S // Q_BLOCK
    cT = jnp.cumsum(logf, axis=1).transpose(0, 2, 1)
    qb = q.reshape(B, nb, Q_BLOCK, H, Dh).transpose(1, 0, 2, 3, 4)
    cqb = cT.reshape(B, H, nb, Q_BLOCK).transpose(2, 0, 1, 3)
    key_pos = jnp.arange(S)

    def block(args):
        i, qi, ci = args
        s = jnp.einsum('bqhd,bkhd->bhqk', qi, k, preferred_element_type=jnp.float32) * ATTN_SCALE
        s = s + ci[..., :, None] - cT[..., None, :]
        q_pos = i * Q_BLOCK + jnp.arange(Q_BLOCK)
        s = jnp.where(key_pos[None, :] <= q_pos[:, None], s, -jnp.inf)
        p = jax.nn.softmax(s, axis=-1)
        return jnp.einsum('bhqk,bkhd->bqhd', p.astype(v.dtype), v)

    out = lax.map(block, (jnp.arange(nb), qb, cqb))
    return out.transpose(1, 0, 2, 3, 4).reshape(B, S, H * Dh)


def fox_sample(q, k_new, v_new, logf_new, k_cache, v_cache, logf_cache):
    B, T, H, Dh = q.shape
    P = k_cache.shape[1]
    k_all = jnp.concatenate([k_cache.astype(k_new.dtype), k_new], axis=1)
    v_all = jnp.concatenate([v_cache.astype(v_new.dtype), v_new], axis=1)
    lf_all = jnp.concatenate([logf_cache.astype(jnp.float32), logf_new], axis=1)
    cT = jnp.cumsum(lf_all, axis=1).transpose(0, 2, 1)
    s = jnp.einsum('bqhd,bkhd->bhqk', q, k_all, preferred_element_type=jnp.float32) * ATTN_SCALE
    s = s + cT[..., P:, None] - cT[..., None, :]
    key_pos = jnp.arange(P + T)
    q_pos = P + jnp.arange(T)
    s = jnp.where(key_pos[None, :] <= q_pos[:, None], s, -jnp.inf)
    p = jax.nn.softmax(s, axis=-1)
    return jnp.einsum('bhqk,bkhd->bqhd', p.astype(v_all.dtype), v_all).reshape(B, T, H * Dh)


def causal_spatial(w_spatial):
    mask = jnp.tril(jnp.ones((GMLP_CHUNK, GMLP_CHUNK), dtype=bool))
    return jnp.where(mask[None], w_spatial, 0)


def gmlp_prompt(u, vb, w_spatial, b_spatial):
    B, S, _ = vb.shape
    nc = S // GMLP_CHUNK
    vr = vb.reshape(B, nc, GMLP_CHUNK, N_GROUPS_B, GROUP_DIM_B)
    mixed = jnp.einsum('gts,bcsgd->bctgd', causal_spatial(w_spatial), vr)
    mixed = mixed + b_spatial.T[None, None, :, :, None]
    return u * mixed.reshape(B, S, WIDTH_B)


def gmlp_sample(u, vb, w_spatial, b_spatial):
    B, T, _ = vb.shape
    ws = causal_spatial(w_spatial)[:, :T, :T]
    vr = vb.reshape(B, T, N_GROUPS_B, GROUP_DIM_B)
    mixed = jnp.einsum('gts,bsgd->btgd', ws, vr) + b_spatial[:, :T].T[None, :, :, None]
    return u * mixed.reshape(B, T, WIDTH_B)


def merge_branches(a, b, ga, gb, w_proj_a, w_proj_b, w_out):
    m = jax.nn.sigmoid(ga) * (a @ w_proj_a) + jax.nn.sigmoid(gb) * (b @ w_proj_b)
    return m @ w_out


def setup_inputs(seed: int = 0) -> dict:
    key = jax.random.key(seed)
    ks = jax.random.split(key, 28)

    def nrm(k, shape, s):
        return jax.random.normal(k, shape, jnp.float32) * s

    def gain(k, shape):
        return 1.0 + nrm(k, shape, 0.05)

    return {
        'x_prompt': nrm(ks[0], (BATCH, SEQ, D_MODEL), 1.0),
        'x_sample': nrm(ks[1], (DEC_BATCH, DEC_SEQ, D_MODEL), 1.0),
        'c_prompt': nrm(ks[2], (BATCH, D_MODEL), 1.0),
        'c_sample': nrm(ks[3], (DEC_BATCH, D_MODEL), 1.0),
        'cache_fox_k': nrm(ks[4], (DEPTH, DEC_BATCH, PAST_LEN, N_HEADS_A, HEAD_DIM_A), 1.0),
        'cache_fox_v': nrm(ks[5], (DEPTH, DEC_BATCH, PAST_LEN, N_HEADS_A, HEAD_DIM_A), 1.0),
        'cache_fox_logf': jax.nn.log_sigmoid(2.0 + nrm(ks[6], (DEPTH, DEC_BATCH, PAST_LEN, N_HEADS_A), 0.5)),
        'w_ada': nrm(ks[7], (DEPTH, D_MODEL, N_MOD * D_MODEL), 0.5 * D_MODEL ** -0.5),
        'b_ada': nrm(ks[8], (DEPTH, N_MOD * D_MODEL), 0.02),
        'g_norm_ffn1': gain(ks[9], (DEPTH, D_MODEL)),
        'w_ffn1_gate': nrm(ks[10], (DEPTH, D_MODEL, D_FF), D_MODEL ** -0.5),
        'w_ffn1_up': nrm(ks[11], (DEPTH, D_MODEL, D_FF), D_MODEL ** -0.5),
        'w_ffn1_down': nrm(ks[12], (DEPTH, D_FF, D_MODEL), D_FF ** -0.5),
        'g_norm_mix': gain(ks[13], (DEPTH, D_MODEL)),
        'w_in': nrm(ks[14], (DEPTH, D_MODEL, IN_COLS), D_MODEL ** -0.5),
        'b_forget': 2.0 + nrm(ks[15], (DEPTH, N_HEADS_A), 0.5),
        'g_q': gain(ks[16], (DEPTH, HEAD_DIM_A)),
        'g_k': gain(ks[17], (DEPTH, HEAD_DIM_A)),
        'g_gmlp_v': gain(ks[18], (DEPTH, WIDTH_B)),
        'w_spatial': nrm(ks[19], (DEPTH, N_GROUPS_B, GMLP_CHUNK, GMLP_CHUNK), GMLP_CHUNK ** -0.5),
        'b_spatial': 1.0 + nrm(ks[20], (DEPTH, N_GROUPS_B, GMLP_CHUNK), 0.1),
        'w_proj_a': nrm(ks[21], (DEPTH, WIDTH_A, D_MODEL), WIDTH_A ** -0.5),
        'w_proj_b': nrm(ks[22], (DEPTH, WIDTH_B, D_MODEL), WIDTH_B ** -0.5),
        'w_out': nrm(ks[23], (DEPTH, D_MODEL, D_MODEL), D_MODEL ** -0.5),
        'g_norm_ffn2': gain(ks[24], (DEPTH, D_MODEL)),
        'w_ffn2_gate': nrm(ks[25], (DEPTH, D_MODEL, D_FF), D_MODEL ** -0.5),
        'w_ffn2_up': nrm(ks[26], (DEPTH, D_MODEL, D_FF), D_MODEL ** -0.5),
        'w_ffn2_down': nrm(ks[27], (DEPTH, D_FF, D_MODEL), D_FF ** -0.5),
    }


def reference(x_prompt, x_sample, c_prompt, c_sample, cache_fox_k, cache_fox_v, cache_fox_logf,
              w_ada, b_ada, g_norm_ffn1, w_ffn1_gate, w_ffn1_up, w_ffn1_down,
              g_norm_mix, w_in, b_forget, g_q, g_k, g_gmlp_v, w_spatial, b_spatial,
              w_proj_a, w_proj_b, w_out, g_norm_ffn2, w_ffn2_gate, w_ffn2_up, w_ffn2_down):
    xp, xs = x_prompt, x_sample
    kp_l, vp_l, fp_l, ks_l, vs_l, fs_l, gs_l = [], [], [], [], [], [], []
    for l in range(DEPTH):
        mp = ada_modulation(c_prompt, w_ada[l], b_ada[l])
        ms = ada_modulation(c_sample, w_ada[l], b_ada[l])
        ffn1 = (g_norm_ffn1[l], w_ffn1_gate[l], w_ffn1_up[l], w_ffn1_down[l])
        ffn2 = (g_norm_ffn2[l], w_ffn2_gate[l], w_ffn2_up[l], w_ffn2_down[l])
        proj = (w_in[l], b_forget[l], g_q[l], g_k[l], g_gmlp_v[l])
        outp = (w_proj_a[l], w_proj_b[l], w_out[l])

        xp = ffn_sublayer(xp, mp[0], mp[1], mp[2], *ffn1)
        xs = ffn_sublayer(xs, ms[0], ms[1], ms[2], *ffn1)

        n = modulate(rms_norm(xp, g_norm_mix[l]), mp[3], mp[4])
        q, k, v, lf, u, vb, ga, gb = mixer_projections(n, *proj)
        a = fox_prompt(q, k, v, lf)
        b = gmlp_prompt(u, vb, w_spatial[l], b_spatial[l])
        xp = xp + mp[5] * merge_branches(a, b, ga, gb, *outp)
        kp_l.append(k)
        vp_l.append(v)
        fp_l.append(lf)

        n = modulate(rms_norm(xs, g_norm_mix[l]), ms[3], ms[4])
        q, k, v, lf, u, vb, ga, gb = mixer_projections(n, *proj)
        a = fox_sample(q, k, v, lf, cache_fox_k[l], cache_fox_v[l], cache_fox_logf[l])
        b = gmlp_sample(u, vb, w_spatial[l], b_spatial[l])
        xs = xs + ms[5] * merge_branches(a, b, ga, gb, *outp)
        ks_l.append(k)
        vs_l.append(v)
        fs_l.append(lf)
        gs_l.append(vb)

        xp = ffn_sublayer(xp, mp[6], mp[7], mp[8], *ffn2)
        xs = ffn_sublayer(xs, ms[6], ms[7], ms[8], *ffn2)

    return (xp, xs, jnp.stack(kp_l), jnp.stack(vp_l), jnp.stack(fp_l),
            jnp.stack(ks_l), jnp.stack(vs_l), jnp.stack(fs_l), jnp.stack(gs_l))
```

```cpp
#include <hip/hip_runtime.h>
#include <hip/hip_cooperative_groups.h>
#include <cstdio>
#include <cstdint>
__device__ __forceinline__ int lane_id_() { return (int)__builtin_amdgcn_mbcnt_hi(~0u, __builtin_amdgcn_mbcnt_lo(~0u, 0u)); }
namespace pg8 {
#define PG8_LAS __attribute__((address_space(3)))
typedef unsigned short bf16_t;
typedef short bf16x8 __attribute__((ext_vector_type(8)));
typedef float f32x4 __attribute__((ext_vector_type(4)));
typedef unsigned u32x4 __attribute__((ext_vector_type(4)));
constexpr int BM = 256, BK = 64, HALF = 128, HTB = HALF * BK * 2  , STAGE_BYTES = 8 * HTB, NXCD = 8, WGM = 8;

__host__ __device__ __forceinline__ int lds_byte(int r, int c) { const int st = (r >> 4) * 2 + (c >> 5), rr = r & 15, cc = c & 31, ob = rr * 64 + cc * 2; return st * 1024 + (ob ^ (((ob >> 9) & 1) << 5)); }
__host__ __device__ __forceinline__ void stage_rc(int b, int& R, int& C) { const int st = b / 1024, sb = b % 1024, swz = sb ^ (((sb >> 9) & 1) << 5); R = (st >> 1) * 16 + swz / 64; C = (st & 1) * 32 + (swz % 64) / 2; }
__host__ __device__ __forceinline__ int perm32(int rho) { const int n = rho >> 4, i = rho & 15; return 8 * (i >> 2) + 4 * n + (i & 3); }

struct Unit { int pm, pn, koff; };
struct Gemm { const bf16_t* A; const bf16_t* Bt; int M, N, K, Kp; };

struct StaticOrder {
    int nM, nN, nwg, G, c;
    __host__ __device__ void init(int M, int N, int G_, int c_) { nM = M / BM; nN = N / BM; nwg = nM * nN; G = G_; c = c_; }
    __host__ __device__ bool next(int i, Unit& u) const {
        const long L = (long)i * G + c; if (L >= nwg) return false;
        int wgid = (int)L; { const int q = nwg / NXCD, r = nwg % NXCD, xcd = wgid % NXCD, off = wgid / NXCD; wgid = (xcd < r ? xcd * (q + 1) : r * (q + 1) + (xcd - r) * q) + off; }
        const int nig = WGM * nN, gid = wgid / nig, fm = gid * WGM, gsz = (nM - fm) < WGM ? (nM - fm) : WGM;
        u.pm = fm + ((wgid % nig) % gsz); u.pn = (wgid % nig) / gsz; u.koff = 0; return true;
    }
    __device__ __forceinline__ void a_ready(const Unit&) const {}
    __device__ __forceinline__ void done(const Unit&) const {}
};

template <int NN, int NS, int KSUB> struct SplitOrderT {
    int G, c;
    __host__ __device__ void init(int G_, int c_) { G = G_; c = c_; }
    __host__ __device__ bool next(int i, Unit& u) const { const int L = i * G + c; if (L >= NN * NS) return false; u.pm = 0; u.pn = L % NN; u.koff = (L / NN) * KSUB; return true; }
    __device__ __forceinline__ void a_ready(const Unit&) const {}
    __device__ __forceinline__ void done(const Unit&) const {}
};
typedef SplitOrderT<4, 11, 256> SplitOrder;
__device__ __forceinline__ unsigned cvt_pk_bf16(float lo, float hi) { unsigned r; asm volatile("v_cvt_pk_bf16_f32 %0, %1, %2" : "=v"(r) : "v"(lo), "v"(hi)); return r; }
typedef float f32x2 __attribute__((ext_vector_type(2)));
__device__ __forceinline__ f32x2 gelu_pk(f32x2 v) {
    const f32x2 av = __builtin_elementwise_abs(v), d = av * 0.2316418882f + 1.0f;
    f32x2 t; t.x = __builtin_amdgcn_rcpf(d.x); t.y = __builtin_amdgcn_rcpf(d.y);
    f32x2 q = t * 0.5307027145f + (-0.7265760135f); q = q * t + 0.7107068705f; q = q * t + (-0.142248368f); q = q * t + 0.127414796f; q = q * t;
    const f32x2 s = (v * v) * (-0.72134752044f);
    f32x2 e; e.x = __builtin_amdgcn_exp2f(s.x); e.y = __builtin_amdgcn_exp2f(s.y);
    const f32x2 m = v * (q * e), r = v - m;
    f32x2 o; o.x = v.x < 0.f ? m.x : r.x; o.y = v.y < 0.f ? m.y : r.y; return o;
}

constexpr int MPROMPT = 32768;
constexpr int NMODC = 9216;
typedef unsigned u32x2v __attribute__((ext_vector_type(2)));
__device__ __forceinline__ float sigm(float x) { return __builtin_amdgcn_rcpf(1.0f + __builtin_amdgcn_exp2f(-1.4426950408889634f * x)); }
__device__ __forceinline__ float gelu_tanh(float x) { const float y = 1.5957691216057308f * (x + 0.044715f * x * x * x); return x * sigm(y); }
__device__ __forceinline__ float bf_lo(unsigned w) { return __uint_as_float(w << 16); }
__device__ __forceinline__ float bf_hi(unsigned w) { return __uint_as_float(w & 0xffff0000u); }
__device__ __forceinline__ int mod_row(int pm, int rloc) { return pm < 128 ? (pm >> 6) : 2 + (rloc >> 5); }

struct EpiUp {
    static constexpr bool PERM = true, AFTER_DRAIN = false;
    bf16_t* ACT; int ldc;
    __device__ __forceinline__ void operator()(const f32x4 (&acc)[2][2][4][2], const Unit& u, int wr, int wc, int fr, int fq) const {
        int fr_ = fr, fq_ = fq; asm volatile("" : "+v"(fr_), "+v"(fq_));
        const int row0 = u.pm * BM + wr * 64 + fr_, ch0 = u.pn * HALF + wc * 32 + 8 * fq_;
#pragma unroll
        for (int ai = 0; ai < 2; ++ai)
#pragma unroll
            for (int m = 0; m < 4; ++m) {
                float o[8];
#pragma unroll
                for (int n = 0; n < 2; ++n)
#pragma unroll
                    for (int i = 0; i < 4; ++i) { const float g = acc[ai][0][m][n][i], up = acc[ai][1][m][n][i]; o[4 * n + i] = g * sigm(g) * up; }
                u32x4 w; w.x = cvt_pk_bf16(o[0], o[1]); w.y = cvt_pk_bf16(o[2], o[3]); w.z = cvt_pk_bf16(o[4], o[5]); w.w = cvt_pk_bf16(o[6], o[7]);
                *(u32x4*)(ACT + (size_t)(row0 + ai * HALF + m * 16) * ldc + ch0) = w;
            }
    }
};
struct EpiRes {
    static constexpr bool PERM = true, AFTER_DRAIN = false;
    const float* resp; const float* ress; float* out; const float* gate; float fac;
    __device__ __forceinline__ void rowgroup(const f32x4 (&v)[2][2], int pn, int ai, int m, int wr, int wc, int fr, int fq) const {
        const int rl = wr * 64 + fr + ai * HALF + m * 16, col0 = pn * BM + wc * 32 + 8 * fq;
        const float* gp = gate + (size_t)(2 + (rl >> 5)) * NMODC + col0; float* obase = out + (size_t)128 * BM * 1024;
#pragma unroll
        for (int bj = 0; bj < 2; ++bj)
#pragma unroll
            for (int n = 0; n < 2; ++n) { const size_t off = (size_t)rl * 1024 + col0 + bj * HALF + 4 * n;
                const f32x4 gv = *(const f32x4*)(gp + bj * HALF + 4 * n), rv = *(const f32x4*)(ress + off);
                *(f32x4*)(obase + off) = rv + (gv * fac) * v[bj][n]; }
    }
    __device__ __forceinline__ void operator()(const f32x4 (&acc)[2][2][4][2], const Unit& u, int wr, int wc, int fr, int fq) const {
        int fr_ = fr, fq_ = fq; asm volatile("" : "+v"(fr_), "+v"(fq_));
        const int rl0 = wr * 64 + fr_, col0 = u.pn * BM + wc * 32 + 8 * fq_;
        const float* rbase = (u.pm < 128) ? resp + (size_t)u.pm * BM * 1024 : ress;
        float* obase = out + (size_t)u.pm * BM * 1024;
#pragma unroll
        for (int ai = 0; ai < 2; ++ai)
#pragma unroll
            for (int m = 0; m < 4; ++m) {
                const int rl = rl0 + ai * HALF + m * 16; const float* gp = gate + (size_t)mod_row(u.pm, rl) * NMODC + col0;
#pragma unroll
                for (int bj = 0; bj < 2; ++bj)
#pragma unroll
                    for (int n = 0; n < 2; ++n) {
                        const size_t off = (size_t)rl * 1024 + col0 + bj * HALF + 4 * n;
                        const f32x4 gv = *(const f32x4*)(gp + bj * HALF + 4 * n), rv = *(const f32x4*)(rbase + off);
                        *(f32x4*)(obase + off) = rv + (gv * fac) * acc[ai][bj][m][n];
                    }
            }
    }
};
struct EpiIn {
    static constexpr bool PERM = true, AFTER_DRAIN = false;
    bf16_t *Q, *K, *V, *U, *G2, *SGA, *SGB; float* G2SS; float* QS;
    float *kout_p, *kout_s, *vout_p, *vout_s;
    const float *gq, *gk; float qscale, eps;
    __device__ __forceinline__ void operator()(const f32x4 (&acc)[2][2][4][2], const Unit& u, int wr, int wc, int fr, int fq) const {
        int fr_ = fr, fq_ = fq; asm volatile("" : "+v"(fr_), "+v"(fq_));
        const int pn = u.pn, rl0 = wr * 64 + fr_; const size_t rg0 = (size_t)u.pm * BM;
        if (pn < 4) {
            const bool isq = pn < 2; const int head = 4 * (pn & 1) + wc; const float* gsrc = isq ? gq : gk;
            f32x4 gv[2][2];
#pragma unroll
            for (int bj = 0; bj < 2; ++bj)
#pragma unroll
                for (int n = 0; n < 2; ++n) { gv[bj][n] = *(const f32x4*)(gsrc + 32 * bj + 8 * fq_ + 4 * n); if (isq) gv[bj][n] = gv[bj][n] * qscale; }
            bf16_t* dst = isq ? Q : K;
#pragma unroll
            for (int ai = 0; ai < 2; ++ai)
#pragma unroll
                for (int m = 0; m < 4; ++m) {
                    float ss = 0.f;
#pragma unroll
                    for (int bj = 0; bj < 2; ++bj)
#pragma unroll
                        for (int n = 0; n < 2; ++n) { const f32x4 x = acc[ai][bj][m][n]; ss += (x[0] * x[0] + x[1] * x[1]) + (x[2] * x[2] + x[3] * x[3]); }
                    ss += __shfl_xor(ss, 16); ss += __shfl_xor(ss, 32);
                    const float rstd = 1.0f / sqrtf(ss * (1.0f / 64.0f) + eps);
                    const int rl = rl0 + ai * HALF + m * 16; const size_t r = rg0 + rl;
#pragma unroll
                    for (int bj = 0; bj < 2; ++bj) {
                        const f32x4 o0 = acc[ai][bj][m][0] * rstd * gv[bj][0], o1 = acc[ai][bj][m][1] * rstd * gv[bj][1];
                        const int c = head * 64 + 32 * bj + 8 * fq_;
                        u32x4 w; w.x = cvt_pk_bf16(o0[0], o0[1]); w.y = cvt_pk_bf16(o0[2], o0[3]); w.z = cvt_pk_bf16(o1[0], o1[1]); w.w = cvt_pk_bf16(o1[2], o1[3]);
                        *(u32x4*)(dst + r * 512 + c) = w;
                        if (isq) { if (u.pm == 128) { float* qp = QS + (size_t)rl * 512 + c; *(f32x4*)qp = o0; *(f32x4*)(qp + 4) = o1; } }
                        else { float* kp = (u.pm < 128) ? kout_p + r * 512 + c : kout_s + (size_t)rl * 512 + c; *(f32x4*)kp = o0; *(f32x4*)(kp + 4) = o1; }
                    }
                    asm volatile("" ::: "memory");
                }
        } else if (pn < 6) {
            const int c0 = (pn - 4) * BM + wc * 32 + 8 * fq_;
#pragma unroll
            for (int ai = 0; ai < 2; ++ai)
#pragma unroll
                for (int m = 0; m < 4; ++m) { const int rl = rl0 + ai * HALF + m * 16; const size_t r = rg0 + rl;
#pragma unroll
                    for (int bj = 0; bj < 2; ++bj) { const f32x4 o0 = acc[ai][bj][m][0], o1 = acc[ai][bj][m][1]; const int c = c0 + bj * HALF;
                        u32x4 w; w.x = cvt_pk_bf16(o0[0], o0[1]); w.y = cvt_pk_bf16(o0[2], o0[3]); w.z = cvt_pk_bf16(o1[0], o1[1]); w.w = cvt_pk_bf16(o1[2], o1[3]);
                        *(u32x4*)(V + r * 512 + c) = w;
                        float* vp = (u.pm < 128) ? vout_p + r * 512 + c : vout_s + (size_t)rl * 512 + c;
                        { *(f32x4*)vp = o0; *(f32x4*)(vp + 4) = o1; } } asm volatile("" ::: "memory"); }
        } else if (pn < 10) {
            const bool isv = pn >= 8; const int t2 = (pn - 6) & 1; const int c0 = t2 * BM + wc * 32 + 8 * fq_; bf16_t* dst = isv ? G2 : U;
#pragma unroll
            for (int ai = 0; ai < 2; ++ai)
#pragma unroll
                for (int m = 0; m < 4; ++m) { const int rl = rl0 + ai * HALF + m * 16; const size_t r = rg0 + rl; float ss = 0.f;
#pragma unroll
                    for (int bj = 0; bj < 2; ++bj) { float o[8];
#pragma unroll
                        for (int n = 0; n < 2; ++n)
#pragma unroll
                            for (int i = 0; i < 4; ++i) { const float g = gelu_tanh(acc[ai][bj][m][n][i]); o[4 * n + i] = g; ss += g * g; }
                        u32x4 w; w.x = cvt_pk_bf16(o[0], o[1]); w.y = cvt_pk_bf16(o[2], o[3]); w.z = cvt_pk_bf16(o[4], o[5]); w.w = cvt_pk_bf16(o[6], o[7]);
                        *(u32x4*)(dst + r * 512 + c0 + bj * HALF) = w; }
                    if (isv) { ss += __shfl_xor(ss, 16); ss += __shfl_xor(ss, 32); if (fq_ == 0) G2SS[r * 8 + t2 * 4 + wc] = ss; } asm volatile("" ::: "memory"); }
        } else {
            const bool isa = pn < 14; const int c0 = ((pn - 10) & 3) * BM + wc * 32 + 8 * fq_; bf16_t* dst = isa ? SGA : SGB;
#pragma unroll
            for (int ai = 0; ai < 2; ++ai)
#pragma unroll
                for (int m = 0; m < 4; ++m) { const size_t r = rg0 + rl0 + ai * HALF + m * 16;
#pragma unroll
                    for (int bj = 0; bj < 2; ++bj) { float o[8];
#pragma unroll
                        for (int n = 0; n < 2; ++n)
#pragma unroll
                            for (int i = 0; i < 4; ++i) o[4 * n + i] = sigm(acc[ai][bj][m][n][i]);
                        u32x4 w; w.x = cvt_pk_bf16(o[0], o[1]); w.y = cvt_pk_bf16(o[2], o[3]); w.z = cvt_pk_bf16(o[4], o[5]); w.w = cvt_pk_bf16(o[6], o[7]);
                        *(u32x4*)(dst + r * 1024 + c0 + bj * HALF) = w;
                        } asm volatile("" ::: "memory"); }
        }
    }
};
struct EpiPartial {
    static constexpr bool PERM = true, AFTER_DRAIN = false;
    float* PART; int nN, Ksub;
    __device__ __forceinline__ void operator()(const f32x4 (&acc)[2][2][4][2], const Unit& u, int wr, int wc, int fr, int fq) const {
        int tid_ = (wr * 4 + wc) * 64 + fq * 16 + fr; asm volatile("" : "+v"(tid_));
        f32x4* dst = (f32x4*)PART + (size_t)((u.koff >> 8) * 4 + u.pn) * 32 * 512 + tid_;
#pragma unroll
        for (int ai = 0; ai < 2; ++ai)
#pragma unroll
            for (int bj = 0; bj < 2; ++bj)
#pragma unroll
                for (int m = 0; m < 4; ++m)
#pragma unroll
                    for (int n = 0; n < 2; ++n) { *dst = acc[ai][bj][m][n]; dst += 512; asm volatile("" : "+v"(dst) :: "memory"); }
        asm volatile("" ::: "memory");
    }
};
template <int NN, int KSHIFT> struct EpiPartialT {
    static constexpr bool PERM = true, AFTER_DRAIN = false;
    float* PART;
    __device__ __forceinline__ void operator()(const f32x4 (&acc)[2][2][4][2], const Unit& u, int wr, int wc, int fr, int fq) const {
        int tid_ = (wr * 4 + wc) * 64 + fq * 16 + fr; asm volatile("" : "+v"(tid_));
        f32x4* dst = (f32x4*)PART + (size_t)((u.koff >> KSHIFT) * NN + u.pn) * 32 * 512 + tid_;
#pragma unroll
        for (int ai = 0; ai < 2; ++ai)
#pragma unroll
            for (int bj = 0; bj < 2; ++bj)
#pragma unroll
                for (int m = 0; m < 4; ++m)
#pragma unroll
                    for (int n = 0; n < 2; ++n) { *dst = acc[ai][bj][m][n]; dst += 512; asm volatile("" : "+v"(dst) :: "memory"); }
    }
};
template <class Epi> __device__ __forceinline__ void reduce_partials(const float* PART, int nN, int nS, int pn, int pm_out, const Epi& E, int wv) {
    int tid = (wv << 6) | lane_id_(); asm volatile("" : "+v"(tid));
    const int wid = __builtin_amdgcn_readfirstlane(tid >> 6), lane = tid & 63, wr = wid >> 2, wc = wid & 3, fr = lane & 15, fq = lane >> 4;
    f32x4 acc[2][2][4][2];
#pragma unroll
    for (int ai = 0; ai < 2; ++ai)
#pragma unroll
        for (int bj = 0; bj < 2; ++bj)
#pragma unroll
            for (int m = 0; m < 4; ++m)
#pragma unroll
                for (int n = 0; n < 2; ++n) acc[ai][bj][m][n] = (f32x4){0.f, 0.f, 0.f, 0.f};
#pragma unroll 1
    for (int s = 0; s < nS; ++s) { const f32x4* src = (const f32x4*)PART + (size_t)(s * nN + pn) * 32 * 512 + tid;
#pragma unroll
        for (int ai = 0; ai < 2; ++ai) {
            f32x4 t[2][4][2];
#pragma unroll
            for (int bj = 0; bj < 2; ++bj)
#pragma unroll
                for (int m = 0; m < 4; ++m)
#pragma unroll
                    for (int n = 0; n < 2; ++n) { t[bj][m][n] = *src; src += 512; asm volatile("" : "+v"(src)); }
#pragma unroll
            for (int bj = 0; bj < 2; ++bj)
#pragma unroll
                for (int m = 0; m < 4; ++m)
#pragma unroll
                    for (int n = 0; n < 2; ++n) acc[ai][bj][m][n] += t[bj][m][n];
            asm volatile("" ::: "memory"); } }
    Unit u; u.pm = pm_out; u.pn = pn; u.koff = 0;
    E(acc, u, wr, wc, fr, fq);
}
template <int NS, class Epi> __device__ __forceinline__ void reduce_rowgroup(const float* PART, int pn, int rg, const Epi& E, int wv) {
    int tid = (wv << 6) | lane_id_(); asm volatile("" : "+v"(tid));
    const int wid = __builtin_amdgcn_readfirstlane(tid >> 6), lane = tid & 63, wr = wid >> 2, wc = wid & 3, fr = lane & 15, fq = lane >> 4;
    const int ai = rg >> 2, m = rg & 3;
    f32x4 t[NS][2][2];
#pragma unroll
    for (int s = 0; s < NS; ++s)
#pragma unroll
        for (int bj = 0; bj < 2; ++bj)
#pragma unroll
            for (int n = 0; n < 2; ++n) t[s][bj][n] = *((const f32x4*)PART + ((size_t)(s * 4 + pn) * 32 + (((ai * 2 + bj) * 4 + m) * 2 + n)) * 512 + tid);
    f32x4 v[2][2];
#pragma unroll
    for (int bj = 0; bj < 2; ++bj)
#pragma unroll
        for (int n = 0; n < 2; ++n) { v[bj][n] = t[0][bj][n];
#pragma unroll
            for (int s = 1; s < NS; ++s) v[bj][n] += t[s][bj][n]; }
    E.rowgroup(v, pn, ai, m, wr, wc, fr, fq);
}
template <int MODE> struct EpiMix {
    static constexpr bool PERM = true, AFTER_DRAIN = false;
    bf16_t* T; const bf16_t* T2;
    __device__ __forceinline__ void one(size_t off, const f32x4 a0, const f32x4 a1) const {
        float o[8] = {a0[0], a0[1], a0[2], a0[3], a1[0], a1[1], a1[2], a1[3]};
        if (MODE >= 1) {
            const u32x4 t = *(const u32x4*)(T + off);
            const float tv[8] = {bf_lo(t.x), bf_hi(t.x), bf_lo(t.y), bf_hi(t.y), bf_lo(t.z), bf_hi(t.z), bf_lo(t.w), bf_hi(t.w)};
            if (MODE == 1) {
#pragma unroll
                for (int i = 0; i < 8; ++i) o[i] = sigm(o[i]) * tv[i];
            } else {
                const u32x4 s2 = *(const u32x4*)(T2 + off);
                const float sv[8] = {bf_lo(s2.x), bf_hi(s2.x), bf_lo(s2.y), bf_hi(s2.y), bf_lo(s2.z), bf_hi(s2.z), bf_lo(s2.w), bf_hi(s2.w)};
#pragma unroll
                for (int i = 0; i < 8; ++i) o[i] = tv[i] + sigm(o[i]) * sv[i];
            }
        }
        u32x4 w; w.x = cvt_pk_bf16(o[0], o[1]); w.y = cvt_pk_bf16(o[2], o[3]); w.z = cvt_pk_bf16(o[4], o[5]); w.w = cvt_pk_bf16(o[6], o[7]);
        *(u32x4*)(T + off) = w;
    }
    __device__ __forceinline__ void operator()(const f32x4 (&acc)[2][2][4][2], const Unit& u, int wr, int wc, int fr, int fq) const {
        int fr_ = fr, fq_ = fq; asm volatile("" : "+v"(fr_), "+v"(fq_));
        const size_t row0 = (size_t)u.pm * BM + wr * 64 + fr_; const int col0 = u.pn * BM + wc * 32 + 8 * fq_;
#pragma unroll
        for (int ai = 0; ai < 2; ++ai)
#pragma unroll
            for (int m = 0; m < 4; ++m) {
#pragma unroll
                for (int bj = 0; bj < 2; ++bj) one((row0 + ai * HALF + m * 16) * 1024 + col0 + bj * HALF, acc[ai][bj][m][0], acc[ai][bj][m][1]);
                asm volatile("" ::: "memory");
            }
    }
    __device__ __forceinline__ void rowgroup(const f32x4 (&v)[2][2], int pn, int ai, int m, int wr, int wc, int fr, int fq) const {
        const size_t row = (size_t)(wr * 64 + fr + ai * HALF + m * 16); const int col0 = pn * BM + wc * 32 + 8 * fq;
#pragma unroll
        for (int bj = 0; bj < 2; ++bj) one(row * 1024 + col0 + bj * HALF, v[bj][0], v[bj][1]);
    }
};
template <class Epi, class Sched, bool ALIGN_EPI = false, bool SP2 = false>
__device__ __forceinline__ void gemm_phase(PG8_LAS unsigned char* lds, const Gemm g, const Sched& S, const Epi& E, int wv) {
    int tid = (wv << 6) | lane_id_(); asm volatile("" : "+v"(tid));
    const int wid = __builtin_amdgcn_readfirstlane(tid >> 6), lane = tid & 63, wr = wid >> 2, wc = wid & 3, fr = lane & 15, fq = lane >> 4;
    const int K = g.Kp, nt = g.K / BK;
    unsigned voffA[2], voffB[2];
#pragma unroll
    for (int i = 0; i < 2; ++i) { int R, C; stage_rc(tid * 16 + i * 8192, R, C); const int Rb = Epi::PERM ? ((R & ~31) + perm32(R & 31)) : R;
        voffA[i] = (unsigned)(R * K + C) * 2u; voffB[i] = (unsigned)(Rb * K + C) * 2u; }
    const size_t kstep = (size_t)(BK * 2);
    const size_t hstep = (size_t)HALF * K * 2;
    const size_t tstep = 2 * hstep;
    const unsigned ldsw = (unsigned)wid * 1024u;
    const int aoff = lds_byte(wr * 64 + fr, fq * 8), boff = lds_byte(wc * 32 + fr, fq * 8);
#define PG8_SA(b, h) (((b) * 2 + (h)) * HTB)
#define PG8_SB(b, h) ((4 + (b) * 2 + (h)) * HTB)
#define PG8_STAGE(bufoff, gbase, voff) do { _Pragma("unroll") for (int _i = 0; _i < 2; ++_i) \
        __builtin_amdgcn_global_load_lds((const unsigned*)((const char*)(gbase) + (voff)[_i]), (PG8_LAS unsigned*)(lds + (bufoff) + ldsw + _i * 8192), 16, 0, 0); } while (0)
#define PG8_LDA(dst, b, h) do { _Pragma("unroll") for (int m = 0; m < 4; ++m) _Pragma("unroll") for (int k = 0; k < 2; ++k) dst[m][k] = *(const PG8_LAS bf16x8*)(lds + PG8_SA(b, h) + aoff + m * 2048 + k * 1024); } while (0)
#define PG8_LDB(dst, b, h) do { _Pragma("unroll") for (int n = 0; n < 2; ++n) _Pragma("unroll") for (int k = 0; k < 2; ++k) dst[n][k] = *(const PG8_LAS bf16x8*)(lds + PG8_SB(b, h) + boff + n * 2048 + k * 1024); } while (0)
#define PG8_MMA(ai, bj, At, Bt) do { __builtin_amdgcn_s_setprio(1); _Pragma("unroll") for (int m = 0; m < 4; ++m) _Pragma("unroll") for (int n = 0; n < 2; ++n) _Pragma("unroll") for (int k = 0; k < 2; ++k) \
        acc[ai][bj][m][n] = __builtin_amdgcn_mfma_f32_16x16x32_bf16(Bt[n][k], At[m][k], acc[ai][bj][m][n], 0, 0, 0); __builtin_amdgcn_s_setprio(0); } while (0)
#define PG8_WAIT_V(n) asm volatile("s_waitcnt vmcnt(" #n ")" ::: "memory")
#define PG8_WAIT_L(n) asm volatile("s_waitcnt lgkmcnt(" #n ")" ::: "memory")
#define PG8_BAR __builtin_amdgcn_s_barrier()
#define PG8_SCHED __builtin_amdgcn_sched_barrier(0)
    Unit cur, nxt; int ui = 0;
    if (!S.next(0, cur)) return;
    f32x4 acc[2][2][4][2];
#pragma unroll
    for (int a = 0; a < 2; ++a)
#pragma unroll
        for (int b = 0; b < 2; ++b)
#pragma unroll
            for (int m = 0; m < 4; ++m)
#pragma unroll
                for (int n = 0; n < 2; ++n) acc[a][b][m][n] = (f32x4){0.f, 0.f, 0.f, 0.f};
    bf16x8 At[4][2], B0[2][2], B1[2][2];
    const char* cA = (const char*)g.A + (size_t)cur.pm * tstep + (size_t)cur.koff * 2; const char* cB = (const char*)g.Bt + (size_t)cur.pn * tstep + (size_t)cur.koff * 2;
    S.a_ready(cur);
    if constexpr (SP2) {
        PG8_STAGE(PG8_SB(0, 0), cB, voffB); PG8_STAGE(PG8_SB(0, 1), cB + hstep, voffB); PG8_STAGE(PG8_SA(0, 0), cA, voffA); PG8_STAGE(PG8_SA(0, 1), cA + hstep, voffA);
        if (wr == 1) PG8_BAR;
        PG8_WAIT_V(2); PG8_BAR;
        PG8_STAGE(PG8_SB(1, 0), cB + kstep, voffB); PG8_STAGE(PG8_SA(1, 0), cA + kstep, voffA); PG8_STAGE(PG8_SB(1, 1), cB + hstep + kstep, voffB);
        PG8_WAIT_V(6); PG8_BAR;
    } else {
        PG8_STAGE(PG8_SB(0, 0), cB, voffB); PG8_STAGE(PG8_SA(0, 0), cA, voffA); PG8_STAGE(PG8_SB(0, 1), cB + hstep, voffB); PG8_STAGE(PG8_SA(0, 1), cA + hstep, voffA);
        if (wr == 1) PG8_BAR;
        PG8_WAIT_V(4); PG8_BAR;
        PG8_STAGE(PG8_SB(1, 0), cB + kstep, voffB); PG8_STAGE(PG8_SA(1, 0), cA + kstep, voffA); PG8_STAGE(PG8_SB(1, 1), cB + hstep + kstep, voffB);
        PG8_WAIT_V(6); PG8_BAR;
    }
    for (;;) {
        const bool has_next = S.next(ui + 1, nxt);
        const char* nA = has_next ? (const char*)g.A + (size_t)nxt.pm * tstep + (size_t)nxt.koff * 2 : cA; const char* nB = has_next ? (const char*)g.Bt + (size_t)nxt.pn * tstep + (size_t)nxt.koff * 2 : cB;
        for (int t = 0; t < nt; t += 2) {
            const bool last = (t == nt - 2);
            const char* a1 = cA + (size_t)(t + 1) * kstep;
            const char* a2 = last ? nA : cA + (size_t)(t + 2) * kstep; const char* b2 = last ? nB : cB + (size_t)(t + 2) * kstep;
            const char* a3 = a2 + kstep; const char* b3 = b2 + kstep;
            if (last && has_next) S.a_ready(nxt);
            if constexpr (SP2) {
            PG8_LDB(B0, 0, 0); PG8_LDB(B1, 0, 1); PG8_SCHED; PG8_LDA(At, 0, 0); PG8_STAGE(PG8_SA(1, 1), a1 + hstep, voffA);
            PG8_WAIT_V(8); PG8_WAIT_L(0); PG8_BAR; PG8_MMA(0, 0, At, B0); PG8_MMA(0, 1, At, B1); PG8_BAR; PG8_SCHED;
            PG8_LDA(At, 0, 1); PG8_STAGE(PG8_SB(0, 0), b2, voffB); PG8_STAGE(PG8_SB(0, 1), b2 + hstep, voffB); PG8_STAGE(PG8_SA(0, 0), a2, voffA);
            PG8_WAIT_V(8); PG8_WAIT_L(0); PG8_BAR; PG8_MMA(1, 0, At, B0); PG8_MMA(1, 1, At, B1); PG8_BAR; PG8_SCHED;
            PG8_LDB(B0, 1, 0); PG8_LDB(B1, 1, 1); PG8_SCHED; PG8_LDA(At, 1, 0); PG8_STAGE(PG8_SA(0, 1), a2 + hstep, voffA);
            PG8_WAIT_V(8); PG8_WAIT_L(0); PG8_BAR; PG8_MMA(0, 0, At, B0); PG8_MMA(0, 1, At, B1); PG8_BAR; PG8_SCHED;
            PG8_LDA(At, 1, 1); PG8_STAGE(PG8_SB(1, 0), b3, voffB); PG8_STAGE(PG8_SB(1, 1), b3 + hstep, voffB); PG8_STAGE(PG8_SA(1, 0), a3, voffA);
            PG8_WAIT_V(8); PG8_WAIT_L(0); PG8_BAR; PG8_MMA(1, 0, At, B0); PG8_MMA(1, 1, At, B1); PG8_BAR; PG8_SCHED;
            } else {
            PG8_LDB(B0, 0, 0); PG8_SCHED; PG8_LDA(At, 0, 0); PG8_STAGE(PG8_SA(1, 1), a1 + hstep, voffA);
            PG8_WAIT_L(8); PG8_BAR; PG8_WAIT_L(0); PG8_MMA(0, 0, At, B0); PG8_BAR; PG8_SCHED;
            PG8_LDB(B1, 0, 1); PG8_STAGE(PG8_SB(0, 0), b2, voffB);
            PG8_BAR; PG8_WAIT_L(0); PG8_MMA(0, 1, At, B1); PG8_BAR;
            PG8_LDA(At, 0, 1); PG8_STAGE(PG8_SA(0, 0), a2, voffA);
            PG8_BAR; PG8_WAIT_L(0); PG8_MMA(1, 0, At, B0); PG8_BAR; PG8_SCHED;
            PG8_STAGE(PG8_SB(0, 1), b2 + hstep, voffB);
            PG8_WAIT_V(6); PG8_BAR; PG8_MMA(1, 1, At, B1); PG8_BAR;
            PG8_LDB(B0, 1, 0); PG8_SCHED; PG8_LDA(At, 1, 0); PG8_STAGE(PG8_SA(0, 1), a2 + hstep, voffA);
            PG8_WAIT_L(8); PG8_BAR; PG8_WAIT_L(0); PG8_MMA(0, 0, At, B0); PG8_BAR; PG8_SCHED;
            PG8_LDB(B1, 1, 1); PG8_STAGE(PG8_SB(1, 0), b3, voffB);
            PG8_BAR; PG8_WAIT_L(0); PG8_MMA(0, 1, At, B1); PG8_BAR;
            PG8_LDA(At, 1, 1); PG8_STAGE(PG8_SA(1, 0), a3, voffA);
            PG8_BAR; PG8_WAIT_L(0); PG8_MMA(1, 0, At, B0); PG8_BAR; PG8_SCHED;
            PG8_STAGE(PG8_SB(1, 1), b3 + hstep, voffB);
            PG8_WAIT_V(6); PG8_BAR; PG8_MMA(1, 1, At, B1); PG8_BAR;
            }
        }
        if constexpr (ALIGN_EPI) { if (wr == 0) PG8_BAR; }
        if constexpr (!Epi::AFTER_DRAIN) { E(acc, cur, wr, wc, fr, fq); S.done(cur); }
        if (!has_next) break;
#pragma unroll
        for (int a = 0; a < 2; ++a)
#pragma unroll
            for (int b = 0; b < 2; ++b)
#pragma unroll
                for (int m = 0; m < 4; ++m)
#pragma unroll
                    for (int n = 0; n < 2; ++n) acc[a][b][m][n] = (f32x4){0.f, 0.f, 0.f, 0.f};
        cur = nxt; cA = nA; cB = nB; ++ui;
        if constexpr (ALIGN_EPI) { if (wr == 1) PG8_BAR; }
    }
    PG8_WAIT_V(0);
    if constexpr (!ALIGN_EPI) { if (wr == 0) PG8_BAR; }
    PG8_BAR;
    if constexpr (Epi::AFTER_DRAIN) { E.fused(acc, cur, wr, wc, fr, fq, lds, wid, lane); S.done(cur); }
#undef PG8_SA
#undef PG8_SB
#undef PG8_STAGE
#undef PG8_LDA
#undef PG8_LDB
#undef PG8_MMA
#undef PG8_WAIT_V
#undef PG8_WAIT_L
#undef PG8_BAR
#undef PG8_SCHED
}

template <class Epi, class Sched>
__device__ __forceinline__ void naive_phase(const Gemm g, const Sched& S, const Epi& E) {
    int tid = threadIdx.x; asm volatile("" : "+v"(tid));
    const int wid = __builtin_amdgcn_readfirstlane(tid >> 6), lane = tid & 63, wr = wid >> 2, wc = wid & 3, fr = lane & 15, fq = lane >> 4;
    Unit u;
#pragma unroll 1
    for (int ui = 0; S.next(ui, u); ++ui) {
        f32x4 acc[2][2][4][2];
#pragma unroll
        for (int ai = 0; ai < 2; ++ai)
#pragma unroll
            for (int m = 0; m < 4; ++m) {
                const bf16_t* arow = g.A + (size_t)(u.pm * BM + ai * HALF + wr * 64 + m * 16 + fr) * g.Kp;
#pragma unroll
                for (int bj = 0; bj < 2; ++bj)
#pragma unroll
                    for (int n = 0; n < 2; ++n)
#pragma unroll
                        for (int i = 0; i < 4; ++i) {
                            const bf16_t* brow = g.Bt + (size_t)(u.pn * BM + bj * HALF + wc * 32 + 8 * fq + 4 * n + i) * g.Kp;
                            float s = 0.f;
#pragma unroll 1
                            for (int k = 0; k < g.K; k += 8) { const u32x4 a = *(const u32x4*)(arow + k), b = *(const u32x4*)(brow + k);
                                s += bf_lo(a.x) * bf_lo(b.x) + bf_hi(a.x) * bf_hi(b.x) + bf_lo(a.y) * bf_lo(b.y) + bf_hi(a.y) * bf_hi(b.y)
                                   + bf_lo(a.z) * bf_lo(b.z) + bf_hi(a.z) * bf_hi(b.z) + bf_lo(a.w) * bf_lo(b.w) + bf_hi(a.w) * bf_hi(b.w); }
                            acc[ai][bj][m][n][i] = s;
                        }
            }
        E(acc, u, wr, wc, fr, fq);
    }
    __syncthreads();
}
}
#include <hip/hip_bf16.h>
#include <cmath>
namespace attn_body {
using bf16=__hip_bfloat16;
using bf16x8=__attribute__((ext_vector_type(8)))short;
using s16x4=__attribute__((ext_vector_type(4)))short;
using f32x16=__attribute__((ext_vector_type(16)))float;
using u32x4=__attribute__((ext_vector_type(4)))unsigned;
using f32x4_t=__attribute__((ext_vector_type(4)))float;
constexpr int BATCH=2,NHEAD=8,SEQ=16384,D=64,DM=NHEAD*D;
constexpr int NW=8,QBLK=32,QB=QBLK*NW,KVBLK=64,NQB=SEQ/QB;
constexpr int ATTN_PITCH=DM, ATTN_UNIT_ROWS=QB;
__device__ __forceinline__ int crow(int r,int hi){return (r&3)+8*(r>>2)+4*hi;}
#define SBAR() __builtin_amdgcn_sched_barrier(0)
__device__ __forceinline__ void cmask(f32x16&p0,f32x16&p1,int jb,int qrel,int hi){
  const float NEG=-INFINITY; int kb=64*jb+4*hi;
  #pragma unroll
  for(int r=0;r<16;++r){int kv=kb+(r&3)+8*(r>>2); if(kv>qrel)p0[r]=NEG; if(kv+32>qrel)p1[r]=NEG;}
}

constexpr int NSLOT=3, SLOTB=8192;
constexpr int LDS_K=0, LDS_V=NSLOT*SLOTB, LDS_WS=2*NSLOT*SLOTB, LDS_OST=LDS_WS+NW*64*4, LDS_BYTES=LDS_OST+NW*4096, LDS_BIAS=LDS_BYTES, LDS_TOTAL=LDS_BIAS+SEQ*4;
constexpr float C2=0.125f*1.4426950408889634f;
__device__ __forceinline__ void glds16(const void*gsrc,unsigned lds_dst){unsigned keep;
  asm volatile("s_mov_b32 %0, m0\n\ts_mov_b32 m0, %2\n\ts_nop 0\n\tglobal_load_lds_dwordx4 %1, off\n\ts_mov_b32 m0, %0":"=&s"(keep):"v"(gsrc),"s"(lds_dst):"memory");}
__device__ __forceinline__ float max3f(float a,float b,float c){float r;asm("v_max3_f32 %0, %1, %2, %3":"=v"(r):"v"(a),"v"(b),"v"(c));return r;}
__device__ __forceinline__ float max2f(float a,float b){float r;asm("v_max_f32_e32 %0, %1, %2":"=v"(r):"v"(a),"v"(b));return r;}
__device__ __forceinline__ float fadd_s(float a,float b){float r;asm("v_add_f32_e32 %0, %1, %2":"=v"(r):"v"(a),"v"(b));return r;}
__device__ __forceinline__ float fsub_s(float a,float b){float r;asm("v_sub_f32_e32 %0, %1, %2":"=v"(r):"v"(a),"v"(b));return r;}
typedef float f32x2_t __attribute__((ext_vector_type(2))); typedef __bf16 bf16x2_t __attribute__((ext_vector_type(2)));
__device__ __forceinline__ unsigned cvtpk_s(float lo,float hi){f32x2_t v={lo,hi};bf16x2_t b=__builtin_convertvector(v,bf16x2_t);return __builtin_bit_cast(unsigned,b);}
#define WAIT_BAR(N) asm volatile("s_waitcnt vmcnt(" #N ") lgkmcnt(0)\n\ts_barrier":::"memory")

__device__ __forceinline__ void qkt(f32x16&p0,f32x16&p1,const char*Kslot,const bf16x8*qr,int r32,int hi){
  const char*kb=Kslot+hi*1024+r32*16;
  #pragma unroll
  for(int d0=0;d0<4;++d0){
    const bf16x8 b0=*reinterpret_cast<const bf16x8*>(kb+d0*2048);
    const bf16x8 b1=*reinterpret_cast<const bf16x8*>(kb+d0*2048+512);
    p0=__builtin_amdgcn_mfma_f32_32x32x16_bf16(b0,qr[d0],p0,0,0,0);p1=__builtin_amdgcn_mfma_f32_32x32x16_bf16(b1,qr[d0],p1,0,0,0);}
}
typedef __attribute__((address_space(3))) const char* lds_cptr;
typedef short v4i16_t __attribute__((ext_vector_type(4)));
__device__ __forceinline__ void kload8(bf16x8*kf,lds_cptr kp){
  kf[0]=*(const __attribute__((address_space(3))) bf16x8*)(kp);      kf[1]=*(const __attribute__((address_space(3))) bf16x8*)(kp+512);
  kf[2]=*(const __attribute__((address_space(3))) bf16x8*)(kp+2048); kf[3]=*(const __attribute__((address_space(3))) bf16x8*)(kp+2560);
  kf[4]=*(const __attribute__((address_space(3))) bf16x8*)(kp+4096); kf[5]=*(const __attribute__((address_space(3))) bf16x8*)(kp+4608);
  kf[6]=*(const __attribute__((address_space(3))) bf16x8*)(kp+6144); kf[7]=*(const __attribute__((address_space(3))) bf16x8*)(kp+6656);
}
__device__ __forceinline__ void kload2(bf16x8*kf,lds_cptr kp,int j){ kf[2*j]=*(const __attribute__((address_space(3))) bf16x8*)(kp+j*2048); kf[2*j+1]=*(const __attribute__((address_space(3))) bf16x8*)(kp+j*2048+512); }
__device__ __forceinline__ s16x4 vtr(lds_cptr p){ return __builtin_bit_cast(s16x4,__builtin_amdgcn_ds_read_tr16_b64_v4i16((__attribute__((address_space(3))) v4i16_t*)p)); }
__device__ __forceinline__ float rowmax(const f32x16&p0,const f32x16&p1){
  float a=max3f(p0[0],p0[1],p1[0]),b=max3f(p0[2],p0[3],p1[1]);a=max3f(a,p1[2],p1[3]);
  #pragma unroll
  for(int r=4;r<16;r+=4){a=max3f(a,p0[r],p0[r+1]);b=max3f(b,p0[r+2],p0[r+3]);a=max3f(a,p1[r],p1[r+1]);b=max3f(b,p1[r+2],p1[r+3]);}
  const float m=max2f(a,b);
  auto rr=__builtin_amdgcn_permlane32_swap(__float_as_uint(m),__float_as_uint(m),false,false);
  return max2f(__uint_as_float(rr[0]),__uint_as_float(rr[1]));
}
__device__ __forceinline__ void pv(f32x16*o,int vb,bf16x8 pa0,bf16x8 pa1,bf16x8 pa2,bf16x8 pa3){
  #pragma unroll
  for(int d0=0;d0<2;++d0){s16x4 lo[4],hi[4];
    #pragma unroll
    for(int ks=0;ks<4;++ks){
      asm volatile("ds_read_b64_tr_b16 %0,%1 offset:%c2":"=&v"(lo[ks]):"v"(vb),"i"(d0*4096+ks*1024):"memory");
      asm volatile("ds_read_b64_tr_b16 %0,%1 offset:%c2":"=&v"(hi[ks]):"v"(vb),"i"(d0*4096+ks*1024+512):"memory");}
    asm volatile("s_waitcnt lgkmcnt(0)":::"memory");SBAR();
    #define PK(k) (bf16x8){lo[k][0],lo[k][1],lo[k][2],lo[k][3],hi[k][0],hi[k][1],hi[k][2],hi[k][3]}
    o[d0]=__builtin_amdgcn_mfma_f32_32x32x16_bf16(pa0,PK(0),o[d0],0,0,0);
    o[d0]=__builtin_amdgcn_mfma_f32_32x32x16_bf16(pa1,PK(1),o[d0],0,0,0);
    o[d0]=__builtin_amdgcn_mfma_f32_32x32x16_bf16(pa2,PK(2),o[d0],0,0,0);
    o[d0]=__builtin_amdgcn_mfma_f32_32x32x16_bf16(pa3,PK(3),o[d0],0,0,0);
    #undef PK
  }
}

#ifndef ATTN_STORE16
#define ATTN_STORE16(p,v) (*(u32x4*)(p)=(v))
#endif
template<int THRL> __device__ __forceinline__ void attn_unit(int b,int h,int qb,int ts,const float*__restrict__ cl2,const bf16*Q,const bf16*__restrict__ K,const bf16*__restrict__ V,bf16*O,char*shm,int wv){
  int tid=(wv<<6)|lane_id_(); asm volatile("":"+v"(tid)); const int lane=tid&63,r32=lane&31,hi=lane>>5; const int wid=__builtin_amdgcn_readfirstlane(tid>>6);
  const long rowbase=(long)b*SEQ; const int q0=qb*QB;
  const bf16*Qw=Q+(rowbase+q0+wid*QBLK)*DM+h*D;
  const bf16*Kh=K+(rowbase+(long)ts*KVBLK)*DM+h*D,*Vh=V+(rowbase+(long)ts*KVBLK)*DM+h*D;
  const unsigned lds0=(unsigned)(uintptr_t)shm;
  float*wsf=(float*)(shm+LDS_WS)+wid*64;
  const bf16*ksrc=Kh+(long)lane*DM+wid*8;
  const bf16*vsrc=Vh+(long)(16*(wid&3)+(lane>>2))*DM+(wid>>2)*32+(lane&3)*8;
  const unsigned kdst=lds0+LDS_K+wid*1024, vdst=lds0+LDS_V+wid*1024;
  #define DMA_K(t,slot) glds16(ksrc+(long)(t)*KVBLK*DM,(unsigned)__builtin_amdgcn_readfirstlane(kdst+(slot)))
  #define DMA_V(t,slot) glds16(vsrc+(long)(t)*KVBLK*DM,(unsigned)__builtin_amdgcn_readfirstlane(vdst+(slot)))
  const int vb0=(int)(lds0+LDS_V)+((lane>>4)&1)*32+(lane&3)*8+(4*hi+((lane&15)>>2))*64;
  const char*Kbase=shm+LDS_K; bf16x8 kf[8];
  const lds_cptr shm3=(lds_cptr)shm; const lds_cptr kp0=shm3+LDS_K+hi*1024+r32*16; const lds_cptr vp0=shm3+LDS_V+((lane>>4)&1)*32+(lane&3)*8+(4*hi+((lane&15)>>2))*64;
  const int NT=(q0+QB)/KVBLK-ts;
  DMA_K(0,0);DMA_V(0,0);DMA_K(1,SLOTB);
  bf16x8 qr[4];
  #pragma unroll
  for(int d0=0;d0<4;++d0)qr[d0]=*reinterpret_cast<const bf16x8*>(&Qw[(long)r32*DM+d0*16+hi*8]);
  float mhat=0.f,l_reg=0.f;f32x16 o[2];o[0]=f32x16{};o[1]=f32x16{};
  typedef __attribute__((address_space(3))) const f32x4_t* lds_f4p; const lds_f4p biasp=(lds_f4p)((lds_cptr)shm+LDS_BIAS)+hi;
  #define BIASINIT(C0,C1,t) do{ _Pragma("unroll") for(int g_=0;g_<4;++g_){ const f32x4_t b0_=biasp[(t)*16+2*g_], b1_=biasp[(t)*16+8+2*g_]; \
      _Pragma("unroll") for(int i_=0;i_<4;++i_){ C0[4*g_+i_]=b0_[i_]-mhat; C1[4*g_+i_]=b1_[i_]-mhat; } } }while(0)
  const int qrel=wid*QBLK+r32;
  #define CMASK(P0,P1,t) do{int jb_=(t)-(NT-4); if(jb_>=0)cmask(P0,P1,jb_,qrel,hi);}while(0)
  bool resc=false;
  #define START(P0,P1) do{ const float rm=rowmax(P0,P1); resc=false; \
    { const float dl=rm; mhat=fadd_s(mhat,dl); \
      _Pragma("unroll") for(int r=0;r<16;++r){P0[r]=fsub_s(P0[r],dl);P1[r]=fsub_s(P1[r],dl);} } \
    _Pragma("unroll") for(int r=0;r<16;++r)P0[r]=__builtin_amdgcn_exp2f(P0[r]); }while(0)
  #define RESC() do{ if(resc){ asm volatile("s_waitcnt lgkmcnt(0)":::"memory"); \
      _Pragma("unroll") for(int d_=0;d_<2;++d_) _Pragma("unroll") for(int r=0;r<16;++r)o[d_][r]*=wsf[crow(r,hi)]; } }while(0)
  f32x16 pA0,pA1,pB0,pB1;
  int sl_prev=0,sl_cur=0,sl_next=SLOTB;
  #define ROT() do{sl_prev=sl_cur;sl_cur=sl_next;sl_next=(sl_next==(NSLOT-1)*SLOTB)?0:sl_next+SLOTB;}while(0)
  {
    const float cref=cl2[q0]; const f32x4_t*src=(const f32x4_t*)(cl2+ts*KVBLK); __attribute__((address_space(3))) f32x4_t*dst=(__attribute__((address_space(3))) f32x4_t*)((__attribute__((address_space(3))) char*)shm+LDS_BIAS);
    for(int i=tid;i<NT*16;i+=NW*64){ const f32x4_t c4=src[i]; dst[i]=(f32x4_t){cref-c4[0],cref-c4[1],cref-c4[2],cref-c4[3]}; } }
  DMA_K(2,2*SLOTB);
  WAIT_BAR(3);
  BIASINIT(pA0,pA1,0); qkt(pA0,pA1,Kbase,qr,r32,hi);asm volatile("s_nop 15\n\ts_nop 7":"+v"(pA0),"+v"(pA1));CMASK(pA0,pA1,0);
  START(pA0,pA1);
  _Pragma("unroll") for(int r=0;r<16;++r)pA1[r]=__builtin_amdgcn_exp2f(pA1[r]);
  WAIT_BAR(0);
  DMA_K(3,0);DMA_V(1,SLOTB);
  ROT();
  kload8(kf,kp0+sl_cur);
  WAIT_BAR(2);
  s16x4 vlo[8],vhi[8]; u32x4 pw0,pw1,pw2,pw3;
  #define PKW(P,B) cvtpk_s(P[B],P[B+1])
  #define PAF(k) __builtin_bit_cast(bf16x8,pw##k)
  #define VFR(i) (bf16x8){vlo[i][0],vlo[i][1],vlo[i][2],vlo[i][3],vhi[i][0],vhi[i][1],vhi[i][2],vhi[i][3]}
  #define PIN(x) asm volatile("":"+v"(x))
  #define MX3(a,b,c) __builtin_fmaxf(__builtin_fmaxf((a),(b)),(c))
  #define GAPA(MF,A0,A1,A2,A3,W0,W1,PW) do{ MF; sacc+=A0; sacc+=A1; sacc+=A2; sacc+=A3; PIN(sacc); W0; W1; PIN(PW); SBAR(); }while(0)
  #define EX(v) __builtin_amdgcn_exp2f(v)
  #define GAPB(MF,X,B) do{ MF; X[B]=EX(X[B]); X[B+1]=EX(X[B+1]); X[B+2]=EX(X[B+2]); X[B+3]=EX(X[B+3]); PIN(X); SBAR(); }while(0)
  #define VRD(i) do{ vlo[i]=vtr(vp_+(((i)>>2)*4096+((i)&3)*1024)); vhi[i]=vtr(vp_+(((i)>>2)*4096+((i)&3)*1024+512)); }while(0)
  #define KRD(G,j) do{ if(G){ kload2(kf,kp0+sl_next,j); SBAR(); } }while(0)
  #define STEP(C0,C1,P0,P1,t,GK,GV,GL) do{ SBAR(); BIASINIT(C0,C1,t); SBAR(); \
    const lds_cptr vp_=vp0+sl_prev; \
    VRD(0); SBAR(); float sacc=(P0[0]+P0[1]); \
    GAPA(C0=__builtin_amdgcn_mfma_f32_32x32x16_bf16(kf[0],qr[0],C0,0,0,0), P0[2],P0[3],P0[4],P0[5],     pw0[0]=PKW(P0,0), pw0[1]=PKW(P0,2), pw0); \
    VRD(4); SBAR(); GAPA(C1=__builtin_amdgcn_mfma_f32_32x32x16_bf16(kf[1],qr[0],C1,0,0,0), P0[6],P0[7],P0[8],P0[9],     pw0[2]=PKW(P0,4), pw0[3]=PKW(P0,6), pw0); \
    VRD(1); SBAR(); GAPA(C0=__builtin_amdgcn_mfma_f32_32x32x16_bf16(kf[2],qr[1],C0,0,0,0),   P0[10],P0[11],P0[12],P0[13], pw1[0]=PKW(P0,8), pw1[1]=PKW(P0,10), pw1); \
    VRD(5); SBAR(); GAPA(C1=__builtin_amdgcn_mfma_f32_32x32x16_bf16(kf[3],qr[1],C1,0,0,0),   P0[14],P0[15],P1[0],P1[1],   pw1[2]=PKW(P0,12),pw1[3]=PKW(P0,14), pw1); \
    VRD(2); SBAR(); GAPA(C0=__builtin_amdgcn_mfma_f32_32x32x16_bf16(kf[4],qr[2],C0,0,0,0),   P1[2],P1[3],P1[4],P1[5],     pw2[0]=PKW(P1,0), pw2[1]=PKW(P1,2), pw2); \
    VRD(6); SBAR(); GAPA(C1=__builtin_amdgcn_mfma_f32_32x32x16_bf16(kf[5],qr[2],C1,0,0,0),   P1[6],P1[7],P1[8],P1[9],     pw2[2]=PKW(P1,4), pw2[3]=PKW(P1,6), pw2); \
    VRD(3); SBAR(); GAPA(C0=__builtin_amdgcn_mfma_f32_32x32x16_bf16(kf[6],qr[3],C0,0,0,0),   P1[10],P1[11],P1[12],P1[13], pw3[0]=PKW(P1,8), pw3[1]=PKW(P1,10), pw3); \
    VRD(7); SBAR(); GAPA(C1=__builtin_amdgcn_mfma_f32_32x32x16_bf16(kf[7],qr[3],C1,0,0,0),   P1[14],P1[15],0.f,0.f,       pw3[2]=PKW(P1,12),pw3[3]=PKW(P1,14), pw3); \
    l_reg+=sacc; \
    if(GK){DMA_K((t)+3,sl_cur);} if(GV){DMA_V((t)+1,sl_next);} \
    CMASK(C0,C1,t); \
    { float a=MX3(C0[0],C0[1],C1[0]),b=MX3(C0[2],C0[3],C1[1]); a=MX3(a,C1[2],C1[3]); \
      _Pragma("unroll") for(int r=4;r<16;r+=4){a=MX3(a,C0[r],C0[r+1]);b=MX3(b,C0[r+2],C0[r+3]);a=MX3(a,C1[r],C1[r+1]);b=MX3(b,C1[r+2],C1[r+3]);} \
      float rm=__builtin_fmaxf(a,b); { auto rr=__builtin_amdgcn_permlane32_swap(__float_as_uint(rm),__float_as_uint(rm),false,false); rm=__builtin_fmaxf(__uint_as_float(rr[0]),__uint_as_float(rr[1])); } \
      resc=false; \
      if(__builtin_expect(__any(rm>(float)THRL),0)){ const float dl=__builtin_fmaxf(rm,0.f); mhat+=dl; \
        _Pragma("unroll") for(int r=0;r<16;++r){C0[r]-=dl;C1[r]-=dl;} \
        const float f=__builtin_amdgcn_exp2f(-dl); l_reg*=f; if(hi==0)wsf[r32]=f; resc=true; } } \
    SBAR(); \
    GAPB(o[0]=__builtin_amdgcn_mfma_f32_32x32x16_bf16(PAF(0),VFR(0),o[0],0,0,0), C0,0); \
    GAPB(o[1]=__builtin_amdgcn_mfma_f32_32x32x16_bf16(PAF(0),VFR(4),o[1],0,0,0), C0,4); \
    KRD(GL,0); GAPB(o[0]=__builtin_amdgcn_mfma_f32_32x32x16_bf16(PAF(1),VFR(1),o[0],0,0,0), C0,8); \
    KRD(GL,1); GAPB(o[1]=__builtin_amdgcn_mfma_f32_32x32x16_bf16(PAF(1),VFR(5),o[1],0,0,0), C0,12); \
    KRD(GL,2); GAPB(o[0]=__builtin_amdgcn_mfma_f32_32x32x16_bf16(PAF(2),VFR(2),o[0],0,0,0), C1,0); \
    KRD(GL,3); GAPB(o[1]=__builtin_amdgcn_mfma_f32_32x32x16_bf16(PAF(2),VFR(6),o[1],0,0,0), C1,4); \
    GAPB(o[0]=__builtin_amdgcn_mfma_f32_32x32x16_bf16(PAF(3),VFR(3),o[0],0,0,0), C1,8); \
    GAPB(o[1]=__builtin_amdgcn_mfma_f32_32x32x16_bf16(PAF(3),VFR(7),o[1],0,0,0), C1,12); \
    }while(0)
  int t=1;
  #undef CMASK
  #define CMASK(P0,P1,t) do{}while(0)
  for(;t+5<NT;t+=2){
    STEP(pB0,pB1,pA0,pA1,t,true,true,true);     WAIT_BAR(2); RESC(); ROT();
    STEP(pA0,pA1,pB0,pB1,t+1,true,true,true);   WAIT_BAR(2); RESC(); ROT();
  }
  #undef CMASK
  #define CMASK(P0,P1,t) do{int jb_=(t)-(NT-4); if(jb_>=0)cmask(P0,P1,jb_,qrel,hi);}while(0)
  #define ENDW(tt) do{ if((tt)+3<NT){WAIT_BAR(2);} else if((tt)+2<NT){WAIT_BAR(1);} else {WAIT_BAR(0);} }while(0)
  for(;t+1<NT;t+=2){
    STEP(pB0,pB1,pA0,pA1,t,(t+3<NT),(t+1<NT),(t+1<NT));       ENDW(t);   RESC(); ROT();
    STEP(pA0,pA1,pB0,pB1,t+1,(t+4<NT),(t+2<NT),(t+2<NT));     ENDW(t+1); RESC(); ROT();
  }
  STEP(pB0,pB1,pA0,pA1,NT-1,false,false,false); RESC();
  { float sacc=pB0[0]+pB0[1]; _Pragma("unroll") for(int r=2;r<16;++r)sacc+=pB0[r]; _Pragma("unroll") for(int r=0;r<16;++r)sacc+=pB1[r]; l_reg+=sacc;
    pw0=(u32x4){PKW(pB0,0),PKW(pB0,2),PKW(pB0,4),PKW(pB0,6)};pw1=(u32x4){PKW(pB0,8),PKW(pB0,10),PKW(pB0,12),PKW(pB0,14)};pw2=(u32x4){PKW(pB1,0),PKW(pB1,2),PKW(pB1,4),PKW(pB1,6)};pw3=(u32x4){PKW(pB1,8),PKW(pB1,10),PKW(pB1,12),PKW(pB1,14)};
    SBAR(); pv(o,vb0+sl_cur,PAF(0),PAF(1),PAF(2),PAF(3)); }
  #undef PKW
  #undef PAF
  #undef VFR
  #undef PIN
  #undef MX3
  #undef GAPA
  #undef GAPB
  #undef EX
  #undef VRD
  #undef KRD
  #undef STEP
  #undef ENDW
  {auto rr=__builtin_amdgcn_permlane32_swap(__float_as_uint(l_reg),__float_as_uint(l_reg),false,false);l_reg=__uint_as_float(rr[0])+__uint_as_float(rr[1]);}
  if(hi==0)wsf[32+r32]=l_reg;asm volatile("s_waitcnt lgkmcnt(0)":::"memory");
  float rli[16];
  #pragma unroll
  for(int r=0;r<16;++r)rli[r]=__builtin_amdgcn_rcpf(wsf[32+crow(r,hi)]);
  bf16*Ow=O+(rowbase+q0+wid*QBLK)*DM+h*D;
  { bf16*stg=(bf16*)(shm+LDS_OST)+wid*2048;
    #pragma unroll
    for(int r=0;r<16;++r){const int orow=crow(r,hi);
      #pragma unroll
      for(int d0=0;d0<2;++d0)stg[orow*64+d0*32+r32]=__float2bfloat16(o[d0][r]*rli[r]);}
    asm volatile("s_waitcnt lgkmcnt(0)":::"memory");
    #pragma unroll
    for(int i=0;i<4;++i){const int row=i*8+(lane>>3),ch=lane&7; const u32x4 v=*(const u32x4*)(stg+row*64+ch*8); ATTN_STORE16(Ow+(long)row*DM+ch*8,v);} }
  asm volatile("s_waitcnt lgkmcnt(0)\n\ts_barrier":::"memory");
  #undef DMA_K
  #undef DMA_V
  #undef CMASK
  #undef BIASINIT
  #undef START
  #undef RESC
  #undef ROT
}
constexpr int ATTN_LDS_BYTES=LDS_BYTES;
struct AttnTensors { const bf16* Q; const bf16* K; const bf16* V; bf16* O; const float* cl2; };
#undef SBAR
#undef WAIT_BAR
}
#define GEMM_PHASE(...) pg8::gemm_phase<__VA_ARGS__, pg8::StaticOrder, PGA, PGS>(ldsl, g, S, E, wave)
#define GEMM_PHASE_SPLIT() pg8::gemm_phase<pg8::EpiPartial, pg8::SplitOrder, PGA, PGS>(ldsl, g2, S2, E2, wave)
#define GEMM_PHASE_SPLIT_T(NN, NS, KSUB, KSH) pg8::gemm_phase<pg8::EpiPartialT<NN, KSH>, pg8::SplitOrderT<NN, NS, KSUB>, PGA, PGS>(ldsl, g2, S2, E2, wave)
#ifndef PGA
#define PGA true
#endif
#ifndef PGS
#define PGS true
#endif
namespace cg = cooperative_groups;
#define LAS __attribute__((address_space(3)))
typedef unsigned short bf16;
typedef unsigned v4u __attribute__((ext_vector_type(4)));
typedef float f32x4 __attribute__((ext_vector_type(4)));
typedef short bf16x8 __attribute__((ext_vector_type(8)));
typedef float f32x16 __attribute__((ext_vector_type(16)));
constexpr int NWAVES = 8, NTHR = 512, NMODC_ = 9216;
constexpr int MP = 32768, MS = 256, M = MP + MS, DM = 1024, FF = 2816, WA = 512, NIN = 4608, INCOLS = 4616, SEQ = 16384, PAST = 1024, DSEQ = 32, SKEYS = PAST + DSEQ;
constexpr float EPS = 1e-6f, LOG2E = 1.4426950408889634f;
constexpr size_t MiB = 1u << 20;
constexpr size_t WS_CTL = 0, CTL_ZERO_BYTES = 65536;
constexpr size_t WS_MOD = 1 * MiB, WS_CUMP = 2 * MiB, WS_CUMS = 3 * MiB, WS_G2SS = 4 * MiB, WS_QS = 6 * MiB, WS_WSP = 7 * MiB;
constexpr size_t WS_WGU1 = 8 * MiB, WS_WD1 = 19 * MiB, WS_WIN = 25 * MiB, WS_WPA = 34 * MiB, WS_WPB = 35 * MiB, WS_WOUT = 36 * MiB, WS_WGU2 = 38 * MiB, WS_WD2 = 49 * MiB;
constexpr size_t WS_XN = 56 * MiB;
constexpr size_t WS_ACT = 121 * MiB;
constexpr size_t QKV_B = (size_t)M * 512 * 2;
constexpr size_t WS_Q = 121 * MiB, WS_K = WS_Q + QKV_B, WS_V = WS_K + QKV_B, WS_U = WS_V + QKV_B, WS_G2 = WS_U + QKV_B;
constexpr size_t WS_AO = WS_Q;
constexpr size_t WS_T1 = WS_U;
constexpr size_t WS_T2 = WS_K;
constexpr size_t WS_BO = 283 * MiB, WS_PART = 300 * MiB, WS_END = 316 * MiB;
static_assert(WS_XN + (size_t)M * 2048 <= WS_ACT && WS_G2 + QKV_B <= WS_BO && WS_BO + QKV_B <= WS_END && WS_ACT + (size_t)M * FF * 2 <= WS_END, "ws map");
constexpr size_t O_Y = 0, O_KP = (size_t)M * 1024, O_VP = O_KP + (size_t)MP * 512, O_FP = O_VP + (size_t)MP * 512, O_KS = O_FP + (size_t)MP * 8, O_VS = O_KS + (size_t)MS * 512,
                 O_FS = O_VS + (size_t)MS * 512, O_GS = O_FS + (size_t)MS * 8, O_END = O_GS + (size_t)MS * 512;
constexpr int LDS_BYTES = 155648, MISC_OFF = LDS_BYTES - 256;
static_assert(attn_body::LDS_TOTAL <= MISC_OFF && pg8::STAGE_BYTES <= LDS_BYTES, "LDS map");

struct Args { const float* in[28]; float* out; unsigned char* ws; };

__device__ __forceinline__ float wave_sum(float v) {
#pragma unroll
    for (int o = 1; o < 64; o <<= 1) v += __shfl_xor(v, o);
    return v;
}
__device__ __forceinline__ unsigned f2bf(float f) { unsigned u = __builtin_bit_cast(unsigned, f); return (u + 0x7fffu + ((u >> 16) & 1u)) >> 16; }
__device__ __forceinline__ unsigned pk2(float lo, float hi) { return f2bf(lo) | (f2bf(hi) << 16); }
__device__ __forceinline__ float bf2f(unsigned short h) { return __uint_as_float((unsigned)h << 16); }

__device__ __forceinline__ void ada_unit(const Args& a, unsigned char* lds, int cb, int tid) {
    asm volatile("" : "+v"(tid));
    float* SC = (float*)lds; float* RED = (float*)(lds + 40960);
    const float* cp = a.in[2]; const float* cs = a.in[3]; const float* w_ada = a.in[7]; const float* b_ada = a.in[8];
    float* MOD = (float*)(a.ws + WS_MOD);
    for (int i = tid; i < 10240; i += NTHR) { const int r = i >> 10, k = i & 1023; const float c = r < 2 ? cp[r * 1024 + k] : cs[(r - 2) * 1024 + k]; SC[i] = c / (1.0f + expf(-c)); }
    __syncthreads();
    if (tid < 504) {
        const int cgp = tid % 9, ks = tid / 9; f32x4 acc[10];
#pragma unroll
        for (int r = 0; r < 10; ++r) acc[r] = (f32x4){0.f, 0.f, 0.f, 0.f};
        f32x4 wv[19];
#pragma unroll
        for (int i = 0; i < 19; ++i) { const int k = ks + 56 * i; wv[i] = (k < 1024) ? *(const f32x4*)(w_ada + (size_t)k * NMODC_ + 36 * cb + 4 * cgp) : (f32x4){0.f, 0.f, 0.f, 0.f}; }
#pragma unroll
        for (int i = 0; i < 19; ++i) { const int k = (ks + 56 * i) & 1023;
#pragma unroll
            for (int r = 0; r < 10; ++r) acc[r] += wv[i] * SC[r * 1024 + k]; }
#pragma unroll
        for (int r = 0; r < 10; ++r) *(f32x4*)(RED + (size_t)tid * 40 + r * 4) = acc[r];
    }
    __syncthreads();
    if (tid < 360) { const int r = tid / 36, c = tid % 36, cgp = c >> 2, i = c & 3; float s = 0.f;
        for (int ks = 0; ks < 56; ++ks) s += RED[(ks * 9 + cgp) * 40 + r * 4 + i];
        MOD[r * NMODC_ + 36 * cb + c] = s + b_ada[36 * cb + c]; }
    __syncthreads();
}
__device__ __forceinline__ void transpose_item(const float* W, int ld, int c0, int K, bf16* WT, int drow0, int k0, float* scr, int lane) {
    { const int r8 = lane >> 3, c4 = lane & 7; f32x4 v[8];
#pragma unroll
      for (int i = 0; i < 8; ++i) v[i] = *(const f32x4*)(W + (size_t)(k0 + 8 * i + r8) * ld + c0 + 4 * c4);
#pragma unroll
      for (int i = 0; i < 8; ++i) { float* d = scr + (8 * i + r8) * 33 + 4 * c4; d[0] = v[i].x; d[1] = v[i].y; d[2] = v[i].z; d[3] = v[i].w; } }
    asm volatile("s_waitcnt lgkmcnt(0)" ::: "memory");
    const int c = lane & 7;
#pragma unroll
    for (int j = 0; j < 4; ++j) { const int n = (lane >> 3) + 8 * j; const float* s = scr + (8 * c) * 33 + n;
        v4u o; o.x = pk2(s[0 * 33], s[1 * 33]); o.y = pk2(s[2 * 33], s[3 * 33]); o.z = pk2(s[4 * 33], s[5 * 33]); o.w = pk2(s[6 * 33], s[7 * 33]);
        *(v4u*)(WT + (size_t)(drow0 + n) * K + k0 + 8 * c) = o; }
    asm volatile("s_waitcnt lgkmcnt(0)" ::: "memory");
}
struct Seg { int in, ld, c0, ncols, K; size_t dst; int drow, mode; };
__device__ const Seg SEGS[13] = {
        {10, FF, 0, FF, 1024, WS_WGU1, 0, 1}, {11, FF, 0, FF, 1024, WS_WGU1, 0, 2}, {12, 1024, 0, 1024, FF, WS_WD1, 0, 0},
        {14, INCOLS, 0, 512, 1024, WS_WIN, 0, 3}, {14, INCOLS, 512, 512, 1024, WS_WIN, 512, 3}, {14, INCOLS, 1024, 512, 1024, WS_WIN, 1024, 0}, {14, INCOLS, 1544, 3072, 1024, WS_WIN, 1536, 0},
        {21, 1024, 0, 1024, 512, WS_WPA, 0, 0}, {22, 1024, 0, 1024, 512, WS_WPB, 0, 0}, {23, 1024, 0, 1024, 1024, WS_WOUT, 0, 0},
        {25, FF, 0, FF, 1024, WS_WGU2, 0, 1}, {26, FF, 0, FF, 1024, WS_WGU2, 0, 2}, {27, 1024, 0, 1024, FF, WS_WD2, 0, 0}};
__device__ __forceinline__ int seg_drow(const Seg& s, int n) {
    if (s.mode == 0) return s.drow + n;
    if (s.mode == 1) return s.drow + 256 * (n >> 7) + (n & 127);
    if (s.mode == 2) return s.drow + 256 * (n >> 7) + 128 + (n & 127);
    const int gs = (n & 255) >> 5; return s.drow + (n & ~255) + 32 * (4 * (gs & 1) + (gs >> 1));
}
__device__ __forceinline__ void p0_weights(const Args& a, unsigned char* lds, int gw, int NGW, int wave, int lane) {
    asm volatile("" : "+v"(lane));
    float* scr = (float*)(lds + wave * 8704);

    int base = 0;
#pragma unroll 1
    for (int si = 0; si < 13; ++si) {
        const Seg s = SEGS[si]; const int nblk = s.ncols / 32, nitems = (s.K / 64) * nblk;
        int first = (gw - base) % NGW; if (first < 0) first += NGW;
        for (int it = first; it < nitems; it += NGW) { const int kb = it / nblk, nb = it % nblk;
            transpose_item(a.in[s.in], s.ld, s.c0 + 32 * nb, s.K, (bf16*)(a.ws + s.dst), seg_drow(s, 32 * nb), 64 * kb, scr, lane); }
        base = (base + nitems) % NGW;
    }
    const float* wsp = a.in[19]; bf16* WSP = (bf16*)(a.ws + WS_WSP);
    for (int i = gw * 64 + lane; i < 4 * 128 * 128; i += NGW * 64) { const int t = (i >> 7) & 127, s2 = i & 127; WSP[i] = (bf16)f2bf(s2 <= t ? wsp[i] : 0.f); }
}
template <bool LOGF> __device__ __forceinline__ void norm_phase(const Args& a, unsigned char* lds, const float* srcp, const float* srcs, const float* g, int ishift, int iscale,
                                                                 int gw, int NGW, int tid, int lane) {
    asm volatile("" : "+v"(tid), "+v"(lane));
    const float* MOD = (const float*)(a.ws + WS_MOD); bf16* XN = (bf16*)(a.ws + WS_XN);
    float* WFt = (float*)lds;
    if (LOGF) { const float* w_in = a.in[14]; for (int i = tid; i < 8192; i += NTHR) { const int k = i >> 3, j = i & 7; WFt[j * 1024 + k] = w_in[(size_t)k * INCOLS + 1536 + j]; } __syncthreads(); }
    int cur = -1; f32x4 gs[4], shv[4], vn[4], vnn[4];
    if (gw < M) { const float* xrow0 = gw < MP ? srcp + (size_t)gw * 1024 : srcs + (size_t)(gw - MP) * 1024;
#pragma unroll
        for (int j = 0; j < 4; ++j) vn[j] = ((const f32x4*)xrow0 + lane)[64 * j]; }
    if (gw + NGW < M) { const int m1 = gw + NGW; const float* xrow1 = m1 < MP ? srcp + (size_t)m1 * 1024 : srcs + (size_t)(m1 - MP) * 1024;
#pragma unroll
        for (int j = 0; j < 4; ++j) vnn[j] = ((const f32x4*)xrow1 + lane)[64 * j]; }
    for (int m = gw; m < M; m += NGW) {
        const int mr = m < MP ? (m >> 14) : 2 + ((m - MP) >> 5);
        if (mr != cur) { cur = mr; const f32x4* g4 = (const f32x4*)g + lane;
            const f32x4* sh4 = (const f32x4*)(MOD + (size_t)mr * 9216 + ishift * 1024) + lane; const f32x4* sc4 = (const f32x4*)(MOD + (size_t)mr * 9216 + iscale * 1024) + lane;
#pragma unroll
            for (int j = 0; j < 4; ++j) { gs[j] = g4[64 * j] * (sc4[64 * j] + 1.0f); shv[j] = sh4[64 * j]; } }
        f32x4 v[4]; float ss = 0.f;
#pragma unroll
        for (int j = 0; j < 4; ++j) { v[j] = vn[j]; vn[j] = vnn[j]; ss += (v[j].x * v[j].x + v[j].y * v[j].y) + (v[j].z * v[j].z + v[j].w * v[j].w); }
        { const int m2 = m + 2 * NGW; if (m2 < M) { const float* xrow2 = m2 < MP ? srcp + (size_t)m2 * 1024 : srcs + (size_t)(m2 - MP) * 1024;
#pragma unroll
            for (int j = 0; j < 4; ++j) vnn[j] = ((const f32x4*)xrow2 + lane)[64 * j]; } }
        const float rstd = 1.0f / sqrtf(wave_sum(ss) * (1.0f / 1024.0f) + EPS);
        unsigned long long* o8 = (unsigned long long*)(XN + (size_t)m * 1024) + lane;
#pragma unroll
        for (int j = 0; j < 4; ++j) { v[j] = (v[j] * rstd) * gs[j] + shv[j];
            o8[64 * j] = (unsigned long long)pk2(v[j].x, v[j].y) | ((unsigned long long)pk2(v[j].z, v[j].w) << 32); }
        if (LOGF) {
            float f[8];
#pragma unroll
            for (int jj = 0; jj < 8; ++jj) { float s = 0.f;
#pragma unroll
                for (int j = 0; j < 4; ++j) { const f32x4 w = *((const f32x4*)(WFt + jj * 1024) + 64 * j + lane); s += (v[j].x * w.x + v[j].y * w.y) + (v[j].z * w.z + v[j].w * w.w); }
                f[jj] = wave_sum(s); }
            float fj = f[0];
#pragma unroll
            for (int jj = 1; jj < 8; ++jj) fj = (lane == jj) ? f[jj] : fj;
            if (lane < 8) { const float x = fj + a.in[15][lane]; const float lf = (x >= 0.f) ? -log1pf(expf(-x)) : x - log1pf(expf(x));
                float* dst = m < MP ? a.out + O_FP + (size_t)m * 8 : a.out + O_FS + (size_t)(m - MP) * 8; dst[lane] = lf; }
        }
    }
}
__device__ __forceinline__ void scan_unit(const Args& a, unsigned char* lds, int unit, int tid) {
    asm volatile("" : "+v"(tid));
    double* tot = (double*)lds;
    if (unit < 16) {
        const int b = unit >> 3, h = unit & 7; const float* lf = a.out + O_FP + ((size_t)b * SEQ) * 8 + h; float* dst = (float*)(a.ws + WS_CUMP) + (size_t)unit * SEQ;
        float x[32]; double s = 0.0;
#pragma unroll
        for (int i = 0; i < 32; ++i) { x[i] = lf[(size_t)(tid * 32 + i) * 8]; s += (double)x[i]; }
        tot[tid] = s; __syncthreads();
        double pre = 0.0; for (int j = 0; j < tid; ++j) pre += tot[j];
#pragma unroll
        for (int i = 0; i < 32; ++i) { pre += (double)x[i]; dst[tid * 32 + i] = (float)(pre * 1.4426950408889634); }
    } else {
        const int bh = unit - 16, b = bh >> 3, h = bh & 7; const float* lfc = a.in[6] + ((size_t)b * PAST) * 8 + h; const float* lfn = a.out + O_FS + ((size_t)b * DSEQ) * 8 + h;
        float* dst = (float*)(a.ws + WS_CUMS) + (size_t)bh * SKEYS;
        float x[3] = {0.f, 0.f, 0.f}; double s = 0.0;
        if (tid < 352) {
#pragma unroll
            for (int i = 0; i < 3; ++i) { const int p = tid * 3 + i; x[i] = p < PAST ? lfc[(size_t)p * 8] : lfn[(size_t)(p - PAST) * 8]; s += (double)x[i]; } }
        tot[tid] = s; __syncthreads();
        if (tid < 352) { double pre = 0.0; for (int j = 0; j < tid; ++j) pre += tot[j];
#pragma unroll
            for (int i = 0; i < 3; ++i) { pre += (double)x[i]; dst[tid * 3 + i] = (float)(pre * 1.4426950408889634); } }
    }
    __syncthreads();
}
__device__ __forceinline__ void gmlp_unit(const Args& a, unsigned char* lds, int ci, int tid, int wave, int lane) {
    asm volatile("" : "+v"(tid), "+v"(lane));
    constexpr int VP = 136;
    bf16* VT = (bf16*)lds; float* rst = (float*)(lds + 128 * VP * 2);
    const bf16* G2 = (const bf16*)(a.ws + WS_G2); const bf16* U = (const bf16*)(a.ws + WS_U); bf16* BO = (bf16*)(a.ws + WS_BO); const bf16* WSP = (const bf16*)(a.ws + WS_WSP);
    const float* G2SS = (const float*)(a.ws + WS_G2SS); const float* gv = a.in[18]; const float* bsp = a.in[20];
    const size_t R0 = (size_t)ci * 128;
    if (tid < 128) { const f32x4* p = (const f32x4*)(G2SS + (R0 + tid) * 8); const f32x4 s0 = p[0], s1 = p[1]; rst[tid] = 1.0f / sqrtf((((s0.x + s0.y) + (s0.z + s0.w)) + ((s1.x + s1.y) + (s1.z + s1.w))) * (1.0f / 512.0f) + EPS); }
    __syncthreads();
    const int r32 = lane & 31, hi = lane >> 5, tb = wave >> 1, dh = wave & 1;
#pragma unroll 1
    for (int g = 0; g < 4; ++g) {
#pragma unroll
        for (int it = 0; it < 4; ++it) { const int q = tid + NTHR * it, s = q & 127, cch = q >> 7;
            const v4u raw = *(const v4u*)(G2 + (R0 + s) * 512 + g * 128 + 8 * cch); const float rs = rst[s];
            const f32x4 g0 = *(const f32x4*)(gv + g * 128 + 8 * cch), g1 = *(const f32x4*)(gv + g * 128 + 8 * cch + 4);
            bf16* col = VT + (8 * cch) * VP + s;
            col[0 * VP] = (bf16)f2bf(pg8::bf_lo(raw.x) * rs * g0.x); col[1 * VP] = (bf16)f2bf(pg8::bf_hi(raw.x) * rs * g0.y); col[2 * VP] = (bf16)f2bf(pg8::bf_lo(raw.y) * rs * g0.z); col[3 * VP] = (bf16)f2bf(pg8::bf_hi(raw.y) * rs * g0.w);
            col[4 * VP] = (bf16)f2bf(pg8::bf_lo(raw.z) * rs * g1.x); col[5 * VP] = (bf16)f2bf(pg8::bf_hi(raw.z) * rs * g1.y); col[6 * VP] = (bf16)f2bf(pg8::bf_lo(raw.w) * rs * g1.z); col[7 * VP] = (bf16)f2bf(pg8::bf_hi(raw.w) * rs * g1.w); }
        __syncthreads();
        f32x16 acc[2]; acc[0] = f32x16{}; acc[1] = f32x16{};
        for (int ks = 0; ks <= 2 * tb + 1; ++ks) {
            const bf16x8 af = *(const bf16x8*)(WSP + ((size_t)(g * 128 + 32 * tb + r32)) * 128 + 16 * ks + 8 * hi);
#pragma unroll
            for (int db = 0; db < 2; ++db) { const bf16x8 bfv = *(const bf16x8*)(VT + (64 * dh + 32 * db + r32) * VP + 16 * ks + 8 * hi); acc[db] = __builtin_amdgcn_mfma_f32_32x32x16_bf16(af, bfv, acc[db], 0, 0, 0); }
        }
#pragma unroll
        for (int db = 0; db < 2; ++db)
#pragma unroll
            for (int r = 0; r < 16; ++r) { const int t = 32 * tb + (r & 3) + 8 * (r >> 2) + 4 * hi, ch = g * 128 + 64 * dh + 32 * db + r32; const size_t off = (R0 + t) * 512 + ch;
                const float mixed = acc[db][r] + bsp[g * 128 + t]; BO[off] = (bf16)f2bf(bf2f(U[off]) * mixed); }
        __syncthreads();
    }
}
__device__ __forceinline__ void gmlp_sample_unit(const Args& a, unsigned char* lds, int b, int tid) {
    asm volatile("" : "+v"(tid));
    float* rst = (float*)lds;
    const bf16* G2 = (const bf16*)(a.ws + WS_G2); const bf16* U = (const bf16*)(a.ws + WS_U); bf16* BO = (bf16*)(a.ws + WS_BO);
    const float* G2SS = (const float*)(a.ws + WS_G2SS); const float* wsp = a.in[19]; const float* bsp = a.in[20];
    const size_t R0 = (size_t)MP + b * 32;
    if (tid < 32) { const float* p = G2SS + (R0 + tid) * 8; float s = 0.f; for (int i = 0; i < 8; ++i) s += p[i]; rst[tid] = 1.0f / sqrtf(s * (1.0f / 512.0f) + EPS); }
    __syncthreads();
    const int ch = tid, g = ch >> 7; const float gvv = a.in[18][ch];
    float vb[32];
#pragma unroll
    for (int s = 0; s < 32; ++s) { vb[s] = bf2f(G2[(R0 + s) * 512 + ch]) * rst[s] * gvv; a.out[O_GS + ((size_t)b * 32 + s) * 512 + ch] = vb[s]; }
#pragma unroll
    for (int t = 0; t < 32; ++t) { float mixed = bsp[g * 128 + t]; const float* wrow = wsp + ((size_t)g * 128 + t) * 128;
#pragma unroll
        for (int s = 0; s < 32; ++s) if (s <= t) mixed += wrow[s] * vb[s];
        const size_t off = (R0 + t) * 512 + ch; BO[off] = (bf16)f2bf(bf2f(U[off]) * mixed); }
    __syncthreads();
}
__device__ __forceinline__ void sattn_unit(const Args& a, unsigned char* lds, int unit, int tid, int wave, int lane) {
    asm volatile("" : "+v"(tid), "+v"(lane));
    const int qg = unit & 3, h = (unit >> 2) & 7, b = unit >> 5;
    float* qs = (float*)lds;
    float* S = qs + 512;
    float* red = S + 8 * SKEYS;
    float* inv = red + 4096;
    const float* QS = (const float*)(a.ws + WS_QS); const float* cum = (const float*)(a.ws + WS_CUMS) + (size_t)(b * 8 + h) * SKEYS;
    const float* kc = a.in[4] + ((size_t)b * PAST) * 512 + h * 64; const float* vc = a.in[5] + ((size_t)b * PAST) * 512 + h * 64;
    const float* kn = a.out + O_KS + ((size_t)b * DSEQ) * 512 + h * 64; const float* vn = a.out + O_VS + ((size_t)b * DSEQ) * 512 + h * 64;
    { const int qi = tid >> 6, d = tid & 63; qs[tid] = QS[((size_t)b * 32 + 8 * qg + qi) * 512 + h * 64 + d]; }
    __syncthreads();
    for (int key = wave * 132 + lane; key < wave * 132 + 132; key += 64) {
        const f32x4* kr = (const f32x4*)(key < PAST ? kc + (size_t)key * 512 : kn + (size_t)(key - PAST) * 512);
        f32x4 kv[16];
#pragma unroll
        for (int i = 0; i < 16; ++i) kv[i] = kr[i];
        const float ck = cum[key];
#pragma unroll
        for (int qi = 0; qi < 8; ++qi) { float s = 0.f;
#pragma unroll
            for (int i = 0; i < 16; ++i) { const f32x4 q4 = *(const f32x4*)(qs + qi * 64 + 4 * i); s += (q4.x * kv[i].x + q4.y * kv[i].y) + (q4.z * kv[i].z + q4.w * kv[i].w); }
            const int qpos = PAST + 8 * qg + qi;
            S[qi * SKEYS + key] = (key <= qpos) ? s + (cum[qpos] - ck) : -INFINITY; }
    }
    __syncthreads();
    { float mx = -INFINITY; for (int k = lane; k < SKEYS; k += 64) mx = fmaxf(mx, S[wave * SKEYS + k]);
#pragma unroll
      for (int o = 1; o < 64; o <<= 1) mx = fmaxf(mx, __shfl_xor(mx, o));
      float sum = 0.f; for (int k = lane; k < SKEYS; k += 64) { const float p = exp2f(S[wave * SKEYS + k] - mx); S[wave * SKEYS + k] = p; sum += p; }
      sum = wave_sum(sum); if (lane == 0) inv[wave] = 1.0f / sum; }
    __syncthreads();
    { float acc[8];
#pragma unroll
      for (int qi = 0; qi < 8; ++qi) acc[qi] = 0.f;
      for (int key = wave * 132; key < wave * 132 + 132; ++key) { const float v = (key < PAST ? vc + (size_t)key * 512 : vn + (size_t)(key - PAST) * 512)[lane];
#pragma unroll
          for (int qi = 0; qi < 8; ++qi) acc[qi] += S[qi * SKEYS + key] * v; }
#pragma unroll
      for (int qi = 0; qi < 8; ++qi) red[(wave * 8 + qi) * 64 + lane] = acc[qi]; }
    __syncthreads();
    { const int qi = tid >> 6, d = tid & 63; float s = 0.f;
#pragma unroll
      for (int w = 0; w < 8; ++w) s += red[(w * 8 + qi) * 64 + d];
      bf16* AO = (bf16*)(a.ws + WS_AO); AO[((size_t)MP + b * 32 + 8 * qg + qi) * 512 + h * 64 + d] = (bf16)f2bf(s * inv[qi]); }
    __syncthreads();
}

#define XB_TMO      128
#define XB_XCNT(j)  (256  + 64 * (j))
#define XB_XSUB(j)  (1280 + 64 * (j))
#define XB_XGEN(j)  (2304 + 64 * (j))
#define XB_TOP      3328
#define XB_TOPGEN   3392
#define XCD_BAR_WORDS 3456
#define XB_SPIN_CAP (1u << 18)

__device__ __forceinline__ unsigned xb_ld(unsigned* p)              { return __hip_atomic_load(p, __ATOMIC_RELAXED, __HIP_MEMORY_SCOPE_AGENT); }
__device__ __forceinline__ unsigned xb_add(unsigned* p, unsigned v) { return __hip_atomic_fetch_add(p, v, __ATOMIC_RELAXED, __HIP_MEMORY_SCOPE_AGENT); }
__device__ __forceinline__ unsigned xb_xcc_id() { return (unsigned)__builtin_amdgcn_s_getreg((3 << 11) | 20) & 0xFu; }
#define XB_SPIN(cond, bar) do { unsigned _sp = 0; while (cond) { __builtin_amdgcn_s_sleep(1); \
    if ((++_sp & 255u) == 0u) { if (xb_ld(&(bar)[XB_TMO])) break; if (_sp > XB_SPIN_CAP) { atomicAdd(&(bar)[XB_TMO], 1u); break; } } } } while (0)

struct XcdBarrier {
    unsigned* bar; unsigned x;
    volatile LAS unsigned* st;
};

__device__ __forceinline__ XcdBarrier xcd_barrier_post(unsigned* bar, volatile LAS unsigned* st, int wv) {
    XcdBarrier b; b.bar = bar; b.x = xb_xcc_id(); b.st = st;
    if (wv == 0 && lane_id_() == 0) (void)xb_add(&bar[XB_XCNT(b.x)], 1u);
    return b;
}
__device__ __forceinline__ void xcd_barrier_complete(unsigned* bar, unsigned x, unsigned& nloc, unsigned& nx) {
    const unsigned G = gridDim.x * gridDim.y * gridDim.z;
    unsigned sum, cnt, mine, sp = 0u;
    for (;;) {
        sum = 0u; cnt = 0u; mine = 0u;
#pragma unroll
        for (unsigned j = 0; j < 16; ++j) { const unsigned c = xb_ld(&bar[XB_XCNT(j)]); sum += c; cnt += (c > 0u) ? 1u : 0u; mine = (j == x) ? c : mine; }
        if (sum == G) break;
        __builtin_amdgcn_s_sleep(1);
        if ((++sp & 255u) == 0u) { if (xb_ld(&bar[XB_TMO])) break; if (sp > XB_SPIN_CAP) { atomicAdd(&bar[XB_TMO], 1u); break; } }
    }
    nloc = mine > 0u ? mine : 1u; nx = cnt > 0u ? cnt : 1u;
}

__device__ __forceinline__ void xcd_barrier(const XcdBarrier& b, int wv) {
    asm volatile("s_waitcnt vmcnt(0)" ::: "memory");
    __syncthreads();
    if (wv == 0 && lane_id_() == 0) {
        unsigned* bar = b.bar;
        __builtin_amdgcn_s_waitcnt(0);
        unsigned nloc = b.st[0], nx = b.st[1];
        if (nloc == 0u) { xcd_barrier_complete(bar, b.x, nloc, nx); b.st[0] = nloc; b.st[1] = nx; }
        const unsigned old = xb_add(&bar[XB_XSUB(b.x)], 1u);
        const unsigned gen = old / nloc;
        if (old + 1u == (gen + 1u) * nloc) {
            __builtin_amdgcn_fence(__ATOMIC_RELEASE, "agent");
            asm volatile("s_waitcnt vmcnt(0)" ::: "memory");
            const unsigned og = xb_add(&bar[XB_TOP], 1u);
            const unsigned tg = og / nx;
            if (og + 1u == (tg + 1u) * nx) xb_add(&bar[XB_TOPGEN], 1u);
            else XB_SPIN(xb_ld(&bar[XB_TOPGEN]) == tg, bar);
            __builtin_amdgcn_fence(__ATOMIC_ACQUIRE, "agent");
            xb_add(&bar[XB_XGEN(b.x)], 1u);
            asm volatile("s_waitcnt vmcnt(0)" ::: "memory");
        } else {
            XB_SPIN(xb_ld(&bar[XB_XGEN(b.x)]) == gen, bar);
            __builtin_amdgcn_fence(__ATOMIC_ACQUIRE, "agent");
            asm volatile("s_waitcnt vmcnt(0)" ::: "memory");
        }
    }
    __syncthreads();
}

#ifndef SKIPMASK
#define SKIPMASK 0u
#endif
#define PH(n) (((SKIPMASK) >> (n) & 1u) == 0u)
#define GSYNC() do { XcdBarrier b_; b_.bar = (unsigned*)(a.ws + WS_CTL); b_.x = xbar_x; b_.st = MISC + 8; xcd_barrier(b_, wave); } while (0)
__global__ void __launch_bounds__(NTHR, 2) fox_fwd(Args a) {
    extern __shared__ __attribute__((aligned(16))) unsigned char lds[];
    cg::grid_group grid = cg::this_grid();
    const int wave = __builtin_amdgcn_readfirstlane((int)threadIdx.x >> 6);
#define tid ((wave << 6) | lane_id_())
#define lane (lane_id_())
    const int G = gridDim.x, bx = blockIdx.x; const int vcu = (G % 8 == 0) ? (bx % 8) * (G / 8) + bx / 8 : bx;
    const int gw = vcu * NWAVES + wave, NGW = G * NWAVES;
    LAS unsigned char* ldsl = (LAS unsigned char*)lds;
    float* MOD = (float*)(a.ws + WS_MOD); bf16* XN = (bf16*)(a.ws + WS_XN); bf16* ACT = (bf16*)(a.ws + WS_ACT);
    volatile LAS unsigned* MISC = (volatile LAS unsigned*)((LAS unsigned char*)lds + MISC_OFF);
    for (int i = tid; i < LDS_BYTES / 16; i += NTHR) ((v4u*)lds)[i] = (v4u){0u, 0u, 0u, 0u};
    __syncthreads();
    __builtin_amdgcn_fence(__ATOMIC_SEQ_CST, ""); asm volatile("s_waitcnt vmcnt(0) lgkmcnt(0)" ::: "memory");
    const unsigned xbar_x = xcd_barrier_post((unsigned*)(a.ws + WS_CTL), MISC + 8, wave).x;
    grid.sync();
    float* Y = a.out + O_Y;

#ifndef NPASS
#define NPASS 1
#endif
#pragma unroll 1
    for (int pass = 0; pass < NPASS; ++pass) {
    if (pass) GSYNC();
    if (PH(0)) { for (int cb = bx; cb < 256; cb += G) ada_unit(a, lds, cb, tid);
    p0_weights(a, lds, gw, NGW, wave, lane); }
    GSYNC();
    if (PH(1)) norm_phase<false>(a, lds, a.in[0], a.in[1], a.in[9], 0, 1, gw, NGW, tid, lane);
    GSYNC();
    if (PH(2)) { pg8::Gemm g{XN, (const bf16*)(a.ws + WS_WGU1), M, 2 * FF, 1024, 1024}; pg8::StaticOrder S; S.init(M, 2 * FF, G, bx); pg8::EpiUp E{ACT, FF};
      GEMM_PHASE(pg8::EpiUp); }
    GSYNC();
    if (PH(3)) { pg8::EpiRes E{a.in[0], a.in[1], Y, MOD + 2 * 1024, 0.5f};
      { int ksub_ = 256; asm volatile("" : "+s"(ksub_)); pg8::Gemm g2{ACT + (size_t)MP * FF, (const bf16*)(a.ws + WS_WD1), 256, 1024, ksub_, FF}; pg8::SplitOrder S2; S2.init(G, bx); pg8::EpiPartial E2{(float*)(a.ws + WS_PART), 4, 256}; GEMM_PHASE_SPLIT(); }
      { pg8::Gemm g{ACT, (const bf16*)(a.ws + WS_WD1), MP, 1024, FF, FF}; pg8::StaticOrder S; S.init(MP, 1024, G, bx); GEMM_PHASE(pg8::EpiRes); }
      GSYNC();
      if (bx < 32) pg8::reduce_rowgroup<11>((const float*)(a.ws + WS_PART), bx & 3, bx >> 2, E, wave); }
    GSYNC();
    if (PH(4)) norm_phase<true>(a, lds, Y, Y + (size_t)MP * 1024, a.in[13], 3, 4, gw, NGW, tid, lane);
    GSYNC();
    if (PH(5)) { if (G >= 160) { const int u = G - 1 - bx; if (u < 80) scan_unit(a, lds, u, tid); }
                 else for (int u = bx; u < 80; u += G) scan_unit(a, lds, u, tid); }
    if (PH(6)) { pg8::Gemm g{XN, (const bf16*)(a.ws + WS_WIN), M, 2560, 1024, 1024}; pg8::StaticOrder S; S.init(M, 2560, G, bx);
      pg8::EpiIn E{(bf16*)(a.ws + WS_Q), (bf16*)(a.ws + WS_K), (bf16*)(a.ws + WS_V), (bf16*)(a.ws + WS_U), (bf16*)(a.ws + WS_G2), nullptr, nullptr,
                   (float*)(a.ws + WS_G2SS), (float*)(a.ws + WS_QS), a.out + O_KP, a.out + O_KS, a.out + O_VP, a.out + O_VS, a.in[16], a.in[17], attn_body::C2, EPS};
      GEMM_PHASE(pg8::EpiIn); }
    GSYNC();
    if (PH(7)) { const attn_body::bf16* Qb = (const attn_body::bf16*)(a.ws + WS_Q); const attn_body::bf16* Kb = (const attn_body::bf16*)(a.ws + WS_K); const attn_body::bf16* Vb = (const attn_body::bf16*)(a.ws + WS_V);
      attn_body::bf16* Ob = (attn_body::bf16*)(a.ws + WS_AO); const float* CUMP = (const float*)(a.ws + WS_CUMP);
      const int nun = (G == 256) ? 4 : (1024 - bx + G - 1) / G;
      float B2;
      { float mq = fabsf(a.in[16][lane]), mk = fabsf(a.in[17][lane]);
#pragma unroll
        for (int o = 1; o < 64; o <<= 1) { mq = fmaxf(mq, __shfl_xor(mq, o)); mk = fmaxf(mk, __shfl_xor(mk, o)); }
        B2 = 64.0f * mq * mk * attn_body::C2 * 1.01f + 0.5f; }
#pragma unroll 1
      for (int i = 0; i < nun; ++i) { int bh, qb;
          if (G == 256) { const int s = vcu & 15; bh = vcu >> 4; qb = (i == 0) ? s : (i == 1) ? 31 - s : (i == 2) ? 32 + s : 63 - s; } else { const int idx = bx + i * G; bh = idx >> 6; qb = idx & 63; }
          int ts = 0;
          { const float* cl = CUMP + (size_t)bh * SEQ; const float cref = cl[qb * 256]; const int ncand = 4 * qb;
            for (int j0 = 0; j0 < ncand; j0 += 64) { const int j = j0 + lane; const bool sk = (j < ncand) && (cref - cl[64 * j + 63] + 2.0f * B2 < -152.0f); ts += (int)__popcll(__ballot(sk)); }
            ts = __builtin_amdgcn_readfirstlane(ts) & ~1; }
          attn_body::attn_unit<8>(bh >> 3, bh & 7, qb, ts, CUMP + (size_t)bh * SEQ, Qb, Kb, Vb, Ob, (char*)lds, wave);
          }
      __syncthreads(); }
    if (PH(8)) for (int ci = bx; ci < 256; ci += G) gmlp_unit(a, lds, ci, tid, wave, lane);
    if (PH(9)) for (int u = bx; u < 256; u += G) sattn_unit(a, lds, u, tid, wave, lane);
    if (PH(10)) { if (G == 256) { if ((vcu & 15) == 0 && (vcu >> 4) < 8) gmlp_sample_unit(a, lds, vcu >> 4, tid); } else for (int b = bx; b < 8; b += G) gmlp_sample_unit(a, lds, b, tid); }
    GSYNC();
    if (PH(11)) { bf16* T = (bf16*)(a.ws + WS_T1); bf16* T2 = (bf16*)(a.ws + WS_T2); const bf16* WIN = (const bf16*)(a.ws + WS_WIN);
      bf16* TS = T + (size_t)MP * 1024; bf16* T2S = T2 + (size_t)MP * 1024; const bf16* XS = XN + (size_t)MP * 1024;
      float* PARTA = (float*)(a.ws + 2 * MiB); float* PARTB = (float*)(a.ws + 4 * MiB);
      { pg8::Gemm g{(const bf16*)(a.ws + WS_AO) + (size_t)MP * 512, (const bf16*)(a.ws + WS_WPA), 256, 1024, 512, 512}; pg8::StaticOrder S; S.init(256, 1024, G, bx); pg8::EpiMix<0> E{TS, nullptr}; GEMM_PHASE(pg8::EpiMix<0>); }
      { pg8::Gemm g{(const bf16*)(a.ws + WS_AO), (const bf16*)(a.ws + WS_WPA), MP, 1024, 512, 512}; pg8::StaticOrder S; S.init(MP, 1024, G, bx); pg8::EpiMix<0> E{T, nullptr}; GEMM_PHASE(pg8::EpiMix<0>); }
      { int ksub_ = 512; asm volatile("" : "+s"(ksub_)); pg8::Gemm g2{XS, WIN + (size_t)2560 * 1024, 256, 1024, ksub_, 1024}; pg8::SplitOrderT<4, 2, 512> S2; S2.init(G, (bx + G - 8) % G); pg8::EpiPartialT<4, 9> E2{PARTA}; GEMM_PHASE_SPLIT_T(4, 2, 512, 9); }
      { pg8::Gemm g{XN, WIN + (size_t)2560 * 1024, MP, 1024, 1024, 1024}; pg8::StaticOrder S; S.init(MP, 1024, G, bx); pg8::EpiMix<1> E{T, nullptr}; GEMM_PHASE(pg8::EpiMix<1>); }
      { pg8::Gemm g{(const bf16*)(a.ws + WS_BO) + (size_t)MP * 512, (const bf16*)(a.ws + WS_WPB), 256, 1024, 512, 512}; pg8::StaticOrder S; S.init(256, 1024, G, (bx + G - 16) % G); pg8::EpiMix<0> E{T2S, nullptr}; GEMM_PHASE(pg8::EpiMix<0>); }
      { pg8::Gemm g{(const bf16*)(a.ws + WS_BO), (const bf16*)(a.ws + WS_WPB), MP, 1024, 512, 512}; pg8::StaticOrder S; S.init(MP, 1024, G, bx); pg8::EpiMix<0> E{T2, nullptr}; GEMM_PHASE(pg8::EpiMix<0>); }
      { int ksub_ = 512; asm volatile("" : "+s"(ksub_)); pg8::Gemm g2{XS, WIN + (size_t)3584 * 1024, 256, 1024, ksub_, 1024}; pg8::SplitOrderT<4, 2, 512> S2; S2.init(G, (bx + G - 24) % G); pg8::EpiPartialT<4, 9> E2{PARTB}; GEMM_PHASE_SPLIT_T(4, 2, 512, 9); }
      { pg8::Gemm g{XN, WIN + (size_t)3584 * 1024, MP, 1024, 1024, 1024}; pg8::StaticOrder S; S.init(MP, 1024, G, bx); pg8::EpiMix<2> E{T, T2}; GEMM_PHASE(pg8::EpiMix<2>); }
      GSYNC();
      if (bx < 32) { pg8::EpiMix<1> E1{TS, nullptr}; pg8::reduce_rowgroup<2>(PARTA, bx & 3, bx >> 2, E1, wave);
                     pg8::EpiMix<2> E2{TS, T2S}; pg8::reduce_rowgroup<2>(PARTB, bx & 3, bx >> 2, E2, wave); } }
    GSYNC();
    if (PH(13)) { pg8::EpiRes E{Y, Y + (size_t)MP * 1024, Y, MOD + 5 * 1024, 1.0f}; const bf16* M1 = (const bf16*)(a.ws + WS_T1);
      { int ksub_ = 256; asm volatile("" : "+s"(ksub_)); pg8::Gemm g2{M1 + (size_t)MP * 1024, (const bf16*)(a.ws + WS_WOUT), 256, 1024, ksub_, 1024}; pg8::SplitOrderT<4, 4, 256> S2; S2.init(G, bx); pg8::EpiPartialT<4, 8> E2{(float*)(a.ws + WS_PART)}; GEMM_PHASE_SPLIT_T(4, 4, 256, 8); }
      { pg8::Gemm g{M1, (const bf16*)(a.ws + WS_WOUT), MP, 1024, 1024, 1024}; pg8::StaticOrder S; S.init(MP, 1024, G, bx); GEMM_PHASE(pg8::EpiRes); }
      GSYNC();
      if (bx < 32) pg8::reduce_rowgroup<4>((const float*)(a.ws + WS_PART), bx & 3, bx >> 2, E, wave); }
    GSYNC();
    if (PH(14)) norm_phase<false>(a, lds, Y, Y + (size_t)MP * 1024, a.in[24], 6, 7, gw, NGW, tid, lane);
    GSYNC();
    if (PH(15)) { pg8::Gemm g{XN, (const bf16*)(a.ws + WS_WGU2), M, 2 * FF, 1024, 1024}; pg8::StaticOrder S; S.init(M, 2 * FF, G, bx); pg8::EpiUp E{ACT, FF};
      GEMM_PHASE(pg8::EpiUp); }
    GSYNC();
    if (PH(16)) { pg8::EpiRes E{Y, Y + (size_t)MP * 1024, Y, MOD + 8 * 1024, 0.5f};
      { int ksub_ = 256; asm volatile("" : "+s"(ksub_)); pg8::Gemm g2{ACT + (size_t)MP * FF, (const bf16*)(a.ws + WS_WD2), 256, 1024, ksub_, FF}; pg8::SplitOrder S2; S2.init(G, bx); pg8::EpiPartial E2{(float*)(a.ws + WS_PART), 4, 256}; GEMM_PHASE_SPLIT(); }
      { pg8::Gemm g{ACT, (const bf16*)(a.ws + WS_WD2), MP, 1024, FF, FF}; pg8::StaticOrder S; S.init(MP, 1024, G, bx); GEMM_PHASE(pg8::EpiRes); }
      GSYNC();
      if (bx < 32) pg8::reduce_rowgroup<11>((const float*)(a.ws + WS_PART), bx & 3, bx >> 2, E, wave); }
    }
}


#undef tid
#undef lane
extern "C" void kernel_launch(void* const* d_in, const int* in_sizes, int n_in, void* d_out, int out_size, void* d_ws, size_t ws_size, hipStream_t stream) {
    static int grid = 0;
    if (grid == 0) {
        if (n_in != 28 || (size_t)out_size != O_END || ws_size < WS_END || in_sizes[0] != MP * 1024) { fprintf(stderr, "kernel_launch: unexpected shapes (n_in %d out %d ws %zu)\n", n_in, out_size, ws_size); grid = -1; return; }
        int dev = 0, cus = 0, per_cu = 0;
        hipGetDevice(&dev); hipDeviceGetAttribute(&cus, hipDeviceAttributeMultiprocessorCount, dev);
        if (hipFuncSetAttribute((const void*)fox_fwd, hipFuncAttributeMaxDynamicSharedMemorySize, LDS_BYTES) != hipSuccess) { fprintf(stderr, "kernel_launch: hipFuncSetAttribute failed\n"); grid = -1; return; }
        if (hipOccupancyMaxActiveBlocksPerMultiprocessor(&per_cu, (const void*)fox_fwd, NTHR, LDS_BYTES) != hipSuccess || per_cu < 1) { fprintf(stderr, "kernel_launch: occupancy query says %d\n", per_cu); per_cu = 1; }
        (void)hipGetLastError();
        grid = cus * 1;
    }
    if (grid < 0) return;
    if (hipMemsetAsync((char*)d_ws + WS_CTL, 0, CTL_ZERO_BYTES, stream) != hipSuccess) { fprintf(stderr, "kernel_launch: hipMemsetAsync failed\n"); return; }
    Args a{};
    for (int i = 0; i < 28; ++i) a.in[i] = (const float*)d_in[i];
    a.out = (float*)d_out; a.ws = (unsigned char*)d_ws;
    void* args[] = {&a};
    hipError_t e = hipLaunchCooperativeKernel((const void*)fox_fwd, dim3(grid), dim3(NTHR), args, LDS_BYTES, stream);
    if (e != hipSuccess) fprintf(stderr, "cooperative launch failed: %s (grid %d)\n", hipGetErrorString(e), grid);
}
```

```cpp
#include <hip/hip_runtime.h>
#include <hip/hip_cooperative_groups.h>
#include <cstdio>
#include <cstdint>
__device__ __forceinline__ int lane_id_() { return (int)__builtin_amdgcn_mbcnt_hi(~0u, __builtin_amdgcn_mbcnt_lo(~0u, 0u)); }
namespace pg8 {
#define PG8_LAS __attribute__((address_space(3)))
typedef unsigned short bf16_t;
typedef short bf16x8 __attribute__((ext_vector_type(8)));
typedef float f32x4 __attribute__((ext_vector_type(4)));
typedef unsigned u32x4 __attribute__((ext_vector_type(4)));
constexpr int BM = 256, BK = 64, HALF = 128, HTB = HALF * BK * 2  , STAGE_BYTES = 8 * HTB, NXCD = 8, WGM = 8;

__host__ __device__ __forceinline__ int lds_byte(int r, int c) { const int st = (r >> 4) * 2 + (c >> 5), rr = r & 15, cc = c & 31, ob = rr * 64 + cc * 2; return st * 1024 + (ob ^ (((ob >> 9) & 1) << 5)); }
__host__ __device__ __forceinline__ void stage_rc(int b, int& R, int& C) { const int st = b / 1024, sb = b % 1024, swz = sb ^ (((sb >> 9) & 1) << 5); R = (st >> 1) * 16 + swz / 64; C = (st & 1) * 32 + (swz % 64) / 2; }
__host__ __device__ __forceinline__ int perm32(int rho) { const int n = rho >> 4, i = rho & 15; return 8 * (i >> 2) + 4 * n + (i & 3); }

struct Unit { int pm, pn, koff; };
struct Gemm { const bf16_t* A; const bf16_t* Bt; int M, N, K, Kp; };

struct StaticOrder {
    int nM, nN, nwg, G, c;
    __host__ __device__ void init(int M, int N, int G_, int c_) { nM = M / BM; nN = N / BM; nwg = nM * nN; G = G_; c = c_; }
    __host__ __device__ bool next(int i, Unit& u) const {
        const long L = (long)i * G + c; if (L >= nwg) return false;
        int wgid = (int)L; { const int q = nwg / NXCD, r = nwg % NXCD, xcd = wgid % NXCD, off = wgid / NXCD; wgid = (xcd < r ? xcd * (q + 1) : r * (q + 1) + (xcd - r) * q) + off; }
        const int nig = WGM * nN, gid = wgid / nig, fm = gid * WGM, gsz = (nM - fm) < WGM ? (nM - fm) : WGM;
        u.pm = fm + ((wgid % nig) % gsz); u.pn = (wgid % nig) / gsz; u.koff = 0; return true;
    }
    __device__ __forceinline__ void a_ready(const Unit&) const {}
    __device__ __forceinline__ void done(const Unit&) const {}
};

template <int NN, int NS, int KSUB> struct SplitOrderT {
    int G, c;
    __host__ __device__ void init(int G_, int c_) { G = G_; c = c_; }
    __host__ __device__ bool next(int i, Unit& u) const { const int L = i * G + c; if (L >= NN * NS) return false; u.pm = 0; u.pn = L % NN; u.koff = (L / NN) * KSUB; return true; }
    __device__ __forceinline__ void a_ready(const Unit&) const {}
    __device__ __forceinline__ void done(const Unit&) const {}
};
typedef SplitOrderT<4, 11, 256> SplitOrder;
__device__ __forceinline__ unsigned cvt_pk_bf16(float lo, float hi) { unsigned r; asm volatile("v_cvt_pk_bf16_f32 %0, %1, %2" : "=v"(r) : "v"(lo), "v"(hi)); return r; }
typedef float f32x2 __attribute__((ext_vector_type(2)));
__device__ __forceinline__ f32x2 gelu_pk(f32x2 v) {
    const f32x2 av = __builtin_elementwise_abs(v), d = av * 0.2316418882f + 1.0f;
    f32x2 t; t.x = __builtin_amdgcn_rcpf(d.x); t.y = __builtin_amdgcn_rcpf(d.y);
    f32x2 q = t * 0.5307027145f + (-0.7265760135f); q = q * t + 0.7107068705f; q = q * t + (-0.142248368f); q = q * t + 0.127414796f; q = q * t;
    const f32x2 s = (v * v) * (-0.72134752044f);
    f32x2 e; e.x = __builtin_amdgcn_exp2f(s.x); e.y = __builtin_amdgcn_exp2f(s.y);
    const f32x2 m = v * (q * e), r = v - m;
    f32x2 o; o.x = v.x < 0.f ? m.x : r.x; o.y = v.y < 0.f ? m.y : r.y; return o;
}

constexpr int MPROMPT = 32768;
constexpr int NMODC = 9216;
typedef unsigned u32x2v __attribute__((ext_vector_type(2)));
__device__ __forceinline__ float sigm(float x) { return __builtin_amdgcn_rcpf(1.0f + __builtin_amdgcn_exp2f(-1.4426950408889634f * x)); }
__device__ __forceinline__ float gelu_tanh(float x) { const float y = 1.5957691216057308f * (x + 0.044715f * x * x * x); return x * sigm(y); }
__device__ __forceinline__ float bf_lo(unsigned w) { return __uint_as_float(w << 16); }
__device__ __forceinline__ float bf_hi(unsigned w) { return __uint_as_float(w & 0xffff0000u); }
__device__ __forceinline__ int mod_row(int pm, int rloc) { return pm < 128 ? (pm >> 6) : 2 + (rloc >> 5); }

struct EpiUp {
    static constexpr bool PERM = true, AFTER_DRAIN = false;
    bf16_t* ACT; int ldc;
    __device__ __forceinline__ void operator()(const f32x4 (&acc)[2][2][4][2], const Unit& u, int wr, int wc, int fr, int fq) const {
        int fr_ = fr, fq_ = fq; asm volatile("" : "+v"(fr_), "+v"(fq_));
        const int row0 = u.pm * BM + wr * 64 + fr_, ch0 = u.pn * HALF + wc * 32 + 8 * fq_;
#pragma unroll
        for (int ai = 0; ai < 2; ++ai)
#pragma unroll
            for (int m = 0; m < 4; ++m) {
                float o[8];
#pragma unroll
                for (int n = 0; n < 2; ++n)
#pragma unroll
                    for (int i = 0; i < 4; ++i) { const float g = acc[ai][0][m][n][i], up = acc[ai][1][m][n][i]; o[4 * n + i] = g * sigm(g) * up; }
                u32x4 w; w.x = cvt_pk_bf16(o[0], o[1]); w.y = cvt_pk_bf16(o[2], o[3]); w.z = cvt_pk_bf16(o[4], o[5]); w.w = cvt_pk_bf16(o[6], o[7]);
                *(u32x4*)(ACT + (size_t)(row0 + ai * HALF + m * 16) * ldc + ch0) = w;
            }
    }
};
struct EpiRes {
    static constexpr bool PERM = true, AFTER_DRAIN = false;
    const float* resp; const float* ress; float* out; const float* gate; float fac;
    __device__ __forceinline__ void rowgroup(const f32x4 (&v)[2][2], int pn, int ai, int m, int wr, int wc, int fr, int fq) const {
        const int rl = wr * 64 + fr + ai * HALF + m * 16, col0 = pn * BM + wc * 32 + 8 * fq;
        const float* gp = gate + (size_t)(2 + (rl >> 5)) * NMODC + col0; float* obase = out + (size_t)128 * BM * 1024;
#pragma unroll
        for (int bj = 0; bj < 2; ++bj)
#pragma unroll
            for (int n = 0; n < 2; ++n) { const size_t off = (size_t)rl * 1024 + col0 + bj * HALF + 4 * n;
                const f32x4 gv = *(const f32x4*)(gp + bj * HALF + 4 * n), rv = *(const f32x4*)(ress + off);
                *(f32x4*)(obase + off) = rv + (gv * fac) * v[bj][n]; }
    }
    __device__ __forceinline__ void operator()(const f32x4 (&acc)[2][2][4][2], const Unit& u, int wr, int wc, int fr, int fq) const {
        int fr_ = fr, fq_ = fq; asm volatile("" : "+v"(fr_), "+v"(fq_));
        const int rl0 = wr * 64 + fr_, col0 = u.pn * BM + wc * 32 + 8 * fq_;
        const float* rbase = (u.pm < 128) ? resp + (size_t)u.pm * BM * 1024 : ress;
        float* obase = out + (size_t)u.pm * BM * 1024;
#pragma unroll
        for (int ai = 0; ai < 2; ++ai)
#pragma unroll
            for (int m = 0; m < 4; ++m) {
                const int rl = rl0 + ai * HALF + m * 16; const float* gp = gate + (size_t)mod_row(u.pm, rl) * NMODC + col0;
#pragma unroll
                for (int bj = 0; bj < 2; ++bj)
#pragma unroll
                    for (int n = 0; n < 2; ++n) {
                        const size_t off = (size_t)rl * 1024 + col0 + bj * HALF + 4 * n;
                        const f32x4 gv = *(const f32x4*)(gp + bj * HALF + 4 * n), rv = *(const f32x4*)(rbase + off);
                        *(f32x4*)(obase + off) = rv + (gv * fac) * acc[ai][bj][m][n];
                    }
            }
    }
};
struct EpiIn {
    static constexpr bool PERM = true, AFTER_DRAIN = false;
    bf16_t *Q, *K, *V, *U, *G2, *SGA, *SGB; float* G2SS; float* QS;
    float *kout_p, *kout_s, *vout_p, *vout_s;
    const float *gq, *gk; float qscale, eps;
    __device__ __forceinline__ void operator()(const f32x4 (&acc)[2][2][4][2], const Unit& u, int wr, int wc, int fr, int fq) const {
        int fr_ = fr, fq_ = fq; asm volatile("" : "+v"(fr_), "+v"(fq_));
        const int pn = u.pn, rl0 = wr * 64 + fr_; const size_t rg0 = (size_t)u.pm * BM;
        if (pn < 4) {
            const bool isq = pn < 2; const int head = 4 * (pn & 1) + wc; const float* gsrc = isq ? gq : gk;
            f32x4 gv[2][2];
#pragma unroll
            for (int bj = 0; bj < 2; ++bj)
#pragma unroll
                for (int n = 0; n < 2; ++n) { gv[bj][n] = *(const f32x4*)(gsrc + 32 * bj + 8 * fq_ + 4 * n); if (isq) gv[bj][n] = gv[bj][n] * qscale; }
            bf16_t* dst = isq ? Q : K;
#pragma unroll
            for (int ai = 0; ai < 2; ++ai)
#pragma unroll
                for (int m = 0; m < 4; ++m) {
                    float ss = 0.f;
#pragma unroll
                    for (int bj = 0; bj < 2; ++bj)
#pragma unroll
                        for (int n = 0; n < 2; ++n) { const f32x4 x = acc[ai][bj][m][n]; ss += (x[0] * x[0] + x[1] * x[1]) + (x[2] * x[2] + x[3] * x[3]); }
                    ss += __shfl_xor(ss, 16); ss += __shfl_xor(ss, 32);
                    const float rstd = 1.0f / sqrtf(ss * (1.0f / 64.0f) + eps);
                    const int rl = rl0 + ai * HALF + m * 16; const size_t r = rg0 + rl;
#pragma unroll
                    for (int bj = 0; bj < 2; ++bj) {
                        const f32x4 o0 = acc[ai][bj][m][0] * rstd * gv[bj][0], o1 = acc[ai][bj][m][1] * rstd * gv[bj][1];
                        const int c = head * 64 + 32 * bj + 8 * fq_;
                        u32x4 w; w.x = cvt_pk_bf16(o0[0], o0[1]); w.y = cvt_pk_bf16(o0[2], o0[3]); w.z = cvt_pk_bf16(o1[0], o1[1]); w.w = cvt_pk_bf16(o1[2], o1[3]);
                        *(u32x4*)(dst + r * 512 + c) = w;
                        if (isq) { if (u.pm == 128) { float* qp = QS + (size_t)rl * 512 + c; *(f32x4*)qp = o0; *(f32x4*)(qp + 4) = o1; } }
                        else { float* kp = (u.pm < 128) ? kout_p + r * 512 + c : kout_s + (size_t)rl * 512 + c; *(f32x4*)kp = o0; *(f32x4*)(kp + 4) = o1; }
                    }
                    asm volatile("" ::: "memory");
                }
        } else if (pn < 6) {
            const int c0 = (pn - 4) * BM + wc * 32 + 8 * fq_;
#pragma unroll
            for (int ai = 0; ai < 2; ++ai)
#pragma unroll
                for (int m = 0; m < 4; ++m) { const int rl = rl0 + ai * HALF + m * 16; const size_t r = rg0 + rl;
#pragma unroll
                    for (int bj = 0; bj < 2; ++bj) { const f32x4 o0 = acc[ai][bj][m][0], o1 = acc[ai][bj][m][1]; const int c = c0 + bj * HALF;
                        u32x4 w; w.x = cvt_pk_bf16(o0[0], o0[1]); w.y = cvt_pk_bf16(o0[2], o0[3]); w.z = cvt_pk_bf16(o1[0], o1[1]); w.w = cvt_pk_bf16(o1[2], o1[3]);
                        *(u32x4*)(V + r * 512 + c) = w;
                        float* vp = (u.pm < 128) ? vout_p + r * 512 + c : vout_s + (size_t)rl * 512 + c;
                        { *(f32x4*)vp = o0; *(f32x4*)(vp + 4) = o1; } } asm volatile("" ::: "memory"); }
        } else if (pn < 10) {
            const bool isv = pn >= 8; const int t2 = (pn - 6) & 1; const int c0 = t2 * BM + wc * 32 + 8 * fq_; bf16_t* dst = isv ? G2 : U;
#pragma unroll
            for (int ai = 0; ai < 2; ++ai)
#pragma unroll
                for (int m = 0; m < 4; ++m) { const int rl = rl0 + ai * HALF + m * 16; const size_t r = rg0 + rl; float ss = 0.f;
#pragma unroll
                    for (int bj = 0; bj < 2; ++bj) { float o[8];
#pragma unroll
                        for (int n = 0; n < 2; ++n)
#pragma unroll
                            for (int i = 0; i < 4; ++i) { const float g = gelu_tanh(acc[ai][bj][m][n][i]); o[4 * n + i] = g; ss += g * g; }
                        u32x4 w; w.x = cvt_pk_bf16(o[0], o[1]); w.y = cvt_pk_bf16(o[2], o[3]); w.z = cvt_pk_bf16(o[4], o[5]); w.w = cvt_pk_bf16(o[6], o[7]);
                        *(u32x4*)(dst + r * 512 + c0 + bj * HALF) = w; }
                    if (isv) { ss += __shfl_xor(ss, 16); ss += __shfl_xor(ss, 32); if (fq_ == 0) G2SS[r * 8 + t2 * 4 + wc] = ss; } asm volatile("" ::: "memory"); }
        } else {
            const bool isa = pn < 14; const int c0 = ((pn - 10) & 3) * BM + wc * 32 + 8 * fq_; bf16_t* dst = isa ? SGA : SGB;
#pragma unroll
            for (int ai = 0; ai < 2; ++ai)
#pragma unroll
                for (int m = 0; m < 4; ++m) { const size_t r = rg0 + rl0 + ai * HALF + m * 16;
#pragma unroll
                    for (int bj = 0; bj < 2; ++bj) { float o[8];
#pragma unroll
                        for (int n = 0; n < 2; ++n)
#pragma unroll
                            for (int i = 0; i < 4; ++i) o[4 * n + i] = sigm(acc[ai][bj][m][n][i]);
                        u32x4 w; w.x = cvt_pk_bf16(o[0], o[1]); w.y = cvt_pk_bf16(o[2], o[3]); w.z = cvt_pk_bf16(o[4], o[5]); w.w = cvt_pk_bf16(o[6], o[7]);
                        *(u32x4*)(dst + r * 1024 + c0 + bj * HALF) = w;
                        } asm volatile("" ::: "memory"); }
        }
    }
};
struct EpiPartial {
    static constexpr bool PERM = true, AFTER_DRAIN = false;
    float* PART; int nN, Ksub;
    __device__ __forceinline__ void operator()(const f32x4 (&acc)[2][2][4][2], const Unit& u, int wr, int wc, int fr, int fq) const {
        int tid_ = (wr * 4 + wc) * 64 + fq * 16 + fr; asm volatile("" : "+v"(tid_));
        f32x4* dst = (f32x4*)PART + (size_t)((u.koff >> 8) * 4 + u.pn) * 32 * 512 + tid_;
#pragma unroll
        for (int ai = 0; ai < 2; ++ai)
#pragma unroll
            for (int bj = 0; bj < 2; ++bj)
#pragma unroll
                for (int m = 0; m < 4; ++m)
#pragma unroll
                    for (int n = 0; n < 2; ++n) { *dst = acc[ai][bj][m][n]; dst += 512; asm volatile("" : "+v"(dst) :: "memory"); }
        asm volatile("" ::: "memory");
    }
};
template <int NN, int KSHIFT> struct EpiPartialT {
    static constexpr bool PERM = true, AFTER_DRAIN = false;
    float* PART;
    __device__ __forceinline__ void operator()(const f32x4 (&acc)[2][2][4][2], const Unit& u, int wr, int wc, int fr, int fq) const {
        int tid_ = (wr * 4 + wc) * 64 + fq * 16 + fr; asm volatile("" : "+v"(tid_));
        f32x4* dst = (f32x4*)PART + (size_t)((u.koff >> KSHIFT) * NN + u.pn) * 32 * 512 + tid_;
#pragma unroll
        for (int ai = 0; ai < 2; ++ai)
#pragma unroll
            for (int bj = 0; bj < 2; ++bj)
#pragma unroll
                for (int m = 0; m < 4; ++m)
#pragma unroll
                    for (int n = 0; n < 2; ++n) { *dst = acc[ai][bj][m][n]; dst += 512; asm volatile("" : "+v"(dst) :: "memory"); }
    }
};
template <class Epi> __device__ __forceinline__ void reduce_partials(const float* PART, int nN, int nS, int pn, int pm_out, const Epi& E, int wv) {
    int tid = (wv << 6) | lane_id_(); asm volatile("" : "+v"(tid));
    const int wid = __builtin_amdgcn_readfirstlane(tid >> 6), lane = tid & 63, wr = wid >> 2, wc = wid & 3, fr = lane & 15, fq = lane >> 4;
    f32x4 acc[2][2][4][2];
#pragma unroll
    for (int ai = 0; ai < 2; ++ai)
#pragma unroll
        for (int bj = 0; bj < 2; ++bj)
#pragma unroll
            for (int m = 0; m < 4; ++m)
#pragma unroll
                for (int n = 0; n < 2; ++n) acc[ai][bj][m][n] = (f32x4){0.f, 0.f, 0.f, 0.f};
#pragma unroll 1
    for (int s = 0; s < nS; ++s) { const f32x4* src = (const f32x4*)PART + (size_t)(s * nN + pn) * 32 * 512 + tid;
#pragma unroll
        for (int ai = 0; ai < 2; ++ai) {
            f32x4 t[2][4][2];
#pragma unroll
            for (int bj = 0; bj < 2; ++bj)
#pragma unroll
                for (int m = 0; m < 4; ++m)
#pragma unroll
                    for (int n = 0; n < 2; ++n) { t[bj][m][n] = *src; src += 512; asm volatile("" : "+v"(src)); }
#pragma unroll
            for (int bj = 0; bj < 2; ++bj)
#pragma unroll
                for (int m = 0; m < 4; ++m)
#pragma unroll
                    for (int n = 0; n < 2; ++n) acc[ai][bj][m][n] += t[bj][m][n];
            asm volatile("" ::: "memory"); } }
    Unit u; u.pm = pm_out; u.pn = pn; u.koff = 0;
    E(acc, u, wr, wc, fr, fq);
}
template <int NS, class Epi> __device__ __forceinline__ void reduce_rowgroup(const float* PART, int pn, int rg, const Epi& E, int wv) {
    int tid = (wv << 6) | lane_id_(); asm volatile("" : "+v"(tid));
    const int wid = __builtin_amdgcn_readfirstlane(tid >> 6), lane = tid & 63, wr = wid >> 2, wc = wid & 3, fr = lane & 15, fq = lane >> 4;
    const int ai = rg >> 2, m = rg & 3;
    f32x4 t[NS][2][2];
#pragma unroll
    for (int s = 0; s < NS; ++s)
#pragma unroll
        for (int bj = 0; bj < 2; ++bj)
#pragma unroll
            for (int n = 0; n < 2; ++n) t[s][bj][n] = *((const f32x4*)PART + ((size_t)(s * 4 + pn) * 32 + (((ai * 2 + bj) * 4 + m) * 2 + n)) * 512 + tid);
    f32x4 v[2][2];
#pragma unroll
    for (int bj = 0; bj < 2; ++bj)
#pragma unroll
        for (int n = 0; n < 2; ++n) { v[bj][n] = t[0][bj][n];
#pragma unroll
            for (int s = 1; s < NS; ++s) v[bj][n] += t[s][bj][n]; }
    E.rowgroup(v, pn, ai, m, wr, wc, fr, fq);
}
template <int MODE> struct EpiMix {
    static constexpr bool PERM = true, AFTER_DRAIN = false;
    bf16_t* T; const bf16_t* T2;
    __device__ __forceinline__ void one(size_t off, const f32x4 a0, const f32x4 a1) const {
        float o[8] = {a0[0], a0[1], a0[2], a0[3], a1[0], a1[1], a1[2], a1[3]};
        if (MODE >= 1) {
            const u32x4 t = *(const u32x4*)(T + off);
            const float tv[8] = {bf_lo(t.x), bf_hi(t.x), bf_lo(t.y), bf_hi(t.y), bf_lo(t.z), bf_hi(t.z), bf_lo(t.w), bf_hi(t.w)};
            if (MODE == 1) {
#pragma unroll
                for (int i = 0; i < 8; ++i) o[i] = sigm(o[i]) * tv[i];
            } else {
                const u32x4 s2 = *(const u32x4*)(T2 + off);
                const float sv[8] = {bf_lo(s2.x), bf_hi(s2.x), bf_lo(s2.y), bf_hi(s2.y), bf_lo(s2.z), bf_hi(s2.z), bf_lo(s2.w), bf_hi(s2.w)};
#pragma unroll
                for (int i = 0; i < 8; ++i) o[i] = tv[i] + sigm(o[i]) * sv[i];
            }
        }
        u32x4 w; w.x = cvt_pk_bf16(o[0], o[1]); w.y = cvt_pk_bf16(o[2], o[3]); w.z = cvt_pk_bf16(o[4], o[5]); w.w = cvt_pk_bf16(o[6], o[7]);
        *(u32x4*)(T + off) = w;
    }
    __device__ __forceinline__ void operator()(const f32x4 (&acc)[2][2][4][2], const Unit& u, int wr, int wc, int fr, int fq) const {
        int fr_ = fr, fq_ = fq; asm volatile("" : "+v"(fr_), "+v"(fq_));
        const size_t row0 = (size_t)u.pm * BM + wr * 64 + fr_; const int col0 = u.pn * BM + wc * 32 + 8 * fq_;
#pragma unroll
        for (int ai = 0; ai < 2; ++ai)
#pragma unroll
            for (int m = 0; m < 4; ++m) {
#pragma unroll
                for (int bj = 0; bj < 2; ++bj) one((row0 + ai * HALF + m * 16) * 1024 + col0 + bj * HALF, acc[ai][bj][m][0], acc[ai][bj][m][1]);
                asm volatile("" ::: "memory");
            }
    }
    __device__ __forceinline__ void rowgroup(const f32x4 (&v)[2][2], int pn, int ai, int m, int wr, int wc, int fr, int fq) const {
        const size_t row = (size_t)(wr * 64 + fr + ai * HALF + m * 16); const int col0 = pn * BM + wc * 32 + 8 * fq;
#pragma unroll
        for (int bj = 0; bj < 2; ++bj) one(row * 1024 + col0 + bj * HALF, v[bj][0], v[bj][1]);
    }
};
template <class Epi, class Sched, bool ALIGN_EPI = false, bool SP2 = false>
__device__ __forceinline__ void gemm_phase(PG8_LAS unsigned char* lds, const Gemm g, const Sched& S, const Epi& E, int wv) {
    int tid = (wv << 6) | lane_id_(); asm volatile("" : "+v"(tid));
    const int wid = __builtin_amdgcn_readfirstlane(tid >> 6), lane = tid & 63, wr = wid >> 2, wc = wid & 3, fr = lane & 15, fq = lane >> 4;
    const int K = g.Kp, nt = g.K / BK;
    unsigned voffA[2], voffB[2];
#pragma unroll
    for (int i = 0; i < 2; ++i) { int R, C; stage_rc(tid * 16 + i * 8192, R, C); const int Rb = Epi::PERM ? ((R & ~31) + perm32(R & 31)) : R;
        voffA[i] = (unsigned)(R * K + C) * 2u; voffB[i] = (unsigned)(Rb * K + C) * 2u; }
    const size_t kstep = (size_t)(BK * 2);
    const size_t hstep = (size_t)HALF * K * 2;
    const size_t tstep = 2 * hstep;
    const unsigned ldsw = (unsigned)wid * 1024u;
    const int aoff = lds_byte(wr * 64 + fr, fq * 8), boff = lds_byte(wc * 32 + fr, fq * 8);
#define PG8_SA(b, h) (((b) * 2 + (h)) * HTB)
#define PG8_SB(b, h) ((4 + (b) * 2 + (h)) * HTB)
#define PG8_STAGE(bufoff, gbase, voff) do { _Pragma("unroll") for (int _i = 0; _i < 2; ++_i) \
        __builtin_amdgcn_global_load_lds((const unsigned*)((const char*)(gbase) + (voff)[_i]), (PG8_LAS unsigned*)(lds + (bufoff) + ldsw + _i * 8192), 16, 0, 0); } while (0)
#define PG8_LDA(dst, b, h) do { _Pragma("unroll") for (int m = 0; m < 4; ++m) _Pragma("unroll") for (int k = 0; k < 2; ++k) dst[m][k] = *(const PG8_LAS bf16x8*)(lds + PG8_SA(b, h) + aoff + m * 2048 + k * 1024); } while (0)
#define PG8_LDB(dst, b, h) do { _Pragma("unroll") for (int n = 0; n < 2; ++n) _Pragma("unroll") for (int k = 0; k < 2; ++k) dst[n][k] = *(const PG8_LAS bf16x8*)(lds + PG8_SB(b, h) + boff + n * 2048 + k * 1024); } while (0)
#define PG8_MMA(ai, bj, At, Bt) do { __builtin_amdgcn_s_setprio(1); _Pragma("unroll") for (int m = 0; m < 4; ++m) _Pragma("unroll") for (int n = 0; n < 2; ++n) _Pragma("unroll") for (int k = 0; k < 2; ++k) \
        acc[ai][bj][m][n] = __builtin_amdgcn_mfma_f32_16x16x32_bf16(Bt[n][k], At[m][k], acc[ai][bj][m][n], 0, 0, 0); __builtin_amdgcn_s_setprio(0); } while (0)
#define PG8_WAIT_V(n) asm volatile("s_waitcnt vmcnt(" #n ")" ::: "memory")
#define PG8_WAIT_L(n) asm volatile("s_waitcnt lgkmcnt(" #n ")" ::: "memory")
#define PG8_BAR __builtin_amdgcn_s_barrier()
#define PG8_SCHED __builtin_amdgcn_sched_barrier(0)
    Unit cur, nxt; int ui = 0;
    if (!S.next(0, cur)) return;
    f32x4 acc[2][2][4][2];
#pragma unroll
    for (int a = 0; a < 2; ++a)
#pragma unroll
        for (int b = 0; b < 2; ++b)
#pragma unroll
            for (int m = 0; m < 4; ++m)
#pragma unroll
                for (int n = 0; n < 2; ++n) acc[a][b][m][n] = (f32x4){0.f, 0.f, 0.f, 0.f};
    bf16x8 At[4][2], B0[2][2], B1[2][2];
    const char* cA = (const char*)g.A + (size_t)cur.pm * tstep + (size_t)cur.koff * 2; const char* cB = (const char*)g.Bt + (size_t)cur.pn * tstep + (size_t)cur.koff * 2;
    S.a_ready(cur);
    if constexpr (SP2) {
        PG8_STAGE(PG8_SB(0, 0), cB, voffB); PG8_STAGE(PG8_SB(0, 1), cB + hstep, voffB); PG8_STAGE(PG8_SA(0, 0), cA, voffA); PG8_STAGE(PG8_SA(0, 1), cA + hstep, voffA);
        if (wr == 1) PG8_BAR;
        PG8_WAIT_V(2); PG8_BAR;
        PG8_STAGE(PG8_SB(1, 0), cB + kstep, voffB); PG8_STAGE(PG8_SA(1, 0), cA + kstep, voffA); PG8_STAGE(PG8_SB(1, 1), cB + hstep + kstep, voffB);
        PG8_WAIT_V(6); PG8_BAR;
    } else {
        PG8_STAGE(PG8_SB(0, 0), cB, voffB); PG8_STAGE(PG8_SA(0, 0), cA, voffA); PG8_STAGE(PG8_SB(0, 1), cB + hstep, voffB); PG8_STAGE(PG8_SA(0, 1), cA + hstep, voffA);
        if (wr == 1) PG8_BAR;
        PG8_WAIT_V(4); PG8_BAR;
        PG8_STAGE(PG8_SB(1, 0), cB + kstep, voffB); PG8_STAGE(PG8_SA(1, 0), cA + kstep, voffA); PG8_STAGE(PG8_SB(1, 1), cB + hstep + kstep, voffB);
        PG8_WAIT_V(6); PG8_BAR;
    }
    for (;;) {
        const bool has_next = S.next(ui + 1, nxt);
        const char* nA = has_next ? (const char*)g.A + (size_t)nxt.pm * tstep + (size_t)nxt.koff * 2 : cA; const char* nB = has_next ? (const char*)g.Bt + (size_t)nxt.pn * tstep + (size_t)nxt.koff * 2 : cB;
        for (int t = 0; t < nt; t += 2) {
            const bool last = (t == nt - 2);
            const char* a1 = cA + (size_t)(t + 1) * kstep;
            const char* a2 = last ? nA : cA + (size_t)(t + 2) * kstep; const char* b2 = last ? nB : cB + (size_t)(t + 2) * kstep;
            const char* a3 = a2 + kstep; const char* b3 = b2 + kstep;
            if (last && has_next) S.a_ready(nxt);
            if constexpr (SP2) {
            PG8_LDB(B0, 0, 0); PG8_LDB(B1, 0, 1); PG8_SCHED; PG8_LDA(At, 0, 0); PG8_STAGE(PG8_SA(1, 1), a1 + hstep, voffA);
            PG8_WAIT_V(8); PG8_WAIT_L(0); PG8_BAR; PG8_MMA(0, 0, At, B0); PG8_MMA(0, 1, At, B1); PG8_BAR; PG8_SCHED;
            PG8_LDA(At, 0, 1); PG8_STAGE(PG8_SB(0, 0), b2, voffB); PG8_STAGE(PG8_SB(0, 1), b2 + hstep, voffB); PG8_STAGE(PG8_SA(0, 0), a2, voffA);
            PG8_WAIT_V(8); PG8_WAIT_L(0); PG8_BAR; PG8_MMA(1, 0, At, B0); PG8_MMA(1, 1, At, B1); PG8_BAR; PG8_SCHED;
            PG8_LDB(B0, 1, 0); PG8_LDB(B1, 1, 1); PG8_SCHED; PG8_LDA(At, 1, 0); PG8_STAGE(PG8_SA(0, 1), a2 + hstep, voffA);
            PG8_WAIT_V(8); PG8_WAIT_L(0); PG8_BAR; PG8_MMA(0, 0, At, B0); PG8_MMA(0, 1, At, B1); PG8_BAR; PG8_SCHED;
            PG8_LDA(At, 1, 1); PG8_STAGE(PG8_SB(1, 0), b3, voffB); PG8_STAGE(PG8_SB(1, 1), b3 + hstep, voffB); PG8_STAGE(PG8_SA(1, 0), a3, voffA);
            PG8_WAIT_V(8); PG8_WAIT_L(0); PG8_BAR; PG8_MMA(1, 0, At, B0); PG8_MMA(1, 1, At, B1); PG8_BAR; PG8_SCHED;
            } else {
            PG8_LDB(B0, 0, 0); PG8_SCHED; PG8_LDA(At, 0, 0); PG8_STAGE(PG8_SA(1, 1), a1 + hstep, voffA);
            PG8_WAIT_L(8); PG8_BAR; PG8_WAIT_L(0); PG8_MMA(0, 0, At, B0); PG8_BAR; PG8_SCHED;
            PG8_LDB(B1, 0, 1); PG8_STAGE(PG8_SB(0, 0), b2, voffB);
            PG8_BAR; PG8_WAIT_L(0); PG8_MMA(0, 1, At, B1); PG8_BAR;
            PG8_LDA(At, 0, 1); PG8_STAGE(PG8_SA(0, 0), a2, voffA);
            PG8_BAR; PG8_WAIT_L(0); PG8_MMA(1, 0, At, B0); PG8_BAR; PG8_SCHED;
            PG8_STAGE(PG8_SB(0, 1), b2 + hstep, voffB);
            PG8_WAIT_V(6); PG8_BAR; PG8_MMA(1, 1, At, B1); PG8_BAR;
            PG8_LDB(B0, 1, 0); PG8_SCHED; PG8_LDA(At, 1, 0); PG8_STAGE(PG8_SA(0, 1), a2 + hstep, voffA);
            PG8_WAIT_L(8); PG8_BAR; PG8_WAIT_L(0); PG8_MMA(0, 0, At, B0); PG8_BAR; PG8_SCHED;
            PG8_LDB(B1, 1, 1); PG8_STAGE(PG8_SB(1, 0), b3, voffB);
            PG8_BAR; PG8_WAIT_L(0); PG8_MMA(0, 1, At, B1); PG8_BAR;
            PG8_LDA(At, 1, 1); PG8_STAGE(PG8_SA(1, 0), a3, voffA);
            PG8_BAR; PG8_WAIT_L(0); PG8_MMA(1, 0, At, B0); PG8_BAR; PG8_SCHED;
            PG8_STAGE(PG8_SB(1, 1), b3 + hstep, voffB);
            PG8_WAIT_V(6); PG8_BAR; PG8_MMA(1, 1, At, B1); PG8_BAR;
            }
        }
        if constexpr (ALIGN_EPI) { if (wr == 0) PG8_BAR; }
        if constexpr (!Epi::AFTER_DRAIN) { E(acc, cur, wr, wc, fr, fq); S.done(cur); }
        if (!has_next) break;
#pragma unroll
        for (int a = 0; a < 2; ++a)
#pragma unroll
            for (int b = 0; b < 2; ++b)
#pragma unroll
                for (int m = 0; m < 4; ++m)
#pragma unroll
                    for (int n = 0; n < 2; ++n) acc[a][b][m][n] = (f32x4){0.f, 0.f, 0.f, 0.f};
        cur = nxt; cA = nA; cB = nB; ++ui;
        if constexpr (ALIGN_EPI) { if (wr == 1) PG8_BAR; }
    }
    PG8_WAIT_V(0);
    if constexpr (!ALIGN_EPI) { if (wr == 0) PG8_BAR; }
    PG8_BAR;
    if constexpr (Epi::AFTER_DRAIN) { E.fused(acc, cur, wr, wc, fr, fq, lds, wid, lane); S.done(cur); }
#undef PG8_SA
#undef PG8_SB
#undef PG8_STAGE
#undef PG8_LDA
#undef PG8_LDB
#undef PG8_MMA
#undef PG8_WAIT_V
#undef PG8_WAIT_L
#undef PG8_BAR
#undef PG8_SCHED
}

template <class Epi, class Sched>
__device__ __forceinline__ void naive_phase(const Gemm g, const Sched& S, const Epi& E) {
    int tid = threadIdx.x; asm volatile("" : "+v"(tid));
    const int wid = __builtin_amdgcn_readfirstlane(tid >> 6), lane = tid & 63, wr = wid >> 2, wc = wid & 3, fr = lane & 15, fq = lane >> 4;
    Unit u;
#pragma unroll 1
    for (int ui = 0; S.next(ui, u); ++ui) {
        f32x4 acc[2][2][4][2];
#pragma unroll
        for (int ai = 0; ai < 2; ++ai)
#pragma unroll
            for (int m = 0; m < 4; ++m) {
                const bf16_t* arow = g.A + (size_t)(u.pm * BM + ai * HALF + wr * 64 + m * 16 + fr) * g.Kp;
#pragma unroll
                for (int bj = 0; bj < 2; ++bj)
#pragma unroll
                    for (int n = 0; n < 2; ++n)
#pragma unroll
                        for (int i = 0; i < 4; ++i) {
                            const bf16_t* brow = g.Bt + (size_t)(u.pn * BM + bj * HALF + wc * 32 + 8 * fq + 4 * n + i) * g.Kp;
                            float s = 0.f;
#pragma unroll 1
                            for (int k = 0; k < g.K; k += 8) { const u32x4 a = *(const u32x4*)(arow + k), b = *(const u32x4*)(brow + k);
                                s += bf_lo(a.x) * bf_lo(b.x) + bf_hi(a.x) * bf_hi(b.x) + bf_lo(a.y) * bf_lo(b.y) + bf_hi(a.y) * bf_hi(b.y)
                                   + bf_lo(a.z) * bf_lo(b.z) + bf_hi(a.z) * bf_hi(b.z) + bf_lo(a.w) * bf_lo(b.w) + bf_hi(a.w) * bf_hi(b.w); }
                            acc[ai][bj][m][n][i] = s;
                        }
            }
        E(acc, u, wr, wc, fr, fq);
    }
    __syncthreads();
}
}
#include <hip/hip_bf16.h>
#include <cmath>
namespace attn_body {
using bf16=__hip_bfloat16;
using bf16x8=__attribute__((ext_vector_type(8)))short;
using s16x4=__attribute__((ext_vector_type(4)))short;
using f32x16=__attribute__((ext_vector_type(16)))float;
using u32x4=__attribute__((ext_vector_type(4)))unsigned;
using f32x4_t=__attribute__((ext_vector_type(4)))float;
constexpr int BATCH=2,NHEAD=8,SEQ=16384,D=64,DM=NHEAD*D;
constexpr int NW=8,QBLK=32,QB=QBLK*NW,KVBLK=64,NQB=SEQ/QB;
constexpr int ATTN_PITCH=DM, ATTN_UNIT_ROWS=QB;
__device__ __forceinline__ int crow(int r,int hi){return (r&3)+8*(r>>2)+4*hi;}
#define SBAR() __builtin_amdgcn_sched_barrier(0)
__device__ __forceinline__ void cmask(f32x16&p0,f32x16&p1,int jb,int qrel,int hi){
  const float NEG=-INFINITY; int kb=64*jb+4*hi;
  #pragma unroll
  for(int r=0;r<16;++r){int kv=kb+(r&3)+8*(r>>2); if(kv>qrel)p0[r]=NEG; if(kv+32>qrel)p1[r]=NEG;}
}

constexpr int NSLOT=3, SLOTB=8192;
constexpr int LDS_K=0, LDS_V=NSLOT*SLOTB, LDS_WS=2*NSLOT*SLOTB, LDS_OST=LDS_WS+NW*64*4, LDS_BYTES=LDS_OST+NW*4096, LDS_BIAS=LDS_BYTES, LDS_TOTAL=LDS_BIAS+SEQ*4;
constexpr float C2=0.125f*1.4426950408889634f;
__device__ __forceinline__ void glds16(const void*gsrc,unsigned lds_dst){unsigned keep;
  asm volatile("s_mov_b32 %0, m0\n\ts_mov_b32 m0, %2\n\ts_nop 0\n\tglobal_load_lds_dwordx4 %1, off\n\ts_mov_b32 m0, %0":"=&s"(keep):"v"(gsrc),"s"(lds_dst):"memory");}
__device__ __forceinline__ float max3f(float a,float b,float c){float r;asm("v_max3_f32 %0, %1, %2, %3":"=v"(r):"v"(a),"v"(b),"v"(c));return r;}
__device__ __forceinline__ float max2f(float a,float b){float r;asm("v_max_f32_e32 %0, %1, %2":"=v"(r):"v"(a),"v"(b));return r;}
__device__ __forceinline__ float fadd_s(float a,float b){float r;asm("v_add_f32_e32 %0, %1, %2":"=v"(r):"v"(a),"v"(b));return r;}
__device__ __forceinline__ float fsub_s(float a,float b){float r;asm("v_sub_f32_e32 %0, %1, %2":"=v"(r):"v"(a),"v"(b));return r;}
typedef float f32x2_t __attribute__((ext_vector_type(2))); typedef __bf16 bf16x2_t __attribute__((ext_vector_type(2)));
__device__ __forceinline__ unsigned cvtpk_s(float lo,float hi){f32x2_t v={lo,hi};bf16x2_t b=__builtin_convertvector(v,bf16x2_t);return __builtin_bit_cast(unsigned,b);}
#define WAIT_BAR(N) asm volatile("s_waitcnt vmcnt(" #N ") lgkmcnt(0)\n\ts_barrier":::"memory")

__device__ __forceinline__ void qkt(f32x16&p0,f32x16&p1,const char*Kslot,const bf16x8*qr,int r32,int hi){
  const char*kb=Kslot+hi*1024+r32*16;
  #pragma unroll
  for(int d0=0;d0<4;++d0){
    const bf16x8 b0=*reinterpret_cast<const bf16x8*>(kb+d0*2048);
    const bf16x8 b1=*reinterpret_cast<const bf16x8*>(kb+d0*2048+512);
    p0=__builtin_amdgcn_mfma_f32_32x32x16_bf16(b0,qr[d0],p0,0,0,0);p1=__builtin_amdgcn_mfma_f32_32x32x16_bf16(b1,qr[d0],p1,0,0,0);}
}
typedef __attribute__((address_space(3))) const char* lds_cptr;
typedef short v4i16_t __attribute__((ext_vector_type(4)));
__device__ __forceinline__ void kload8(bf16x8*kf,lds_cptr kp){
  kf[0]=*(const __attribute__((address_space(3))) bf16x8*)(kp);      kf[1]=*(const __attribute__((address_space(3))) bf16x8*)(kp+512);
  kf[2]=*(const __attribute__((address_space(3))) bf16x8*)(kp+2048); kf[3]=*(const __attribute__((address_space(3))) bf16x8*)(kp+2560);
  kf[4]=*(const __attribute__((address_space(3))) bf16x8*)(kp+4096); kf[5]=*(const __attribute__((address_space(3))) bf16x8*)(kp+4608);
  kf[6]=*(const __attribute__((address_space(3))) bf16x8*)(kp+6144); kf[7]=*(const __attribute__((address_space(3))) bf16x8*)(kp+6656);
}
__device__ __forceinline__ void kload2(bf16x8*kf,lds_cptr kp,int j){ kf[2*j]=*(const __attribute__((address_space(3))) bf16x8*)(kp+j*2048); kf[2*j+1]=*(const __attribute__((address_space(3))) bf16x8*)(kp+j*2048+512); }
__device__ __forceinline__ s16x4 vtr(lds_cptr p){ return __builtin_bit_cast(s16x4,__builtin_amdgcn_ds_read_tr16_b64_v4i16((__attribute__((address_space(3))) v4i16_t*)p)); }
__device__ __forceinline__ float rowmax(const f32x16&p0,const f32x16&p1){
  float a=max3f(p0[0],p0[1],p1[0]),b=max3f(p0[2],p0[3],p1[1]);a=max3f(a,p1[2],p1[3]);
  #pragma unroll
  for(int r=4;r<16;r+=4){a=max3f(a,p0[r],p0[r+1]);b=max3f(b,p0[r+2],p0[r+3]);a=max3f(a,p1[r],p1[r+1]);b=max3f(b,p1[r+2],p1[r+3]);}
  const float m=max2f(a,b);
  auto rr=__builtin_amdgcn_permlane32_swap(__float_as_uint(m),__float_as_uint(m),false,false);
  return max2f(__uint_as_float(rr[0]),__uint_as_float(rr[1]));
}
__device__ __forceinline__ void pv(f32x16*o,int vb,bf16x8 pa0,bf16x8 pa1,bf16x8 pa2,bf16x8 pa3){
  #pragma unroll
  for(int d0=0;d0<2;++d0){s16x4 lo[4],hi[4];
    #pragma unroll
    for(int ks=0;ks<4;++ks){
      asm volatile("ds_read_b64_tr_b16 %0,%1 offset:%c2":"=&v"(lo[ks]):"v"(vb),"i"(d0*4096+ks*1024):"memory");
      asm volatile("ds_read_b64_tr_b16 %0,%1 offset:%c2":"=&v"(hi[ks]):"v"(vb),"i"(d0*4096+ks*1024+512):"memory");}
    asm volatile("s_waitcnt lgkmcnt(0)":::"memory");SBAR();
    #define PK(k) (bf16x8){lo[k][0],lo[k][1],lo[k][2],lo[k][3],hi[k][0],hi[k][1],hi[k][2],hi[k][3]}
    o[d0]=__builtin_amdgcn_mfma_f32_32x32x16_bf16(pa0,PK(0),o[d0],0,0,0);
    o[d0]=__builtin_amdgcn_mfma_f32_32x32x16_bf16(pa1,PK(1),o[d0],0,0,0);
    o[d0]=__builtin_amdgcn_mfma_f32_32x32x16_bf16(pa2,PK(2),o[d0],0,0,0);
    o[d0]=__builtin_amdgcn_mfma_f32_32x32x16_bf16(pa3,PK(3),o[d0],0,0,0);
    #undef PK
  }
}

#ifndef ATTN_STORE16
#define ATTN_STORE16(p,v) (*(u32x4*)(p)=(v))
#endif
template<int THRL> __device__ __forceinline__ void attn_unit(int b,int h,int qb,int ts,const float*__restrict__ cl2,const bf16*Q,const bf16*__restrict__ K,const bf16*__restrict__ V,bf16*O,char*shm,int wv){
  int tid=(wv<<6)|lane_id_(); asm volatile("":"+v"(tid)); const int lane=tid&63,r32=lane&31,hi=lane>>5; const int wid=__builtin_amdgcn_readfirstlane(tid>>6);
  const long rowbase=(long)b*SEQ; const int q0=qb*QB;
  const bf16*Qw=Q+(rowbase+q0+wid*QBLK)*DM+h*D;
  const bf16*Kh=K+(rowbase+(long)ts*KVBLK)*DM+h*D,*Vh=V+(rowbase+(long)ts*KVBLK)*DM+h*D;
  const unsigned lds0=(unsigned)(uintptr_t)shm;
  float*wsf=(float*)(shm+LDS_WS)+wid*64;
  const bf16*ksrc=Kh+(long)lane*DM+wid*8;
  const bf16*vsrc=Vh+(long)(16*(wid&3)+(lane>>2))*DM+(wid>>2)*32+(lane&3)*8;
  const unsigned kdst=lds0+LDS_K+wid*1024, vdst=lds0+LDS_V+wid*1024;
  #define DMA_K(t,slot) glds16(ksrc+(long)(t)*KVBLK*DM,(unsigned)__builtin_amdgcn_readfirstlane(kdst+(slot)))
  #define DMA_V(t,slot) glds16(vsrc+(long)(t)*KVBLK*DM,(unsigned)__builtin_amdgcn_readfirstlane(vdst+(slot)))
  const int vb0=(int)(lds0+LDS_V)+((lane>>4)&1)*32+(lane&3)*8+(4*hi+((lane&15)>>2))*64;
  const char*Kbase=shm+LDS_K; bf16x8 kf[8];
  const lds_cptr shm3=(lds_cptr)shm; const lds_cptr kp0=shm3+LDS_K+hi*1024+r32*16; const lds_cptr vp0=shm3+LDS_V+((lane>>4)&1)*32+(lane&3)*8+(4*hi+((lane&15)>>2))*64;
  const int NT=(q0+QB)/KVBLK-ts;
  DMA_K(0,0);DMA_V(0,0);DMA_K(1,SLOTB);
  bf16x8 qr[4];
  #pragma unroll
  for(int d0=0;d0<4;++d0)qr[d0]=*reinterpret_cast<const bf16x8*>(&Qw[(long)r32*DM+d0*16+hi*8]);
  float mhat=0.f,l_reg=0.f;f32x16 o[2];o[0]=f32x16{};o[1]=f32x16{};
  typedef __attribute__((address_space(3))) const f32x4_t* lds_f4p; const lds_f4p biasp=(lds_f4p)((lds_cptr)shm+LDS_BIAS)+hi;
  #define BIASINIT(C0,C1,t) do{ _Pragma("unroll") for(int g_=0;g_<4;++g_){ const f32x4_t b0_=biasp[(t)*16+2*g_], b1_=biasp[(t)*16+8+2*g_]; \
      _Pragma("unroll") for(int i_=0;i_<4;++i_){ C0[4*g_+i_]=b0_[i_]-mhat; C1[4*g_+i_]=b1_[i_]-mhat; } } }while(0)
  const int qrel=wid*QBLK+r32;
  #define CMASK(P0,P1,t) do{int jb_=(t)-(NT-4); if(jb_>=0)cmask(P0,P1,jb_,qrel,hi);}while(0)
  bool resc=false;
  #define START(P0,P1) do{ const float rm=rowmax(P0,P1); resc=false; \
    { const float dl=rm; mhat=fadd_s(mhat,dl); \
      _Pragma("unroll") for(int r=0;r<16;++r){P0[r]=fsub_s(P0[r],dl);P1[r]=fsub_s(P1[r],dl);} } \
    _Pragma("unroll") for(int r=0;r<16;++r)P0[r]=__builtin_amdgcn_exp2f(P0[r]); }while(0)
  #define RESC() do{ if(resc){ asm volatile("s_waitcnt lgkmcnt(0)":::"memory"); \
      _Pragma("unroll") for(int d_=0;d_<2;++d_) _Pragma("unroll") for(int r=0;r<16;++r)o[d_][r]*=wsf[crow(r,hi)]; } }while(0)
  f32x16 pA0,pA1,pB0,pB1;
  int sl_prev=0,sl_cur=0,sl_next=SLOTB;
  #define ROT() do{sl_prev=sl_cur;sl_cur=sl_next;sl_next=(sl_next==(NSLOT-1)*SLOTB)?0:sl_next+SLOTB;}while(0)
  {
    const float cref=cl2[q0]; const f32x4_t*src=(const f32x4_t*)(cl2+ts*KVBLK); __attribute__((address_space(3))) f32x4_t*dst=(__attribute__((address_space(3))) f32x4_t*)((__attribute__((address_space(3))) char*)shm+LDS_BIAS);
    for(int i=tid;i<NT*16;i+=NW*64){ const f32x4_t c4=src[i]; dst[i]=(f32x4_t){cref-c4[0],cref-c4[1],cref-c4[2],cref-c4[3]}; } }
  DMA_K(2,2*SLOTB);
  WAIT_BAR(3);
  BIASINIT(pA0,pA1,0); qkt(pA0,pA1,Kbase,qr,r32,hi);asm volatile("s_nop 15\n\ts_nop 7":"+v"(pA0),"+v"(pA1));CMASK(pA0,pA1,0);
  START(pA0,pA1);
  _Pragma("unroll") for(int r=0;r<16;++r)pA1[r]=__builtin_amdgcn_exp2f(pA1[r]);
  WAIT_BAR(0);
  DMA_K(3,0);DMA_V(1,SLOTB);
  ROT();
  kload8(kf,kp0+sl_cur);
  WAIT_BAR(2);
  s16x4 vlo[8],vhi[8]; u32x4 pw0,pw1,pw2,pw3;
  #define PKW(P,B) cvtpk_s(P[B],P[B+1])
  #define PAF(k) __builtin_bit_cast(bf16x8,pw##k)
  #define VFR(i) (bf16x8){vlo[i][0],vlo[i][1],vlo[i][2],vlo[i][3],vhi[i][0],vhi[i][1],vhi[i][2],vhi[i][3]}
  #define PIN(x) asm volatile("":"+v"(x))
  #define MX3(a,b,c) __builtin_fmaxf(__builtin_fmaxf((a),(b)),(c))
  #define GAPA(MF,A0,A1,A2,A3,W0,W1,PW) do{ MF; sacc+=A0; sacc+=A1; sacc+=A2; sacc+=A3; PIN(sacc); W0; W1; PIN(PW); SBAR(); }while(0)
  #define EX(v) __builtin_amdgcn_exp2f(v)
  #define GAPB(MF,X,B) do{ MF; X[B]=EX(X[B]); X[B+1]=EX(X[B+1]); X[B+2]=EX(X[B+2]); X[B+3]=EX(X[B+3]); PIN(X); SBAR(); }while(0)
  #define VRD(i) do{ vlo[i]=vtr(vp_+(((i)>>2)*4096+((i)&3)*1024)); vhi[i]=vtr(vp_+(((i)>>2)*4096+((i)&3)*1024+512)); }while(0)
  #define KRD(G,j) do{ if(G){ kload2(kf,kp0+sl_next,j); SBAR(); } }while(0)
  #define STEP(C0,C1,P0,P1,t,GK,GV,GL) do{ SBAR(); BIASINIT(C0,C1,t); SBAR(); \
    const lds_cptr vp_=vp0+sl_prev; \
    VRD(0); SBAR(); float sacc=(P0[0]+P0[1]); \
    GAPA(C0=__builtin_amdgcn_mfma_f32_32x32x16_bf16(kf[0],qr[0],C0,0,0,0), P0[2],P0[3],P0[4],P0[5],     pw0[0]=PKW(P0,0), pw0[1]=PKW(P0,2), pw0); \
    VRD(4); SBAR(); GAPA(C1=__builtin_amdgcn_mfma_f32_32x32x16_bf16(kf[1],qr[0],C1,0,0,0), P0[6],P0[7],P0[8],P0[9],     pw0[2]=PKW(P0,4), pw0[3]=PKW(P0,6), pw0); \
    VRD(1); SBAR(); GAPA(C0=__builtin_amdgcn_mfma_f32_32x32x16_bf16(kf[2],qr[1],C0,0,0,0),   P0[10],P0[11],P0[12],P0[13], pw1[0]=PKW(P0,8), pw1[1]=PKW(P0,10), pw1); \
    VRD(5); SBAR(); GAPA(C1=__builtin_amdgcn_mfma_f32_32x32x16_bf16(kf[3],qr[1],C1,0,0,0),   P0[14],P0[15],P1[0],P1[1],   pw1[2]=PKW(P0,12),pw1[3]=PKW(P0,14), pw1); \
    VRD(2); SBAR(); GAPA(C0=__builtin_amdgcn_mfma_f32_32x32x16_bf16(kf[4],qr[2],C0,0,0,0),   P1[2],P1[3],P1[4],P1[5],     pw2[0]=PKW(P1,0), pw2[1]=PKW(P1,2), pw2); \
    VRD(6); SBAR(); GAPA(C1=__builtin_amdgcn_mfma_f32_32x32x16_bf16(kf[5],qr[2],C1,0,0,0),   P1[6],P1[7],P1[8],P1[9],     pw2[2]=PKW(P1,4), pw2[3]=PKW(P1,6), pw2); \
    VRD(3); SBAR(); GAPA(C0=__builtin_amdgcn_mfma_f32_32x32x16_bf16(kf[6],qr[3],C0,0,0,0),   P1[10],P1[11],P1[12],P1[13], pw3[0]=PKW(P1,8), pw3[1]=PKW(P1,10), pw3); \
    VRD(7); SBAR(); GAPA(C1=__builtin_amdgcn_mfma_f32_32x32x16_bf16(kf[7],qr[3],C1,0,0,0),   P1[14],P1[15],0.f,0.f,       pw3[2]=PKW(P1,12),pw3[3]=PKW(P1,14), pw3); \
    l_reg+=sacc; \
    if(GK){DMA_K((t)+3,sl_cur);} if(GV){DMA_V((t)+1,sl_next);} \
    CMASK(C0,C1,t); \
    { float a=MX3(C0[0],C0[1],C1[0]),b=MX3(C0[2],C0[3],C1[1]); a=MX3(a,C1[2],C1[3]); \
      _Pragma("unroll") for(int r=4;r<16;r+=4){a=MX3(a,C0[r],C0[r+1]);b=MX3(b,C0[r+2],C0[r+3]);a=MX3(a,C1[r],C1[r+1]);b=MX3(b,C1[r+2],C1[r+3]);} \
      float rm=__builtin_fmaxf(a,b); { auto rr=__builtin_amdgcn_permlane32_swap(__float_as_uint(rm),__float_as_uint(rm),false,false); rm=__builtin_fmaxf(__uint_as_float(rr[0]),__uint_as_float(rr[1])); } \
      resc=false; \
      if(__builtin_expect(__any(rm>(float)THRL),0)){ const float dl=__builtin_fmaxf(rm,0.f); mhat+=dl; \
        _Pragma("unroll") for(int r=0;r<16;++r){C0[r]-=dl;C1[r]-=dl;} \
        const float f=__builtin_amdgcn_exp2f(-dl); l_reg*=f; if(hi==0)wsf[r32]=f; resc=true; } } \
    SBAR(); \
    GAPB(o[0]=__builtin_amdgcn_mfma_f32_32x32x16_bf16(PAF(0),VFR(0),o[0],0,0,0), C0,0); \
    GAPB(o[1]=__builtin_amdgcn_mfma_f32_32x32x16_bf16(PAF(0),VFR(4),o[1],0,0,0), C0,4); \
    KRD(GL,0); GAPB(o[0]=__builtin_amdgcn_mfma_f32_32x32x16_bf16(PAF(1),VFR(1),o[0],0,0,0), C0,8); \
    KRD(GL,1); GAPB(o[1]=__builtin_amdgcn_mfma_f32_32x32x16_bf16(PAF(1),VFR(5),o[1],0,0,0), C0,12); \
    KRD(GL,2); GAPB(o[0]=__builtin_amdgcn_mfma_f32_32x32x16_bf16(PAF(2),VFR(2),o[0],0,0,0), C1,0); \
    KRD(GL,3); GAPB(o[1]=__builtin_amdgcn_mfma_f32_32x32x16_bf16(PAF(2),VFR(6),o[1],0,0,0), C1,4); \
    GAPB(o[0]=__builtin_amdgcn_mfma_f32_32x32x16_bf16(PAF(3),VFR(3),o[0],0,0,0), C1,8); \
    GAPB(o[1]=__builtin_amdgcn_mfma_f32_32x32x16_bf16(PAF(3),VFR(7),o[1],0,0,0), C1,12); \
    }while(0)
  int t=1;
  #undef CMASK
  #define CMASK(P0,P1,t) do{}while(0)
  for(;t+5<NT;t+=2){
    STEP(pB0,pB1,pA0,pA1,t,true,true,true);     WAIT_BAR(2); RESC(); ROT();
    STEP(pA0,pA1,pB0,pB1,t+1,true,true,true);   WAIT_BAR(2); RESC(); ROT();
  }
  #undef CMASK
  #define CMASK(P0,P1,t) do{int jb_=(t)-(NT-4); if(jb_>=0)cmask(P0,P1,jb_,qrel,hi);}while(0)
  #define ENDW(tt) do{ if((tt)+3<NT){WAIT_BAR(2);} else if((tt)+2<NT){WAIT_BAR(1);} else {WAIT_BAR(0);} }while(0)
  for(;t+1<NT;t+=2){
    STEP(pB0,pB1,pA0,pA1,t,(t+3<NT),(t+1<NT),(t+1<NT));       ENDW(t);   RESC(); ROT();
    STEP(pA0,pA1,pB0,pB1,t+1,(t+4<NT),(t+2<NT),(t+2<NT));     ENDW(t+1); RESC(); ROT();
  }
  STEP(pB0,pB1,pA0,pA1,NT-1,false,false,false); RESC();
  { float sacc=pB0[0]+pB0[1]; _Pragma("unroll") for(int r=2;r<16;++r)sacc+=pB0[r]; _Pragma("unroll") for(int r=0;r<16;++r)sacc+=pB1[r]; l_reg+=sacc;
    pw0=(u32x4){PKW(pB0,0),PKW(pB0,2),PKW(pB0,4),PKW(pB0,6)};pw1=(u32x4){PKW(pB0,8),PKW(pB0,10),PKW(pB0,12),PKW(pB0,14)};pw2=(u32x4){PKW(pB1,0),PKW(pB1,2),PKW(pB1,4),PKW(pB1,6)};pw3=(u32x4){PKW(pB1,8),PKW(pB1,10),PKW(pB1,12),PKW(pB1,14)};
    SBAR(); pv(o,vb0+sl_cur,PAF(0),PAF(1),PAF(2),PAF(3)); }
  #undef PKW
  #undef PAF
  #undef VFR
  #undef PIN
  #undef MX3
  #undef GAPA
  #undef GAPB
  #undef EX
  #undef VRD
  #undef KRD
  #undef STEP
  #undef ENDW
  {auto rr=__builtin_amdgcn_permlane32_swap(__float_as_uint(l_reg),__float_as_uint(l_reg),false,false);l_reg=__uint_as_float(rr[0])+__uint_as_float(rr[1]);}
  if(hi==0)wsf[32+r32]=l_reg;asm volatile("s_waitcnt lgkmcnt(0)":::"memory");
  float rli[16];
  #pragma unroll
  for(int r=0;r<16;++r)rli[r]=__builtin_amdgcn_rcpf(wsf[32+crow(r,hi)]);
  bf16*Ow=O+(rowbase+q0+wid*QBLK)*DM+h*D;
  { bf16*stg=(bf16*)(shm+LDS_OST)+wid*2048;
    #pragma unroll
    for(int r=0;r<16;++r){const int orow=crow(r,hi);
      #pragma unroll
      for(int d0=0;d0<2;++d0)stg[orow*64+d0*32+r32]=__float2bfloat16(o[d0][r]*rli[r]);}
    asm volatile("s_waitcnt lgkmcnt(0)":::"memory");
    #pragma unroll
    for(int i=0;i<4;++i){const int row=i*8+(lane>>3),ch=lane&7; const u32x4 v=*(const u32x4*)(stg+row*64+ch*8); ATTN_STORE16(Ow+(long)row*DM+ch*8,v);} }
  asm volatile("s_waitcnt lgkmcnt(0)\n\ts_barrier":::"memory");
  #undef DMA_K
  #undef DMA_V
  #undef CMASK
  #undef BIASINIT
  #undef START
  #undef RESC
  #undef ROT
}
constexpr int ATTN_LDS_BYTES=LDS_BYTES;
struct AttnTensors { const bf16* Q; const bf16* K; const bf16* V; bf16* O; const float* cl2; };
#undef SBAR
#undef WAIT_BAR
}
#define GEMM_PHASE(...) pg8::gemm_phase<__VA_ARGS__, pg8::StaticOrder, PGA, PGS>(ldsl, g, S, E, wave)
#define GEMM_PHASE_SPLIT() pg8::gemm_phase<pg8::EpiPartial, pg8::SplitOrder, PGA, PGS>(ldsl, g2, S2, E2, wave)
#define GEMM_PHASE_SPLIT_T(NN, NS, KSUB, KSH) pg8::gemm_phase<pg8::EpiPartialT<NN, KSH>, pg8::SplitOrderT<NN, NS, KSUB>, PGA, PGS>(ldsl, g2, S2, E2, wave)
#ifndef PGA
#define PGA true
#endif
#ifndef PGS
#define PGS true
#endif
namespace cg = cooperative_groups;
#define LAS __attribute__((address_space(3)))
typedef unsigned short bf16;
typedef unsigned v4u __attribute__((ext_vector_type(4)));
typedef float f32x4 __attribute__((ext_vector_type(4)));
typedef short bf16x8 __attribute__((ext_vector_type(8)));
typedef float f32x16 __attribute__((ext_vector_type(16)));
constexpr int NWAVES = 8, NTHR = 512, NMODC_ = 9216;
constexpr int MP = 32768, MS = 256, M = MP + MS, DM = 1024, FF = 2816, WA = 512, NIN = 4608, INCOLS = 4616, SEQ = 16384, PAST = 1024, DSEQ = 32, SKEYS = PAST + DSEQ;
constexpr float EPS = 1e-6f, LOG2E = 1.4426950408889634f;
constexpr size_t MiB = 1u << 20;
constexpr size_t WS_CTL = 0, CTL_ZERO_BYTES = 65536;
constexpr size_t WS_MOD = 1 * MiB, WS_CUMP = 2 * MiB, WS_CUMS = 3 * MiB, WS_G2SS = 4 * MiB, WS_QS = 6 * MiB, WS_WSP = 7 * MiB;
constexpr size_t WS_WGU1 = 8 * MiB, WS_WD1 = 19 * MiB, WS_WIN = 25 * MiB, WS_WPA = 34 * MiB, WS_WPB = 35 * MiB, WS_WOUT = 36 * MiB, WS_WGU2 = 38 * MiB, WS_WD2 = 49 * MiB;
constexpr size_t WS_XN = 56 * MiB;
constexpr size_t WS_ACT = 121 * MiB;
constexpr size_t QKV_B = (size_t)M * 512 * 2;
constexpr size_t WS_Q = 121 * MiB, WS_K = WS_Q + QKV_B, WS_V = WS_K + QKV_B, WS_U = WS_V + QKV_B, WS_G2 = WS_U + QKV_B;
constexpr size_t WS_AO = WS_Q;
constexpr size_t WS_T1 = WS_U;
constexpr size_t WS_T2 = WS_K;
constexpr size_t WS_BO = 283 * MiB, WS_PART = 300 * MiB, WS_END = 316 * MiB;
static_assert(WS_XN + (size_t)M * 2048 <= WS_ACT && WS_G2 + QKV_B <= WS_BO && WS_BO + QKV_B <= WS_END && WS_ACT + (size_t)M * FF * 2 <= WS_END, "ws map");
constexpr size_t O_Y = 0, O_KP = (size_t)M * 1024, O_VP = O_KP + (size_t)MP * 512, O_FP = O_VP + (size_t)MP * 512, O_KS = O_FP + (size_t)MP * 8, O_VS = O_KS + (size_t)MS * 512,
                 O_FS = O_VS + (size_t)MS * 512, O_GS = O_FS + (size_t)MS * 8, O_END = O_GS + (size_t)MS * 512;
constexpr int LDS_BYTES = 155648, MISC_OFF = LDS_BYTES - 256;
static_assert(attn_body::LDS_TOTAL <= MISC_OFF && pg8::STAGE_BYTES <= LDS_BYTES, "LDS map");

struct Args { const float* in[28]; float* out; unsigned char* ws; };

__device__ __forceinline__ float wave_sum(float v) {
#pragma unroll
    for (int o = 1; o < 64; o <<= 1) v += __shfl_xor(v, o);
    return v;
}
__device__ __forceinline__ unsigned f2bf(float f) { unsigned u = __builtin_bit_cast(unsigned, f); return (u + 0x7fffu + ((u >> 16) & 1u)) >> 16; }
__device__ __forceinline__ unsigned pk2(float lo, float hi) { return f2bf(lo) | (f2bf(hi) << 16); }
__device__ __forceinline__ float bf2f(unsigned short h) { return __uint_as_float((unsigned)h << 16); }

__device__ __forceinline__ void ada_unit(const Args& a, unsigned char* lds, int cb, int tid) {
    asm volatile("" : "+v"(tid));
    float* SC = (float*)lds; float* RED = (float*)(lds + 40960);
    const float* cp = a.in[2]; const float* cs = a.in[3]; const float* w_ada = a.in[7]; const float* b_ada = a.in[8];
    float* MOD = (float*)(a.ws + WS_MOD);
    for (int i = tid; i < 10240; i += NTHR) { const int r = i >> 10, k = i & 1023; const float c = r < 2 ? cp[r * 1024 + k] : cs[(r - 2) * 1024 + k]; SC[i] = c / (1.0f + expf(-c)); }
    __syncthreads();
    if (tid < 504) {
        const int cgp = tid % 9, ks = tid / 9; f32x4 acc[10];
#pragma unroll
        for (int r = 0; r < 10; ++r) acc[r] = (f32x4){0.f, 0.f, 0.f, 0.f};
        for (int k = ks; k < 1024; k += 56) { const f32x4 w = *(const f32x4*)(w_ada + (size_t)k * NMODC_ + 36 * cb + 4 * cgp);
#pragma unroll
            for (int r = 0; r < 10; ++r) acc[r] += w * SC[r * 1024 + k]; }
#pragma unroll
        for (int r = 0; r < 10; ++r) *(f32x4*)(RED + (size_t)tid * 40 + r * 4) = acc[r];
    }
    __syncthreads();
    if (tid < 360) { const int r = tid / 36, c = tid % 36, cgp = c >> 2, i = c & 3; float s = 0.f;
        for (int ks = 0; ks < 56; ++ks) s += RED[(ks * 9 + cgp) * 40 + r * 4 + i];
        MOD[r * NMODC_ + 36 * cb + c] = s + b_ada[36 * cb + c]; }
    __syncthreads();
}
__device__ __forceinline__ void transpose_item(const float* W, int ld, int c0, int K, bf16* WT, int drow0, int k0, float* scr, int lane) {
    { const int r8 = lane >> 3, c4 = lane & 7; f32x4 v[8];
#pragma unroll
      for (int i = 0; i < 8; ++i) v[i] = *(const f32x4*)(W + (size_t)(k0 + 8 * i + r8) * ld + c0 + 4 * c4);
#pragma unroll
      for (int i = 0; i < 8; ++i) { float* d = scr + (8 * i + r8) * 33 + 4 * c4; d[0] = v[i].x; d[1] = v[i].y; d[2] = v[i].z; d[3] = v[i].w; } }
    asm volatile("s_waitcnt lgkmcnt(0)" ::: "memory");
    const int c = lane & 7;
#pragma unroll
    for (int j = 0; j < 4; ++j) { const int n = (lane >> 3) + 8 * j; const float* s = scr + (8 * c) * 33 + n;
        v4u o; o.x = pk2(s[0 * 33], s[1 * 33]); o.y = pk2(s[2 * 33], s[3 * 33]); o.z = pk2(s[4 * 33], s[5 * 33]); o.w = pk2(s[6 * 33], s[7 * 33]);
        *(v4u*)(WT + (size_t)(drow0 + n) * K + k0 + 8 * c) = o; }
    asm volatile("s_waitcnt lgkmcnt(0)" ::: "memory");
}
struct Seg { int in, ld, c0, ncols, K; size_t dst; int drow, mode; };
__device__ const Seg SEGS[13] = {
        {10, FF, 0, FF, 1024, WS_WGU1, 0, 1}, {11, FF, 0, FF, 1024, WS_WGU1, 0, 2}, {12, 1024, 0, 1024, FF, WS_WD1, 0, 0},
        {14, INCOLS, 0, 512, 1024, WS_WIN, 0, 3}, {14, INCOLS, 512, 512, 1024, WS_WIN, 512, 3}, {14, INCOLS, 1024, 512, 1024, WS_WIN, 1024, 0}, {14, INCOLS, 1544, 3072, 1024, WS_WIN, 1536, 0},
        {21, 1024, 0, 1024, 512, WS_WPA, 0, 0}, {22, 1024, 0, 1024, 512, WS_WPB, 0, 0}, {23, 1024, 0, 1024, 1024, WS_WOUT, 0, 0},
        {25, FF, 0, FF, 1024, WS_WGU2, 0, 1}, {26, FF, 0, FF, 1024, WS_WGU2, 0, 2}, {27, 1024, 0, 1024, FF, WS_WD2, 0, 0}};
__device__ __forceinline__ int seg_drow(const Seg& s, int n) {
    if (s.mode == 0) return s.drow + n;
    if (s.mode == 1) return s.drow + 256 * (n >> 7) + (n & 127);
    if (s.mode == 2) return s.drow + 256 * (n >> 7) + 128 + (n & 127);
    const int gs = (n & 255) >> 5; return s.drow + (n & ~255) + 32 * (4 * (gs & 1) + (gs >> 1));
}
__device__ __forceinline__ void p0_weights(const Args& a, unsigned char* lds, int gw, int NGW, int wave, int lane) {
    asm volatile("" : "+v"(lane));
    float* scr = (float*)(lds + wave * 8704);

    int base = 0;
#pragma unroll 1
    for (int si = 0; si < 13; ++si) {
        const Seg s = SEGS[si]; const int nblk = s.ncols / 32, nitems = (s.K / 64) * nblk;
        int first = (gw - base) % NGW; if (first < 0) first += NGW;
        for (int it = first; it < nitems; it += NGW) { const int kb = it / nblk, nb = it % nblk;
            transpose_item(a.in[s.in], s.ld, s.c0 + 32 * nb, s.K, (bf16*)(a.ws + s.dst), seg_drow(s, 32 * nb), 64 * kb, scr, lane); }
        base = (base + nitems) % NGW;
    }
    const float* wsp = a.in[19]; bf16* WSP = (bf16*)(a.ws + WS_WSP);
    for (int i = gw * 64 + lane; i < 4 * 128 * 128; i += NGW * 64) { const int t = (i >> 7) & 127, s2 = i & 127; WSP[i] = (bf16)f2bf(s2 <= t ? wsp[i] : 0.f); }
}
template <bool LOGF> __device__ __forceinline__ void norm_phase(const Args& a, unsigned char* lds, const float* srcp, const float* srcs, const float* g, int ishift, int iscale,
                                                                 int gw, int NGW, int tid, int lane) {
    asm volatile("" : "+v"(tid), "+v"(lane));
    const float* MOD = (const float*)(a.ws + WS_MOD); bf16* XN = (bf16*)(a.ws + WS_XN);
    float* WFt = (float*)lds;
    if (LOGF) { const float* w_in = a.in[14]; for (int i = tid; i < 8192; i += NTHR) { const int k = i >> 3, j = i & 7; WFt[j * 1024 + k] = w_in[(size_t)k * INCOLS + 1536 + j]; } __syncthreads(); }
    int cur = -1; f32x4 gs[4], shv[4], vn[4], vnn[4];
    if (gw < M) { const float* xrow0 = gw < MP ? srcp + (size_t)gw * 1024 : srcs + (size_t)(gw - MP) * 1024;
#pragma unroll
        for (int j = 0; j < 4; ++j) vn[j] = ((const f32x4*)xrow0 + lane)[64 * j]; }
    if (gw + NGW < M) { const int m1 = gw + NGW; const float* xrow1 = m1 < MP ? srcp + (size_t)m1 * 1024 : srcs + (size_t)(m1 - MP) * 1024;
#pragma unroll
        for (int j = 0; j < 4; ++j) vnn[j] = ((const f32x4*)xrow1 + lane)[64 * j]; }
    for (int m = gw; m < M; m += NGW) {
        const int mr = m < MP ? (m >> 14) : 2 + ((m - MP) >> 5);
        if (mr != cur) { cur = mr; const f32x4* g4 = (const f32x4*)g + lane;
            const f32x4* sh4 = (const f32x4*)(MOD + (size_t)mr * 9216 + ishift * 1024) + lane; const f32x4* sc4 = (const f32x4*)(MOD + (size_t)mr * 9216 + iscale * 1024) + lane;
#pragma unroll
            for (int j = 0; j < 4; ++j) { gs[j] = g4[64 * j] * (sc4[64 * j] + 1.0f); shv[j] = sh4[64 * j]; } }
        f32x4 v[4]; float ss = 0.f;
#pragma unroll
        for (int j = 0; j < 4; ++j) { v[j] = vn[j]; vn[j] = vnn[j]; ss += (v[j].x * v[j].x + v[j].y * v[j].y) + (v[j].z * v[j].z + v[j].w * v[j].w); }
        { const int m2 = m + 2 * NGW; if (m2 < M) { const float* xrow2 = m2 < MP ? srcp + (size_t)m2 * 1024 : srcs + (size_t)(m2 - MP) * 1024;
#pragma unroll
            for (int j = 0; j < 4; ++j) vnn[j] = ((const f32x4*)xrow2 + lane)[64 * j]; } }
        const float rstd = 1.0f / sqrtf(wave_sum(ss) * (1.0f / 1024.0f) + EPS);
        unsigned long long* o8 = (unsigned long long*)(XN + (size_t)m * 1024) + lane;
#pragma unroll
        for (int j = 0; j < 4; ++j) { v[j] = (v[j] * rstd) * gs[j] + shv[j];
            o8[64 * j] = (unsigned long long)pk2(v[j].x, v[j].y) | ((unsigned long long)pk2(v[j].z, v[j].w) << 32); }
        if (LOGF) {
            float f[8];
#pragma unroll
            for (int jj = 0; jj < 8; ++jj) { float s = 0.f;
#pragma unroll
                for (int j = 0; j < 4; ++j) { const f32x4 w = *((const f32x4*)(WFt + jj * 1024) + 64 * j + lane); s += (v[j].x * w.x + v[j].y * w.y) + (v[j].z * w.z + v[j].w * w.w); }
                f[jj] = wave_sum(s); }
            float fj = f[0];
#pragma unroll
            for (int jj = 1; jj < 8; ++jj) fj = (lane == jj) ? f[jj] : fj;
            if (lane < 8) { const float x = fj + a.in[15][lane]; const float lf = (x >= 0.f) ? -log1pf(expf(-x)) : x - log1pf(expf(x));
                float* dst = m < MP ? a.out + O_FP + (size_t)m * 8 : a.out + O_FS + (size_t)(m - MP) * 8; dst[lane] = lf; }
        }
    }
}
__device__ __forceinline__ void scan_unit(const Args& a, unsigned char* lds, int unit, int tid) {
    asm volatile("" : "+v"(tid));
    double* tot = (double*)lds;
    if (unit < 16) {
        const int b = unit >> 3, h = unit & 7; const float* lf = a.out + O_FP + ((size_t)b * SEQ) * 8 + h; float* dst = (float*)(a.ws + WS_CUMP) + (size_t)unit * SEQ;
        float x[32]; double s = 0.0;
#pragma unroll
        for (int i = 0; i < 32; ++i) { x[i] = lf[(size_t)(tid * 32 + i) * 8]; s += (double)x[i]; }
        tot[tid] = s; __syncthreads();
        double pre = 0.0; for (int j = 0; j < tid; ++j) pre += tot[j];
#pragma unroll
        for (int i = 0; i < 32; ++i) { pre += (double)x[i]; dst[tid * 32 + i] = (float)(pre * 1.4426950408889634); }
    } else {
        const int bh = unit - 16, b = bh >> 3, h = bh & 7; const float* lfc = a.in[6] + ((size_t)b * PAST) * 8 + h; const float* lfn = a.out + O_FS + ((size_t)b * DSEQ) * 8 + h;
        float* dst = (float*)(a.ws + WS_CUMS) + (size_t)bh * SKEYS;
        float x[3] = {0.f, 0.f, 0.f}; double s = 0.0;
        if (tid < 352) {
#pragma unroll
            for (int i = 0; i < 3; ++i) { const int p = tid * 3 + i; x[i] = p < PAST ? lfc[(size_t)p * 8] : lfn[(size_t)(p - PAST) * 8]; s += (double)x[i]; } }
        tot[tid] = s; __syncthreads();
        if (tid < 352) { double pre = 0.0; for (int j = 0; j < tid; ++j) pre += tot[j];
#pragma unroll
            for (int i = 0; i < 3; ++i) { pre += (double)x[i]; dst[tid * 3 + i] = (float)(pre * 1.4426950408889634); } }
    }
    __syncthreads();
}
__device__ __forceinline__ void gmlp_unit(const Args& a, unsigned char* lds, int ci, int tid, int wave, int lane) {
    asm volatile("" : "+v"(tid), "+v"(lane));
    constexpr int VP = 136;
    bf16* VT = (bf16*)lds; float* rst = (float*)(lds + 128 * VP * 2);
    const bf16* G2 = (const bf16*)(a.ws + WS_G2); const bf16* U = (const bf16*)(a.ws + WS_U); bf16* BO = (bf16*)(a.ws + WS_BO); const bf16* WSP = (const bf16*)(a.ws + WS_WSP);
    const float* G2SS = (const float*)(a.ws + WS_G2SS); const float* gv = a.in[18]; const float* bsp = a.in[20];
    const size_t R0 = (size_t)ci * 128;
    if (tid < 128) { const f32x4* p = (const f32x4*)(G2SS + (R0 + tid) * 8); const f32x4 s0 = p[0], s1 = p[1]; rst[tid] = 1.0f / sqrtf((((s0.x + s0.y) + (s0.z + s0.w)) + ((s1.x + s1.y) + (s1.z + s1.w))) * (1.0f / 512.0f) + EPS); }
    __syncthreads();
    const int r32 = lane & 31, hi = lane >> 5, tb = wave >> 1, dh = wave & 1;
#pragma unroll 1
    for (int g = 0; g < 4; ++g) {
#pragma unroll
        for (int it = 0; it < 4; ++it) { const int q = tid + NTHR * it, s = q & 127, cch = q >> 7;
            const v4u raw = *(const v4u*)(G2 + (R0 + s) * 512 + g * 128 + 8 * cch); const float rs = rst[s];
            const f32x4 g0 = *(const f32x4*)(gv + g * 128 + 8 * cch), g1 = *(const f32x4*)(gv + g * 128 + 8 * cch + 4);
            bf16* col = VT + (8 * cch) * VP + s;
            col[0 * VP] = (bf16)f2bf(pg8::bf_lo(raw.x) * rs * g0.x); col[1 * VP] = (bf16)f2bf(pg8::bf_hi(raw.x) * rs * g0.y); col[2 * VP] = (bf16)f2bf(pg8::bf_lo(raw.y) * rs * g0.z); col[3 * VP] = (bf16)f2bf(pg8::bf_hi(raw.y) * rs * g0.w);
            col[4 * VP] = (bf16)f2bf(pg8::bf_lo(raw.z) * rs * g1.x); col[5 * VP] = (bf16)f2bf(pg8::bf_hi(raw.z) * rs * g1.y); col[6 * VP] = (bf16)f2bf(pg8::bf_lo(raw.w) * rs * g1.z); col[7 * VP] = (bf16)f2bf(pg8::bf_hi(raw.w) * rs * g1.w); }
        __syncthreads();
        f32x16 acc[2]; acc[0] = f32x16{}; acc[1] = f32x16{};
        for (int ks = 0; ks <= 2 * tb + 1; ++ks) {
            const bf16x8 af = *(const bf16x8*)(WSP + ((size_t)(g * 128 + 32 * tb + r32)) * 128 + 16 * ks + 8 * hi);
#pragma unroll
            for (int db = 0; db < 2; ++db) { const bf16x8 bfv = *(const bf16x8*)(VT + (64 * dh + 32 * db + r32) * VP + 16 * ks + 8 * hi); acc[db] = __builtin_amdgcn_mfma_f32_32x32x16_bf16(af, bfv, acc[db], 0, 0, 0); }
        }
#pragma unroll
        for (int db = 0; db < 2; ++db)
#pragma unroll
            for (int r = 0; r < 16; ++r) { const int t = 32 * tb + (r & 3) + 8 * (r >> 2) + 4 * hi, ch = g * 128 + 64 * dh + 32 * db + r32; const size_t off = (R0 + t) * 512 + ch;
                const float mixed = acc[db][r] + bsp[g * 128 + t]; BO[off] = (bf16)f2bf(bf2f(U[off]) * mixed); }
        __syncthreads();
    }
}
__device__ __forceinline__ void gmlp_sample_unit(const Args& a, unsigned char* lds, int b, int tid) {
    asm volatile("" : "+v"(tid));
    float* rst = (float*)lds;
    const bf16* G2 = (const bf16*)(a.ws + WS_G2); const bf16* U = (const bf16*)(a.ws + WS_U); bf16* BO = (bf16*)(a.ws + WS_BO);
    const float* G2SS = (const float*)(a.ws + WS_G2SS); const float* wsp = a.in[19]; const float* bsp = a.in[20];
    const size_t R0 = (size_t)MP + b * 32;
    if (tid < 32) { const float* p = G2SS + (R0 + tid) * 8; float s = 0.f; for (int i = 0; i < 8; ++i) s += p[i]; rst[tid] = 1.0f / sqrtf(s * (1.0f / 512.0f) + EPS); }
    __syncthreads();
    const int ch = tid, g = ch >> 7; const float gvv = a.in[18][ch];
    float vb[32];
#pragma unroll
    for (int s = 0; s < 32; ++s) { vb[s] = bf2f(G2[(R0 + s) * 512 + ch]) * rst[s] * gvv; a.out[O_GS + ((size_t)b * 32 + s) * 512 + ch] = vb[s]; }
#pragma unroll
    for (int t = 0; t < 32; ++t) { float mixed = bsp[g * 128 + t]; const float* wrow = wsp + ((size_t)g * 128 + t) * 128;
#pragma unroll
        for (int s = 0; s < 32; ++s) if (s <= t) mixed += wrow[s] * vb[s];
        const size_t off = (R0 + t) * 512 + ch; BO[off] = (bf16)f2bf(bf2f(U[off]) * mixed); }
    __syncthreads();
}
__device__ __forceinline__ void sattn_unit(const Args& a, unsigned char* lds, int unit, int tid, int wave, int lane) {
    asm volatile("" : "+v"(tid), "+v"(lane));
    const int qg = unit & 3, h = (unit >> 2) & 7, b = unit >> 5;
    float* qs = (float*)lds;
    float* S = qs + 512;
    float* red = S + 8 * SKEYS;
    float* inv = red + 4096;
    const float* QS = (const float*)(a.ws + WS_QS); const float* cum = (const float*)(a.ws + WS_CUMS) + (size_t)(b * 8 + h) * SKEYS;
    const float* kc = a.in[4] + ((size_t)b * PAST) * 512 + h * 64; const float* vc = a.in[5] + ((size_t)b * PAST) * 512 + h * 64;
    const float* kn = a.out + O_KS + ((size_t)b * DSEQ) * 512 + h * 64; const float* vn = a.out + O_VS + ((size_t)b * DSEQ) * 512 + h * 64;
    { const int qi = tid >> 6, d = tid & 63; qs[tid] = QS[((size_t)b * 32 + 8 * qg + qi) * 512 + h * 64 + d]; }
    __syncthreads();
    for (int key = wave * 132 + lane; key < wave * 132 + 132; key += 64) {
        const f32x4* kr = (const f32x4*)(key < PAST ? kc + (size_t)key * 512 : kn + (size_t)(key - PAST) * 512);
        f32x4 kv[16];
#pragma unroll
        for (int i = 0; i < 16; ++i) kv[i] = kr[i];
        const float ck = cum[key];
#pragma unroll
        for (int qi = 0; qi < 8; ++qi) { float s = 0.f;
#pragma unroll
            for (int i = 0; i < 16; ++i) { const f32x4 q4 = *(const f32x4*)(qs + qi * 64 + 4 * i); s += (q4.x * kv[i].x + q4.y * kv[i].y) + (q4.z * kv[i].z + q4.w * kv[i].w); }
            const int qpos = PAST + 8 * qg + qi;
            S[qi * SKEYS + key] = (key <= qpos) ? s + (cum[qpos] - ck) : -INFINITY; }
    }
    __syncthreads();
    { float mx = -INFINITY; for (int k = lane; k < SKEYS; k += 64) mx = fmaxf(mx, S[wave * SKEYS + k]);
#pragma unroll
      for (int o = 1; o < 64; o <<= 1) mx = fmaxf(mx, __shfl_xor(mx, o));
      float sum = 0.f; for (int k = lane; k < SKEYS; k += 64) { const float p = exp2f(S[wave * SKEYS + k] - mx); S[wave * SKEYS + k] = p; sum += p; }
      sum = wave_sum(sum); if (lane == 0) inv[wave] = 1.0f / sum; }
    __syncthreads();
    { float acc[8];
#pragma unroll
      for (int qi = 0; qi < 8; ++qi) acc[qi] = 0.f;
      for (int key = wave * 132; key < wave * 132 + 132; ++key) { const float v = (key < PAST ? vc + (size_t)key * 512 : vn + (size_t)(key - PAST) * 512)[lane];
#pragma unroll
          for (int qi = 0; qi < 8; ++qi) acc[qi] += S[qi * SKEYS + key] * v; }
#pragma unroll
      for (int qi = 0; qi < 8; ++qi) red[(wave * 8 + qi) * 64 + lane] = acc[qi]; }
    __syncthreads();
    { const int qi = tid >> 6, d = tid & 63; float s = 0.f;
#pragma unroll
      for (int w = 0; w < 8; ++w) s += red[(w * 8 + qi) * 64 + d];
      bf16* AO = (bf16*)(a.ws + WS_AO); AO[((size_t)MP + b * 32 + 8 * qg + qi) * 512 + h * 64 + d] = (bf16)f2bf(s * inv[qi]); }
    __syncthreads();
}

#define XB_TMO      128
#define XB_XCNT(j)  (256  + 64 * (j))
#define XB_XSUB(j)  (1280 + 64 * (j))
#define XB_XGEN(j)  (2304 + 64 * (j))
#define XB_TOP      3328
#define XB_TOPGEN   3392
#define XCD_BAR_WORDS 3456
#define XB_SPIN_CAP (1u << 18)

__device__ __forceinline__ unsigned xb_ld(unsigned* p)              { return __hip_atomic_load(p, __ATOMIC_RELAXED, __HIP_MEMORY_SCOPE_AGENT); }
__device__ __forceinline__ unsigned xb_add(unsigned* p, unsigned v) { return __hip_atomic_fetch_add(p, v, __ATOMIC_RELAXED, __HIP_MEMORY_SCOPE_AGENT); }
__device__ __forceinline__ unsigned xb_xcc_id() { return (unsigned)__builtin_amdgcn_s_getreg((3 << 11) | 20) & 0xFu; }
#define XB_SPIN(cond, bar) do { unsigned _sp = 0; while (cond) { __builtin_amdgcn_s_sleep(1); \
    if ((++_sp & 255u) == 0u) { if (xb_ld(&(bar)[XB_TMO])) break; if (_sp > XB_SPIN_CAP) { atomicAdd(&(bar)[XB_TMO], 1u); break; } } } } while (0)

struct XcdBarrier {
    unsigned* bar; unsigned x;
    volatile LAS unsigned* st;
};

__device__ __forceinline__ XcdBarrier xcd_barrier_post(unsigned* bar, volatile LAS unsigned* st, int wv) {
    XcdBarrier b; b.bar = bar; b.x = xb_xcc_id(); b.st = st;
    if (wv == 0 && lane_id_() == 0) (void)xb_add(&bar[XB_XCNT(b.x)], 1u);
    return b;
}
__device__ __forceinline__ void xcd_barrier_complete(unsigned* bar, unsigned x, unsigned& nloc, unsigned& nx) {
    const unsigned G = gridDim.x * gridDim.y * gridDim.z;
    unsigned sum, cnt, mine, sp = 0u;
    for (;;) {
        sum = 0u; cnt = 0u; mine = 0u;
#pragma unroll
        for (unsigned j = 0; j < 16; ++j) { const unsigned c = xb_ld(&bar[XB_XCNT(j)]); sum += c; cnt += (c > 0u) ? 1u : 0u; mine = (j == x) ? c : mine; }
        if (sum == G) break;
        __builtin_amdgcn_s_sleep(1);
        if ((++sp & 255u) == 0u) { if (xb_ld(&bar[XB_TMO])) break; if (sp > XB_SPIN_CAP) { atomicAdd(&bar[XB_TMO], 1u); break; } }
    }
    nloc = mine > 0u ? mine : 1u; nx = cnt > 0u ? cnt : 1u;
}

__device__ __forceinline__ void xcd_barrier(const XcdBarrier& b, int wv) {
    asm volatile("s_waitcnt vmcnt(0)" ::: "memory");
    __syncthreads();
    if (wv == 0 && lane_id_() == 0) {
        unsigned* bar = b.bar;
        __builtin_amdgcn_s_waitcnt(0);
        unsigned nloc = b.st[0], nx = b.st[1];
        if (nloc == 0u) { xcd_barrier_complete(bar, b.x, nloc, nx); b.st[0] = nloc; b.st[1] = nx; }
        const unsigned old = xb_add(&bar[XB_XSUB(b.x)], 1u);
        const unsigned gen = old / nloc;
        if (old + 1u == (gen + 1u) * nloc) {
            __builtin_amdgcn_fence(__ATOMIC_RELEASE, "agent");
            asm volatile("s_waitcnt vmcnt(0)" ::: "memory");
            const unsigned og = xb_add(&bar[XB_TOP], 1u);
            const unsigned tg = og / nx;
            if (og + 1u == (tg + 1u) * nx) xb_add(&bar[XB_TOPGEN], 1u);
            else XB_SPIN(xb_ld(&bar[XB_TOPGEN]) == tg, bar);
            __builtin_amdgcn_fence(__ATOMIC_ACQUIRE, "agent");
            xb_add(&bar[XB_XGEN(b.x)], 1u);
            asm volatile("s_waitcnt vmcnt(0)" ::: "memory");
        } else {
            XB_SPIN(xb_ld(&bar[XB_XGEN(b.x)]) == gen, bar);
            __builtin_amdgcn_fence(__ATOMIC_ACQUIRE, "agent");
            asm volatile("s_waitcnt vmcnt(0)" ::: "memory");
        }
    }
    __syncthreads();
}

#ifndef SKIPMASK
#define SKIPMASK 0u
#endif
#define PH(n) (((SKIPMASK) >> (n) & 1u) == 0u)
#define GSYNC() do { XcdBarrier b_; b_.bar = (unsigned*)(a.ws + WS_CTL); b_.x = xbar_x; b_.st = MISC + 8; xcd_barrier(b_, wave); } while (0)
__global__ void __launch_bounds__(NTHR, 2) fox_fwd(Args a) {
    extern __shared__ __attribute__((aligned(16))) unsigned char lds[];
    cg::grid_group grid = cg::this_grid();
    const int wave = __builtin_amdgcn_readfirstlane((int)threadIdx.x >> 6);
#define tid ((wave << 6) | lane_id_())
#define lane (lane_id_())
    const int G = gridDim.x, bx = blockIdx.x; const int vcu = (G % 8 == 0) ? (bx % 8) * (G / 8) + bx / 8 : bx;
    const int gw = vcu * NWAVES + wave, NGW = G * NWAVES;
    LAS unsigned char* ldsl = (LAS unsigned char*)lds;
    float* MOD = (float*)(a.ws + WS_MOD); bf16* XN = (bf16*)(a.ws + WS_XN); bf16* ACT = (bf16*)(a.ws + WS_ACT);
    volatile LAS unsigned* MISC = (volatile LAS unsigned*)((LAS unsigned char*)lds + MISC_OFF);
    for (int i = tid; i < LDS_BYTES / 16; i += NTHR) ((v4u*)lds)[i] = (v4u){0u, 0u, 0u, 0u};
    __syncthreads();
    __builtin_amdgcn_fence(__ATOMIC_SEQ_CST, ""); asm volatile("s_waitcnt vmcnt(0) lgkmcnt(0)" ::: "memory");
    const unsigned xbar_x = xcd_barrier_post((unsigned*)(a.ws + WS_CTL), MISC + 8, wave).x;
    grid.sync();
    float* Y = a.out + O_Y;

#ifndef NPASS
#define NPASS 1
#endif
#pragma unroll 1
    for (int pass = 0; pass < NPASS; ++pass) {
    if (pass) GSYNC();
    if (PH(0)) { for (int cb = bx; cb < 256; cb += G) ada_unit(a, lds, cb, tid);
    p0_weights(a, lds, gw, NGW, wave, lane); }
    GSYNC();
    if (PH(1)) norm_phase<false>(a, lds, a.in[0], a.in[1], a.in[9], 0, 1, gw, NGW, tid, lane);
    GSYNC();
    if (PH(2)) { pg8::Gemm g{XN, (const bf16*)(a.ws + WS_WGU1), M, 2 * FF, 1024, 1024}; pg8::StaticOrder S; S.init(M, 2 * FF, G, bx); pg8::EpiUp E{ACT, FF};
      GEMM_PHASE(pg8::EpiUp); }
    GSYNC();
    if (PH(3)) { pg8::EpiRes E{a.in[0], a.in[1], Y, MOD + 2 * 1024, 0.5f};
      { int ksub_ = 256; asm volatile("" : "+s"(ksub_)); pg8::Gemm g2{ACT + (size_t)MP * FF, (const bf16*)(a.ws + WS_WD1), 256, 1024, ksub_, FF}; pg8::SplitOrder S2; S2.init(G, bx); pg8::EpiPartial E2{(float*)(a.ws + WS_PART), 4, 256}; GEMM_PHASE_SPLIT(); }
      { pg8::Gemm g{ACT, (const bf16*)(a.ws + WS_WD1), MP, 1024, FF, FF}; pg8::StaticOrder S; S.init(MP, 1024, G, bx); GEMM_PHASE(pg8::EpiRes); }
      GSYNC();
      if (bx < 32) pg8::reduce_rowgroup<11>((const float*)(a.ws + WS_PART), bx & 3, bx >> 2, E, wave); }
    GSYNC();
    if (PH(4)) norm_phase<true>(a, lds, Y, Y + (size_t)MP * 1024, a.in[13], 3, 4, gw, NGW, tid, lane);
    GSYNC();
    if (PH(5)) { if (G >= 160) { const int u = G - 1 - bx; if (u < 80) scan_unit(a, lds, u, tid); }
                 else for (int u = bx; u < 80; u += G) scan_unit(a, lds, u, tid); }
    if (PH(6)) { pg8::Gemm g{XN, (const bf16*)(a.ws + WS_WIN), M, 2560, 1024, 1024}; pg8::StaticOrder S; S.init(M, 2560, G, bx);
      pg8::EpiIn E{(bf16*)(a.ws + WS_Q), (bf16*)(a.ws + WS_K), (bf16*)(a.ws + WS_V), (bf16*)(a.ws + WS_U), (bf16*)(a.ws + WS_G2), nullptr, nullptr,
                   (float*)(a.ws + WS_G2SS), (float*)(a.ws + WS_QS), a.out + O_KP, a.out + O_KS, a.out + O_VP, a.out + O_VS, a.in[16], a.in[17], attn_body::C2, EPS};
      GEMM_PHASE(pg8::EpiIn); }
    GSYNC();
    if (PH(7)) { const attn_body::bf16* Qb = (const attn_body::bf16*)(a.ws + WS_Q); const attn_body::bf16* Kb = (const attn_body::bf16*)(a.ws + WS_K); const attn_body::bf16* Vb = (const attn_body::bf16*)(a.ws + WS_V);
      attn_body::bf16* Ob = (attn_body::bf16*)(a.ws + WS_AO); const float* CUMP = (const float*)(a.ws + WS_CUMP);
      const int nun = (G == 256) ? 4 : (1024 - bx + G - 1) / G;
      float B2;
      { float mq = fabsf(a.in[16][lane]), mk = fabsf(a.in[17][lane]);
#pragma unroll
        for (int o = 1; o < 64; o <<= 1) { mq = fmaxf(mq, __shfl_xor(mq, o)); mk = fmaxf(mk, __shfl_xor(mk, o)); }
        B2 = 64.0f * mq * mk * attn_body::C2 * 1.01f + 0.5f; }
#pragma unroll 1
      for (int i = 0; i < nun; ++i) { int bh, qb;
          if (G == 256) { const int s = vcu & 15; bh = vcu >> 4; qb = (i == 0) ? s : (i == 1) ? 31 - s : (i == 2) ? 32 + s : 63 - s; } else { const int idx = bx + i * G; bh = idx >> 6; qb = idx & 63; }
          int ts = 0;
          { const float* cl = CUMP + (size_t)bh * SEQ; const float cref = cl[qb * 256]; const int ncand = 4 * qb;
            for (int j0 = 0; j0 < ncand; j0 += 64) { const int j = j0 + lane; const bool sk = (j < ncand) && (cref - cl[64 * j + 63] + 2.0f * B2 < -152.0f); ts += (int)__popcll(__ballot(sk)); }
            ts = __builtin_amdgcn_readfirstlane(ts) & ~1; }
          attn_body::attn_unit<8>(bh >> 3, bh & 7, qb, ts, CUMP + (size_t)bh * SEQ, Qb, Kb, Vb, Ob, (char*)lds, wave);
          }
      __syncthreads(); }
    if (PH(8)) for (int ci = bx; ci < 256; ci += G) gmlp_unit(a, lds, ci, tid, wave, lane);
    if (PH(9)) for (int u = bx; u < 256; u += G) sattn_unit(a, lds, u, tid, wave, lane);
    if (PH(10)) { if (G == 256) { if ((vcu & 15) == 0 && (vcu >> 4) < 8) gmlp_sample_unit(a, lds, vcu >> 4, tid); } else for (int b = bx; b < 8; b += G) gmlp_sample_unit(a, lds, b, tid); }
    GSYNC();
    if (PH(11)) { bf16* T = (bf16*)(a.ws + WS_T1); bf16* T2 = (bf16*)(a.ws + WS_T2); const bf16* WIN = (const bf16*)(a.ws + WS_WIN);
      bf16* TS = T + (size_t)MP * 1024; bf16* T2S = T2 + (size_t)MP * 1024; const bf16* XS = XN + (size_t)MP * 1024;
      float* PARTA = (float*)(a.ws + 2 * MiB); float* PARTB = (float*)(a.ws + 4 * MiB);
      { pg8::Gemm g{(const bf16*)(a.ws + WS_AO) + (size_t)MP * 512, (const bf16*)(a.ws + WS_WPA), 256, 1024, 512, 512}; pg8::StaticOrder S; S.init(256, 1024, G, bx); pg8::EpiMix<0> E{TS, nullptr}; GEMM_PHASE(pg8::EpiMix<0>); }
      { pg8::Gemm g{(const bf16*)(a.ws + WS_AO), (const bf16*)(a.ws + WS_WPA), MP, 1024, 512, 512}; pg8::StaticOrder S; S.init(MP, 1024, G, bx); pg8::EpiMix<0> E{T, nullptr}; GEMM_PHASE(pg8::EpiMix<0>); }
      { int ksub_ = 512; asm volatile("" : "+s"(ksub_)); pg8::Gemm g2{XS, WIN + (size_t)2560 * 1024, 256, 1024, ksub_, 1024}; pg8::SplitOrderT<4, 2, 512> S2; S2.init(G, (bx + G - 8) % G); pg8::EpiPartialT<4, 9> E2{PARTA}; GEMM_PHASE_SPLIT_T(4, 2, 512, 9); }
      { pg8::Gemm g{XN, WIN + (size_t)2560 * 1024, MP, 1024, 1024, 1024}; pg8::StaticOrder S; S.init(MP, 1024, G, bx); pg8::EpiMix<1> E{T, nullptr}; GEMM_PHASE(pg8::EpiMix<1>); }
      { pg8::Gemm g{(const bf16*)(a.ws + WS_BO) + (size_t)MP * 512, (const bf16*)(a.ws + WS_WPB), 256, 1024, 512, 512}; pg8::StaticOrder S; S.init(256, 1024, G, (bx + G - 16) % G); pg8::EpiMix<0> E{T2S, nullptr}; GEMM_PHASE(pg8::EpiMix<0>); }
      { pg8::Gemm g{(const bf16*)(a.ws + WS_BO), (const bf16*)(a.ws + WS_WPB), MP, 1024, 512, 512}; pg8::StaticOrder S; S.init(MP, 1024, G, bx); pg8::EpiMix<0> E{T2, nullptr}; GEMM_PHASE(pg8::EpiMix<0>); }
      { int ksub_ = 512; asm volatile("" : "+s"(ksub_)); pg8::Gemm g2{XS, WIN + (size_t)3584 * 1024, 256, 1024, ksub_, 1024}; pg8::SplitOrderT<4, 2, 512> S2; S2.init(G, (bx + G - 24) % G); pg8::EpiPartialT<4, 9> E2{PARTB}; GEMM_PHASE_SPLIT_T(4, 2, 512, 9); }
      { pg8::Gemm g{XN, WIN + (size_t)3584 * 1024, MP, 1024, 1024, 1024}; pg8::StaticOrder S; S.init(MP, 1024, G, bx); pg8::EpiMix<2> E{T, T2}; GEMM_PHASE(pg8::EpiMix<2>); }
      GSYNC();
      if (bx < 32) { pg8::EpiMix<1> E1{TS, nullptr}; pg8::reduce_rowgroup<2>(PARTA, bx & 3, bx >> 2, E1, wave);
                     pg8::EpiMix<2> E2{TS, T2S}; pg8::reduce_rowgroup<2>(PARTB, bx & 3, bx >> 2, E2, wave); } }
    GSYNC();
    if (PH(13)) { pg8::EpiRes E{Y, Y + (size_t)MP * 1024, Y, MOD + 5 * 1024, 1.0f}; const bf16* M1 = (const bf16*)(a.ws + WS_T1);
      { int ksub_ = 256; asm volatile("" : "+s"(ksub_)); pg8::Gemm g2{M1 + (size_t)MP * 1024, (const bf16*)(a.ws + WS_WOUT), 256, 1024, ksub_, 1024}; pg8::SplitOrderT<4, 4, 256> S2; S2.init(G, bx); pg8::EpiPartialT<4, 8> E2{(float*)(a.ws + WS_PART)}; GEMM_PHASE_SPLIT_T(4, 4, 256, 8); }
      { pg8::Gemm g{M1, (const bf16*)(a.ws + WS_WOUT), MP, 1024, 1024, 1024}; pg8::StaticOrder S; S.init(MP, 1024, G, bx); GEMM_PHASE(pg8::EpiRes); }
      GSYNC();
      if (bx < 32) pg8::reduce_rowgroup<4>((const float*)(a.ws + WS_PART), bx & 3, bx >> 2, E, wave); }
    GSYNC();
    if (PH(14)) norm_phase<false>(a, lds, Y, Y + (size_t)MP * 1024, a.in[24], 6, 7, gw, NGW, tid, lane);
    GSYNC();
    if (PH(15)) { pg8::Gemm g{XN, (const bf16*)(a.ws + WS_WGU2), M, 2 * FF, 1024, 1024}; pg8::StaticOrder S; S.init(M, 2 * FF, G, bx); pg8::EpiUp E{ACT, FF};
      GEMM_PHASE(pg8::EpiUp); }
    GSYNC();
    if (PH(16)) { pg8::EpiRes E{Y, Y + (size_t)MP * 1024, Y, MOD + 8 * 1024, 0.5f};
      { int ksub_ = 256; asm volatile("" : "+s"(ksub_)); pg8::Gemm g2{ACT + (size_t)MP * FF, (const bf16*)(a.ws + WS_WD2), 256, 1024, ksub_, FF}; pg8::SplitOrder S2; S2.init(G, bx); pg8::EpiPartial E2{(float*)(a.ws + WS_PART), 4, 256}; GEMM_PHASE_SPLIT(); }
      { pg8::Gemm g{ACT, (const bf16*)(a.ws + WS_WD2), MP, 1024, FF, FF}; pg8::StaticOrder S; S.init(MP, 1024, G, bx); GEMM_PHASE(pg8::EpiRes); }
      GSYNC();
      if (bx < 32) pg8::reduce_rowgroup<11>((const float*)(a.ws + WS_PART), bx & 3, bx >> 2, E, wave); }
    }
}


#undef tid
#undef lane
extern "C" void kernel_launch(void* const* d_in, const int* in_sizes, int n_in, void* d_out, int out_size, void* d_ws, size_t ws_size, hipStream_t stream) {
    static int grid = 0;
    if (grid == 0) {
        if (n_in != 28 || (size_t)out_size != O_END || ws_size < WS_END || in_sizes[0] != MP * 1024) { fprintf(stderr, "kernel_launch: unexpected shapes (n_in %d out %d ws %zu)\n", n_in, out_size, ws_size); grid = -1; return; }
        int dev = 0, cus = 0, per_cu = 0;
        hipGetDevice(&dev); hipDeviceGetAttribute(&cus, hipDeviceAttributeMultiprocessorCount, dev);
        if (hipFuncSetAttribute((const void*)fox_fwd, hipFuncAttributeMaxDynamicSharedMemorySize, LDS_BYTES) != hipSuccess) { fprintf(stderr, "kernel_launch: hipFuncSetAttribute failed\n"); grid = -1; return; }
        if (hipOccupancyMaxActiveBlocksPerMultiprocessor(&per_cu, (const void*)fox_fwd, NTHR, LDS_BYTES) != hipSuccess || per_cu < 1) { fprintf(stderr, "kernel_launch: occupancy query says %d\n", per_cu); per_cu = 1; }
        (void)hipGetLastError();
        grid = cus * 1;
    }
    if (grid < 0) return;
    if (hipMemsetAsync((char*)d_ws + WS_CTL, 0, CTL_ZERO_BYTES, stream) != hipSuccess) { fprintf(stderr, "kernel_launch: hipMemsetAsync failed\n"); return; }
    Args a{};
    for (int i = 0; i < 28; ++i) a.in[i] = (const float*)d_in[i];
    a.out = (float*)d_out; a.ws = (unsigned char*)d_ws;
    void* args[] = {&a};
    hipError_t e = hipLaunchCooperativeKernel((const void*)fox_fwd, dim3(grid), dim3(NTHR), args, LDS_BYTES, stream);
    if (e != hipSuccess) fprintf(stderr, "cooperative launch failed: %s (grid %d)\n", hipGetErrorString(e), grid);
}
```

```cpp
#include <hip/hip_runtime.h>
#include <hip/hip_cooperative_groups.h>
#include <cstdio>
#include <cstdint>
__device__ __forceinline__ int lane_id_() { return (int)__builtin_amdgcn_mbcnt_hi(~0u, __builtin_amdgcn_mbcnt_lo(~0u, 0u)); }
namespace pg8 {
#define PG8_LAS __attribute__((address_space(3)))
typedef unsigned short bf16_t;
typedef short bf16x8 __attribute__((ext_vector_type(8)));
typedef float f32x4 __attribute__((ext_vector_type(4)));
typedef unsigned u32x4 __attribute__((ext_vector_type(4)));
constexpr int BM = 256, BK = 64, HALF = 128, HTB = HALF * BK * 2  , STAGE_BYTES = 8 * HTB, NXCD = 8, WGM = 8;

__host__ __device__ __forceinline__ int lds_byte(int r, int c) { const int st = (r >> 4) * 2 + (c >> 5), rr = r & 15, cc = c & 31, ob = rr * 64 + cc * 2; return st * 1024 + (ob ^ (((ob >> 9) & 1) << 5)); }
__host__ __device__ __forceinline__ void stage_rc(int b, int& R, int& C) { const int st = b / 1024, sb = b % 1024, swz = sb ^ (((sb >> 9) & 1) << 5); R = (st >> 1) * 16 + swz / 64; C = (st & 1) * 32 + (swz % 64) / 2; }
__host__ __device__ __forceinline__ int perm32(int rho) { const int n = rho >> 4, i = rho & 15; return 8 * (i >> 2) + 4 * n + (i & 3); }

struct Unit { int pm, pn, koff; };
struct Gemm { const bf16_t* A; const bf16_t* Bt; int M, N, K, Kp; };

struct StaticOrder {
    int nM, nN, nwg, G, c;
    __host__ __device__ void init(int M, int N, int G_, int c_) { nM = M / BM; nN = N / BM; nwg = nM * nN; G = G_; c = c_; }
    __host__ __device__ bool next(int i, Unit& u) const {
        const long L = (long)i * G + c; if (L >= nwg) return false;
        int wgid = (int)L; { const int q = nwg / NXCD, r = nwg % NXCD, xcd = wgid % NXCD, off = wgid / NXCD; wgid = (xcd < r ? xcd * (q + 1) : r * (q + 1) + (xcd - r) * q) + off; }
        const int nig = WGM * nN, gid = wgid / nig, fm = gid * WGM, gsz = (nM - fm) < WGM ? (nM - fm) : WGM;
        u.pm = fm + ((wgid % nig) % gsz); u.pn = (wgid % nig) / gsz; u.koff = 0; return true;
    }
    __device__ __forceinline__ void a_ready(const Unit&) const {}
    __device__ __forceinline__ void done(const Unit&) const {}
};

template <int NN, int NS, int KSUB> struct SplitOrderT {
    int G, c;
    __host__ __device__ void init(int G_, int c_) { G = G_; c = c_; }
    __host__ __device__ bool next(int i, Unit& u) const { const int L = i * G + c; if (L >= NN * NS) return false; u.pm = 0; u.pn = L % NN; u.koff = (L / NN) * KSUB; return true; }
    __device__ __forceinline__ void a_ready(const Unit&) const {}
    __device__ __forceinline__ void done(const Unit&) const {}
};
typedef SplitOrderT<4, 11, 256> SplitOrder;
__device__ __forceinline__ unsigned cvt_pk_bf16(float lo, float hi) { unsigned r; asm volatile("v_cvt_pk_bf16_f32 %0, %1, %2" : "=v"(r) : "v"(lo), "v"(hi)); return r; }
typedef float f32x2 __attribute__((ext_vector_type(2)));
__device__ __forceinline__ f32x2 gelu_pk(f32x2 v) {
    const f32x2 av = __builtin_elementwise_abs(v), d = av * 0.2316418882f + 1.0f;
    f32x2 t; t.x = __builtin_amdgcn_rcpf(d.x); t.y = __builtin_amdgcn_rcpf(d.y);
    f32x2 q = t * 0.5307027145f + (-0.7265760135f); q = q * t + 0.7107068705f; q = q * t + (-0.142248368f); q = q * t + 0.127414796f; q = q * t;
    const f32x2 s = (v * v) * (-0.72134752044f);
    f32x2 e; e.x = __builtin_amdgcn_exp2f(s.x); e.y = __builtin_amdgcn_exp2f(s.y);
    const f32x2 m = v * (q * e), r = v - m;
    f32x2 o; o.x = v.x < 0.f ? m.x : r.x; o.y = v.y < 0.f ? m.y : r.y; return o;
}

constexpr int MPROMPT = 32768;
constexpr int NMODC = 9216;
typedef unsigned u32x2v __attribute__((ext_vector_type(2)));
__device__ __forceinline__ float sigm(float x) { return __builtin_amdgcn_rcpf(1.0f + __builtin_amdgcn_exp2f(-1.4426950408889634f * x)); }
__device__ __forceinline__ float gelu_tanh(float x) { const float y = 1.5957691216057308f * (x + 0.044715f * x * x * x); return x * sigm(y); }
__device__ __forceinline__ float bf_lo(unsigned w) { return __uint_as_float(w << 16); }
__device__ __forceinline__ float bf_hi(unsigned w) { return __uint_as_float(w & 0xffff0000u); }
__device__ __forceinline__ int mod_row(int pm, int rloc) { return pm < 128 ? (pm >> 6) : 2 + (rloc >> 5); }

struct EpiUp {
    static constexpr bool PERM = true, AFTER_DRAIN = false;
    bf16_t* ACT; int ldc;
    __device__ __forceinline__ void operator()(const f32x4 (&acc)[2][2][4][2], const Unit& u, int wr, int wc, int fr, int fq) const {
        int fr_ = fr, fq_ = fq; asm volatile("" : "+v"(fr_), "+v"(fq_));
        const int row0 = u.pm * BM + wr * 64 + fr_, ch0 = u.pn * HALF + wc * 32 + 8 * fq_;
#pragma unroll
        for (int ai = 0; ai < 2; ++ai)
#pragma unroll
            for (int m = 0; m < 4; ++m) {
                float o[8];
#pragma unroll
                for (int n = 0; n < 2; ++n)
#pragma unroll
                    for (int i = 0; i < 4; ++i) { const float g = acc[ai][0][m][n][i], up = acc[ai][1][m][n][i]; o[4 * n + i] = g * sigm(g) * up; }
                u32x4 w; w.x = cvt_pk_bf16(o[0], o[1]); w.y = cvt_pk_bf16(o[2], o[3]); w.z = cvt_pk_bf16(o[4], o[5]); w.w = cvt_pk_bf16(o[6], o[7]);
                *(u32x4*)(ACT + (size_t)(row0 + ai * HALF + m * 16) * ldc + ch0) = w;
            }
    }
};
struct EpiRes {
    static constexpr bool PERM = true, AFTER_DRAIN = false;
    const float* resp; const float* ress; float* out; const float* gate; float fac;
    __device__ __forceinline__ void rowgroup(const f32x4 (&v)[2][2], int pn, int ai, int m, int wr, int wc, int fr, int fq) const {
        const int rl = wr * 64 + fr + ai * HALF + m * 16, col0 = pn * BM + wc * 32 + 8 * fq;
        const float* gp = gate + (size_t)(2 + (rl >> 5)) * NMODC + col0; float* obase = out + (size_t)128 * BM * 1024;
#pragma unroll
        for (int bj = 0; bj < 2; ++bj)
#pragma unroll
            for (int n = 0; n < 2; ++n) { const size_t off = (size_t)rl * 1024 + col0 + bj * HALF + 4 * n;
                const f32x4 gv = *(const f32x4*)(gp + bj * HALF + 4 * n), rv = *(const f32x4*)(ress + off);
                *(f32x4*)(obase + off) = rv + (gv * fac) * v[bj][n]; }
    }
    __device__ __forceinline__ void operator()(const f32x4 (&acc)[2][2][4][2], const Unit& u, int wr, int wc, int fr, int fq) const {
        int fr_ = fr, fq_ = fq; asm volatile("" : "+v"(fr_), "+v"(fq_));
        const int rl0 = wr * 64 + fr_, col0 = u.pn * BM + wc * 32 + 8 * fq_;
        const float* rbase = (u.pm < 128) ? resp + (size_t)u.pm * BM * 1024 : ress;
        float* obase = out + (size_t)u.pm * BM * 1024;
#pragma unroll
        for (int ai = 0; ai < 2; ++ai)
#pragma unroll
            for (int m = 0; m < 4; ++m) {
                const int rl = rl0 + ai * HALF + m * 16; const float* gp = gate + (size_t)mod_row(u.pm, rl) * NMODC + col0;
#pragma unroll
                for (int bj = 0; bj < 2; ++bj)
#pragma unroll
                    for (int n = 0; n < 2; ++n) {
                        const size_t off = (size_t)rl * 1024 + col0 + bj * HALF + 4 * n;
                        const f32x4 gv = *(const f32x4*)(gp + bj * HALF + 4 * n), rv = *(const f32x4*)(rbase + off);
                        *(f32x4*)(obase + off) = rv + (gv * fac) * acc[ai][bj][m][n];
                    }
            }
    }
};
struct EpiIn {
    static constexpr bool PERM = true, AFTER_DRAIN = false;
    bf16_t *Q, *K, *V, *U, *G2, *SGA, *SGB; float* G2SS; float* QS;
    float *kout_p, *kout_s, *vout_p, *vout_s;
    const float *gq, *gk; float qscale, eps;
    __device__ __forceinline__ void operator()(const f32x4 (&acc)[2][2][4][2], const Unit& u, int wr, int wc, int fr, int fq) const {
        int fr_ = fr, fq_ = fq; asm volatile("" : "+v"(fr_), "+v"(fq_));
        const int pn = u.pn, rl0 = wr * 64 + fr_; const size_t rg0 = (size_t)u.pm * BM;
        if (pn < 4) {
            const bool isq = pn < 2; const int head = 4 * (pn & 1) + wc; const float* gsrc = isq ? gq : gk;
            f32x4 gv[2][2];
#pragma unroll
            for (int bj = 0; bj < 2; ++bj)
#pragma unroll
                for (int n = 0; n < 2; ++n) { gv[bj][n] = *(const f32x4*)(gsrc + 32 * bj + 8 * fq_ + 4 * n); if (isq) gv[bj][n] = gv[bj][n] * qscale; }
            bf16_t* dst = isq ? Q : K;
#pragma unroll
            for (int ai = 0; ai < 2; ++ai)
#pragma unroll
                for (int m = 0; m < 4; ++m) {
                    float ss = 0.f;
#pragma unroll
                    for (int bj = 0; bj < 2; ++bj)
#pragma unroll
                        for (int n = 0; n < 2; ++n) { const f32x4 x = acc[ai][bj][m][n]; ss += (x[0] * x[0] + x[1] * x[1]) + (x[2] * x[2] + x[3] * x[3]); }
                    ss += __shfl_xor(ss, 16); ss += __shfl_xor(ss, 32);
                    const float rstd = 1.0f / sqrtf(ss * (1.0f / 64.0f) + eps);
                    const int rl = rl0 + ai * HALF + m * 16; const size_t r = rg0 + rl;
#pragma unroll
                    for (int bj = 0; bj < 2; ++bj) {
                        const f32x4 o0 = acc[ai][bj][m][0] * rstd * gv[bj][0], o1 = acc[ai][bj][m][1] * rstd * gv[bj][1];
                        const int c = head * 64 + 32 * bj + 8 * fq_;
                        u32x4 w; w.x = cvt_pk_bf16(o0[0], o0[1]); w.y = cvt_pk_bf16(o0[2], o0[3]); w.z = cvt_pk_bf16(o1[0], o1[1]); w.w = cvt_pk_bf16(o1[2], o1[3]);
                        *(u32x4*)(dst + r * 512 + c) = w;
                        if (isq) { if (u.pm == 128) { float* qp = QS + (size_t)rl * 512 + c; *(f32x4*)qp = o0; *(f32x4*)(qp + 4) = o1; } }
                        else { float* kp = (u.pm < 128) ? kout_p + r * 512 + c : kout_s + (size_t)rl * 512 + c; *(f32x4*)kp = o0; *(f32x4*)(kp + 4) = o1; }
                    }
                    asm volatile("" ::: "memory");
                }
        } else if (pn < 6) {
            const int c0 = (pn - 4) * BM + wc * 32 + 8 * fq_;
#pragma unroll
            for (int ai = 0; ai < 2; ++ai)
#pragma unroll
                for (int m = 0; m < 4; ++m) { const int rl = rl0 + ai * HALF + m * 16; const size_t r = rg0 + rl;
#pragma unroll
                    for (int bj = 0; bj < 2; ++bj) { const f32x4 o0 = acc[ai][bj][m][0], o1 = acc[ai][bj][m][1]; const int c = c0 + bj * HALF;
                        u32x4 w; w.x = cvt_pk_bf16(o0[0], o0[1]); w.y = cvt_pk_bf16(o0[2], o0[3]); w.z = cvt_pk_bf16(o1[0], o1[1]); w.w = cvt_pk_bf16(o1[2], o1[3]);
                        *(u32x4*)(V + r * 512 + c) = w;
                        float* vp = (u.pm < 128) ? vout_p + r * 512 + c : vout_s + (size_t)rl * 512 + c;
                        { *(f32x4*)vp = o0; *(f32x4*)(vp + 4) = o1; } } asm volatile("" ::: "memory"); }
        } else if (pn < 10) {
            const bool isv = pn >= 8; const int t2 = (pn - 6) & 1; const int c0 = t2 * BM + wc * 32 + 8 * fq_; bf16_t* dst = isv ? G2 : U;
#pragma unroll
            for (int ai = 0; ai < 2; ++ai)
#pragma unroll
                for (int m = 0; m < 4; ++m) { const int rl = rl0 + ai * HALF + m * 16; const size_t r = rg0 + rl; float ss = 0.f;
#pragma unroll
                    for (int bj = 0; bj < 2; ++bj) { float o[8];
#pragma unroll
                        for (int n = 0; n < 2; ++n)
#pragma unroll
                            for (int i = 0; i < 4; ++i) { const float g = gelu_tanh(acc[ai][bj][m][n][i]); o[4 * n + i] = g; ss += g * g; }
                        u32x4 w; w.x = cvt_pk_bf16(o[0], o[1]); w.y = cvt_pk_bf16(o[2], o[3]); w.z = cvt_pk_bf16(o[4], o[5]); w.w = cvt_pk_bf16(o[6], o[7]);
                        *(u32x4*)(dst + r * 512 + c0 + bj * HALF) = w; }
                    if (isv) { ss += __shfl_xor(ss, 16); ss += __shfl_xor(ss, 32); if (fq_ == 0) G2SS[r * 8 + t2 * 4 + wc] = ss; } asm volatile("" ::: "memory"); }
        } else {
            const bool isa = pn < 14; const int c0 = ((pn - 10) & 3) * BM + wc * 32 + 8 * fq_; bf16_t* dst = isa ? SGA : SGB;
#pragma unroll
            for (int ai = 0; ai < 2; ++ai)
#pragma unroll
                for (int m = 0; m < 4; ++m) { const size_t r = rg0 + rl0 + ai * HALF + m * 16;
#pragma unroll
                    for (int bj = 0; bj < 2; ++bj) { float o[8];
#pragma unroll
                        for (int n = 0; n < 2; ++n)
#pragma unroll
                            for (int i = 0; i < 4; ++i) o[4 * n + i] = sigm(acc[ai][bj][m][n][i]);
                        u32x4 w; w.x = cvt_pk_bf16(o[0], o[1]); w.y = cvt_pk_bf16(o[2], o[3]); w.z = cvt_pk_bf16(o[4], o[5]); w.w = cvt_pk_bf16(o[6], o[7]);
                        *(u32x4*)(dst + r * 1024 + c0 + bj * HALF) = w;
                        } asm volatile("" ::: "memory"); }
        }
    }
};
struct EpiPartial {
    static constexpr bool PERM = true, AFTER_DRAIN = false;
    float* PART; int nN, Ksub;
    __device__ __forceinline__ void operator()(const f32x4 (&acc)[2][2][4][2], const Unit& u, int wr, int wc, int fr, int fq) const {
        int tid_ = (wr * 4 + wc) * 64 + fq * 16 + fr; asm volatile("" : "+v"(tid_));
        f32x4* dst = (f32x4*)PART + (size_t)((u.koff >> 8) * 4 + u.pn) * 32 * 512 + tid_;
#pragma unroll
        for (int ai = 0; ai < 2; ++ai)
#pragma unroll
            for (int bj = 0; bj < 2; ++bj)
#pragma unroll
                for (int m = 0; m < 4; ++m)
#pragma unroll
                    for (int n = 0; n < 2; ++n) { *dst = acc[ai][bj][m][n]; dst += 512; asm volatile("" : "+v"(dst) :: "memory"); }
        asm volatile("" ::: "memory");
    }
};
template <int NN, int KSHIFT> struct EpiPartialT {
    static constexpr bool PERM = true, AFTER_DRAIN = false;
    float* PART;
    __device__ __forceinline__ void operator()(const f32x4 (&acc)[2][2][4][2], const Unit& u, int wr, int wc, int fr, int fq) const {
        int tid_ = (wr * 4 + wc) * 64 + fq * 16 + fr; asm volatile("" : "+v"(tid_));
        f32x4* dst = (f32x4*)PART + (size_t)((u.koff >> KSHIFT) * NN + u.pn) * 32 * 512 + tid_;
#pragma unroll
        for (int ai = 0; ai < 2; ++ai)
#pragma unroll
            for (int bj = 0; bj < 2; ++bj)
#pragma unroll
                for (int m = 0; m < 4; ++m)
#pragma unroll
                    for (int n = 0; n < 2; ++n) { *dst = acc[ai][bj][m][n]; dst += 512; asm volatile("" : "+v"(dst) :: "memory"); }
    }
};
template <class Epi> __device__ __forceinline__ void reduce_partials(const float* PART, int nN, int nS, int pn, int pm_out, const Epi& E, int wv) {
    int tid = (wv << 6) | lane_id_(); asm volatile("" : "+v"(tid));
    const int wid = __builtin_amdgcn_readfirstlane(tid >> 6), lane = tid & 63, wr = wid >> 2, wc = wid & 3, fr = lane & 15, fq = lane >> 4;
    f32x4 acc[2][2][4][2];
#pragma unroll
    for (int ai = 0; ai < 2; ++ai)
#pragma unroll
        for (int bj = 0; bj < 2; ++bj)
#pragma unroll
            for (int m = 0; m < 4; ++m)
#pragma unroll
                for (int n = 0; n < 2; ++n) acc[ai][bj][m][n] = (f32x4){0.f, 0.f, 0.f, 0.f};
#pragma unroll 1
    for (int s = 0; s < nS; ++s) { const f32x4* src = (const f32x4*)PART + (size_t)(s * nN + pn) * 32 * 512 + tid;
#pragma unroll
        for (int ai = 0; ai < 2; ++ai) {
            f32x4 t[2][4][2];
#pragma unroll
            for (int bj = 0; bj < 2; ++bj)
#pragma unroll
                for (int m = 0; m < 4; ++m)
#pragma unroll
                    for (int n = 0; n < 2; ++n) { t[bj][m][n] = *src; src += 512; asm volatile("" : "+v"(src)); }
#pragma unroll
            for (int bj = 0; bj < 2; ++bj)
#pragma unroll
                for (int m = 0; m < 4; ++m)
#pragma unroll
                    for (int n = 0; n < 2; ++n) acc[ai][bj][m][n] += t[bj][m][n];
            asm volatile("" ::: "memory"); } }
    Unit u; u.pm = pm_out; u.pn = pn; u.koff = 0;
    E(acc, u, wr, wc, fr, fq);
}
template <int NS, class Epi> __device__ __forceinline__ void reduce_rowgroup(const float* PART, int pn, int rg, const Epi& E, int wv) {
    int tid = (wv << 6) | lane_id_(); asm volatile("" : "+v"(tid));
    const int wid = __builtin_amdgcn_readfirstlane(tid >> 6), lane = tid & 63, wr = wid >> 2, wc = wid & 3, fr = lane & 15, fq = lane >> 4;
    const int ai = rg >> 2, m = rg & 3;
    f32x4 t[NS][2][2];
#pragma unroll
    for (int s = 0; s < NS; ++s)
#pragma unroll
        for (int bj = 0; bj < 2; ++bj)
#pragma unroll
            for (int n = 0; n < 2; ++n) t[s][bj][n] = *((const f32x4*)PART + ((size_t)(s * 4 + pn) * 32 + (((ai * 2 + bj) * 4 + m) * 2 + n)) * 512 + tid);
    f32x4 v[2][2];
#pragma unroll
    for (int bj = 0; bj < 2; ++bj)
#pragma unroll
        for (int n = 0; n < 2; ++n) { v[bj][n] = t[0][bj][n];
#pragma unroll
            for (int s = 1; s < NS; ++s) v[bj][n] += t[s][bj][n]; }
    E.rowgroup(v, pn, ai, m, wr, wc, fr, fq);
}
template <int MODE> struct EpiMix {
    static constexpr bool PERM = true, AFTER_DRAIN = false;
    bf16_t* T; const bf16_t* T2;
    __device__ __forceinline__ void one(size_t off, const f32x4 a0, const f32x4 a1) const {
        float o[8] = {a0[0], a0[1], a0[2], a0[3], a1[0], a1[1], a1[2], a1[3]};
        if (MODE >= 1) {
            const u32x4 t = *(const u32x4*)(T + off);
            const float tv[8] = {bf_lo(t.x), bf_hi(t.x), bf_lo(t.y), bf_hi(t.y), bf_lo(t.z), bf_hi(t.z), bf_lo(t.w), bf_hi(t.w)};
            if (MODE == 1) {
#pragma unroll
                for (int i = 0; i < 8; ++i) o[i] = sigm(o[i]) * tv[i];
            } else {
                const u32x4 s2 = *(const u32x4*)(T2 + off);
                const float sv[8] = {bf_lo(s2.x), bf_hi(s2.x), bf_lo(s2.y), bf_hi(s2.y), bf_lo(s2.z), bf_hi(s2.z), bf_lo(s2.w), bf_hi(s2.w)};
#pragma unroll
                for (int i = 0; i < 8; ++i) o[i] = tv[i] + sigm(o[i]) * sv[i];
            }
        }
        u32x4 w; w.x = cvt_pk_bf16(o[0], o[1]); w.y = cvt_pk_bf16(o[2], o[3]); w.z = cvt_pk_bf16(o[4], o[5]); w.w = cvt_pk_bf16(o[6], o[7]);
        *(u32x4*)(T + off) = w;
    }
    __device__ __forceinline__ void operator()(const f32x4 (&acc)[2][2][4][2], const Unit& u, int wr, int wc, int fr, int fq) const {
        int fr_ = fr, fq_ = fq; asm volatile("" : "+v"(fr_), "+v"(fq_));
        const size_t row0 = (size_t)u.pm * BM + wr * 64 + fr_; const int col0 = u.pn * BM + wc * 32 + 8 * fq_;
#pragma unroll
        for (int ai = 0; ai < 2; ++ai)
#pragma unroll
            for (int m = 0; m < 4; ++m) {
#pragma unroll
                for (int bj = 0; bj < 2; ++bj) one((row0 + ai * HALF + m * 16) * 1024 + col0 + bj * HALF, acc[ai][bj][m][0], acc[ai][bj][m][1]);
                asm volatile("" ::: "memory");
            }
    }
    __device__ __forceinline__ void rowgroup(const f32x4 (&v)[2][2], int pn, int ai, int m, int wr, int wc, int fr, int fq) const {
        const size_t row = (size_t)(wr * 64 + fr + ai * HALF + m * 16); const int col0 = pn * BM + wc * 32 + 8 * fq;
#pragma unroll
        for (int bj = 0; bj < 2; ++bj) one(row * 1024 + col0 + bj * HALF, v[bj][0], v[bj][1]);
    }
};
template <class Epi, class Sched, bool ALIGN_EPI = false, bool SP2 = false>
__device__ __forceinline__ void gemm_phase(PG8_LAS unsigned char* lds, const Gemm g, const Sched& S, const Epi& E, int wv) {
    int tid = (wv << 6) | lane_id_(); asm volatile("" : "+v"(tid));
    const int wid = __builtin_amdgcn_readfirstlane(tid >> 6), lane = tid & 63, wr = wid >> 2, wc = wid & 3, fr = lane & 15, fq = lane >> 4;
    const int K = g.Kp, nt = g.K / BK;
    unsigned voffA[2], voffB[2];
#pragma unroll
    for (int i = 0; i < 2; ++i) { int R, C; stage_rc(tid * 16 + i * 8192, R, C); const int Rb = Epi::PERM ? ((R & ~31) + perm32(R & 31)) : R;
        voffA[i] = (unsigned)(R * K + C) * 2u; voffB[i] = (unsigned)(Rb * K + C) * 2u; }
    const size_t kstep = (size_t)(BK * 2);
    const size_t hstep = (size_t)HALF * K * 2;
    const size_t tstep = 2 * hstep;
    const unsigned ldsw = (unsigned)wid * 1024u;
    const int aoff = lds_byte(wr * 64 + fr, fq * 8), boff = lds_byte(wc * 32 + fr, fq * 8);
#define PG8_SA(b, h) (((b) * 2 + (h)) * HTB)
#define PG8_SB(b, h) ((4 + (b) * 2 + (h)) * HTB)
#define PG8_STAGE(bufoff, gbase, voff) do { _Pragma("unroll") for (int _i = 0; _i < 2; ++_i) \
        __builtin_amdgcn_global_load_lds((const unsigned*)((const char*)(gbase) + (voff)[_i]), (PG8_LAS unsigned*)(lds + (bufoff) + ldsw + _i * 8192), 16, 0, 0); } while (0)
#define PG8_LDA(dst, b, h) do { _Pragma("unroll") for (int m = 0; m < 4; ++m) _Pragma("unroll") for (int k = 0; k < 2; ++k) dst[m][k] = *(const PG8_LAS bf16x8*)(lds + PG8_SA(b, h) + aoff + m * 2048 + k * 1024); } while (0)
#define PG8_LDB(dst, b, h) do { _Pragma("unroll") for (int n = 0; n < 2; ++n) _Pragma("unroll") for (int k = 0; k < 2; ++k) dst[n][k] = *(const PG8_LAS bf16x8*)(lds + PG8_SB(b, h) + boff + n * 2048 + k * 1024); } while (0)
#define PG8_MMA(ai, bj, At, Bt) do { __builtin_amdgcn_s_setprio(1); _Pragma("unroll") for (int m = 0; m < 4; ++m) _Pragma("unroll") for (int n = 0; n < 2; ++n) _Pragma("unroll") for (int k = 0; k < 2; ++k) \
        acc[ai][bj][m][n] = __builtin_amdgcn_mfma_f32_16x16x32_bf16(Bt[n][k], At[m][k], acc[ai][bj][m][n], 0, 0, 0); __builtin_amdgcn_s_setprio(0); } while (0)
#define PG8_WAIT_V(n) asm volatile("s_waitcnt vmcnt(" #n ")" ::: "memory")
#define PG8_WAIT_L(n) asm volatile("s_waitcnt lgkmcnt(" #n ")" ::: "memory")
#define PG8_BAR __builtin_amdgcn_s_barrier()
#define PG8_SCHED __builtin_amdgcn_sched_barrier(0)
    Unit cur, nxt; int ui = 0;
    if (!S.next(0, cur)) return;
    f32x4 acc[2][2][4][2];
#pragma unroll
    for (int a = 0; a < 2; ++a)
#pragma unroll
        for (int b = 0; b < 2; ++b)
#pragma unroll
            for (int m = 0; m < 4; ++m)
#pragma unroll
                for (int n = 0; n < 2; ++n) acc[a][b][m][n] = (f32x4){0.f, 0.f, 0.f, 0.f};
    bf16x8 At[4][2], B0[2][2], B1[2][2];
    const char* cA = (const char*)g.A + (size_t)cur.pm * tstep + (size_t)cur.koff * 2; const char* cB = (const char*)g.Bt + (size_t)cur.pn * tstep + (size_t)cur.koff * 2;
    S.a_ready(cur);
    if constexpr (SP2) {
        PG8_STAGE(PG8_SB(0, 0), cB, voffB); PG8_STAGE(PG8_SB(0, 1), cB + hstep, voffB); PG8_STAGE(PG8_SA(0, 0), cA, voffA); PG8_STAGE(PG8_SA(0, 1), cA + hstep, voffA);
        if (wr == 1) PG8_BAR;
        PG8_WAIT_V(2); PG8_BAR;
        PG8_STAGE(PG8_SB(1, 0), cB + kstep, voffB); PG8_STAGE(PG8_SA(1, 0), cA + kstep, voffA); PG8_STAGE(PG8_SB(1, 1), cB + hstep + kstep, voffB);
        PG8_WAIT_V(6); PG8_BAR;
    } else {
        PG8_STAGE(PG8_SB(0, 0), cB, voffB); PG8_STAGE(PG8_SA(0, 0), cA, voffA); PG8_STAGE(PG8_SB(0, 1), cB + hstep, voffB); PG8_STAGE(PG8_SA(0, 1), cA + hstep, voffA);
        if (wr == 1) PG8_BAR;
        PG8_WAIT_V(4); PG8_BAR;
        PG8_STAGE(PG8_SB(1, 0), cB + kstep, voffB); PG8_STAGE(PG8_SA(1, 0), cA + kstep, voffA); PG8_STAGE(PG8_SB(1, 1), cB + hstep + kstep, voffB);
        PG8_WAIT_V(6); PG8_BAR;
    }
    for (;;) {
        const bool has_next = S.next(ui + 1, nxt);
        const char* nA = has_next ? (const char*)g.A + (size_t)nxt.pm * tstep + (size_t)nxt.koff * 2 : cA; const char* nB = has_next ? (const char*)g.Bt + (size_t)nxt.pn * tstep + (size_t)nxt.koff * 2 : cB;
        for (int t = 0; t < nt; t += 2) {
            const bool last = (t == nt - 2);
            const char* a1 = cA + (size_t)(t + 1) * kstep;
            const char* a2 = last ? nA : cA + (size_t)(t + 2) * kstep; const char* b2 = last ? nB : cB + (size_t)(t + 2) * kstep;
            const char* a3 = a2 + kstep; const char* b3 = b2 + kstep;
            if (last && has_next) S.a_ready(nxt);
            if constexpr (SP2) {
            PG8_LDB(B0, 0, 0); PG8_LDB(B1, 0, 1); PG8_SCHED; PG8_LDA(At, 0, 0); PG8_STAGE(PG8_SA(1, 1), a1 + hstep, voffA);
            PG8_WAIT_V(8); PG8_WAIT_L(0); PG8_BAR; PG8_MMA(0, 0, At, B0); PG8_MMA(0, 1, At, B1); PG8_BAR; PG8_SCHED;
            PG8_LDA(At, 0, 1); PG8_STAGE(PG8_SB(0, 0), b2, voffB); PG8_STAGE(PG8_SB(0, 1), b2 + hstep, voffB); PG8_STAGE(PG8_SA(0, 0), a2, voffA);
            PG8_WAIT_V(8); PG8_WAIT_L(0); PG8_BAR; PG8_MMA(1, 0, At, B0); PG8_MMA(1, 1, At, B1); PG8_BAR; PG8_SCHED;
            PG8_LDB(B0, 1, 0); PG8_LDB(B1, 1, 1); PG8_SCHED; PG8_LDA(At, 1, 0); PG8_STAGE(PG8_SA(0, 1), a2 + hstep, voffA);
            PG8_WAIT_V(8); PG8_WAIT_L(0); PG8_BAR; PG8_MMA(0, 0, At, B0); PG8_MMA(0, 1, At, B1); PG8_BAR; PG8_SCHED;
            PG8_LDA(At, 1, 1); PG8_STAGE(PG8_SB(1, 0), b3, voffB); PG8_STAGE(PG8_SB(1, 1), b3 + hstep, voffB); PG8_STAGE(PG8_SA(1, 0), a3, voffA);
            PG8_WAIT_V(8); PG8_WAIT_L(0); PG8_BAR; PG8_MMA(1, 0, At, B0); PG8_MMA(1, 1, At, B1); PG8_BAR; PG8_SCHED;
            } else {
            PG8_LDB(B0, 0, 0); PG8_SCHED; PG8_LDA(At, 0, 0); PG8_STAGE(PG8_SA(1, 1), a1 + hstep, voffA);
            PG8_WAIT_L(8); PG8_BAR; PG8_WAIT_L(0); PG8_MMA(0, 0, At, B0); PG8_BAR; PG8_SCHED;
            PG8_LDB(B1, 0, 1); PG8_STAGE(PG8_SB(0, 0), b2, voffB);
            PG8_BAR; PG8_WAIT_L(0); PG8_MMA(0, 1, At, B1); PG8_BAR;
            PG8_LDA(At, 0, 1); PG8_STAGE(PG8_SA(0, 0), a2, voffA);
            PG8_BAR; PG8_WAIT_L(0); PG8_MMA(1, 0, At, B0); PG8_BAR; PG8_SCHED;
            PG8_STAGE(PG8_SB(0, 1), b2 + hstep, voffB);
            PG8_WAIT_V(6); PG8_BAR; PG8_MMA(1, 1, At, B1); PG8_BAR;
            PG8_LDB(B0, 1, 0); PG8_SCHED; PG8_LDA(At, 1, 0); PG8_STAGE(PG8_SA(0, 1), a2 + hstep, voffA);
            PG8_WAIT_L(8); PG8_BAR; PG8_WAIT_L(0); PG8_MMA(0, 0, At, B0); PG8_BAR; PG8_SCHED;
            PG8_LDB(B1, 1, 1); PG8_STAGE(PG8_SB(1, 0), b3, voffB);
            PG8_BAR; PG8_WAIT_L(0); PG8_MMA(0, 1, At, B1); PG8_BAR;
            PG8_LDA(At, 1, 1); PG8_STAGE(PG8_SA(1, 0), a3, voffA);
            PG8_BAR; PG8_WAIT_L(0); PG8_MMA(1, 0, At, B0); PG8_BAR; PG8_SCHED;
            PG8_STAGE(PG8_SB(1, 1), b3 + hstep, voffB);
            PG8_WAIT_V(6); PG8_BAR; PG8_MMA(1, 1, At, B1); PG8_BAR;
            }
        }
        if constexpr (ALIGN_EPI) { if (wr == 0) PG8_BAR; }
        if constexpr (!Epi::AFTER_DRAIN) { E(acc, cur, wr, wc, fr, fq); S.done(cur); }
        if (!has_next) break;
#pragma unroll
        for (int a = 0; a < 2; ++a)
#pragma unroll
            for (int b = 0; b < 2; ++b)
#pragma unroll
                for (int m = 0; m < 4; ++m)
#pragma unroll
                    for (int n = 0; n < 2; ++n) acc[a][b][m][n] = (f32x4){0.f, 0.f, 0.f, 0.f};
        cur = nxt; cA = nA; cB = nB; ++ui;
        if constexpr (ALIGN_EPI) { if (wr == 1) PG8_BAR; }
    }
    PG8_WAIT_V(0);
    if constexpr (!ALIGN_EPI) { if (wr == 0) PG8_BAR; }
    PG8_BAR;
    if constexpr (Epi::AFTER_DRAIN) { E.fused(acc, cur, wr, wc, fr, fq, lds, wid, lane); S.done(cur); }
#undef PG8_SA
#undef PG8_SB
#undef PG8_STAGE
#undef PG8_LDA
#undef PG8_LDB
#undef PG8_MMA
#undef PG8_WAIT_V
#undef PG8_WAIT_L
#undef PG8_BAR
#undef PG8_SCHED
}

template <class Epi, class Sched>
__device__ __forceinline__ void naive_phase(const Gemm g, const Sched& S, const Epi& E) {
    int tid = threadIdx.x; asm volatile("" : "+v"(tid));
    const int wid = __builtin_amdgcn_readfirstlane(tid >> 6), lane = tid & 63, wr = wid >> 2, wc = wid & 3, fr = lane & 15, fq = lane >> 4;
    Unit u;
#pragma unroll 1
    for (int ui = 0; S.next(ui, u); ++ui) {
        f32x4 acc[2][2][4][2];
#pragma unroll
        for (int ai = 0; ai < 2; ++ai)
#pragma unroll
            for (int m = 0; m < 4; ++m) {
                const bf16_t* arow = g.A + (size_t)(u.pm * BM + ai * HALF + wr * 64 + m * 16 + fr) * g.Kp;
#pragma unroll
                for (int bj = 0; bj < 2; ++bj)
#pragma unroll
                    for (int n = 0; n < 2; ++n)
#pragma unroll
                        for (int i = 0; i < 4; ++i) {
                            const bf16_t* brow = g.Bt + (size_t)(u.pn * BM + bj * HALF + wc * 32 + 8 * fq + 4 * n + i) * g.Kp;
                            float s = 0.f;
#pragma unroll 1
                            for (int k = 0; k < g.K; k += 8) { const u32x4 a = *(const u32x4*)(arow + k), b = *(const u32x4*)(brow + k);
                                s += bf_lo(a.x) * bf_lo(b.x) + bf_hi(a.x) * bf_hi(b.x) + bf_lo(a.y) * bf_lo(b.y) + bf_hi(a.y) * bf_hi(b.y)
                                   + bf_lo(a.z) * bf_lo(b.z) + bf_hi(a.z) * bf_hi(b.z) + bf_lo(a.w) * bf_lo(b.w) + bf_hi(a.w) * bf_hi(b.w); }
                            acc[ai][bj][m][n][i] = s;
                        }
            }
        E(acc, u, wr, wc, fr, fq);
    }
    __syncthreads();
}
}
#include <hip/hip_bf16.h>
#include <cmath>
namespace attn_body {
using bf16=__hip_bfloat16;
using bf16x8=__attribute__((ext_vector_type(8)))short;
using s16x4=__attribute__((ext_vector_type(4)))short;
using f32x16=__attribute__((ext_vector_type(16)))float;
using u32x4=__attribute__((ext_vector_type(4)))unsigned;
using f32x4_t=__attribute__((ext_vector_type(4)))float;
constexpr int BATCH=2,NHEAD=8,SEQ=16384,D=64,DM=NHEAD*D;
constexpr int NW=8,QBLK=32,QB=QBLK*NW,KVBLK=64,NQB=SEQ/QB;
constexpr int ATTN_PITCH=DM, ATTN_UNIT_ROWS=QB;
__device__ __forceinline__ int crow(int r,int hi){return (r&3)+8*(r>>2)+4*hi;}
#define SBAR() __builtin_amdgcn_sched_barrier(0)
__device__ __forceinline__ void cmask(f32x16&p0,f32x16&p1,int jb,int qrel,int hi){
  const float NEG=-INFINITY; int kb=64*jb+4*hi;
  #pragma unroll
  for(int r=0;r<16;++r){int kv=kb+(r&3)+8*(r>>2); if(kv>qrel)p0[r]=NEG; if(kv+32>qrel)p1[r]=NEG;}
}

constexpr int NSLOT=3, SLOTB=8192;
constexpr int LDS_K=0, LDS_V=NSLOT*SLOTB, LDS_WS=2*NSLOT*SLOTB, LDS_OST=LDS_WS+NW*64*4, LDS_BYTES=LDS_OST+NW*4096, LDS_BIAS=LDS_BYTES, LDS_TOTAL=LDS_BIAS+SEQ*4;
constexpr float C2=0.125f*1.4426950408889634f;
__device__ __forceinline__ void glds16(const void*gsrc,unsigned lds_dst){unsigned keep;
  asm volatile("s_mov_b32 %0, m0\n\ts_mov_b32 m0, %2\n\ts_nop 0\n\tglobal_load_lds_dwordx4 %1, off\n\ts_mov_b32 m0, %0":"=&s"(keep):"v"(gsrc),"s"(lds_dst):"memory");}
__device__ __forceinline__ float max3f(float a,float b,float c){float r;asm("v_max3_f32 %0, %1, %2, %3":"=v"(r):"v"(a),"v"(b),"v"(c));return r;}
__device__ __forceinline__ float max2f(float a,float b){float r;asm("v_max_f32_e32 %0, %1, %2":"=v"(r):"v"(a),"v"(b));return r;}
__device__ __forceinline__ float fadd_s(float a,float b){float r;asm("v_add_f32_e32 %0, %1, %2":"=v"(r):"v"(a),"v"(b));return r;}
__device__ __forceinline__ float fsub_s(float a,float b){float r;asm("v_sub_f32_e32 %0, %1, %2":"=v"(r):"v"(a),"v"(b));return r;}
typedef float f32x2_t __attribute__((ext_vector_type(2))); typedef __bf16 bf16x2_t __attribute__((ext_vector_type(2)));
__device__ __forceinline__ unsigned cvtpk_s(float lo,float hi){f32x2_t v={lo,hi};bf16x2_t b=__builtin_convertvector(v,bf16x2_t);return __builtin_bit_cast(unsigned,b);}
#define WAIT_BAR(N) asm volatile("s_waitcnt vmcnt(" #N ") lgkmcnt(0)\n\ts_barrier":::"memory")

__device__ __forceinline__ void qkt(f32x16&p0,f32x16&p1,const char*Kslot,const bf16x8*qr,int r32,int hi){
  const char*kb=Kslot+hi*1024+r32*16;
  #pragma unroll
  for(int d0=0;d0<4;++d0){
    const bf16x8 b0=*reinterpret_cast<const bf16x8*>(kb+d0*2048);
    const bf16x8 b1=*reinterpret_cast<const bf16x8*>(kb+d0*2048+512);
    p0=__builtin_amdgcn_mfma_f32_32x32x16_bf16(b0,qr[d0],p0,0,0,0);p1=__builtin_amdgcn_mfma_f32_32x32x16_bf16(b1,qr[d0],p1,0,0,0);}
}
typedef __attribute__((address_space(3))) const char* lds_cptr;
typedef short v4i16_t __attribute__((ext_vector_type(4)));
__device__ __forceinline__ void kload8(bf16x8*kf,lds_cptr kp){
  kf[0]=*(const __attribute__((address_space(3))) bf16x8*)(kp);      kf[1]=*(const __attribute__((address_space(3))) bf16x8*)(kp+512);
  kf[2]=*(const __attribute__((address_space(3))) bf16x8*)(kp+2048); kf[3]=*(const __attribute__((address_space(3))) bf16x8*)(kp+2560);
  kf[4]=*(const __attribute__((address_space(3))) bf16x8*)(kp+4096); kf[5]=*(const __attribute__((address_space(3))) bf16x8*)(kp+4608);
  kf[6]=*(const __attribute__((address_space(3))) bf16x8*)(kp+6144); kf[7]=*(const __attribute__((address_space(3))) bf16x8*)(kp+6656);
}
__device__ __forceinline__ void kload2(bf16x8*kf,lds_cptr kp,int j){ kf[2*j]=*(const __attribute__((address_space(3))) bf16x8*)(kp+j*2048); kf[2*j+1]=*(const __attribute__((address_space(3))) bf16x8*)(kp+j*2048+512); }
__device__ __forceinline__ s16x4 vtr(lds_cptr p){ return __builtin_bit_cast(s16x4,__builtin_amdgcn_ds_read_tr16_b64_v4i16((__attribute__((address_space(3))) v4i16_t*)p)); }
__device__ __forceinline__ float rowmax(const f32x16&p0,const f32x16&p1){
  float a=max3f(p0[0],p0[1],p1[0]),b=max3f(p0[2],p0[3],p1[1]);a=max3f(a,p1[2],p1[3]);
  #pragma unroll
  for(int r=4;r<16;r+=4){a=max3f(a,p0[r],p0[r+1]);b=max3f(b,p0[r+2],p0[r+3]);a=max3f(a,p1[r],p1[r+1]);b=max3f(b,p1[r+2],p1[r+3]);}
  const float m=max2f(a,b);
  auto rr=__builtin_amdgcn_permlane32_swap(__float_as_uint(m),__float_as_uint(m),false,false);
  return max2f(__uint_as_float(rr[0]),__uint_as_float(rr[1]));
}
__device__ __forceinline__ void pv(f32x16*o,int vb,bf16x8 pa0,bf16x8 pa1,bf16x8 pa2,bf16x8 pa3){
  #pragma unroll
  for(int d0=0;d0<2;++d0){s16x4 lo[4],hi[4];
    #pragma unroll
    for(int ks=0;ks<4;++ks){
      asm volatile("ds_read_b64_tr_b16 %0,%1 offset:%c2":"=&v"(lo[ks]):"v"(vb),"i"(d0*4096+ks*1024):"memory");
      asm volatile("ds_read_b64_tr_b16 %0,%1 offset:%c2":"=&v"(hi[ks]):"v"(vb),"i"(d0*4096+ks*1024+512):"memory");}
    asm volatile("s_waitcnt lgkmcnt(0)":::"memory");SBAR();
    #define PK(k) (bf16x8){lo[k][0],lo[k][1],lo[k][2],lo[k][3],hi[k][0],hi[k][1],hi[k][2],hi[k][3]}
    o[d0]=__builtin_amdgcn_mfma_f32_32x32x16_bf16(pa0,PK(0),o[d0],0,0,0);
    o[d0]=__builtin_amdgcn_mfma_f32_32x32x16_bf16(pa1,PK(1),o[d0],0,0,0);
    o[d0]=__builtin_amdgcn_mfma_f32_32x32x16_bf16(pa2,PK(2),o[d0],0,0,0);
    o[d0]=__builtin_amdgcn_mfma_f32_32x32x16_bf16(pa3,PK(3),o[d0],0,0,0);
    #undef PK
  }
}

#ifndef ATTN_STORE16
#define ATTN_STORE16(p,v) (*(u32x4*)(p)=(v))
#endif
template<int THRL> __device__ __forceinline__ void attn_unit(int b,int h,int qb,int ts,const float*__restrict__ cl2,const bf16*Q,const bf16*__restrict__ K,const bf16*__restrict__ V,bf16*O,char*shm,int wv){
  int tid=(wv<<6)|lane_id_(); asm volatile("":"+v"(tid)); const int lane=tid&63,r32=lane&31,hi=lane>>5; const int wid=__builtin_amdgcn_readfirstlane(tid>>6);
  const long rowbase=(long)b*SEQ; const int q0=qb*QB;
  const bf16*Qw=Q+(rowbase+q0+wid*QBLK)*DM+h*D;
  const bf16*Kh=K+(rowbase+(long)ts*KVBLK)*DM+h*D,*Vh=V+(rowbase+(long)ts*KVBLK)*DM+h*D;
  const unsigned lds0=(unsigned)(uintptr_t)shm;
  float*wsf=(float*)(shm+LDS_WS)+wid*64;
  const bf16*ksrc=Kh+(long)lane*DM+wid*8;
  const bf16*vsrc=Vh+(long)(16*(wid&3)+(lane>>2))*DM+(wid>>2)*32+(lane&3)*8;
  const unsigned kdst=lds0+LDS_K+wid*1024, vdst=lds0+LDS_V+wid*1024;
  #define DMA_K(t,slot) glds16(ksrc+(long)(t)*KVBLK*DM,(unsigned)__builtin_amdgcn_readfirstlane(kdst+(slot)))
  #define DMA_V(t,slot) glds16(vsrc+(long)(t)*KVBLK*DM,(unsigned)__builtin_amdgcn_readfirstlane(vdst+(slot)))
  const int vb0=(int)(lds0+LDS_V)+((lane>>4)&1)*32+(lane&3)*8+(4*hi+((lane&15)>>2))*64;
  const char*Kbase=shm+LDS_K; bf16x8 kf[8];
  const lds_cptr shm3=(lds_cptr)shm; const lds_cptr kp0=shm3+LDS_K+hi*1024+r32*16; const lds_cptr vp0=shm3+LDS_V+((lane>>4)&1)*32+(lane&3)*8+(4*hi+((lane&15)>>2))*64;
  const int NT=(q0+QB)/KVBLK-ts;
  DMA_K(0,0);DMA_V(0,0);DMA_K(1,SLOTB);
  bf16x8 qr[4];
  #pragma unroll
  for(int d0=0;d0<4;++d0)qr[d0]=*reinterpret_cast<const bf16x8*>(&Qw[(long)r32*DM+d0*16+hi*8]);
  float mhat=0.f,l_reg=0.f;f32x16 o[2];o[0]=f32x16{};o[1]=f32x16{};
  typedef __attribute__((address_space(3))) const f32x4_t* lds_f4p; const lds_f4p biasp=(lds_f4p)((lds_cptr)shm+LDS_BIAS)+hi;
  #define BIASINIT(C0,C1,t) do{ _Pragma("unroll") for(int g_=0;g_<4;++g_){ const f32x4_t b0_=biasp[(t)*16+2*g_], b1_=biasp[(t)*16+8+2*g_]; \
      _Pragma("unroll") for(int i_=0;i_<4;++i_){ C0[4*g_+i_]=b0_[i_]-mhat; C1[4*g_+i_]=b1_[i_]-mhat; } } }while(0)
  const int qrel=wid*QBLK+r32;
  #define CMASK(P0,P1,t) do{int jb_=(t)-(NT-4); if(jb_>=0)cmask(P0,P1,jb_,qrel,hi);}while(0)
  bool resc=false;
  #define START(P0,P1) do{ const float rm=rowmax(P0,P1); resc=false; \
    { const float dl=rm; mhat=fadd_s(mhat,dl); \
      _Pragma("unroll") for(int r=0;r<16;++r){P0[r]=fsub_s(P0[r],dl);P1[r]=fsub_s(P1[r],dl);} } \
    _Pragma("unroll") for(int r=0;r<16;++r)P0[r]=__builtin_amdgcn_exp2f(P0[r]); }while(0)
  #define RESC() do{ if(resc){ asm volatile("s_waitcnt lgkmcnt(0)":::"memory"); \
      _Pragma("unroll") for(int d_=0;d_<2;++d_) _Pragma("unroll") for(int r=0;r<16;++r)o[d_][r]*=wsf[crow(r,hi)]; } }while(0)
  f32x16 pA0,pA1,pB0,pB1;
  int sl_prev=0,sl_cur=0,sl_next=SLOTB;
  #define ROT() do{sl_prev=sl_cur;sl_cur=sl_next;sl_next=(sl_next==(NSLOT-1)*SLOTB)?0:sl_next+SLOTB;}while(0)
  {
    const float cref=cl2[q0]; const f32x4_t*src=(const f32x4_t*)(cl2+ts*KVBLK); __attribute__((address_space(3))) f32x4_t*dst=(__attribute__((address_space(3))) f32x4_t*)((__attribute__((address_space(3))) char*)shm+LDS_BIAS);
    for(int i=tid;i<NT*16;i+=NW*64){ const f32x4_t c4=src[i]; dst[i]=(f32x4_t){cref-c4[0],cref-c4[1],cref-c4[2],cref-c4[3]}; } }
  DMA_K(2,2*SLOTB);
  WAIT_BAR(3);
  BIASINIT(pA0,pA1,0); qkt(pA0,pA1,Kbase,qr,r32,hi);asm volatile("s_nop 15\n\ts_nop 7":"+v"(pA0),"+v"(pA1));CMASK(pA0,pA1,0);
  START(pA0,pA1);
  _Pragma("unroll") for(int r=0;r<16;++r)pA1[r]=__builtin_amdgcn_exp2f(pA1[r]);
  WAIT_BAR(0);
  DMA_K(3,0);DMA_V(1,SLOTB);
  ROT();
  kload8(kf,kp0+sl_cur);
  WAIT_BAR(2);
  s16x4 vlo[8],vhi[8]; u32x4 pw0,pw1,pw2,pw3;
  #define PKW(P,B) cvtpk_s(P[B],P[B+1])
  #define PAF(k) __builtin_bit_cast(bf16x8,pw##k)
  #define VFR(i) (bf16x8){vlo[i][0],vlo[i][1],vlo[i][2],vlo[i][3],vhi[i][0],vhi[i][1],vhi[i][2],vhi[i][3]}
  #define PIN(x) asm volatile("":"+v"(x))
  #define MX3(a,b,c) __builtin_fmaxf(__builtin_fmaxf((a),(b)),(c))
  #define GAPA(MF,A0,A1,A2,A3,W0,W1,PW) do{ MF; sacc+=A0; sacc+=A1; sacc+=A2; sacc+=A3; PIN(sacc); W0; W1; PIN(PW); SBAR(); }while(0)
  #define EX(v) __builtin_amdgcn_exp2f(v)
  #define GAPB(MF,X,B) do{ MF; X[B]=EX(X[B]); X[B+1]=EX(X[B+1]); X[B+2]=EX(X[B+2]); X[B+3]=EX(X[B+3]); PIN(X); SBAR(); }while(0)
  #define VRD(i) do{ vlo[i]=vtr(vp_+(((i)>>2)*4096+((i)&3)*1024)); vhi[i]=vtr(vp_+(((i)>>2)*4096+((i)&3)*1024+512)); }while(0)
  #define KRD(G,j) do{ if(G){ kload2(kf,kp0+sl_next,j); SBAR(); } }while(0)
  #define STEP(C0,C1,P0,P1,t,GK,GV,GL) do{ SBAR(); BIASINIT(C0,C1,t); SBAR(); \
    const lds_cptr vp_=vp0+sl_prev; \
    VRD(0); SBAR(); float sacc=(P0[0]+P0[1]); \
    GAPA(C0=__builtin_amdgcn_mfma_f32_32x32x16_bf16(kf[0],qr[0],C0,0,0,0), P0[2],P0[3],P0[4],P0[5],     pw0[0]=PKW(P0,0), pw0[1]=PKW(P0,2), pw0); \
    VRD(4); SBAR(); GAPA(C1=__builtin_amdgcn_mfma_f32_32x32x16_bf16(kf[1],qr[0],C1,0,0,0), P0[6],P0[7],P0[8],P0[9],     pw0[2]=PKW(P0,4), pw0[3]=PKW(P0,6), pw0); \
    VRD(1); SBAR(); GAPA(C0=__builtin_amdgcn_mfma_f32_32x32x16_bf16(kf[2],qr[1],C0,0,0,0),   P0[10],P0[11],P0[12],P0[13], pw1[0]=PKW(P0,8), pw1[1]=PKW(P0,10), pw1); \
    VRD(5); SBAR(); GAPA(C1=__builtin_amdgcn_mfma_f32_32x32x16_bf16(kf[3],qr[1],C1,0,0,0),   P0[14],P0[15],P1[0],P1[1],   pw1[2]=PKW(P0,12),pw1[3]=PKW(P0,14), pw1); \
    VRD(2); SBAR(); GAPA(C0=__builtin_amdgcn_mfma_f32_32x32x16_bf16(kf[4],qr[2],C0,0,0,0),   P1[2],P1[3],P1[4],P1[5],     pw2[0]=PKW(P1,0), pw2[1]=PKW(P1,2), pw2); \
    VRD(6); SBAR(); GAPA(C1=__builtin_amdgcn_mfma_f32_32x32x16_bf16(kf[5],qr[2],C1,0,0,0),   P1[6],P1[7],P1[8],P1[9],     pw2[2]=PKW(P1,4), pw2[3]=PKW(P1,6), pw2); \
    VRD(3); SBAR(); GAPA(C0=__builtin_amdgcn_mfma_f32_32x32x16_bf16(kf[6],qr[3],C0,0,0,0),   P1[10],P1[11],P1[12],P1[13], pw3[0]=PKW(P1,8), pw3[1]=PKW(P1,10), pw3); \
    VRD(7); SBAR(); GAPA(C1=__builtin_amdgcn_mfma_f32_32x32x16_bf16(kf[7],qr[3],C1,0,0,0),   P1[14],P1[15],0.f,0.f,       pw3[2]=PKW(P1,12),pw3[3]=PKW(P1,14), pw3); \
    l_reg+=sacc; \
    if(GK){DMA_K((t)+3,sl_cur);} if(GV){DMA_V((t)+1,sl_next);} \
    CMASK(C0,C1,t); \
    { float a=MX3(C0[0],C0[1],C1[0]),b=MX3(C0[2],C0[3],C1[1]); a=MX3(a,C1[2],C1[3]); \
      _Pragma("unroll") for(int r=4;r<16;r+=4){a=MX3(a,C0[r],C0[r+1]);b=MX3(b,C0[r+2],C0[r+3]);a=MX3(a,C1[r],C1[r+1]);b=MX3(b,C1[r+2],C1[r+3]);} \
      float rm=__builtin_fmaxf(a,b); { auto rr=__builtin_amdgcn_permlane32_swap(__float_as_uint(rm),__float_as_uint(rm),false,false); rm=__builtin_fmaxf(__uint_as_float(rr[0]),__uint_as_float(rr[1])); } \
      resc=false; \
      if(__builtin_expect(__any(rm>(float)THRL),0)){ const float dl=__builtin_fmaxf(rm,0.f); mhat+=dl; \
        _Pragma("unroll") for(int r=0;r<16;++r){C0[r]-=dl;C1[r]-=dl;} \
        const float f=__builtin_amdgcn_exp2f(-dl); l_reg*=f; if(hi==0)wsf[r32]=f; resc=true; } } \
    SBAR(); \
    GAPB(o[0]=__builtin_amdgcn_mfma_f32_32x32x16_bf16(PAF(0),VFR(0),o[0],0,0,0), C0,0); \
    GAPB(o[1]=__builtin_amdgcn_mfma_f32_32x32x16_bf16(PAF(0),VFR(4),o[1],0,0,0), C0,4); \
    KRD(GL,0); GAPB(o[0]=__builtin_amdgcn_mfma_f32_32x32x16_bf16(PAF(1),VFR(1),o[0],0,0,0), C0,8); \
    KRD(GL,1); GAPB(o[1]=__builtin_amdgcn_mfma_f32_32x32x16_bf16(PAF(1),VFR(5),o[1],0,0,0), C0,12); \
    KRD(GL,2); GAPB(o[0]=__builtin_amdgcn_mfma_f32_32x32x16_bf16(PAF(2),VFR(2),o[0],0,0,0), C1,0); \
    KRD(GL,3); GAPB(o[1]=__builtin_amdgcn_mfma_f32_32x32x16_bf16(PAF(2),VFR(6),o[1],0,0,0), C1,4); \
    GAPB(o[0]=__builtin_amdgcn_mfma_f32_32x32x16_bf16(PAF(3),VFR(3),o[0],0,0,0), C1,8); \
    GAPB(o[1]=__builtin_amdgcn_mfma_f32_32x32x16_bf16(PAF(3),VFR(7),o[1],0,0,0), C1,12); \
    }while(0)
  int t=1;
  #undef CMASK
  #define CMASK(P0,P1,t) do{}while(0)
  for(;t+5<NT;t+=2){
    STEP(pB0,pB1,pA0,pA1,t,true,true,true);     WAIT_BAR(2); RESC(); ROT();
    STEP(pA0,pA1,pB0,pB1,t+1,true,true,true);   WAIT_BAR(2); RESC(); ROT();
  }
  #undef CMASK
  #define CMASK(P0,P1,t) do{int jb_=(t)-(NT-4); if(jb_>=0)cmask(P0,P1,jb_,qrel,hi);}while(0)
  #define ENDW(tt) do{ if((tt)+3<NT){WAIT_BAR(2);} else if((tt)+2<NT){WAIT_BAR(1);} else {WAIT_BAR(0);} }while(0)
  for(;t+1<NT;t+=2){
    STEP(pB0,pB1,pA0,pA1,t,(t+3<NT),(t+1<NT),(t+1<NT));       ENDW(t);   RESC(); ROT();
    STEP(pA0,pA1,pB0,pB1,t+1,(t+4<NT),(t+2<NT),(t+2<NT));     ENDW(t+1); RESC(); ROT();
  }
  STEP(pB0,pB1,pA0,pA1,NT-1,false,false,false); RESC();
  { float sacc=pB0[0]+pB0[1]; _Pragma("unroll") for(int r=2;r<16;++r)sacc+=pB0[r]; _Pragma("unroll") for(int r=0;r<16;++r)sacc+=pB1[r]; l_reg+=sacc;
    pw0=(u32x4){PKW(pB0,0),PKW(pB0,2),PKW(pB0,4),PKW(pB0,6)};pw1=(u32x4){PKW(pB0,8),PKW(pB0,10),PKW(pB0,12),PKW(pB0,14)};pw2=(u32x4){PKW(pB1,0),PKW(pB1,2),PKW(pB1,4),PKW(pB1,6)};pw3=(u32x4){PKW(pB1,8),PKW(pB1,10),PKW(pB1,12),PKW(pB1,14)};
    SBAR(); pv(o,vb0+sl_cur,PAF(0),PAF(1),PAF(2),PAF(3)); }
  #undef PKW
  #undef PAF
  #undef VFR
  #undef PIN
  #undef MX3
  #undef GAPA
  #undef GAPB
  #undef EX
  #undef VRD
  #undef KRD
  #undef STEP
  #undef ENDW
  {auto rr=__builtin_amdgcn_permlane32_swap(__float_as_uint(l_reg),__float_as_uint(l_reg),false,false);l_reg=__uint_as_float(rr[0])+__uint_as_float(rr[1]);}
  if(hi==0)wsf[32+r32]=l_reg;asm volatile("s_waitcnt lgkmcnt(0)":::"memory");
  float rli[16];
  #pragma unroll
  for(int r=0;r<16;++r)rli[r]=__builtin_amdgcn_rcpf(wsf[32+crow(r,hi)]);
  bf16*Ow=O+(rowbase+q0+wid*QBLK)*DM+h*D;
  { bf16*stg=(bf16*)(shm+LDS_OST)+wid*2048;
    #pragma unroll
    for(int r=0;r<16;++r){const int orow=crow(r,hi);
      #pragma unroll
      for(int d0=0;d0<2;++d0)stg[orow*64+d0*32+r32]=__float2bfloat16(o[d0][r]*rli[r]);}
    asm volatile("s_waitcnt lgkmcnt(0)":::"memory");
    #pragma unroll
    for(int i=0;i<4;++i){const int row=i*8+(lane>>3),ch=lane&7; const u32x4 v=*(const u32x4*)(stg+row*64+ch*8); ATTN_STORE16(Ow+(long)row*DM+ch*8,v);} }
  asm volatile("s_waitcnt lgkmcnt(0)\n\ts_barrier":::"memory");
  #undef DMA_K
  #undef DMA_V
  #undef CMASK
  #undef BIASINIT
  #undef START
  #undef RESC
  #undef ROT
}
constexpr int ATTN_LDS_BYTES=LDS_BYTES;
struct AttnTensors { const bf16* Q; const bf16* K; const bf16* V; bf16* O; const float* cl2; };
#undef SBAR
#undef WAIT_BAR
}
#define GEMM_PHASE(...) pg8::gemm_phase<__VA_ARGS__, pg8::StaticOrder, PGA, PGS>(ldsl, g, S, E, wave)
#define GEMM_PHASE_SPLIT() pg8::gemm_phase<pg8::EpiPartial, pg8::SplitOrder, PGA, PGS>(ldsl, g2, S2, E2, wave)
#define GEMM_PHASE_SPLIT_T(NN, NS, KSUB, KSH) pg8::gemm_phase<pg8::EpiPartialT<NN, KSH>, pg8::SplitOrderT<NN, NS, KSUB>, PGA, PGS>(ldsl, g2, S2, E2, wave)
#ifndef PGA
#define PGA true
#endif
#ifndef PGS
#define PGS true
#endif
namespace cg = cooperative_groups;
#define LAS __attribute__((address_space(3)))
typedef unsigned short bf16;
typedef unsigned v4u __attribute__((ext_vector_type(4)));
typedef float f32x4 __attribute__((ext_vector_type(4)));
typedef short bf16x8 __attribute__((ext_vector_type(8)));
typedef float f32x16 __attribute__((ext_vector_type(16)));
constexpr int NWAVES = 8, NTHR = 512, NMODC_ = 9216;
constexpr int MP = 32768, MS = 256, M = MP + MS, DM = 1024, FF = 2816, WA = 512, NIN = 4608, INCOLS = 4616, SEQ = 16384, PAST = 1024, DSEQ = 32, SKEYS = PAST + DSEQ;
constexpr float EPS = 1e-6f, LOG2E = 1.4426950408889634f;
constexpr size_t MiB = 1u << 20;
constexpr size_t WS_CTL = 0, CTL_ZERO_BYTES = 65536;
constexpr size_t WS_MOD = 1 * MiB, WS_CUMP = 2 * MiB, WS_CUMS = 3 * MiB, WS_G2SS = 4 * MiB, WS_QS = 6 * MiB, WS_WSP = 7 * MiB;
constexpr size_t WS_WGU1 = 8 * MiB, WS_WD1 = 19 * MiB, WS_WIN = 25 * MiB, WS_WPA = 34 * MiB, WS_WPB = 35 * MiB, WS_WOUT = 36 * MiB, WS_WGU2 = 38 * MiB, WS_WD2 = 49 * MiB;
constexpr size_t WS_XN = 56 * MiB;
constexpr size_t WS_ACT = 121 * MiB;
constexpr size_t QKV_B = (size_t)M * 512 * 2;
constexpr size_t WS_Q = 121 * MiB, WS_K = WS_Q + QKV_B, WS_V = WS_K + QKV_B, WS_U = WS_V + QKV_B, WS_G2 = WS_U + QKV_B;
constexpr size_t WS_AO = WS_Q;
constexpr size_t WS_T1 = WS_U;
constexpr size_t WS_T2 = WS_K;
constexpr size_t WS_BO = 283 * MiB, WS_PART = 300 * MiB, WS_END = 316 * MiB;
static_assert(WS_XN + (size_t)M * 2048 <= WS_ACT && WS_G2 + QKV_B <= WS_BO && WS_BO + QKV_B <= WS_END && WS_ACT + (size_t)M * FF * 2 <= WS_END, "ws map");
constexpr size_t O_Y = 0, O_KP = (size_t)M * 1024, O_VP = O_KP + (size_t)MP * 512, O_FP = O_VP + (size_t)MP * 512, O_KS = O_FP + (size_t)MP * 8, O_VS = O_KS + (size_t)MS * 512,
                 O_FS = O_VS + (size_t)MS * 512, O_GS = O_FS + (size_t)MS * 8, O_END = O_GS + (size_t)MS * 512;
constexpr int LDS_BYTES = 155648, MISC_OFF = LDS_BYTES - 256;
static_assert(attn_body::LDS_TOTAL <= MISC_OFF && pg8::STAGE_BYTES <= LDS_BYTES, "LDS map");

struct Args { const float* in[28]; float* out; unsigned char* ws; };

__device__ __forceinline__ float wave_sum(float v) {
#pragma unroll
    for (int o = 1; o < 64; o <<= 1) v += __shfl_xor(v, o);
    return v;
}
__device__ __forceinline__ unsigned f2bf(float f) { unsigned u = __builtin_bit_cast(unsigned, f); return (u + 0x7fffu + ((u >> 16) & 1u)) >> 16; }
__device__ __forceinline__ unsigned pk2(float lo, float hi) { return f2bf(lo) | (f2bf(hi) << 16); }
__device__ __forceinline__ float bf2f(unsigned short h) { return __uint_as_float((unsigned)h << 16); }

__device__ __forceinline__ void ada_unit(const Args& a, unsigned char* lds, int cb, int tid) {
    asm volatile("" : "+v"(tid));
    float* SC = (float*)lds; float* RED = (float*)(lds + 40960);
    const float* cp = a.in[2]; const float* cs = a.in[3]; const float* w_ada = a.in[7]; const float* b_ada = a.in[8];
    float* MOD = (float*)(a.ws + WS_MOD);
    for (int i = tid; i < 10240; i += NTHR) { const int r = i >> 10, k = i & 1023; const float c = r < 2 ? cp[r * 1024 + k] : cs[(r - 2) * 1024 + k]; SC[i] = c / (1.0f + expf(-c)); }
    __syncthreads();
    if (tid < 504) {
        const int cgp = tid % 9, ks = tid / 9; f32x4 acc[10];
#pragma unroll
        for (int r = 0; r < 10; ++r) acc[r] = (f32x4){0.f, 0.f, 0.f, 0.f};
        for (int k = ks; k < 1024; k += 56) { const f32x4 w = *(const f32x4*)(w_ada + (size_t)k * NMODC_ + 36 * cb + 4 * cgp);
#pragma unroll
            for (int r = 0; r < 10; ++r) acc[r] += w * SC[r * 1024 + k]; }
#pragma unroll
        for (int r = 0; r < 10; ++r) *(f32x4*)(RED + (size_t)tid * 40 + r * 4) = acc[r];
    }
    __syncthreads();
    if (tid < 360) { const int r = tid / 36, c = tid % 36, cgp = c >> 2, i = c & 3; float s = 0.f;
        for (int ks = 0; ks < 56; ++ks) s += RED[(ks * 9 + cgp) * 40 + r * 4 + i];
        MOD[r * NMODC_ + 36 * cb + c] = s + b_ada[36 * cb + c]; }
    __syncthreads();
}
__device__ __forceinline__ void transpose_item(const float* W, int ld, int c0, int K, bf16* WT, int drow0, int k0, float* scr, int lane) {
#pragma unroll 8
    for (int i = 0; i < 32; ++i) { const int kk = 2 * i + (lane >> 5); scr[kk * 33 + (lane & 31)] = W[(size_t)(k0 + kk) * ld + c0 + (lane & 31)]; }
    asm volatile("s_waitcnt lgkmcnt(0)" ::: "memory");
    const int c = lane & 7;
#pragma unroll
    for (int j = 0; j < 4; ++j) { const int n = (lane >> 3) + 8 * j; const float* s = scr + (8 * c) * 33 + n;
        v4u o; o.x = pk2(s[0 * 33], s[1 * 33]); o.y = pk2(s[2 * 33], s[3 * 33]); o.z = pk2(s[4 * 33], s[5 * 33]); o.w = pk2(s[6 * 33], s[7 * 33]);
        *(v4u*)(WT + (size_t)(drow0 + n) * K + k0 + 8 * c) = o; }
    asm volatile("s_waitcnt lgkmcnt(0)" ::: "memory");
}
struct Seg { int in, ld, c0, ncols, K; size_t dst; int drow, mode; };
__device__ const Seg SEGS[13] = {
        {10, FF, 0, FF, 1024, WS_WGU1, 0, 1}, {11, FF, 0, FF, 1024, WS_WGU1, 0, 2}, {12, 1024, 0, 1024, FF, WS_WD1, 0, 0},
        {14, INCOLS, 0, 512, 1024, WS_WIN, 0, 3}, {14, INCOLS, 512, 512, 1024, WS_WIN, 512, 3}, {14, INCOLS, 1024, 512, 1024, WS_WIN, 1024, 0}, {14, INCOLS, 1544, 3072, 1024, WS_WIN, 1536, 0},
        {21, 1024, 0, 1024, 512, WS_WPA, 0, 0}, {22, 1024, 0, 1024, 512, WS_WPB, 0, 0}, {23, 1024, 0, 1024, 1024, WS_WOUT, 0, 0},
        {25, FF, 0, FF, 1024, WS_WGU2, 0, 1}, {26, FF, 0, FF, 1024, WS_WGU2, 0, 2}, {27, 1024, 0, 1024, FF, WS_WD2, 0, 0}};
__device__ __forceinline__ int seg_drow(const Seg& s, int n) {
    if (s.mode == 0) return s.drow + n;
    if (s.mode == 1) return s.drow + 256 * (n >> 7) + (n & 127);
    if (s.mode == 2) return s.drow + 256 * (n >> 7) + 128 + (n & 127);
    const int gs = (n & 255) >> 5; return s.drow + (n & ~255) + 32 * (4 * (gs & 1) + (gs >> 1));
}
__device__ __forceinline__ void p0_weights(const Args& a, unsigned char* lds, int gw, int NGW, int wave, int lane) {
    asm volatile("" : "+v"(lane));
    float* scr = (float*)(lds + wave * 8704);

    int base = 0;
#pragma unroll 1
    for (int si = 0; si < 13; ++si) {
        const Seg s = SEGS[si]; const int nblk = s.ncols / 32, nitems = (s.K / 64) * nblk;
        int first = (gw - base) % NGW; if (first < 0) first += NGW;
        for (int it = first; it < nitems; it += NGW) { const int kb = it / nblk, nb = it % nblk;
            transpose_item(a.in[s.in], s.ld, s.c0 + 32 * nb, s.K, (bf16*)(a.ws + s.dst), seg_drow(s, 32 * nb), 64 * kb, scr, lane); }
        base = (base + nitems) % NGW;
    }
    const float* wsp = a.in[19]; bf16* WSP = (bf16*)(a.ws + WS_WSP);
    for (int i = gw * 64 + lane; i < 4 * 128 * 128; i += NGW * 64) { const int t = (i >> 7) & 127, s2 = i & 127; WSP[i] = (bf16)f2bf(s2 <= t ? wsp[i] : 0.f); }
}
template <bool LOGF> __device__ __forceinline__ void norm_phase(const Args& a, unsigned char* lds, const float* srcp, const float* srcs, const float* g, int ishift, int iscale,
                                                                 int gw, int NGW, int tid, int lane) {
    asm volatile("" : "+v"(tid), "+v"(lane));
    const float* MOD = (const float*)(a.ws + WS_MOD); bf16* XN = (bf16*)(a.ws + WS_XN);
    float* WFt = (float*)lds;
    if (LOGF) { const float* w_in = a.in[14]; for (int i = tid; i < 8192; i += NTHR) { const int k = i >> 3, j = i & 7; WFt[j * 1024 + k] = w_in[(size_t)k * INCOLS + 1536 + j]; } __syncthreads(); }
    int cur = -1; f32x4 gs[4], shv[4], vn[4], vnn[4];
    if (gw < M) { const float* xrow0 = gw < MP ? srcp + (size_t)gw * 1024 : srcs + (size_t)(gw - MP) * 1024;
#pragma unroll
        for (int j = 0; j < 4; ++j) vn[j] = ((const f32x4*)xrow0 + lane)[64 * j]; }
    if (gw + NGW < M) { const int m1 = gw + NGW; const float* xrow1 = m1 < MP ? srcp + (size_t)m1 * 1024 : srcs + (size_t)(m1 - MP) * 1024;
#pragma unroll
        for (int j = 0; j < 4; ++j) vnn[j] = ((const f32x4*)xrow1 + lane)[64 * j]; }
    for (int m = gw; m < M; m += NGW) {
        const int mr = m < MP ? (m >> 14) : 2 + ((m - MP) >> 5);
        if (mr != cur) { cur = mr; const f32x4* g4 = (const f32x4*)g + lane;
            const f32x4* sh4 = (const f32x4*)(MOD + (size_t)mr * 9216 + ishift * 1024) + lane; const f32x4* sc4 = (const f32x4*)(MOD + (size_t)mr * 9216 + iscale * 1024) + lane;
#pragma unroll
            for (int j = 0; j < 4; ++j) { gs[j] = g4[64 * j] * (sc4[64 * j] + 1.0f); shv[j] = sh4[64 * j]; } }
        f32x4 v[4]; float ss = 0.f;
#pragma unroll
        for (int j = 0; j < 4; ++j) { v[j] = vn[j]; vn[j] = vnn[j]; ss += (v[j].x * v[j].x + v[j].y * v[j].y) + (v[j].z * v[j].z + v[j].w * v[j].w); }
        { const int m2 = m + 2 * NGW; if (m2 < M) { const float* xrow2 = m2 < MP ? srcp + (size_t)m2 * 1024 : srcs + (size_t)(m2 - MP) * 1024;
#pragma unroll
            for (int j = 0; j < 4; ++j) vnn[j] = ((const f32x4*)xrow2 + lane)[64 * j]; } }
        const float rstd = 1.0f / sqrtf(wave_sum(ss) * (1.0f / 1024.0f) + EPS);
        unsigned long long* o8 = (unsigned long long*)(XN + (size_t)m * 1024) + lane;
#pragma unroll
        for (int j = 0; j < 4; ++j) { v[j] = (v[j] * rstd) * gs[j] + shv[j];
            o8[64 * j] = (unsigned long long)pk2(v[j].x, v[j].y) | ((unsigned long long)pk2(v[j].z, v[j].w) << 32); }
        if (LOGF) {
            float f[8];
#pragma unroll
            for (int jj = 0; jj < 8; ++jj) { float s = 0.f;
#pragma unroll
                for (int j = 0; j < 4; ++j) { const f32x4 w = *((const f32x4*)(WFt + jj * 1024) + 64 * j + lane); s += (v[j].x * w.x + v[j].y * w.y) + (v[j].z * w.z + v[j].w * w.w); }
                f[jj] = wave_sum(s); }
            float fj = f[0];
#pragma unroll
            for (int jj = 1; jj < 8; ++jj) fj = (lane == jj) ? f[jj] : fj;
            if (lane < 8) { const float x = fj + a.in[15][lane]; const float lf = (x >= 0.f) ? -log1pf(expf(-x)) : x - log1pf(expf(x));
                float* dst = m < MP ? a.out + O_FP + (size_t)m * 8 : a.out + O_FS + (size_t)(m - MP) * 8; dst[lane] = lf; }
        }
    }
}
__device__ __forceinline__ void scan_unit(const Args& a, unsigned char* lds, int unit, int tid) {
    asm volatile("" : "+v"(tid));
    double* tot = (double*)lds;
    if (unit < 16) {
        const int b = unit >> 3, h = unit & 7; const float* lf = a.out + O_FP + ((size_t)b * SEQ) * 8 + h; float* dst = (float*)(a.ws + WS_CUMP) + (size_t)unit * SEQ;
        float x[32]; double s = 0.0;
#pragma unroll
        for (int i = 0; i < 32; ++i) { x[i] = lf[(size_t)(tid * 32 + i) * 8]; s += (double)x[i]; }
        tot[tid] = s; __syncthreads();
        double pre = 0.0; for (int j = 0; j < tid; ++j) pre += tot[j];
#pragma unroll
        for (int i = 0; i < 32; ++i) { pre += (double)x[i]; dst[tid * 32 + i] = (float)(pre * 1.4426950408889634); }
    } else {
        const int bh = unit - 16, b = bh >> 3, h = bh & 7; const float* lfc = a.in[6] + ((size_t)b * PAST) * 8 + h; const float* lfn = a.out + O_FS + ((size_t)b * DSEQ) * 8 + h;
        float* dst = (float*)(a.ws + WS_CUMS) + (size_t)bh * SKEYS;
        float x[3] = {0.f, 0.f, 0.f}; double s = 0.0;
        if (tid < 352) {
#pragma unroll
            for (int i = 0; i < 3; ++i) { const int p = tid * 3 + i; x[i] = p < PAST ? lfc[(size_t)p * 8] : lfn[(size_t)(p - PAST) * 8]; s += (double)x[i]; } }
        tot[tid] = s; __syncthreads();
        if (tid < 352) { double pre = 0.0; for (int j = 0; j < tid; ++j) pre += tot[j];
#pragma unroll
            for (int i = 0; i < 3; ++i) { pre += (double)x[i]; dst[tid * 3 + i] = (float)(pre * 1.4426950408889634); } }
    }
    __syncthreads();
}
__device__ __forceinline__ void gmlp_unit(const Args& a, unsigned char* lds, int ci, int tid, int wave, int lane) {
    asm volatile("" : "+v"(tid), "+v"(lane));
    constexpr int VP = 136;
    bf16* VT = (bf16*)lds; float* rst = (float*)(lds + 128 * VP * 2);
    const bf16* G2 = (const bf16*)(a.ws + WS_G2); const bf16* U = (const bf16*)(a.ws + WS_U); bf16* BO = (bf16*)(a.ws + WS_BO); const bf16* WSP = (const bf16*)(a.ws + WS_WSP);
    const float* G2SS = (const float*)(a.ws + WS_G2SS); const float* gv = a.in[18]; const float* bsp = a.in[20];
    const size_t R0 = (size_t)ci * 128;
    if (tid < 128) { const f32x4* p = (const f32x4*)(G2SS + (R0 + tid) * 8); const f32x4 s0 = p[0], s1 = p[1]; rst[tid] = 1.0f / sqrtf((((s0.x + s0.y) + (s0.z + s0.w)) + ((s1.x + s1.y) + (s1.z + s1.w))) * (1.0f / 512.0f) + EPS); }
    __syncthreads();
    const int r32 = lane & 31, hi = lane >> 5, tb = wave >> 1, dh = wave & 1;
#pragma unroll 1
    for (int g = 0; g < 4; ++g) {
#pragma unroll
        for (int it = 0; it < 4; ++it) { const int q = tid + NTHR * it, s = q & 127, cch = q >> 7;
            const v4u raw = *(const v4u*)(G2 + (R0 + s) * 512 + g * 128 + 8 * cch); const float rs = rst[s];
            const f32x4 g0 = *(const f32x4*)(gv + g * 128 + 8 * cch), g1 = *(const f32x4*)(gv + g * 128 + 8 * cch + 4);
            bf16* col = VT + (8 * cch) * VP + s;
            col[0 * VP] = (bf16)f2bf(pg8::bf_lo(raw.x) * rs * g0.x); col[1 * VP] = (bf16)f2bf(pg8::bf_hi(raw.x) * rs * g0.y); col[2 * VP] = (bf16)f2bf(pg8::bf_lo(raw.y) * rs * g0.z); col[3 * VP] = (bf16)f2bf(pg8::bf_hi(raw.y) * rs * g0.w);
            col[4 * VP] = (bf16)f2bf(pg8::bf_lo(raw.z) * rs * g1.x); col[5 * VP] = (bf16)f2bf(pg8::bf_hi(raw.z) * rs * g1.y); col[6 * VP] = (bf16)f2bf(pg8::bf_lo(raw.w) * rs * g1.z); col[7 * VP] = (bf16)f2bf(pg8::bf_hi(raw.w) * rs * g1.w); }
        __syncthreads();
        f32x16 acc[2]; acc[0] = f32x16{}; acc[1] = f32x16{};
        for (int ks = 0; ks <= 2 * tb + 1; ++ks) {
            const bf16x8 af = *(const bf16x8*)(WSP + ((size_t)(g * 128 + 32 * tb + r32)) * 128 + 16 * ks + 8 * hi);
#pragma unroll
            for (int db = 0; db < 2; ++db) { const bf16x8 bfv = *(const bf16x8*)(VT + (64 * dh + 32 * db + r32) * VP + 16 * ks + 8 * hi); acc[db] = __builtin_amdgcn_mfma_f32_32x32x16_bf16(af, bfv, acc[db], 0, 0, 0); }
        }
#pragma unroll
        for (int db = 0; db < 2; ++db)
#pragma unroll
            for (int r = 0; r < 16; ++r) { const int t = 32 * tb + (r & 3) + 8 * (r >> 2) + 4 * hi, ch = g * 128 + 64 * dh + 32 * db + r32; const size_t off = (R0 + t) * 512 + ch;
                const float mixed = acc[db][r] + bsp[g * 128 + t]; BO[off] = (bf16)f2bf(bf2f(U[off]) * mixed); }
        __syncthreads();
    }
}
__device__ __forceinline__ void gmlp_sample_unit(const Args& a, unsigned char* lds, int b, int tid) {
    asm volatile("" : "+v"(tid));
    float* rst = (float*)lds;
    const bf16* G2 = (const bf16*)(a.ws + WS_G2); const bf16* U = (const bf16*)(a.ws + WS_U); bf16* BO = (bf16*)(a.ws + WS_BO);
    const float* G2SS = (const float*)(a.ws + WS_G2SS); const float* wsp = a.in[19]; const float* bsp = a.in[20];
    const size_t R0 = (size_t)MP + b * 32;
    if (tid < 32) { const float* p = G2SS + (R0 + tid) * 8; float s = 0.f; for (int i = 0; i < 8; ++i) s += p[i]; rst[tid] = 1.0f / sqrtf(s * (1.0f / 512.0f) + EPS); }
    __syncthreads();
    const int ch = tid, g = ch >> 7; const float gvv = a.in[18][ch];
    float vb[32];
#pragma unroll
    for (int s = 0; s < 32; ++s) { vb[s] = bf2f(G2[(R0 + s) * 512 + ch]) * rst[s] * gvv; a.out[O_GS + ((size_t)b * 32 + s) * 512 + ch] = vb[s]; }
#pragma unroll
    for (int t = 0; t < 32; ++t) { float mixed = bsp[g * 128 + t]; const float* wrow = wsp + ((size_t)g * 128 + t) * 128;
#pragma unroll
        for (int s = 0; s < 32; ++s) if (s <= t) mixed += wrow[s] * vb[s];
        const size_t off = (R0 + t) * 512 + ch; BO[off] = (bf16)f2bf(bf2f(U[off]) * mixed); }
    __syncthreads();
}
__device__ __forceinline__ void sattn_unit(const Args& a, unsigned char* lds, int unit, int tid, int wave, int lane) {
    asm volatile("" : "+v"(tid), "+v"(lane));
    const int qg = unit & 3, h = (unit >> 2) & 7, b = unit >> 5;
    float* qs = (float*)lds;
    float* S = qs + 512;
    float* red = S + 8 * SKEYS;
    float* inv = red + 4096;
    const float* QS = (const float*)(a.ws + WS_QS); const float* cum = (const float*)(a.ws + WS_CUMS) + (size_t)(b * 8 + h) * SKEYS;
    const float* kc = a.in[4] + ((size_t)b * PAST) * 512 + h * 64; const float* vc = a.in[5] + ((size_t)b * PAST) * 512 + h * 64;
    const float* kn = a.out + O_KS + ((size_t)b * DSEQ) * 512 + h * 64; const float* vn = a.out + O_VS + ((size_t)b * DSEQ) * 512 + h * 64;
    { const int qi = tid >> 6, d = tid & 63; qs[tid] = QS[((size_t)b * 32 + 8 * qg + qi) * 512 + h * 64 + d]; }
    __syncthreads();
    for (int key = wave * 132 + lane; key < wave * 132 + 132; key += 64) {
        const f32x4* kr = (const f32x4*)(key < PAST ? kc + (size_t)key * 512 : kn + (size_t)(key - PAST) * 512);
        f32x4 kv[16];
#pragma unroll
        for (int i = 0; i < 16; ++i) kv[i] = kr[i];
        const float ck = cum[key];
#pragma unroll
        for (int qi = 0; qi < 8; ++qi) { float s = 0.f;
#pragma unroll
            for (int i = 0; i < 16; ++i) { const f32x4 q4 = *(const f32x4*)(qs + qi * 64 + 4 * i); s += (q4.x * kv[i].x + q4.y * kv[i].y) + (q4.z * kv[i].z + q4.w * kv[i].w); }
            const int qpos = PAST + 8 * qg + qi;
            S[qi * SKEYS + key] = (key <= qpos) ? s + (cum[qpos] - ck) : -INFINITY; }
    }
    __syncthreads();
    { float mx = -INFINITY; for (int k = lane; k < SKEYS; k += 64) mx = fmaxf(mx, S[wave * SKEYS + k]);
#pragma unroll
      for (int o = 1; o < 64; o <<= 1) mx = fmaxf(mx, __shfl_xor(mx, o));
      float sum = 0.f; for (int k = lane; k < SKEYS; k += 64) { const float p = exp2f(S[wave * SKEYS + k] - mx); S[wave * SKEYS + k] = p; sum += p; }
      sum = wave_sum(sum); if (lane == 0) inv[wave] = 1.0f / sum; }
    __syncthreads();
    { float acc[8];
#pragma unroll
      for (int qi = 0; qi < 8; ++qi) acc[qi] = 0.f;
#pragma unroll 1
      for (int key0 = wave * 132; key0 < wave * 132 + 132; key0 += 12) {
          float vv[12];
#pragma unroll
          for (int j = 0; j < 12; ++j) { const int key = key0 + j; vv[j] = (key < PAST ? vc + (size_t)key * 512 : vn + (size_t)(key - PAST) * 512)[lane]; }
#pragma unroll
          for (int j = 0; j < 12; ++j)
#pragma unroll
              for (int qi = 0; qi < 8; ++qi) acc[qi] += S[qi * SKEYS + key0 + j] * vv[j]; }
#pragma unroll
      for (int qi = 0; qi < 8; ++qi) red[(wave * 8 + qi) * 64 + lane] = acc[qi]; }
    __syncthreads();
    { const int qi = tid >> 6, d = tid & 63; float s = 0.f;
#pragma unroll
      for (int w = 0; w < 8; ++w) s += red[(w * 8 + qi) * 64 + d];
      bf16* AO = (bf16*)(a.ws + WS_AO); AO[((size_t)MP + b * 32 + 8 * qg + qi) * 512 + h * 64 + d] = (bf16)f2bf(s * inv[qi]); }
    __syncthreads();
}

#define XB_TMO      128
#define XB_XCNT(j)  (256  + 64 * (j))
#define XB_XSUB(j)  (1280 + 64 * (j))
#define XB_XGEN(j)  (2304 + 64 * (j))
#define XB_TOP      3328
#define XB_TOPGEN   3392
#define XCD_BAR_WORDS 3456
#define XB_SPIN_CAP (1u << 18)

__device__ __forceinline__ unsigned xb_ld(unsigned* p)              { return __hip_atomic_load(p, __ATOMIC_RELAXED, __HIP_MEMORY_SCOPE_AGENT); }
__device__ __forceinline__ unsigned xb_add(unsigned* p, unsigned v) { return __hip_atomic_fetch_add(p, v, __ATOMIC_RELAXED, __HIP_MEMORY_SCOPE_AGENT); }
__device__ __forceinline__ unsigned xb_xcc_id() { return (unsigned)__builtin_amdgcn_s_getreg((3 << 11) | 20) & 0xFu; }
#define XB_SPIN(cond, bar) do { unsigned _sp = 0; while (cond) { __builtin_amdgcn_s_sleep(1); \
    if ((++_sp & 255u) == 0u) { if (xb_ld(&(bar)[XB_TMO])) break; if (_sp > XB_SPIN_CAP) { atomicAdd(&(bar)[XB_TMO], 1u); break; } } } } while (0)

struct XcdBarrier {
    unsigned* bar; unsigned x;
    volatile LAS unsigned* st;
};

__device__ __forceinline__ XcdBarrier xcd_barrier_post(unsigned* bar, volatile LAS unsigned* st, int wv) {
    XcdBarrier b; b.bar = bar; b.x = xb_xcc_id(); b.st = st;
    if (wv == 0 && lane_id_() == 0) (void)xb_add(&bar[XB_XCNT(b.x)], 1u);
    return b;
}
__device__ __forceinline__ void xcd_barrier_complete(unsigned* bar, unsigned x, unsigned& nloc, unsigned& nx) {
    const unsigned G = gridDim.x * gridDim.y * gridDim.z;
    unsigned sum, cnt, mine, sp = 0u;
    for (;;) {
        sum = 0u; cnt = 0u; mine = 0u;
#pragma unroll
        for (unsigned j = 0; j < 16; ++j) { const unsigned c = xb_ld(&bar[XB_XCNT(j)]); sum += c; cnt += (c > 0u) ? 1u : 0u; mine = (j == x) ? c : mine; }
        if (sum == G) break;
        __builtin_amdgcn_s_sleep(1);
        if ((++sp & 255u) == 0u) { if (xb_ld(&bar[XB_TMO])) break; if (sp > XB_SPIN_CAP) { atomicAdd(&bar[XB_TMO], 1u); break; } }
    }
    nloc = mine > 0u ? mine : 1u; nx = cnt > 0u ? cnt : 1u;
}

__device__ __forceinline__ void xcd_barrier(const XcdBarrier& b, int wv) {
    asm volatile("s_waitcnt vmcnt(0)" ::: "memory");
    __syncthreads();
    if (wv == 0 && lane_id_() == 0) {
        unsigned* bar = b.bar;
        __builtin_amdgcn_s_waitcnt(0);
        unsigned nloc = b.st[0], nx = b.st[1];
        if (nloc == 0u) { xcd_barrier_complete(bar, b.x, nloc, nx); b.st[0] = nloc; b.st[1] = nx; }
        const unsigned old = xb_add(&bar[XB_XSUB(b.x)], 1u);
        const unsigned gen = old / nloc;
        if (old + 1u == (gen + 1u) * nloc) {
            __builtin_amdgcn_fence(__ATOMIC_RELEASE, "agent");
            asm volatile("s_waitcnt vmcnt(0)" ::: "memory");
            const unsigned og = xb_add(&bar[XB_TOP], 1u);
            const unsigned tg = og / nx;
            if (og + 1u == (tg + 1u) * nx) xb_add(&bar[XB_TOPGEN], 1u);
            else XB_SPIN(xb_ld(&bar[XB_TOPGEN]) == tg, bar);
            __builtin_amdgcn_fence(__ATOMIC_ACQUIRE, "agent");
            xb_add(&bar[XB_XGEN(b.x)], 1u);
            asm volatile("s_waitcnt vmcnt(0)" ::: "memory");
        } else {
            XB_SPIN(xb_ld(&bar[XB_XGEN(b.x)]) == gen, bar);
            __builtin_amdgcn_fence(__ATOMIC_ACQUIRE, "agent");
            asm volatile("s_waitcnt vmcnt(0)" ::: "memory");
        }
    }
    __syncthreads();
}

#ifndef SKIPMASK
#define SKIPMASK 0u
#endif
#define PH(n) (((SKIPMASK) >> (n) & 1u) == 0u)
#define GSYNC() do { XcdBarrier b_; b_.bar = (unsigned*)(a.ws + WS_CTL); b_.x = xbar_x; b_.st = MISC + 8; xcd_barrier(b_, wave); } while (0)
__global__ void __launch_bounds__(NTHR, 2) fox_fwd(Args a) {
    extern __shared__ __attribute__((aligned(16))) unsigned char lds[];
    cg::grid_group grid = cg::this_grid();
    const int wave = __builtin_amdgcn_readfirstlane((int)threadIdx.x >> 6);
#define tid ((wave << 6) | lane_id_())
#define lane (lane_id_())
    const int G = gridDim.x, bx = blockIdx.x; const int vcu = (G % 8 == 0) ? (bx % 8) * (G / 8) + bx / 8 : bx;
    const int gw = vcu * NWAVES + wave, NGW = G * NWAVES;
    LAS unsigned char* ldsl = (LAS unsigned char*)lds;
    float* MOD = (float*)(a.ws + WS_MOD); bf16* XN = (bf16*)(a.ws + WS_XN); bf16* ACT = (bf16*)(a.ws + WS_ACT);
    volatile LAS unsigned* MISC = (volatile LAS unsigned*)((LAS unsigned char*)lds + MISC_OFF);
    for (int i = tid; i < LDS_BYTES / 16; i += NTHR) ((v4u*)lds)[i] = (v4u){0u, 0u, 0u, 0u};
    __syncthreads();
    __builtin_amdgcn_fence(__ATOMIC_SEQ_CST, ""); asm volatile("s_waitcnt vmcnt(0) lgkmcnt(0)" ::: "memory");
    const unsigned xbar_x = xcd_barrier_post((unsigned*)(a.ws + WS_CTL), MISC + 8, wave).x;
    grid.sync();
    float* Y = a.out + O_Y;

#ifndef NPASS
#define NPASS 1
#endif
#pragma unroll 1
    for (int pass = 0; pass < NPASS; ++pass) {
    if (pass) GSYNC();
    if (PH(0)) { for (int cb = bx; cb < 256; cb += G) ada_unit(a, lds, cb, tid);
    p0_weights(a, lds, gw, NGW, wave, lane); }
    GSYNC();
    if (PH(1)) norm_phase<false>(a, lds, a.in[0], a.in[1], a.in[9], 0, 1, gw, NGW, tid, lane);
    GSYNC();
    if (PH(2)) { pg8::Gemm g{XN, (const bf16*)(a.ws + WS_WGU1), M, 2 * FF, 1024, 1024}; pg8::StaticOrder S; S.init(M, 2 * FF, G, bx); pg8::EpiUp E{ACT, FF};
      GEMM_PHASE(pg8::EpiUp); }
    GSYNC();
    if (PH(3)) { pg8::EpiRes E{a.in[0], a.in[1], Y, MOD + 2 * 1024, 0.5f};
      { int ksub_ = 256; asm volatile("" : "+s"(ksub_)); pg8::Gemm g2{ACT + (size_t)MP * FF, (const bf16*)(a.ws + WS_WD1), 256, 1024, ksub_, FF}; pg8::SplitOrder S2; S2.init(G, bx); pg8::EpiPartial E2{(float*)(a.ws + WS_PART), 4, 256}; GEMM_PHASE_SPLIT(); }
      { pg8::Gemm g{ACT, (const bf16*)(a.ws + WS_WD1), MP, 1024, FF, FF}; pg8::StaticOrder S; S.init(MP, 1024, G, bx); GEMM_PHASE(pg8::EpiRes); }
      GSYNC();
      if (bx < 32) pg8::reduce_rowgroup<11>((const float*)(a.ws + WS_PART), bx & 3, bx >> 2, E, wave); }
    GSYNC();
    if (PH(4)) norm_phase<true>(a, lds, Y, Y + (size_t)MP * 1024, a.in[13], 3, 4, gw, NGW, tid, lane);
    GSYNC();
    if (PH(5)) { if (G >= 160) { const int u = G - 1 - bx; if (u < 80) scan_unit(a, lds, u, tid); }
                 else for (int u = bx; u < 80; u += G) scan_unit(a, lds, u, tid); }
    if (PH(6)) { pg8::Gemm g{XN, (const bf16*)(a.ws + WS_WIN), M, 2560, 1024, 1024}; pg8::StaticOrder S; S.init(M, 2560, G, bx);
      pg8::EpiIn E{(bf16*)(a.ws + WS_Q), (bf16*)(a.ws + WS_K), (bf16*)(a.ws + WS_V), (bf16*)(a.ws + WS_U), (bf16*)(a.ws + WS_G2), nullptr, nullptr,
                   (float*)(a.ws + WS_G2SS), (float*)(a.ws + WS_QS), a.out + O_KP, a.out + O_KS, a.out + O_VP, a.out + O_VS, a.in[16], a.in[17], attn_body::C2, EPS};
      GEMM_PHASE(pg8::EpiIn); }
    GSYNC();
    if (PH(7)) { const attn_body::bf16* Qb = (const attn_body::bf16*)(a.ws + WS_Q); const attn_body::bf16* Kb = (const attn_body::bf16*)(a.ws + WS_K); const attn_body::bf16* Vb = (const attn_body::bf16*)(a.ws + WS_V);
      attn_body::bf16* Ob = (attn_body::bf16*)(a.ws + WS_AO); const float* CUMP = (const float*)(a.ws + WS_CUMP);
      const int nun = (G == 256) ? 4 : (1024 - bx + G - 1) / G;
      float B2;
      { float mq = fabsf(a.in[16][lane]), mk = fabsf(a.in[17][lane]);
#pragma unroll
        for (int o = 1; o < 64; o <<= 1) { mq = fmaxf(mq, __shfl_xor(mq, o)); mk = fmaxf(mk, __shfl_xor(mk, o)); }
        B2 = 64.0f * mq * mk * attn_body::C2 * 1.01f + 0.5f; }
#pragma unroll 1
      for (int i = 0; i < nun; ++i) { int bh, qb;
          if (G == 256) { const int s = vcu & 15; bh = vcu >> 4; qb = (i == 0) ? s : (i == 1) ? 31 - s : (i == 2) ? 32 + s : 63 - s; } else { const int idx = bx + i * G; bh = idx >> 6; qb = idx & 63; }
          int ts = 0;
          { const float* cl = CUMP + (size_t)bh * SEQ; const float cref = cl[qb * 256]; const int ncand = 4 * qb;
            for (int j0 = 0; j0 < ncand; j0 += 64) { const int j = j0 + lane; const bool sk = (j < ncand) && (cref - cl[64 * j + 63] + 2.0f * B2 < -152.0f); ts += (int)__popcll(__ballot(sk)); }
            ts = __builtin_amdgcn_readfirstlane(ts) & ~1; }
          attn_body::attn_unit<8>(bh >> 3, bh & 7, qb, ts, CUMP + (size_t)bh * SEQ, Qb, Kb, Vb, Ob, (char*)lds, wave);
          }
      __syncthreads(); }
    if (PH(8)) for (int ci = bx; ci < 256; ci += G) gmlp_unit(a, lds, ci, tid, wave, lane);
    if (PH(9)) for (int u = bx; u < 256; u += G) sattn_unit(a, lds, u, tid, wave, lane);
    if (PH(10)) { if (G == 256) { if ((vcu & 15) == 0 && (vcu >> 4) < 8) gmlp_sample_unit(a, lds, vcu >> 4, tid); } else for (int b = bx; b < 8; b += G) gmlp_sample_unit(a, lds, b, tid); }
    GSYNC();
    if (PH(11)) { bf16* T = (bf16*)(a.ws + WS_T1); bf16* T2 = (bf16*)(a.ws + WS_T2); const bf16* WIN = (const bf16*)(a.ws + WS_WIN);
      bf16* TS = T + (size_t)MP * 1024; bf16* T2S = T2 + (size_t)MP * 1024; const bf16* XS = XN + (size_t)MP * 1024;
      float* PARTA = (float*)(a.ws + 2 * MiB); float* PARTB = (float*)(a.ws + 4 * MiB);
      { pg8::Gemm g{(const bf16*)(a.ws + WS_AO) + (size_t)MP * 512, (const bf16*)(a.ws + WS_WPA), 256, 1024, 512, 512}; pg8::StaticOrder S; S.init(256, 1024, G, bx); pg8::EpiMix<0> E{TS, nullptr}; GEMM_PHASE(pg8::EpiMix<0>); }
      { pg8::Gemm g{(const bf16*)(a.ws + WS_AO), (const bf16*)(a.ws + WS_WPA), MP, 1024, 512, 512}; pg8::StaticOrder S; S.init(MP, 1024, G, bx); pg8::EpiMix<0> E{T, nullptr}; GEMM_PHASE(pg8::EpiMix<0>); }
      { int ksub_ = 512; asm volatile("" : "+s"(ksub_)); pg8::Gemm g2{XS, WIN + (size_t)2560 * 1024, 256, 1024, ksub_, 1024}; pg8::SplitOrderT<4, 2, 512> S2; S2.init(G, (bx + G - 8) % G); pg8::EpiPartialT<4, 9> E2{PARTA}; GEMM_PHASE_SPLIT_T(4, 2, 512, 9); }
      { pg8::Gemm g{XN, WIN + (size_t)2560 * 1024, MP, 1024, 1024, 1024}; pg8::StaticOrder S; S.init(MP, 1024, G, bx); pg8::EpiMix<1> E{T, nullptr}; GEMM_PHASE(pg8::EpiMix<1>); }
      { pg8::Gemm g{(const bf16*)(a.ws + WS_BO) + (size_t)MP * 512, (const bf16*)(a.ws + WS_WPB), 256, 1024, 512, 512}; pg8::StaticOrder S; S.init(256, 1024, G, (bx + G - 16) % G); pg8::EpiMix<0> E{T2S, nullptr}; GEMM_PHASE(pg8::EpiMix<0>); }
      { pg8::Gemm g{(const bf16*)(a.ws + WS_BO), (const bf16*)(a.ws + WS_WPB), MP, 1024, 512, 512}; pg8::StaticOrder S; S.init(MP, 1024, G, bx); pg8::EpiMix<0> E{T2, nullptr}; GEMM_PHASE(pg8::EpiMix<0>); }
      { int ksub_ = 512; asm volatile("" : "+s"(ksub_)); pg8::Gemm g2{XS, WIN + (size_t)3584 * 1024, 256, 1024, ksub_, 1024}; pg8::SplitOrderT<4, 2, 512> S2; S2.init(G, (bx + G - 24) % G); pg8::EpiPartialT<4, 9> E2{PARTB}; GEMM_PHASE_SPLIT_T(4, 2, 512, 9); }
      { pg8::Gemm g{XN, WIN + (size_t)3584 * 1024, MP, 1024, 1024, 1024}; pg8::StaticOrder S; S.init(MP, 1024, G, bx); pg8::EpiMix<2> E{T, T2}; GEMM_PHASE(pg8::EpiMix<2>); }
      GSYNC();
      if (bx < 32) { pg8::EpiMix<1> E1{TS, nullptr}; pg8::reduce_rowgroup<2>(PARTA, bx & 3, bx >> 2, E1, wave);
                     pg8::EpiMix<2> E2{TS, T2S}; pg8::reduce_rowgroup<2>(PARTB, bx & 3, bx >> 2, E2, wave); } }
    GSYNC();
    if (PH(13)) { pg8::EpiRes E{Y, Y + (size_t)MP * 1024, Y, MOD + 5 * 1024, 1.0f}; const bf16* M1 = (const bf16*)(a.ws + WS_T1);
      { int ksub_ = 256; asm volatile("" : "+s"(ksub_)); pg8::Gemm g2{M1 + (size_t)MP * 1024, (const bf16*)(a.ws + WS_WOUT), 256, 1024, ksub_, 1024}; pg8::SplitOrderT<4, 4, 256> S2; S2.init(G, bx); pg8::EpiPartialT<4, 8> E2{(float*)(a.ws + WS_PART)}; GEMM_PHASE_SPLIT_T(4, 4, 256, 8); }
      { pg8::Gemm g{M1, (const bf16*)(a.ws + WS_WOUT), MP, 1024, 1024, 1024}; pg8::StaticOrder S; S.init(MP, 1024, G, bx); GEMM_PHASE(pg8::EpiRes); }
      GSYNC();
      if (bx < 32) pg8::reduce_rowgroup<4>((const float*)(a.ws + WS_PART), bx & 3, bx >> 2, E, wave); }
    GSYNC();
    if (PH(14)) norm_phase<false>(a, lds, Y, Y + (size_t)MP * 1024, a.in[24], 6, 7, gw, NGW, tid, lane);
    GSYNC();
    if (PH(15)) { pg8::Gemm g{XN, (const bf16*)(a.ws + WS_WGU2), M, 2 * FF, 1024, 1024}; pg8::StaticOrder S; S.init(M, 2 * FF, G, bx); pg8::EpiUp E{ACT, FF};
      GEMM_PHASE(pg8::EpiUp); }
    GSYNC();
    if (PH(16)) { pg8::EpiRes E{Y, Y + (size_t)MP * 1024, Y, MOD + 8 * 1024, 0.5f};
      { int ksub_ = 256; asm volatile("" : "+s"(ksub_)); pg8::Gemm g2{ACT + (size_t)MP * FF, (const bf16*)(a.ws + WS_WD2), 256, 1024, ksub_, FF}; pg8::SplitOrder S2; S2.init(G, bx); pg8::EpiPartial E2{(float*)(a.ws + WS_PART), 4, 256}; GEMM_PHASE_SPLIT(); }
      { pg8::Gemm g{ACT, (const bf16*)(a.ws + WS_WD2), MP, 1024, FF, FF}; pg8::StaticOrder S; S.init(MP, 1024, G, bx); GEMM_PHASE(pg8::EpiRes); }
      GSYNC();
      if (bx < 32) pg8::reduce_rowgroup<11>((const float*)(a.ws + WS_PART), bx & 3, bx >> 2, E, wave); }
    }
}


#undef tid
#undef lane
extern "C" void kernel_launch(void* const* d_in, const int* in_sizes, int n_in, void* d_out, int out_size, void* d_ws, size_t ws_size, hipStream_t stream) {
    static int grid = 0;
    if (grid == 0) {
        if (n_in != 28 || (size_t)out_size != O_END || ws_size < WS_END || in_sizes[0] != MP * 1024) { fprintf(stderr, "kernel_launch: unexpected shapes (n_in %d out %d ws %zu)\n", n_in, out_size, ws_size); grid = -1; return; }
        int dev = 0, cus = 0, per_cu = 0;
        hipGetDevice(&dev); hipDeviceGetAttribute(&cus, hipDeviceAttributeMultiprocessorCount, dev);
        if (hipFuncSetAttribute((const void*)fox_fwd, hipFuncAttributeMaxDynamicSharedMemorySize, LDS_BYTES) != hipSuccess) { fprintf(stderr, "kernel_launch: hipFuncSetAttribute failed\n"); grid = -1; return; }
        if (hipOccupancyMaxActiveBlocksPerMultiprocessor(&per_cu, (const void*)fox_fwd, NTHR, LDS_BYTES) != hipSuccess || per_cu < 1) { fprintf(stderr, "kernel_launch: occupancy query says %d\n", per_cu); per_cu = 1; }
        (void)hipGetLastError();
        grid = cus * 1;
    }
    if (grid < 0) return;
    if (hipMemsetAsync((char*)d_ws + WS_CTL, 0, CTL_ZERO_BYTES, stream) != hipSuccess) { fprintf(stderr, "kernel_launch: hipMemsetAsync failed\n"); return; }
    Args a{};
    for (int i = 0; i < 28; ++i) a.in[i] = (const float*)d_in[i];
    a.out = (float*)d_out; a.ws = (unsigned char*)d_ws;
    void* args[] = {&a};
    hipError_t e = hipLaunchCooperativeKernel((const void*)fox_fwd, dim3(grid), dim3(NTHR), args, LDS_BYTES, stream);
    if (e != hipSuccess) fprintf(stderr, "cooperative launch failed: %s (grid %d)\n", hipGetErrorString(e), grid);
}
```

```cpp
#include <hip/hip_runtime.h>
#include <hip/hip_cooperative_groups.h>
#include <cstdio>
#include <cstdint>
__device__ __forceinline__ int lane_id_() { return (int)__builtin_amdgcn_mbcnt_hi(~0u, __builtin_amdgcn_mbcnt_lo(~0u, 0u)); }
namespace pg8 {
#define PG8_LAS __attribute__((address_space(3)))
typedef unsigned short bf16_t;
typedef short bf16x8 __attribute__((ext_vector_type(8)));
typedef float f32x4 __attribute__((ext_vector_type(4)));
typedef unsigned u32x4 __attribute__((ext_vector_type(4)));
constexpr int BM = 256, BK = 64, HALF = 128, HTB = HALF * BK * 2  , STAGE_BYTES = 8 * HTB, NXCD = 8, WGM = 8;

__host__ __device__ __forceinline__ int lds_byte(int r, int c) { const int st = (r >> 4) * 2 + (c >> 5), rr = r & 15, cc = c & 31, ob = rr * 64 + cc * 2; return st * 1024 + (ob ^ (((ob >> 9) & 1) << 5)); }
__host__ __device__ __forceinline__ void stage_rc(int b, int& R, int& C) { const int st = b / 1024, sb = b % 1024, swz = sb ^ (((sb >> 9) & 1) << 5); R = (st >> 1) * 16 + swz / 64; C = (st & 1) * 32 + (swz % 64) / 2; }
__host__ __device__ __forceinline__ int perm32(int rho) { const int n = rho >> 4, i = rho & 15; return 8 * (i >> 2) + 4 * n + (i & 3); }

struct Unit { int pm, pn, koff; };
struct Gemm { const bf16_t* A; const bf16_t* Bt; int M, N, K, Kp; };

struct StaticOrder {
    int nM, nN, nwg, G, c;
    __host__ __device__ void init(int M, int N, int G_, int c_) { nM = M / BM; nN = N / BM; nwg = nM * nN; G = G_; c = c_; }
    __host__ __device__ bool next(int i, Unit& u) const {
        const long L = (long)i * G + c; if (L >= nwg) return false;
        int wgid = (int)L; { const int q = nwg / NXCD, r = nwg % NXCD, xcd = wgid % NXCD, off = wgid / NXCD; wgid = (xcd < r ? xcd * (q + 1) : r * (q + 1) + (xcd - r) * q) + off; }
        const int nig = WGM * nN, gid = wgid / nig, fm = gid * WGM, gsz = (nM - fm) < WGM ? (nM - fm) : WGM;
        u.pm = fm + ((wgid % nig) % gsz); u.pn = (wgid % nig) / gsz; u.koff = 0; return true;
    }
    __device__ __forceinline__ void a_ready(const Unit&) const {}
    __device__ __forceinline__ void done(const Unit&) const {}
};

template <int NN, int NS, int KSUB> struct SplitOrderT {
    int G, c;
    __host__ __device__ void init(int G_, int c_) { G = G_; c = c_; }
    __host__ __device__ bool next(int i, Unit& u) const { const int L = i * G + c; if (L >= NN * NS) return false; u.pm = 0; u.pn = L % NN; u.koff = (L / NN) * KSUB; return true; }
    __device__ __forceinline__ void a_ready(const Unit&) const {}
    __device__ __forceinline__ void done(const Unit&) const {}
};
typedef SplitOrderT<4, 11, 256> SplitOrder;
__device__ __forceinline__ unsigned cvt_pk_bf16(float lo, float hi) { unsigned r; asm volatile("v_cvt_pk_bf16_f32 %0, %1, %2" : "=v"(r) : "v"(lo), "v"(hi)); return r; }
typedef float f32x2 __attribute__((ext_vector_type(2)));
__device__ __forceinline__ f32x2 gelu_pk(f32x2 v) {
    const f32x2 av = __builtin_elementwise_abs(v), d = av * 0.2316418882f + 1.0f;
    f32x2 t; t.x = __builtin_amdgcn_rcpf(d.x); t.y = __builtin_amdgcn_rcpf(d.y);
    f32x2 q = t * 0.5307027145f + (-0.7265760135f); q = q * t + 0.7107068705f; q = q * t + (-0.142248368f); q = q * t + 0.127414796f; q = q * t;
    const f32x2 s = (v * v) * (-0.72134752044f);
    f32x2 e; e.x = __builtin_amdgcn_exp2f(s.x); e.y = __builtin_amdgcn_exp2f(s.y);
    const f32x2 m = v * (q * e), r = v - m;
    f32x2 o; o.x = v.x < 0.f ? m.x : r.x; o.y = v.y < 0.f ? m.y : r.y; return o;
}

constexpr int MPROMPT = 32768;
constexpr int NMODC = 9216;
typedef unsigned u32x2v __attribute__((ext_vector_type(2)));
__device__ __forceinline__ float sigm(float x) { return __builtin_amdgcn_rcpf(1.0f + __builtin_amdgcn_exp2f(-1.4426950408889634f * x)); }
__device__ __forceinline__ float gelu_tanh(float x) { const float y = 1.5957691216057308f * (x + 0.044715f * x * x * x); return x * sigm(y); }
__device__ __forceinline__ float bf_lo(unsigned w) { return __uint_as_float(w << 16); }
__device__ __forceinline__ float bf_hi(unsigned w) { return __uint_as_float(w & 0xffff0000u); }
__device__ __forceinline__ int mod_row(int pm, int rloc) { return pm < 128 ? (pm >> 6) : 2 + (rloc >> 5); }

struct EpiUp {
    static constexpr bool PERM = true, AFTER_DRAIN = false;
    bf16_t* ACT; int ldc;
    __device__ __forceinline__ void operator()(const f32x4 (&acc)[2][2][4][2], const Unit& u, int wr, int wc, int fr, int fq) const {
        int fr_ = fr, fq_ = fq; asm volatile("" : "+v"(fr_), "+v"(fq_));
        const int row0 = u.pm * BM + wr * 64 + fr_, ch0 = u.pn * HALF + wc * 32 + 8 * fq_;
#pragma unroll
        for (int ai = 0; ai < 2; ++ai)
#pragma unroll
            for (int m = 0; m < 4; ++m) {
                float o[8];
#pragma unroll
                for (int n = 0; n < 2; ++n)
#pragma unroll
                    for (int i = 0; i < 4; ++i) { const float g = acc[ai][0][m][n][i], up = acc[ai][1][m][n][i]; o[4 * n + i] = g * sigm(g) * up; }
                u32x4 w; w.x = cvt_pk_bf16(o[0], o[1]); w.y = cvt_pk_bf16(o[2], o[3]); w.z = cvt_pk_bf16(o[4], o[5]); w.w = cvt_pk_bf16(o[6], o[7]);
                *(u32x4*)(ACT + (size_t)(row0 + ai * HALF + m * 16) * ldc + ch0) = w;
            }
    }
};
struct EpiRes {
    static constexpr bool PERM = true, AFTER_DRAIN = false;
    const float* resp; const float* ress; float* out; const float* gate; float fac;
    __device__ __forceinline__ void rowgroup(const f32x4 (&v)[2][2], int pn, int ai, int m, int wr, int wc, int fr, int fq) const {
        const int rl = wr * 64 + fr + ai * HALF + m * 16, col0 = pn * BM + wc * 32 + 8 * fq;
        const float* gp = gate + (size_t)(2 + (rl >> 5)) * NMODC + col0; float* obase = out + (size_t)128 * BM * 1024;
#pragma unroll
        for (int bj = 0; bj < 2; ++bj)
#pragma unroll
            for (int n = 0; n < 2; ++n) { const size_t off = (size_t)rl * 1024 + col0 + bj * HALF + 4 * n;
                const f32x4 gv = *(const f32x4*)(gp + bj * HALF + 4 * n), rv = *(const f32x4*)(ress + off);
                *(f32x4*)(obase + off) = rv + (gv * fac) * v[bj][n]; }
    }
    __device__ __forceinline__ void operator()(const f32x4 (&acc)[2][2][4][2], const Unit& u, int wr, int wc, int fr, int fq) const {
        int fr_ = fr, fq_ = fq; asm volatile("" : "+v"(fr_), "+v"(fq_));
        const int rl0 = wr * 64 + fr_, col0 = u.pn * BM + wc * 32 + 8 * fq_;
        const float* rbase = (u.pm < 128) ? resp + (size_t)u.pm * BM * 1024 : ress;
        float* obase = out + (size_t)u.pm * BM * 1024;
#pragma unroll
        for (int ai = 0; ai < 2; ++ai)
#pragma unroll
            for (int m = 0; m < 4; ++m) {
                const int rl = rl0 + ai * HALF + m * 16; const float* gp = gate + (size_t)mod_row(u.pm, rl) * NMODC + col0;
#pragma unroll
                for (int bj = 0; bj < 2; ++bj)
#pragma unroll
                    for (int n = 0; n < 2; ++n) {
                        const size_t off = (size_t)rl * 1024 + col0 + bj * HALF + 4 * n;
                        const f32x4 gv = *(const f32x4*)(gp + bj * HALF + 4 * n), rv = *(const f32x4*)(rbase + off);
                        *(f32x4*)(obase + off) = rv + (gv * fac) * acc[ai][bj][m][n];
                    }
            }
    }
};
struct EpiIn {
    static constexpr bool PERM = true, AFTER_DRAIN = false;
    bf16_t *Q, *K, *V, *U, *G2, *SGA, *SGB; float* G2SS; float* QS;
    float *kout_p, *kout_s, *vout_p, *vout_s;
    const float *gq, *gk; float qscale, eps;
    __device__ __forceinline__ void operator()(const f32x4 (&acc)[2][2][4][2], const Unit& u, int wr, int wc, int fr, int fq) const {
        int fr_ = fr, fq_ = fq; asm volatile("" : "+v"(fr_), "+v"(fq_));
        const int pn = u.pn, rl0 = wr * 64 + fr_; const size_t rg0 = (size_t)u.pm * BM;
        if (pn < 4) {
            const bool isq = pn < 2; const int head = 4 * (pn & 1) + wc; const float* gsrc = isq ? gq : gk;
            f32x4 gv[2][2];
#pragma unroll
            for (int bj = 0; bj < 2; ++bj)
#pragma unroll
                for (int n = 0; n < 2; ++n) { gv[bj][n] = *(const f32x4*)(gsrc + 32 * bj + 8 * fq_ + 4 * n); if (isq) gv[bj][n] = gv[bj][n] * qscale; }
            bf16_t* dst = isq ? Q : K;
#pragma unroll
            for (int ai = 0; ai < 2; ++ai)
#pragma unroll
                for (int m = 0; m < 4; ++m) {
                    float ss = 0.f;
#pragma unroll
                    for (int bj = 0; bj < 2; ++bj)
#pragma unroll
                        for (int n = 0; n < 2; ++n) { const f32x4 x = acc[ai][bj][m][n]; ss += (x[0] * x[0] + x[1] * x[1]) + (x[2] * x[2] + x[3] * x[3]); }
                    ss += __shfl_xor(ss, 16); ss += __shfl_xor(ss, 32);
                    const float rstd = 1.0f / sqrtf(ss * (1.0f / 64.0f) + eps);
                    const int rl = rl0 + ai * HALF + m * 16; const size_t r = rg0 + rl;
#pragma unroll
                    for (int bj = 0; bj < 2; ++bj) {
                        const f32x4 o0 = acc[ai][bj][m][0] * rstd * gv[bj][0], o1 = acc[ai][bj][m][1] * rstd * gv[bj][1];
                        const int c = head * 64 + 32 * bj + 8 * fq_;
                        u32x4 w; w.x = cvt_pk_bf16(o0[0], o0[1]); w.y = cvt_pk_bf16(o0[2], o0[3]); w.z = cvt_pk_bf16(o1[0], o1[1]); w.w = cvt_pk_bf16(o1[2], o1[3]);
                        *(u32x4*)(dst + r * 512 + c) = w;
                        if (isq) { if (u.pm == 128) { float* qp = QS + (size_t)rl * 512 + c; *(f32x4*)qp = o0; *(f32x4*)(qp + 4) = o1; } }
                        else { float* kp = (u.pm < 128) ? kout_p + r * 512 + c : kout_s + (size_t)rl * 512 + c; *(f32x4*)kp = o0; *(f32x4*)(kp + 4) = o1; }
                    }
                    asm volatile("" ::: "memory");
                }
        } else if (pn < 6) {
            const int c0 = (pn - 4) * BM + wc * 32 + 8 * fq_;
#pragma unroll
            for (int ai = 0; ai < 2; ++ai)
#pragma unroll
                for (int m = 0; m < 4; ++m) { const int rl = rl0 + ai * HALF + m * 16; const size_t r = rg0 + rl;
#pragma unroll
                    for (int bj = 0; bj < 2; ++bj) { const f32x4 o0 = acc[ai][bj][m][0], o1 = acc[ai][bj][m][1]; const int c = c0 + bj * HALF;
                        u32x4 w; w.x = cvt_pk_bf16(o0[0], o0[1]); w.y = cvt_pk_bf16(o0[2], o0[3]); w.z = cvt_pk_bf16(o1[0], o1[1]); w.w = cvt_pk_bf16(o1[2], o1[3]);
                        *(u32x4*)(V + r * 512 + c) = w;
                        float* vp = (u.pm < 128) ? vout_p + r * 512 + c : vout_s + (size_t)rl * 512 + c;
                        { *(f32x4*)vp = o0; *(f32x4*)(vp + 4) = o1; } } asm volatile("" ::: "memory"); }
        } else if (pn < 10) {
            const bool isv = pn >= 8; const int t2 = (pn - 6) & 1; const int c0 = t2 * BM + wc * 32 + 8 * fq_; bf16_t* dst = isv ? G2 : U;
#pragma unroll
            for (int ai = 0; ai < 2; ++ai)
#pragma unroll
                for (int m = 0; m < 4; ++m) { const int rl = rl0 + ai * HALF + m * 16; const size_t r = rg0 + rl; float ss = 0.f;
#pragma unroll
                    for (int bj = 0; bj < 2; ++bj) { float o[8];
#pragma unroll
                        for (int n = 0; n < 2; ++n)
#pragma unroll
                            for (int i = 0; i < 4; ++i) { const float g = gelu_tanh(acc[ai][bj][m][n][i]); o[4 * n + i] = g; ss += g * g; }
                        u32x4 w; w.x = cvt_pk_bf16(o[0], o[1]); w.y = cvt_pk_bf16(o[2], o[3]); w.z = cvt_pk_bf16(o[4], o[5]); w.w = cvt_pk_bf16(o[6], o[7]);
                        *(u32x4*)(dst + r * 512 + c0 + bj * HALF) = w; }
                    if (isv) { ss += __shfl_xor(ss, 16); ss += __shfl_xor(ss, 32); if (fq_ == 0) G2SS[r * 8 + t2 * 4 + wc] = ss; } asm volatile("" ::: "memory"); }
        } else {
            const bool isa = pn < 14; const int c0 = ((pn - 10) & 3) * BM + wc * 32 + 8 * fq_; bf16_t* dst = isa ? SGA : SGB;
#pragma unroll
            for (int ai = 0; ai < 2; ++ai)
#pragma unroll
                for (int m = 0; m < 4; ++m) { const size_t r = rg0 + rl0 + ai * HALF + m * 16;
#pragma unroll
                    for (int bj = 0; bj < 2; ++bj) { float o[8];
#pragma unroll
                        for (int n = 0; n < 2; ++n)
#pragma unroll
                            for (int i = 0; i < 4; ++i) o[4 * n + i] = sigm(acc[ai][bj][m][n][i]);
                        u32x4 w; w.x = cvt_pk_bf16(o[0], o[1]); w.y = cvt_pk_bf16(o[2], o[3]); w.z = cvt_pk_bf16(o[4], o[5]); w.w = cvt_pk_bf16(o[6], o[7]);
                        *(u32x4*)(dst + r * 1024 + c0 + bj * HALF) = w;
                        } asm volatile("" ::: "memory"); }
        }
    }
};
struct EpiPartial {
    static constexpr bool PERM = true, AFTER_DRAIN = false;
    float* PART; int nN, Ksub;
    __device__ __forceinline__ void operator()(const f32x4 (&acc)[2][2][4][2], const Unit& u, int wr, int wc, int fr, int fq) const {
        int tid_ = (wr * 4 + wc) * 64 + fq * 16 + fr; asm volatile("" : "+v"(tid_));
        f32x4* dst = (f32x4*)PART + (size_t)((u.koff >> 8) * 4 + u.pn) * 32 * 512 + tid_;
#pragma unroll
        for (int ai = 0; ai < 2; ++ai)
#pragma unroll
            for (int bj = 0; bj < 2; ++bj)
#pragma unroll
                for (int m = 0; m < 4; ++m)
#pragma unroll
                    for (int n = 0; n < 2; ++n) { *dst = acc[ai][bj][m][n]; dst += 512; asm volatile("" : "+v"(dst) :: "memory"); }
        asm volatile("" ::: "memory");
    }
};
template <int NN, int KSHIFT> struct EpiPartialT {
    static constexpr bool PERM = true, AFTER_DRAIN = false;
    float* PART;
    __device__ __forceinline__ void operator()(const f32x4 (&acc)[2][2][4][2], const Unit& u, int wr, int wc, int fr, int fq) const {
        int tid_ = (wr * 4 + wc) * 64 + fq * 16 + fr; asm volatile("" : "+v"(tid_));
        f32x4* dst = (f32x4*)PART + (size_t)((u.koff >> KSHIFT) * NN + u.pn) * 32 * 512 + tid_;
#pragma unroll
        for (int ai = 0; ai < 2; ++ai)
#pragma unroll
            for (int bj = 0; bj < 2; ++bj)
#pragma unroll
                for (int m = 0; m < 4; ++m)
#pragma unroll
                    for (int n = 0; n < 2; ++n) { *dst = acc[ai][bj][m][n]; dst += 512; asm volatile("" : "+v"(dst) :: "memory"); }
    }
};
template <class Epi> __device__ __forceinline__ void reduce_partials(const float* PART, int nN, int nS, int pn, int pm_out, const Epi& E, int wv) {
    int tid = (wv << 6) | lane_id_(); asm volatile("" : "+v"(tid));
    const int wid = __builtin_amdgcn_readfirstlane(tid >> 6), lane = tid & 63, wr = wid >> 2, wc = wid & 3, fr = lane & 15, fq = lane >> 4;
    f32x4 acc[2][2][4][2];
#pragma unroll
    for (int ai = 0; ai < 2; ++ai)
#pragma unroll
        for (int bj = 0; bj < 2; ++bj)
#pragma unroll
            for (int m = 0; m < 4; ++m)
#pragma unroll
                for (int n = 0; n < 2; ++n) acc[ai][bj][m][n] = (f32x4){0.f, 0.f, 0.f, 0.f};
#pragma unroll 1
    for (int s = 0; s < nS; ++s) { const f32x4* src = (const f32x4*)PART + (size_t)(s * nN + pn) * 32 * 512 + tid;
#pragma unroll
        for (int ai = 0; ai < 2; ++ai) {
            f32x4 t[2][4][2];
#pragma unroll
            for (int bj = 0; bj < 2; ++bj)
#pragma unroll
                for (int m = 0; m < 4; ++m)
#pragma unroll
                    for (int n = 0; n < 2; ++n) { t[bj][m][n] = *src; src += 512; asm volatile("" : "+v"(src)); }
#pragma unroll
            for (int bj = 0; bj < 2; ++bj)
#pragma unroll
                for (int m = 0; m < 4; ++m)
#pragma unroll
                    for (int n = 0; n < 2; ++n) acc[ai][bj][m][n] += t[bj][m][n];
            asm volatile("" ::: "memory"); } }
    Unit u; u.pm = pm_out; u.pn = pn; u.koff = 0;
    E(acc, u, wr, wc, fr, fq);
}
template <int NS, class Epi> __device__ __forceinline__ void reduce_rowgroup(const float* PART, int pn, int rg, const Epi& E, int wv) {
    int tid = (wv << 6) | lane_id_(); asm volatile("" : "+v"(tid));
    const int wid = __builtin_amdgcn_readfirstlane(tid >> 6), lane = tid & 63, wr = wid >> 2, wc = wid & 3, fr = lane & 15, fq = lane >> 4;
    const int ai = rg >> 2, m = rg & 3;
    f32x4 t[NS][2][2];
#pragma unroll
    for (int s = 0; s < NS; ++s)
#pragma unroll
        for (int bj = 0; bj < 2; ++bj)
#pragma unroll
            for (int n = 0; n < 2; ++n) t[s][bj][n] = *((const f32x4*)PART + ((size_t)(s * 4 + pn) * 32 + (((ai * 2 + bj) * 4 + m) * 2 + n)) * 512 + tid);
    f32x4 v[2][2];
#pragma unroll
    for (int bj = 0; bj < 2; ++bj)
#pragma unroll
        for (int n = 0; n < 2; ++n) { v[bj][n] = t[0][bj][n];
#pragma unroll
            for (int s = 1; s < NS; ++s) v[bj][n] += t[s][bj][n]; }
    E.rowgroup(v, pn, ai, m, wr, wc, fr, fq);
}
template <int MODE> struct EpiMix {
    static constexpr bool PERM = true, AFTER_DRAIN = false;
    bf16_t* T; const bf16_t* T2;
    __device__ __forceinline__ void one(size_t off, const f32x4 a0, const f32x4 a1) const {
        float o[8] = {a0[0], a0[1], a0[2], a0[3], a1[0], a1[1], a1[2], a1[3]};
        if (MODE >= 1) {
            const u32x4 t = *(const u32x4*)(T + off);
            const float tv[8] = {bf_lo(t.x), bf_hi(t.x), bf_lo(t.y), bf_hi(t.y), bf_lo(t.z), bf_hi(t.z), bf_lo(t.w), bf_hi(t.w)};
            if (MODE == 1) {
#pragma unroll
                for (int i = 0; i < 8; ++i) o[i] = sigm(o[i]) * tv[i];
            } else {
                const u32x4 s2 = *(const u32x4*)(T2 + off);
                const float sv[8] = {bf_lo(s2.x), bf_hi(s2.x), bf_lo(s2.y), bf_hi(s2.y), bf_lo(s2.z), bf_hi(s2.z), bf_lo(s2.w), bf_hi(s2.w)};
#pragma unroll
                for (int i = 0; i < 8; ++i) o[i] = tv[i] + sigm(o[i]) * sv[i];
            }
        }
        u32x4 w; w.x = cvt_pk_bf16(o[0], o[1]); w.y = cvt_pk_bf16(o[2], o[3]); w.z = cvt_pk_bf16(o[4], o[5]); w.w = cvt_pk_bf16(o[6], o[7]);
        *(u32x4*)(T + off) = w;
    }
    __device__ __forceinline__ void operator()(const f32x4 (&acc)[2][2][4][2], const Unit& u, int wr, int wc, int fr, int fq) const {
        int fr_ = fr, fq_ = fq; asm volatile("" : "+v"(fr_), "+v"(fq_));
        const size_t row0 = (size_t)u.pm * BM + wr * 64 + fr_; const int col0 = u.pn * BM + wc * 32 + 8 * fq_;
#pragma unroll
        for (int ai = 0; ai < 2; ++ai)
#pragma unroll
            for (int m = 0; m < 4; ++m) {
#pragma unroll
                for (int bj = 0; bj < 2; ++bj) one((row0 + ai * HALF + m * 16) * 1024 + col0 + bj * HALF, acc[ai][bj][m][0], acc[ai][bj][m][1]);
                asm volatile("" ::: "memory");
            }
    }
    __device__ __forceinline__ void rowgroup(const f32x4 (&v)[2][2], int pn, int ai, int m, int wr, int wc, int fr, int fq) const {
        const size_t row = (size_t)(wr * 64 + fr + ai * HALF + m * 16); const int col0 = pn * BM + wc * 32 + 8 * fq;
#pragma unroll
        for (int bj = 0; bj < 2; ++bj) one(row * 1024 + col0 + bj * HALF, v[bj][0], v[bj][1]);
    }
};
template <class Epi, class Sched, bool ALIGN_EPI = false, bool SP2 = false>
__device__ __forceinline__ void gemm_phase(PG8_LAS unsigned char* lds, const Gemm g, const Sched& S, const Epi& E, int wv) {
    int tid = (wv << 6) | lane_id_(); asm volatile("" : "+v"(tid));
    const int wid = __builtin_amdgcn_readfirstlane(tid >> 6), lane = tid & 63, wr = wid >> 2, wc = wid & 3, fr = lane & 15, fq = lane >> 4;
    const int K = g.Kp, nt = g.K / BK;
    unsigned voffA[2], voffB[2];
#pragma unroll
    for (int i = 0; i < 2; ++i) { int R, C; stage_rc(tid * 16 + i * 8192, R, C); const int Rb = Epi::PERM ? ((R & ~31) + perm32(R & 31)) : R;
        voffA[i] = (unsigned)(R * K + C) * 2u; voffB[i] = (unsigned)(Rb * K + C) * 2u; }
    const size_t kstep = (size_t)(BK * 2);
    const size_t hstep = (size_t)HALF * K * 2;
    const size_t tstep = 2 * hstep;
    const unsigned ldsw = (unsigned)wid * 1024u;
    const int aoff = lds_byte(wr * 64 + fr, fq * 8), boff = lds_byte(wc * 32 + fr, fq * 8);
#define PG8_SA(b, h) (((b) * 2 + (h)) * HTB)
#define PG8_SB(b, h) ((4 + (b) * 2 + (h)) * HTB)
#define PG8_STAGE(bufoff, gbase, voff) do { _Pragma("unroll") for (int _i = 0; _i < 2; ++_i) \
        __builtin_amdgcn_global_load_lds((const unsigned*)((const char*)(gbase) + (voff)[_i]), (PG8_LAS unsigned*)(lds + (bufoff) + ldsw + _i * 8192), 16, 0, 0); } while (0)
#define PG8_LDA(dst, b, h) do { _Pragma("unroll") for (int m = 0; m < 4; ++m) _Pragma("unroll") for (int k = 0; k < 2; ++k) dst[m][k] = *(const PG8_LAS bf16x8*)(lds + PG8_SA(b, h) + aoff + m * 2048 + k * 1024); } while (0)
#define PG8_LDB(dst, b, h) do { _Pragma("unroll") for (int n = 0; n < 2; ++n) _Pragma("unroll") for (int k = 0; k < 2; ++k) dst[n][k] = *(const PG8_LAS bf16x8*)(lds + PG8_SB(b, h) + boff + n * 2048 + k * 1024); } while (0)
#define PG8_MMA(ai, bj, At, Bt) do { __builtin_amdgcn_s_setprio(1); _Pragma("unroll") for (int m = 0; m < 4; ++m) _Pragma("unroll") for (int n = 0; n < 2; ++n) _Pragma("unroll") for (int k = 0; k < 2; ++k) \
        acc[ai][bj][m][n] = __builtin_amdgcn_mfma_f32_16x16x32_bf16(Bt[n][k], At[m][k], acc[ai][bj][m][n], 0, 0, 0); __builtin_amdgcn_s_setprio(0); } while (0)
#define PG8_WAIT_V(n) asm volatile("s_waitcnt vmcnt(" #n ")" ::: "memory")
#define PG8_WAIT_L(n) asm volatile("s_waitcnt lgkmcnt(" #n ")" ::: "memory")
#define PG8_BAR __builtin_amdgcn_s_barrier()
#define PG8_SCHED __builtin_amdgcn_sched_barrier(0)
    Unit cur, nxt; int ui = 0;
    if (!S.next(0, cur)) return;
    f32x4 acc[2][2][4][2];
#pragma unroll
    for (int a = 0; a < 2; ++a)
#pragma unroll
        for (int b = 0; b < 2; ++b)
#pragma unroll
            for (int m = 0; m < 4; ++m)
#pragma unroll
                for (int n = 0; n < 2; ++n) acc[a][b][m][n] = (f32x4){0.f, 0.f, 0.f, 0.f};
    bf16x8 At[4][2], B0[2][2], B1[2][2];
    const char* cA = (const char*)g.A + (size_t)cur.pm * tstep + (size_t)cur.koff * 2; const char* cB = (const char*)g.Bt + (size_t)cur.pn * tstep + (size_t)cur.koff * 2;
    S.a_ready(cur);
    if constexpr (SP2) {
        PG8_STAGE(PG8_SB(0, 0), cB, voffB); PG8_STAGE(PG8_SB(0, 1), cB + hstep, voffB); PG8_STAGE(PG8_SA(0, 0), cA, voffA); PG8_STAGE(PG8_SA(0, 1), cA + hstep, voffA);
        if (wr == 1) PG8_BAR;
        PG8_WAIT_V(2); PG8_BAR;
        PG8_STAGE(PG8_SB(1, 0), cB + kstep, voffB); PG8_STAGE(PG8_SA(1, 0), cA + kstep, voffA); PG8_STAGE(PG8_SB(1, 1), cB + hstep + kstep, voffB);
        PG8_WAIT_V(6); PG8_BAR;
    } else {
        PG8_STAGE(PG8_SB(0, 0), cB, voffB); PG8_STAGE(PG8_SA(0, 0), cA, voffA); PG8_STAGE(PG8_SB(0, 1), cB + hstep, voffB); PG8_STAGE(PG8_SA(0, 1), cA + hstep, voffA);
        if (wr == 1) PG8_BAR;
        PG8_WAIT_V(4); PG8_BAR;
        PG8_STAGE(PG8_SB(1, 0), cB + kstep, voffB); PG8_STAGE(PG8_SA(1, 0), cA + kstep, voffA); PG8_STAGE(PG8_SB(1, 1), cB + hstep + kstep, voffB);
        PG8_WAIT_V(6); PG8_BAR;
    }
    for (;;) {
        const bool has_next = S.next(ui + 1, nxt);
        const char* nA = has_next ? (const char*)g.A + (size_t)nxt.pm * tstep + (size_t)nxt.koff * 2 : cA; const char* nB = has_next ? (const char*)g.Bt + (size_t)nxt.pn * tstep + (size_t)nxt.koff * 2 : cB;
        for (int t = 0; t < nt; t += 2) {
            const bool last = (t == nt - 2);
            const char* a1 = cA + (size_t)(t + 1) * kstep;
            const char* a2 = last ? nA : cA + (size_t)(t + 2) * kstep; const char* b2 = last ? nB : cB + (size_t)(t + 2) * kstep;
            const char* a3 = a2 + kstep; const char* b3 = b2 + kstep;
            if (last && has_next) S.a_ready(nxt);
            if constexpr (SP2) {
            PG8_LDB(B0, 0, 0); PG8_LDB(B1, 0, 1); PG8_SCHED; PG8_LDA(At, 0, 0); PG8_STAGE(PG8_SA(1, 1), a1 + hstep, voffA);
            PG8_WAIT_V(8); PG8_WAIT_L(0); PG8_BAR; PG8_MMA(0, 0, At, B0); PG8_MMA(0, 1, At, B1); PG8_BAR; PG8_SCHED;
            PG8_LDA(At, 0, 1); PG8_STAGE(PG8_SB(0, 0), b2, voffB); PG8_STAGE(PG8_SB(0, 1), b2 + hstep, voffB); PG8_STAGE(PG8_SA(0, 0), a2, voffA);
            PG8_WAIT_V(8); PG8_WAIT_L(0); PG8_BAR; PG8_MMA(1, 0, At, B0); PG8_MMA(1, 1, At, B1); PG8_BAR; PG8_SCHED;
            PG8_LDB(B0, 1, 0); PG8_LDB(B1, 1, 1); PG8_SCHED; PG8_LDA(At, 1, 0); PG8_STAGE(PG8_SA(0, 1), a2 + hstep, voffA);
            PG8_WAIT_V(8); PG8_WAIT_L(0); PG8_BAR; PG8_MMA(0, 0, At, B0); PG8_MMA(0, 1, At, B1); PG8_BAR; PG8_SCHED;
            PG8_LDA(At, 1, 1); PG8_STAGE(PG8_SB(1, 0), b3, voffB); PG8_STAGE(PG8_SB(1, 1), b3 + hstep, voffB); PG8_STAGE(PG8_SA(1, 0), a3, voffA);
            PG8_WAIT_V(8); PG8_WAIT_L(0); PG8_BAR; PG8_MMA(1, 0, At, B0); PG8_MMA(1, 1, At, B1); PG8_BAR; PG8_SCHED;
            } else {
            PG8_LDB(B0, 0, 0); PG8_SCHED; PG8_LDA(At, 0, 0); PG8_STAGE(PG8_SA(1, 1), a1 + hstep, voffA);
            PG8_WAIT_L(8); PG8_BAR; PG8_WAIT_L(0); PG8_MMA(0, 0, At, B0); PG8_BAR; PG8_SCHED;
            PG8_LDB(B1, 0, 1); PG8_STAGE(PG8_SB(0, 0), b2, voffB);
            PG8_BAR; PG8_WAIT_L(0); PG8_MMA(0, 1, At, B1); PG8_BAR;
            PG8_LDA(At, 0, 1); PG8_STAGE(PG8_SA(0, 0), a2, voffA);
            PG8_BAR; PG8_WAIT_L(0); PG8_MMA(1, 0, At, B0); PG8_BAR; PG8_SCHED;
            PG8_STAGE(PG8_SB(0, 1), b2 + hstep, voffB);
            PG8_WAIT_V(6); PG8_BAR; PG8_MMA(1, 1, At, B1); PG8_BAR;
            PG8_LDB(B0, 1, 0); PG8_SCHED; PG8_LDA(At, 1, 0); PG8_STAGE(PG8_SA(0, 1), a2 + hstep, voffA);
            PG8_WAIT_L(8); PG8_BAR; PG8_WAIT_L(0); PG8_MMA(0, 0, At, B0); PG8_BAR; PG8_SCHED;
            PG8_LDB(B1, 1, 1); PG8_STAGE(PG8_SB(1, 0), b3, voffB);
            PG8_BAR; PG8_WAIT_L(0); PG8_MMA(0, 1, At, B1); PG8_BAR;
            PG8_LDA(At, 1, 1); PG8_STAGE(PG8_SA(1, 0), a3, voffA);
            PG8_BAR; PG8_WAIT_L(0); PG8_MMA(1, 0, At, B0); PG8_BAR; PG8_SCHED;
            PG8_STAGE(PG8_SB(1, 1), b3 + hstep, voffB);
            PG8_WAIT_V(6); PG8_BAR; PG8_MMA(1, 1, At, B1); PG8_BAR;
            }
        }
        if constexpr (ALIGN_EPI) { if (wr == 0) PG8_BAR; }
        if constexpr (!Epi::AFTER_DRAIN) { E(acc, cur, wr, wc, fr, fq); S.done(cur); }
        if (!has_next) break;
#pragma unroll
        for (int a = 0; a < 2; ++a)
#pragma unroll
            for (int b = 0; b < 2; ++b)
#pragma unroll
                for (int m = 0; m < 4; ++m)
#pragma unroll
                    for (int n = 0; n < 2; ++n) acc[a][b][m][n] = (f32x4){0.f, 0.f, 0.f, 0.f};
        cur = nxt; cA = nA; cB = nB; ++ui;
        if constexpr (ALIGN_EPI) { if (wr == 1) PG8_BAR; }
    }
    PG8_WAIT_V(0);
    if constexpr (!ALIGN_EPI) { if (wr == 0) PG8_BAR; }
    PG8_BAR;
    if constexpr (Epi::AFTER_DRAIN) { E.fused(acc, cur, wr, wc, fr, fq, lds, wid, lane); S.done(cur); }
#undef PG8_SA
#undef PG8_SB
#undef PG8_STAGE
#undef PG8_LDA
#undef PG8_LDB
#undef PG8_MMA
#undef PG8_WAIT_V
#undef PG8_WAIT_L
#undef PG8_BAR
#undef PG8_SCHED
}

template <class Epi, class Sched>
__device__ __forceinline__ void naive_phase(const Gemm g, const Sched& S, const Epi& E) {
    int tid = threadIdx.x; asm volatile("" : "+v"(tid));
    const int wid = __builtin_amdgcn_readfirstlane(tid >> 6), lane = tid & 63, wr = wid >> 2, wc = wid & 3, fr = lane & 15, fq = lane >> 4;
    Unit u;
#pragma unroll 1
    for (int ui = 0; S.next(ui, u); ++ui) {
        f32x4 acc[2][2][4][2];
#pragma unroll
        for (int ai = 0; ai < 2; ++ai)
#pragma unroll
            for (int m = 0; m < 4; ++m) {
                const bf16_t* arow = g.A + (size_t)(u.pm * BM + ai * HALF + wr * 64 + m * 16 + fr) * g.Kp;
#pragma unroll
                for (int bj = 0; bj < 2; ++bj)
#pragma unroll
                    for (int n = 0; n < 2; ++n)
#pragma unroll
                        for (int i = 0; i < 4; ++i) {
                            const bf16_t* brow = g.Bt + (size_t)(u.pn * BM + bj * HALF + wc * 32 + 8 * fq + 4 * n + i) * g.Kp;
                            float s = 0.f;
#pragma unroll 1
                            for (int k = 0; k < g.K; k += 8) { const u32x4 a = *(const u32x4*)(arow + k), b = *(const u32x4*)(brow + k);
                                s += bf_lo(a.x) * bf_lo(b.x) + bf_hi(a.x) * bf_hi(b.x) + bf_lo(a.y) * bf_lo(b.y) + bf_hi(a.y) * bf_hi(b.y)
                                   + bf_lo(a.z) * bf_lo(b.z) + bf_hi(a.z) * bf_hi(b.z) + bf_lo(a.w) * bf_lo(b.w) + bf_hi(a.w) * bf_hi(b.w); }
                            acc[ai][bj][m][n][i] = s;
                        }
            }
        E(acc, u, wr, wc, fr, fq);
    }
    __syncthreads();
}
}
#include <hip/hip_bf16.h>
#include <cmath>
namespace attn_body {
using bf16=__hip_bfloat16;
using bf16x8=__attribute__((ext_vector_type(8)))short;
using s16x4=__attribute__((ext_vector_type(4)))short;
using f32x16=__attribute__((ext_vector_type(16)))float;
using u32x4=__attribute__((ext_vector_type(4)))unsigned;
using f32x4_t=__attribute__((ext_vector_type(4)))float;
constexpr int BATCH=2,NHEAD=8,SEQ=16384,D=64,DM=NHEAD*D;
constexpr int NW=8,QBLK=32,QB=QBLK*NW,KVBLK=64,NQB=SEQ/QB;
constexpr int ATTN_PITCH=DM, ATTN_UNIT_ROWS=QB;
__device__ __forceinline__ int crow(int r,int hi){return (r&3)+8*(r>>2)+4*hi;}
#define SBAR() __builtin_amdgcn_sched_barrier(0)
__device__ __forceinline__ void cmask(f32x16&p0,f32x16&p1,int jb,int qrel,int hi){
  const float NEG=-INFINITY; int kb=64*jb+4*hi;
  #pragma unroll
  for(int r=0;r<16;++r){int kv=kb+(r&3)+8*(r>>2); if(kv>qrel)p0[r]=NEG; if(kv+32>qrel)p1[r]=NEG;}
}

constexpr int NSLOT=3, SLOTB=8192;
constexpr int LDS_K=0, LDS_V=NSLOT*SLOTB, LDS_WS=2*NSLOT*SLOTB, LDS_OST=LDS_WS+NW*64*4, LDS_BYTES=LDS_OST+NW*4096, LDS_BIAS=LDS_BYTES, LDS_TOTAL=LDS_BIAS+SEQ*4;
constexpr float C2=0.125f*1.4426950408889634f;
__device__ __forceinline__ void glds16(const void*gsrc,unsigned lds_dst){unsigned keep;
  asm volatile("s_mov_b32 %0, m0\n\ts_mov_b32 m0, %2\n\ts_nop 0\n\tglobal_load_lds_dwordx4 %1, off\n\ts_mov_b32 m0, %0":"=&s"(keep):"v"(gsrc),"s"(lds_dst):"memory");}
__device__ __forceinline__ float max3f(float a,float b,float c){float r;asm("v_max3_f32 %0, %1, %2, %3":"=v"(r):"v"(a),"v"(b),"v"(c));return r;}
__device__ __forceinline__ float max2f(float a,float b){float r;asm("v_max_f32_e32 %0, %1, %2":"=v"(r):"v"(a),"v"(b));return r;}
__device__ __forceinline__ float fadd_s(float a,float b){float r;asm("v_add_f32_e32 %0, %1, %2":"=v"(r):"v"(a),"v"(b));return r;}
__device__ __forceinline__ float fsub_s(float a,float b){float r;asm("v_sub_f32_e32 %0, %1, %2":"=v"(r):"v"(a),"v"(b));return r;}
typedef float f32x2_t __attribute__((ext_vector_type(2))); typedef __bf16 bf16x2_t __attribute__((ext_vector_type(2)));
__device__ __forceinline__ unsigned cvtpk_s(float lo,float hi){f32x2_t v={lo,hi};bf16x2_t b=__builtin_convertvector(v,bf16x2_t);return __builtin_bit_cast(unsigned,b);}
#define WAIT_BAR(N) asm volatile("s_waitcnt vmcnt(" #N ") lgkmcnt(0)\n\ts_barrier":::"memory")

__device__ __forceinline__ void qkt(f32x16&p0,f32x16&p1,const char*Kslot,const bf16x8*qr,int r32,int hi){
  const char*kb=Kslot+hi*1024+r32*16;
  #pragma unroll
  for(int d0=0;d0<4;++d0){
    const bf16x8 b0=*reinterpret_cast<const bf16x8*>(kb+d0*2048);
    const bf16x8 b1=*reinterpret_cast<const bf16x8*>(kb+d0*2048+512);
    p0=__builtin_amdgcn_mfma_f32_32x32x16_bf16(b0,qr[d0],p0,0,0,0);p1=__builtin_amdgcn_mfma_f32_32x32x16_bf16(b1,qr[d0],p1,0,0,0);}
}
typedef __attribute__((address_space(3))) const char* lds_cptr;
typedef short v4i16_t __attribute__((ext_vector_type(4)));
__device__ __forceinline__ void kload8(bf16x8*kf,lds_cptr kp){
  kf[0]=*(const __attribute__((address_space(3))) bf16x8*)(kp);      kf[1]=*(const __attribute__((address_space(3))) bf16x8*)(kp+512);
  kf[2]=*(const __attribute__((address_space(3))) bf16x8*)(kp+2048); kf[3]=*(const __attribute__((address_space(3))) bf16x8*)(kp+2560);
  kf[4]=*(const __attribute__((address_space(3))) bf16x8*)(kp+4096); kf[5]=*(const __attribute__((address_space(3))) bf16x8*)(kp+4608);
  kf[6]=*(const __attribute__((address_space(3))) bf16x8*)(kp+6144); kf[7]=*(const __attribute__((address_space(3))) bf16x8*)(kp+6656);
}
__device__ __forceinline__ void kload2(bf16x8*kf,lds_cptr kp,int j){ kf[2*j]=*(const __attribute__((address_space(3))) bf16x8*)(kp+j*2048); kf[2*j+1]=*(const __attribute__((address_space(3))) bf16x8*)(kp+j*2048+512); }
__device__ __forceinline__ s16x4 vtr(lds_cptr p){ return __builtin_bit_cast(s16x4,__builtin_amdgcn_ds_read_tr16_b64_v4i16((__attribute__((address_space(3))) v4i16_t*)p)); }
__device__ __forceinline__ float rowmax(const f32x16&p0,const f32x16&p1){
  float a=max3f(p0[0],p0[1],p1[0]),b=max3f(p0[2],p0[3],p1[1]);a=max3f(a,p1[2],p1[3]);
  #pragma unroll
  for(int r=4;r<16;r+=4){a=max3f(a,p0[r],p0[r+1]);b=max3f(b,p0[r+2],p0[r+3]);a=max3f(a,p1[r],p1[r+1]);b=max3f(b,p1[r+2],p1[r+3]);}
  const float m=max2f(a,b);
  auto rr=__builtin_amdgcn_permlane32_swap(__float_as_uint(m),__float_as_uint(m),false,false);
  return max2f(__uint_as_float(rr[0]),__uint_as_float(rr[1]));
}
__device__ __forceinline__ void pv(f32x16*o,int vb,bf16x8 pa0,bf16x8 pa1,bf16x8 pa2,bf16x8 pa3){
  #pragma unroll
  for(int d0=0;d0<2;++d0){s16x4 lo[4],hi[4];
    #pragma unroll
    for(int ks=0;ks<4;++ks){
      asm volatile("ds_read_b64_tr_b16 %0,%1 offset:%c2":"=&v"(lo[ks]):"v"(vb),"i"(d0*4096+ks*1024):"memory");
      asm volatile("ds_read_b64_tr_b16 %0,%1 offset:%c2":"=&v"(hi[ks]):"v"(vb),"i"(d0*4096+ks*1024+512):"memory");}
    asm volatile("s_waitcnt lgkmcnt(0)":::"memory");SBAR();
    #define PK(k) (bf16x8){lo[k][0],lo[k][1],lo[k][2],lo[k][3],hi[k][0],hi[k][1],hi[k][2],hi[k][3]}
    o[d0]=__builtin_amdgcn_mfma_f32_32x32x16_bf16(pa0,PK(0),o[d0],0,0,0);
    o[d0]=__builtin_amdgcn_mfma_f32_32x32x16_bf16(pa1,PK(1),o[d0],0,0,0);
    o[d0]=__builtin_amdgcn_mfma_f32_32x32x16_bf16(pa2,PK(2),o[d0],0,0,0);
    o[d0]=__builtin_amdgcn_mfma_f32_32x32x16_bf16(pa3,PK(3),o[d0],0,0,0);
    #undef PK
  }
}

#ifndef ATTN_STORE16
#define ATTN_STORE16(p,v) (*(u32x4*)(p)=(v))
#endif
template<int THRL> __device__ __forceinline__ void attn_unit(int b,int h,int qb,int ts,const float*__restrict__ cl2,const bf16*Q,const bf16*__restrict__ K,const bf16*__restrict__ V,bf16*O,char*shm,int wv){
  int tid=(wv<<6)|lane_id_(); asm volatile("":"+v"(tid)); const int lane=tid&63,r32=lane&31,hi=lane>>5; const int wid=__builtin_amdgcn_readfirstlane(tid>>6);
  const long rowbase=(long)b*SEQ; const int q0=qb*QB;
  const bf16*Qw=Q+(rowbase+q0+wid*QBLK)*DM+h*D;
  const bf16*Kh=K+(rowbase+(long)ts*KVBLK)*DM+h*D,*Vh=V+(rowbase+(long)ts*KVBLK)*DM+h*D;
  const unsigned lds0=(unsigned)(uintptr_t)shm;
  float*wsf=(float*)(shm+LDS_WS)+wid*64;
  const bf16*ksrc=Kh+(long)lane*DM+wid*8;
  const bf16*vsrc=Vh+(long)(16*(wid&3)+(lane>>2))*DM+(wid>>2)*32+(lane&3)*8;
  const unsigned kdst=lds0+LDS_K+wid*1024, vdst=lds0+LDS_V+wid*1024;
  #define DMA_K(t,slot) glds16(ksrc+(long)(t)*KVBLK*DM,(unsigned)__builtin_amdgcn_readfirstlane(kdst+(slot)))
  #define DMA_V(t,slot) glds16(vsrc+(long)(t)*KVBLK*DM,(unsigned)__builtin_amdgcn_readfirstlane(vdst+(slot)))
  const int vb0=(int)(lds0+LDS_V)+((lane>>4)&1)*32+(lane&3)*8+(4*hi+((lane&15)>>2))*64;
  const char*Kbase=shm+LDS_K; bf16x8 kf[8];
  const lds_cptr shm3=(lds_cptr)shm; const lds_cptr kp0=shm3+LDS_K+hi*1024+r32*16; const lds_cptr vp0=shm3+LDS_V+((lane>>4)&1)*32+(lane&3)*8+(4*hi+((lane&15)>>2))*64;
  const int NT=(q0+QB)/KVBLK-ts;
  DMA_K(0,0);DMA_V(0,0);DMA_K(1,SLOTB);
  bf16x8 qr[4];
  #pragma unroll
  for(int d0=0;d0<4;++d0)qr[d0]=*reinterpret_cast<const bf16x8*>(&Qw[(long)r32*DM+d0*16+hi*8]);
  float mhat=0.f,l_reg=0.f;f32x16 o[2];o[0]=f32x16{};o[1]=f32x16{};
  typedef __attribute__((address_space(3))) const f32x4_t* lds_f4p; const lds_f4p biasp=(lds_f4p)((lds_cptr)shm+LDS_BIAS)+hi;
  #define BIASINIT(C0,C1,t) do{ _Pragma("unroll") for(int g_=0;g_<4;++g_){ const f32x4_t b0_=biasp[(t)*16+2*g_], b1_=biasp[(t)*16+8+2*g_]; \
      _Pragma("unroll") for(int i_=0;i_<4;++i_){ C0[4*g_+i_]=b0_[i_]-mhat; C1[4*g_+i_]=b1_[i_]-mhat; } } }while(0)
  const int qrel=wid*QBLK+r32;
  #define CMASK(P0,P1,t) do{int jb_=(t)-(NT-4); if(jb_>=0)cmask(P0,P1,jb_,qrel,hi);}while(0)
  bool resc=false;
  #define START(P0,P1) do{ const float rm=rowmax(P0,P1); resc=false; \
    { const float dl=rm; mhat=fadd_s(mhat,dl); \
      _Pragma("unroll") for(int r=0;r<16;++r){P0[r]=fsub_s(P0[r],dl);P1[r]=fsub_s(P1[r],dl);} } \
    _Pragma("unroll") for(int r=0;r<16;++r)P0[r]=__builtin_amdgcn_exp2f(P0[r]); }while(0)
  #define RESC() do{ if(resc){ asm volatile("s_waitcnt lgkmcnt(0)":::"memory"); \
      _Pragma("unroll") for(int d_=0;d_<2;++d_) _Pragma("unroll") for(int r=0;r<16;++r)o[d_][r]*=wsf[crow(r,hi)]; } }while(0)
  f32x16 pA0,pA1,pB0,pB1;
  int sl_prev=0,sl_cur=0,sl_next=SLOTB;
  #define ROT() do{sl_prev=sl_cur;sl_cur=sl_next;sl_next=(sl_next==(NSLOT-1)*SLOTB)?0:sl_next+SLOTB;}while(0)
  {
    const float cref=cl2[q0]; const f32x4_t*src=(const f32x4_t*)(cl2+ts*KVBLK); __attribute__((address_space(3))) f32x4_t*dst=(__attribute__((address_space(3))) f32x4_t*)((__attribute__((address_space(3))) char*)shm+LDS_BIAS);
    for(int i=tid;i<NT*16;i+=NW*64){ const f32x4_t c4=src[i]; dst[i]=(f32x4_t){cref-c4[0],cref-c4[1],cref-c4[2],cref-c4[3]}; } }
  DMA_K(2,2*SLOTB);
  WAIT_BAR(3);
  BIASINIT(pA0,pA1,0); qkt(pA0,pA1,Kbase,qr,r32,hi);asm volatile("s_nop 15\n\ts_nop 7":"+v"(pA0),"+v"(pA1));CMASK(pA0,pA1,0);
  START(pA0,pA1);
  _Pragma("unroll") for(int r=0;r<16;++r)pA1[r]=__builtin_amdgcn_exp2f(pA1[r]);
  WAIT_BAR(0);
  DMA_K(3,0);DMA_V(1,SLOTB);
  ROT();
  kload8(kf,kp0+sl_cur);
  WAIT_BAR(2);
  s16x4 vlo[8],vhi[8]; u32x4 pw0,pw1,pw2,pw3;
  #define PKW(P,B) cvtpk_s(P[B],P[B+1])
  #define PAF(k) __builtin_bit_cast(bf16x8,pw##k)
  #define VFR(i) (bf16x8){vlo[i][0],vlo[i][1],vlo[i][2],vlo[i][3],vhi[i][0],vhi[i][1],vhi[i][2],vhi[i][3]}
  #define PIN(x) asm volatile("":"+v"(x))
  #define MX3(a,b,c) __builtin_fmaxf(__builtin_fmaxf((a),(b)),(c))
  #define GAPA(MF,A0,A1,A2,A3,W0,W1,PW) do{ MF; sacc+=A0; sacc+=A1; sacc+=A2; sacc+=A3; PIN(sacc); W0; W1; PIN(PW); SBAR(); }while(0)
  #define EX(v) __builtin_amdgcn_exp2f(v)
  #define GAPB(MF,X,B) do{ MF; X[B]=EX(X[B]); X[B+1]=EX(X[B+1]); X[B+2]=EX(X[B+2]); X[B+3]=EX(X[B+3]); PIN(X); SBAR(); }while(0)
  #define VRD(i) do{ vlo[i]=vtr(vp_+(((i)>>2)*4096+((i)&3)*1024)); vhi[i]=vtr(vp_+(((i)>>2)*4096+((i)&3)*1024+512)); }while(0)
  #define KRD(G,j) do{ if(G){ kload2(kf,kp0+sl_next,j); SBAR(); } }while(0)
  #define STEP(C0,C1,P0,P1,t,GK,GV,GL) do{ SBAR(); BIASINIT(C0,C1,t); SBAR(); \
    const lds_cptr vp_=vp0+sl_prev; \
    VRD(0); SBAR(); float sacc=(P0[0]+P0[1]); \
    GAPA(C0=__builtin_amdgcn_mfma_f32_32x32x16_bf16(kf[0],qr[0],C0,0,0,0), P0[2],P0[3],P0[4],P0[5],     pw0[0]=PKW(P0,0), pw0[1]=PKW(P0,2), pw0); \
    VRD(4); SBAR(); GAPA(C1=__builtin_amdgcn_mfma_f32_32x32x16_bf16(kf[1],qr[0],C1,0,0,0), P0[6],P0[7],P0[8],P0[9],     pw0[2]=PKW(P0,4), pw0[3]=PKW(P0,6), pw0); \
    VRD(1); SBAR(); GAPA(C0=__builtin_amdgcn_mfma_f32_32x32x16_bf16(kf[2],qr[1],C0,0,0,0),   P0[10],P0[11],P0[12],P0[13], pw1[0]=PKW(P0,8), pw1[1]=PKW(P0,10), pw1); \
    VRD(5); SBAR(); GAPA(C1=__builtin_amdgcn_mfma_f32_32x32x16_bf16(kf[3],qr[1],C1,0,0,0),   P0[14],P0[15],P1[0],P1[1],   pw1[2]=PKW(P0,12),pw1[3]=PKW(P0,14), pw1); \
    VRD(2); SBAR(); GAPA(C0=__builtin_amdgcn_mfma_f32_32x32x16_bf16(kf[4],qr[2],C0,0,0,0),   P1[2],P1[3],P1[4],P1[5],     pw2[0]=PKW(P1,0), pw2[1]=PKW(P1,2), pw2); \
    VRD(6); SBAR(); GAPA(C1=__builtin_amdgcn_mfma_f32_32x32x16_bf16(kf[5],qr[2],C1,0,0,0),   P1[6],P1[7],P1[8],P1[9],     pw2[2]=PKW(P1,4), pw2[3]=PKW(P1,6), pw2); \
    VRD(3); SBAR(); GAPA(C0=__builtin_amdgcn_mfma_f32_32x32x16_bf16(kf[6],qr[3],C0,0,0,0),   P1[10],P1[11],P1[12],P1[13], pw3[0]=PKW(P1,8), pw3[1]=PKW(P1,10), pw3); \
    VRD(7); SBAR(); GAPA(C1=__builtin_amdgcn_mfma_f32_32x32x16_bf16(kf[7],qr[3],C1,0,0,0),   P1[14],P1[15],0.f,0.f,       pw3[2]=PKW(P1,12),pw3[3]=PKW(P1,14), pw3); \
    l_reg+=sacc; \
    if(GK){DMA_K((t)+3,sl_cur);} if(GV){DMA_V((t)+1,sl_next);} \
    CMASK(C0,C1,t); \
    { float a=MX3(C0[0],C0[1],C1[0]),b=MX3(C0[2],C0[3],C1[1]); a=MX3(a,C1[2],C1[3]); \
      _Pragma("unroll") for(int r=4;r<16;r+=4){a=MX3(a,C0[r],C0[r+1]);b=MX3(b,C0[r+2],C0[r+3]);a=MX3(a,C1[r],C1[r+1]);b=MX3(b,C1[r+2],C1[r+3]);} \
      float rm=__builtin_fmaxf(a,b); { auto rr=__builtin_amdgcn_permlane32_swap(__float_as_uint(rm),__float_as_uint(rm),false,false); rm=__builtin_fmaxf(__uint_as_float(rr[0]),__uint_as_float(rr[1])); } \
      resc=false; \
      if(__builtin_expect(__any(rm>(float)THRL),0)){ const float dl=__builtin_fmaxf(rm,0.f); mhat+=dl; \
        _Pragma("unroll") for(int r=0;r<16;++r){C0[r]-=dl;C1[r]-=dl;} \
        const float f=__builtin_amdgcn_exp2f(-dl); l_reg*=f; if(hi==0)wsf[r32]=f; resc=true; } } \
    SBAR(); \
    GAPB(o[0]=__builtin_amdgcn_mfma_f32_32x32x16_bf16(PAF(0),VFR(0),o[0],0,0,0), C0,0); \
    GAPB(o[1]=__builtin_amdgcn_mfma_f32_32x32x16_bf16(PAF(0),VFR(4),o[1],0,0,0), C0,4); \
    KRD(GL,0); GAPB(o[0]=__builtin_amdgcn_mfma_f32_32x32x16_bf16(PAF(1),VFR(1),o[0],0,0,0), C0,8); \
    KRD(GL,1); GAPB(o[1]=__builtin_amdgcn_mfma_f32_32x32x16_bf16(PAF(1),VFR(5),o[1],0,0,0), C0,12); \
    KRD(GL,2); GAPB(o[0]=__builtin_amdgcn_mfma_f32_32x32x16_bf16(PAF(2),VFR(2),o[0],0,0,0), C1,0); \
    KRD(GL,3); GAPB(o[1]=__builtin_amdgcn_mfma_f32_32x32x16_bf16(PAF(2),VFR(6),o[1],0,0,0), C1,4); \
    GAPB(o[0]=__builtin_amdgcn_mfma_f32_32x32x16_bf16(PAF(3),VFR(3),o[0],0,0,0), C1,8); \
    GAPB(o[1]=__builtin_amdgcn_mfma_f32_32x32x16_bf16(PAF(3),VFR(7),o[1],0,0,0), C1,12); \
    }while(0)
  int t=1;
  #undef CMASK
  #define CMASK(P0,P1,t) do{}while(0)
  for(;t+5<NT;t+=2){
    STEP(pB0,pB1,pA0,pA1,t,true,true,true);     WAIT_BAR(2); RESC(); ROT();
    STEP(pA0,pA1,pB0,pB1,t+1,true,true,true);   WAIT_BAR(2); RESC(); ROT();
  }
  #undef CMASK
  #define CMASK(P0,P1,t) do{int jb_=(t)-(NT-4); if(jb_>=0)cmask(P0,P1,jb_,qrel,hi);}while(0)
  #define ENDW(tt) do{ if((tt)+3<NT){WAIT_BAR(2);} else if((tt)+2<NT){WAIT_BAR(1);} else {WAIT_BAR(0);} }while(0)
  for(;t+1<NT;t+=2){
    STEP(pB0,pB1,pA0,pA1,t,(t+3<NT),(t+1<NT),(t+1<NT));       ENDW(t);   RESC(); ROT();
    STEP(pA0,pA1,pB0,pB1,t+1,(t+4<NT),(t+2<NT),(t+2<NT));     ENDW(t+1); RESC(); ROT();
  }
  STEP(pB0,pB1,pA0,pA1,NT-1,false,false,false); RESC();
  { float sacc=pB0[0]+pB0[1]; _Pragma("unroll") for(int r=2;r<16;++r)sacc+=pB0[r]; _Pragma("unroll") for(int r=0;r<16;++r)sacc+=pB1[r]; l_reg+=sacc;
    pw0=(u32x4){PKW(pB0,0),PKW(pB0,2),PKW(pB0,4),PKW(pB0,6)};pw1=(u32x4){PKW(pB0,8),PKW(pB0,10),PKW(pB0,12),PKW(pB0,14)};pw2=(u32x4){PKW(pB1,0),PKW(pB1,2),PKW(pB1,4),PKW(pB1,6)};pw3=(u32x4){PKW(pB1,8),PKW(pB1,10),PKW(pB1,12),PKW(pB1,14)};
    SBAR(); pv(o,vb0+sl_cur,PAF(0),PAF(1),PAF(2),PAF(3)); }
  #undef PKW
  #undef PAF
  #undef VFR
  #undef PIN
  #undef MX3
  #undef GAPA
  #undef GAPB
  #undef EX
  #undef VRD
  #undef KRD
  #undef STEP
  #undef ENDW
  {auto rr=__builtin_amdgcn_permlane32_swap(__float_as_uint(l_reg),__float_as_uint(l_reg),false,false);l_reg=__uint_as_float(rr[0])+__uint_as_float(rr[1]);}
  if(hi==0)wsf[32+r32]=l_reg;asm volatile("s_waitcnt lgkmcnt(0)":::"memory");
  float rli[16];
  #pragma unroll
  for(int r=0;r<16;++r)rli[r]=__builtin_amdgcn_rcpf(wsf[32+crow(r,hi)]);
  bf16*Ow=O+(rowbase+q0+wid*QBLK)*DM+h*D;
  { bf16*stg=(bf16*)(shm+LDS_OST)+wid*2048;
    #pragma unroll
    for(int r=0;r<16;++r){const int orow=crow(r,hi);
      #pragma unroll
      for(int d0=0;d0<2;++d0)stg[orow*64+d0*32+r32]=__float2bfloat16(o[d0][r]*rli[r]);}
    asm volatile("s_waitcnt lgkmcnt(0)":::"memory");
    #pragma unroll
    for(int i=0;i<4;++i){const int row=i*8+(lane>>3),ch=lane&7; const u32x4 v=*(const u32x4*)(stg+row*64+ch*8); ATTN_STORE16(Ow+(long)row*DM+ch*8,v);} }
  asm volatile("s_waitcnt lgkmcnt(0)\n\ts_barrier":::"memory");
  #undef DMA_K
  #undef DMA_V
  #undef CMASK
  #undef BIASINIT
  #undef START
  #undef RESC
  #undef ROT
}
constexpr int ATTN_LDS_BYTES=LDS_BYTES;
struct AttnTensors { const bf16* Q; const bf16* K; const bf16* V; bf16* O; const float* cl2; };
#undef SBAR
#undef WAIT_BAR
}
#define GEMM_PHASE(...) pg8::gemm_phase<__VA_ARGS__, pg8::StaticOrder, PGA, PGS>(ldsl, g, S, E, wave)
#define GEMM_PHASE_SPLIT() pg8::gemm_phase<pg8::EpiPartial, pg8::SplitOrder, PGA, PGS>(ldsl, g2, S2, E2, wave)
#define GEMM_PHASE_SPLIT_T(NN, NS, KSUB, KSH) pg8::gemm_phase<pg8::EpiPartialT<NN, KSH>, pg8::SplitOrderT<NN, NS, KSUB>, PGA, PGS>(ldsl, g2, S2, E2, wave)
#ifndef PGA
#define PGA true
#endif
#ifndef PGS
#define PGS true
#endif
namespace cg = cooperative_groups;
#define LAS __attribute__((address_space(3)))
typedef unsigned short bf16;
typedef unsigned v4u __attribute__((ext_vector_type(4)));
typedef float f32x4 __attribute__((ext_vector_type(4)));
typedef short bf16x8 __attribute__((ext_vector_type(8)));
typedef float f32x16 __attribute__((ext_vector_type(16)));
constexpr int NWAVES = 8, NTHR = 512, NMODC_ = 9216;
constexpr int MP = 32768, MS = 256, M = MP + MS, DM = 1024, FF = 2816, WA = 512, NIN = 4608, INCOLS = 4616, SEQ = 16384, PAST = 1024, DSEQ = 32, SKEYS = PAST + DSEQ;
constexpr float EPS = 1e-6f, LOG2E = 1.4426950408889634f;
constexpr size_t MiB = 1u << 20;
constexpr size_t WS_CTL = 0, CTL_ZERO_BYTES = 65536;
constexpr size_t WS_MOD = 1 * MiB, WS_CUMP = 2 * MiB, WS_CUMS = 3 * MiB, WS_G2SS = 4 * MiB, WS_QS = 6 * MiB, WS_WSP = 7 * MiB;
constexpr size_t WS_WGU1 = 8 * MiB, WS_WD1 = 19 * MiB, WS_WIN = 25 * MiB, WS_WPA = 34 * MiB, WS_WPB = 35 * MiB, WS_WOUT = 36 * MiB, WS_WGU2 = 38 * MiB, WS_WD2 = 49 * MiB;
constexpr size_t WS_XN = 56 * MiB;
constexpr size_t WS_ACT = 121 * MiB;
constexpr size_t QKV_B = (size_t)M * 512 * 2;
constexpr size_t WS_Q = 121 * MiB, WS_K = WS_Q + QKV_B, WS_V = WS_K + QKV_B, WS_U = WS_V + QKV_B, WS_G2 = WS_U + QKV_B;
constexpr size_t WS_AO = WS_Q;
constexpr size_t WS_T1 = WS_U;
constexpr size_t WS_T2 = WS_K;
constexpr size_t WS_BO = 283 * MiB, WS_PART = 300 * MiB, WS_END = 316 * MiB;
static_assert(WS_XN + (size_t)M * 2048 <= WS_ACT && WS_G2 + QKV_B <= WS_BO && WS_BO + QKV_B <= WS_END && WS_ACT + (size_t)M * FF * 2 <= WS_END, "ws map");
constexpr size_t O_Y = 0, O_KP = (size_t)M * 1024, O_VP = O_KP + (size_t)MP * 512, O_FP = O_VP + (size_t)MP * 512, O_KS = O_FP + (size_t)MP * 8, O_VS = O_KS + (size_t)MS * 512,
                 O_FS = O_VS + (size_t)MS * 512, O_GS = O_FS + (size_t)MS * 8, O_END = O_GS + (size_t)MS * 512;
constexpr int LDS_BYTES = 155648, MISC_OFF = LDS_BYTES - 256;
static_assert(attn_body::LDS_TOTAL <= MISC_OFF && pg8::STAGE_BYTES <= LDS_BYTES, "LDS map");

struct Args { const float* in[28]; float* out; unsigned char* ws; };

__device__ __forceinline__ float wave_sum(float v) {
#pragma unroll
    for (int o = 1; o < 64; o <<= 1) v += __shfl_xor(v, o);
    return v;
}
__device__ __forceinline__ unsigned f2bf(float f) { unsigned u = __builtin_bit_cast(unsigned, f); return (u + 0x7fffu + ((u >> 16) & 1u)) >> 16; }
__device__ __forceinline__ unsigned pk2(float lo, float hi) { return f2bf(lo) | (f2bf(hi) << 16); }
__device__ __forceinline__ float bf2f(unsigned short h) { return __uint_as_float((unsigned)h << 16); }

__device__ __forceinline__ void ada_unit(const Args& a, unsigned char* lds, int cb, int tid) {
    asm volatile("" : "+v"(tid));
    float* SC = (float*)lds; float* RED = (float*)(lds + 40960);
    const float* cp = a.in[2]; const float* cs = a.in[3]; const float* w_ada = a.in[7]; const float* b_ada = a.in[8];
    float* MOD = (float*)(a.ws + WS_MOD);
    for (int i = tid; i < 10240; i += NTHR) { const int r = i >> 10, k = i & 1023; const float c = r < 2 ? cp[r * 1024 + k] : cs[(r - 2) * 1024 + k]; SC[i] = c / (1.0f + expf(-c)); }
    __syncthreads();
    if (tid < 504) {
        const int cgp = tid % 9, ks = tid / 9; f32x4 acc[10];
#pragma unroll
        for (int r = 0; r < 10; ++r) acc[r] = (f32x4){0.f, 0.f, 0.f, 0.f};
        for (int k = ks; k < 1024; k += 56) { const f32x4 w = *(const f32x4*)(w_ada + (size_t)k * NMODC_ + 36 * cb + 4 * cgp);
#pragma unroll
            for (int r = 0; r < 10; ++r) acc[r] += w * SC[r * 1024 + k]; }
#pragma unroll
        for (int r = 0; r < 10; ++r) *(f32x4*)(RED + (size_t)tid * 40 + r * 4) = acc[r];
    }
    __syncthreads();
    if (tid < 360) { const int r = tid / 36, c = tid % 36, cgp = c >> 2, i = c & 3; float s = 0.f;
        for (int ks = 0; ks < 56; ++ks) s += RED[(ks * 9 + cgp) * 40 + r * 4 + i];
        MOD[r * NMODC_ + 36 * cb + c] = s + b_ada[36 * cb + c]; }
    __syncthreads();
}
__device__ __forceinline__ void transpose_item(const float* W, int ld, int c0, int K, bf16* WT, int drow0, int k0, float* scr, int lane) {
#pragma unroll 8
    for (int i = 0; i < 32; ++i) { const int kk = 2 * i + (lane >> 5); scr[kk * 33 + (lane & 31)] = W[(size_t)(k0 + kk) * ld + c0 + (lane & 31)]; }
    asm volatile("s_waitcnt lgkmcnt(0)" ::: "memory");
    const int c = lane & 7;
#pragma unroll
    for (int j = 0; j < 4; ++j) { const int n = (lane >> 3) + 8 * j; const float* s = scr + (8 * c) * 33 + n;
        v4u o; o.x = pk2(s[0 * 33], s[1 * 33]); o.y = pk2(s[2 * 33], s[3 * 33]); o.z = pk2(s[4 * 33], s[5 * 33]); o.w = pk2(s[6 * 33], s[7 * 33]);
        *(v4u*)(WT + (size_t)(drow0 + n) * K + k0 + 8 * c) = o; }
    asm volatile("s_waitcnt lgkmcnt(0)" ::: "memory");
}
struct Seg { int in, ld, c0, ncols, K; size_t dst; int drow, mode; };
__device__ const Seg SEGS[13] = {
        {10, FF, 0, FF, 1024, WS_WGU1, 0, 1}, {11, FF, 0, FF, 1024, WS_WGU1, 0, 2}, {12, 1024, 0, 1024, FF, WS_WD1, 0, 0},
        {14, INCOLS, 0, 512, 1024, WS_WIN, 0, 3}, {14, INCOLS, 512, 512, 1024, WS_WIN, 512, 3}, {14, INCOLS, 1024, 512, 1024, WS_WIN, 1024, 0}, {14, INCOLS, 1544, 3072, 1024, WS_WIN, 1536, 0},
        {21, 1024, 0, 1024, 512, WS_WPA, 0, 0}, {22, 1024, 0, 1024, 512, WS_WPB, 0, 0}, {23, 1024, 0, 1024, 1024, WS_WOUT, 0, 0},
        {25, FF, 0, FF, 1024, WS_WGU2, 0, 1}, {26, FF, 0, FF, 1024, WS_WGU2, 0, 2}, {27, 1024, 0, 1024, FF, WS_WD2, 0, 0}};
__device__ __forceinline__ int seg_drow(const Seg& s, int n) {
    if (s.mode == 0) return s.drow + n;
    if (s.mode == 1) return s.drow + 256 * (n >> 7) + (n & 127);
    if (s.mode == 2) return s.drow + 256 * (n >> 7) + 128 + (n & 127);
    const int gs = (n & 255) >> 5; return s.drow + (n & ~255) + 32 * (4 * (gs & 1) + (gs >> 1));
}
__device__ __forceinline__ void p0_weights(const Args& a, unsigned char* lds, int gw, int NGW, int wave, int lane) {
    asm volatile("" : "+v"(lane));
    float* scr = (float*)(lds + wave * 8704);

    int base = 0;
#pragma unroll 1
    for (int si = 0; si < 13; ++si) {
        const Seg s = SEGS[si]; const int nblk = s.ncols / 32, nitems = (s.K / 64) * nblk;
        int first = (gw - base) % NGW; if (first < 0) first += NGW;
        for (int it = first; it < nitems; it += NGW) { const int kb = it / nblk, nb = it % nblk;
            transpose_item(a.in[s.in], s.ld, s.c0 + 32 * nb, s.K, (bf16*)(a.ws + s.dst), seg_drow(s, 32 * nb), 64 * kb, scr, lane); }
        base = (base + nitems) % NGW;
    }
    const float* wsp = a.in[19]; bf16* WSP = (bf16*)(a.ws + WS_WSP);
    for (int i = gw * 64 + lane; i < 4 * 128 * 128; i += NGW * 64) { const int t = (i >> 7) & 127, s2 = i & 127; WSP[i] = (bf16)f2bf(s2 <= t ? wsp[i] : 0.f); }
}
template <bool LOGF> __device__ __forceinline__ void norm_phase(const Args& a, unsigned char* lds, const float* srcp, const float* srcs, const float* g, int ishift, int iscale,
                                                                 int gw, int NGW, int tid, int lane) {
    asm volatile("" : "+v"(tid), "+v"(lane));
    const float* MOD = (const float*)(a.ws + WS_MOD); bf16* XN = (bf16*)(a.ws + WS_XN);
    float* WFt = (float*)lds;
    if (LOGF) { const float* w_in = a.in[14]; for (int i = tid; i < 8192; i += NTHR) { const int k = i >> 3, j = i & 7; WFt[j * 1024 + k] = w_in[(size_t)k * INCOLS + 1536 + j]; } __syncthreads(); }
    int cur = -1; f32x4 gs[4], shv[4], vn[4], vnn[4];
    if (gw < M) { const float* xrow0 = gw < MP ? srcp + (size_t)gw * 1024 : srcs + (size_t)(gw - MP) * 1024;
#pragma unroll
        for (int j = 0; j < 4; ++j) vn[j] = ((const f32x4*)xrow0 + lane)[64 * j]; }
    if (gw + NGW < M) { const int m1 = gw + NGW; const float* xrow1 = m1 < MP ? srcp + (size_t)m1 * 1024 : srcs + (size_t)(m1 - MP) * 1024;
#pragma unroll
        for (int j = 0; j < 4; ++j) vnn[j] = ((const f32x4*)xrow1 + lane)[64 * j]; }
    for (int m = gw; m < M; m += NGW) {
        const int mr = m < MP ? (m >> 14) : 2 + ((m - MP) >> 5);
        if (mr != cur) { cur = mr; const f32x4* g4 = (const f32x4*)g + lane;
            const f32x4* sh4 = (const f32x4*)(MOD + (size_t)mr * 9216 + ishift * 1024) + lane; const f32x4* sc4 = (const f32x4*)(MOD + (size_t)mr * 9216 + iscale * 1024) + lane;
#pragma unroll
            for (int j = 0; j < 4; ++j) { gs[j] = g4[64 * j] * (sc4[64 * j] + 1.0f); shv[j] = sh4[64 * j]; } }
        f32x4 v[4]; float ss = 0.f;
#pragma unroll
        for (int j = 0; j < 4; ++j) { v[j] = vn[j]; vn[j] = vnn[j]; ss += (v[j].x * v[j].x + v[j].y * v[j].y) + (v[j].z * v[j].z + v[j].w * v[j].w); }
        { const int m2 = m + 2 * NGW; if (m2 < M) { const float* xrow2 = m2 < MP ? srcp + (size_t)m2 * 1024 : srcs + (size_t)(m2 - MP) * 1024;
#pragma unroll
            for (int j = 0; j < 4; ++j) vnn[j] = ((const f32x4*)xrow2 + lane)[64 * j]; } }
        const float rstd = 1.0f / sqrtf(wave_sum(ss) * (1.0f / 1024.0f) + EPS);
        unsigned long long* o8 = (unsigned long long*)(XN + (size_t)m * 1024) + lane;
#pragma unroll
        for (int j = 0; j < 4; ++j) { v[j] = (v[j] * rstd) * gs[j] + shv[j];
            o8[64 * j] = (unsigned long long)pk2(v[j].x, v[j].y) | ((unsigned long long)pk2(v[j].z, v[j].w) << 32); }
        if (LOGF) {
            float f[8];
#pragma unroll
            for (int jj = 0; jj < 8; ++jj) { float s = 0.f;
#pragma unroll
                for (int j = 0; j < 4; ++j) { const f32x4 w = *((const f32x4*)(WFt + jj * 1024) + 64 * j + lane); s += (v[j].x * w.x + v[j].y * w.y) + (v[j].z * w.z + v[j].w * w.w); }
                f[jj] = wave_sum(s); }
            float fj = f[0];
#pragma unroll
            for (int jj = 1; jj < 8; ++jj) fj = (lane == jj) ? f[jj] : fj;
            if (lane < 8) { const float x = fj + a.in[15][lane]; const float lf = (x >= 0.f) ? -log1pf(expf(-x)) : x - log1pf(expf(x));
                float* dst = m < MP ? a.out + O_FP + (size_t)m * 8 : a.out + O_FS + (size_t)(m - MP) * 8; dst[lane] = lf; }
        }
    }
}
__device__ __forceinline__ void scan_unit(const Args& a, unsigned char* lds, int unit, int tid) {
    asm volatile("" : "+v"(tid));
    double* tot = (double*)lds;
    if (unit < 16) {
        const int b = unit >> 3, h = unit & 7; const float* lf = a.out + O_FP + ((size_t)b * SEQ) * 8 + h; float* dst = (float*)(a.ws + WS_CUMP) + (size_t)unit * SEQ;
        float x[32]; double s = 0.0;
#pragma unroll
        for (int i = 0; i < 32; ++i) { x[i] = lf[(size_t)(tid * 32 + i) * 8]; s += (double)x[i]; }
        tot[tid] = s; __syncthreads();
        double pre = 0.0; for (int j = 0; j < tid; ++j) pre += tot[j];
#pragma unroll
        for (int i = 0; i < 32; ++i) { pre += (double)x[i]; dst[tid * 32 + i] = (float)(pre * 1.4426950408889634); }
    } else {
        const int bh = unit - 16, b = bh >> 3, h = bh & 7; const float* lfc = a.in[6] + ((size_t)b * PAST) * 8 + h; const float* lfn = a.out + O_FS + ((size_t)b * DSEQ) * 8 + h;
        float* dst = (float*)(a.ws + WS_CUMS) + (size_t)bh * SKEYS;
        float x[3] = {0.f, 0.f, 0.f}; double s = 0.0;
        if (tid < 352) {
#pragma unroll
            for (int i = 0; i < 3; ++i) { const int p = tid * 3 + i; x[i] = p < PAST ? lfc[(size_t)p * 8] : lfn[(size_t)(p - PAST) * 8]; s += (double)x[i]; } }
        tot[tid] = s; __syncthreads();
        if (tid < 352) { double pre = 0.0; for (int j = 0; j < tid; ++j) pre += tot[j];
#pragma unroll
            for (int i = 0; i < 3; ++i) { pre += (double)x[i]; dst[tid * 3 + i] = (float)(pre * 1.4426950408889634); } }
    }
    __syncthreads();
}
__device__ __forceinline__ void gmlp_unit(const Args& a, unsigned char* lds, int ci, int tid, int wave, int lane) {
    asm volatile("" : "+v"(tid), "+v"(lane));
    constexpr int VP = 136;
    bf16* VT = (bf16*)lds; float* rst = (float*)(lds + 128 * VP * 2);
    const bf16* G2 = (const bf16*)(a.ws + WS_G2); const bf16* U = (const bf16*)(a.ws + WS_U); bf16* BO = (bf16*)(a.ws + WS_BO); const bf16* WSP = (const bf16*)(a.ws + WS_WSP);
    const float* G2SS = (const float*)(a.ws + WS_G2SS); const float* gv = a.in[18]; const float* bsp = a.in[20];
    const size_t R0 = (size_t)ci * 128;
    if (tid < 128) { const f32x4* p = (const f32x4*)(G2SS + (R0 + tid) * 8); const f32x4 s0 = p[0], s1 = p[1]; rst[tid] = 1.0f / sqrtf((((s0.x + s0.y) + (s0.z + s0.w)) + ((s1.x + s1.y) + (s1.z + s1.w))) * (1.0f / 512.0f) + EPS); }
    __syncthreads();
    const int r32 = lane & 31, hi = lane >> 5, tb = wave >> 1, dh = wave & 1;
#pragma unroll 1
    for (int g = 0; g < 4; ++g) {
#pragma unroll
        for (int it = 0; it < 4; ++it) { const int q = tid + NTHR * it, s = q & 127, cch = q >> 7;
            const v4u raw = *(const v4u*)(G2 + (R0 + s) * 512 + g * 128 + 8 * cch); const float rs = rst[s];
            const f32x4 g0 = *(const f32x4*)(gv + g * 128 + 8 * cch), g1 = *(const f32x4*)(gv + g * 128 + 8 * cch + 4);
            bf16* col = VT + (8 * cch) * VP + s;
            col[0 * VP] = (bf16)f2bf(pg8::bf_lo(raw.x) * rs * g0.x); col[1 * VP] = (bf16)f2bf(pg8::bf_hi(raw.x) * rs * g0.y); col[2 * VP] = (bf16)f2bf(pg8::bf_lo(raw.y) * rs * g0.z); col[3 * VP] = (bf16)f2bf(pg8::bf_hi(raw.y) * rs * g0.w);
            col[4 * VP] = (bf16)f2bf(pg8::bf_lo(raw.z) * rs * g1.x); col[5 * VP] = (bf16)f2bf(pg8::bf_hi(raw.z) * rs * g1.y); col[6 * VP] = (bf16)f2bf(pg8::bf_lo(raw.w) * rs * g1.z); col[7 * VP] = (bf16)f2bf(pg8::bf_hi(raw.w) * rs * g1.w); }
        bf16x8 af[8];
#pragma unroll
        for (int ks = 0; ks < 8; ++ks) af[ks] = *(const bf16x8*)(WSP + ((size_t)(g * 128 + 32 * tb + r32)) * 128 + 16 * ks + 8 * hi);
        __syncthreads();
        f32x16 acc[2]; acc[0] = f32x16{}; acc[1] = f32x16{};
#pragma unroll
        for (int ks = 0; ks < 8; ++ks) if (ks <= 2 * tb + 1) {
#pragma unroll
            for (int db = 0; db < 2; ++db) { const bf16x8 bfv = *(const bf16x8*)(VT + (64 * dh + 32 * db + r32) * VP + 16 * ks + 8 * hi); acc[db] = __builtin_amdgcn_mfma_f32_32x32x16_bf16(af[ks], bfv, acc[db], 0, 0, 0); }
        }
#pragma unroll
        for (int db = 0; db < 2; ++db)
#pragma unroll
            for (int r = 0; r < 16; ++r) { const int t = 32 * tb + (r & 3) + 8 * (r >> 2) + 4 * hi, ch = g * 128 + 64 * dh + 32 * db + r32; const size_t off = (R0 + t) * 512 + ch;
                const float mixed = acc[db][r] + bsp[g * 128 + t]; BO[off] = (bf16)f2bf(bf2f(U[off]) * mixed); }
        __syncthreads();
    }
}
__device__ __forceinline__ void gmlp_sample_unit(const Args& a, unsigned char* lds, int b, int tid) {
    asm volatile("" : "+v"(tid));
    float* rst = (float*)lds;
    const bf16* G2 = (const bf16*)(a.ws + WS_G2); const bf16* U = (const bf16*)(a.ws + WS_U); bf16* BO = (bf16*)(a.ws + WS_BO);
    const float* G2SS = (const float*)(a.ws + WS_G2SS); const float* wsp = a.in[19]; const float* bsp = a.in[20];
    const size_t R0 = (size_t)MP + b * 32;
    if (tid < 32) { const float* p = G2SS + (R0 + tid) * 8; float s = 0.f; for (int i = 0; i < 8; ++i) s += p[i]; rst[tid] = 1.0f / sqrtf(s * (1.0f / 512.0f) + EPS); }
    __syncthreads();
    const int ch = tid, g = ch >> 7; const float gvv = a.in[18][ch];
    float vb[32];
#pragma unroll
    for (int s = 0; s < 32; ++s) { vb[s] = bf2f(G2[(R0 + s) * 512 + ch]) * rst[s] * gvv; a.out[O_GS + ((size_t)b * 32 + s) * 512 + ch] = vb[s]; }
#pragma unroll
    for (int t = 0; t < 32; ++t) { float mixed = bsp[g * 128 + t]; const float* wrow = wsp + ((size_t)g * 128 + t) * 128;
#pragma unroll
        for (int s = 0; s < 32; ++s) if (s <= t) mixed += wrow[s] * vb[s];
        const size_t off = (R0 + t) * 512 + ch; BO[off] = (bf16)f2bf(bf2f(U[off]) * mixed); }
    __syncthreads();
}
__device__ __forceinline__ void sattn_unit(const Args& a, unsigned char* lds, int unit, int tid, int wave, int lane) {
    asm volatile("" : "+v"(tid), "+v"(lane));
    const int qg = unit & 3, h = (unit >> 2) & 7, b = unit >> 5;
    float* qs = (float*)lds;
    float* S = qs + 512;
    float* red = S + 8 * SKEYS;
    float* inv = red + 4096;
    const float* QS = (const float*)(a.ws + WS_QS); const float* cum = (const float*)(a.ws + WS_CUMS) + (size_t)(b * 8 + h) * SKEYS;
    const float* kc = a.in[4] + ((size_t)b * PAST) * 512 + h * 64; const float* vc = a.in[5] + ((size_t)b * PAST) * 512 + h * 64;
    const float* kn = a.out + O_KS + ((size_t)b * DSEQ) * 512 + h * 64; const float* vn = a.out + O_VS + ((size_t)b * DSEQ) * 512 + h * 64;
    { const int qi = tid >> 6, d = tid & 63; qs[tid] = QS[((size_t)b * 32 + 8 * qg + qi) * 512 + h * 64 + d]; }
    __syncthreads();
    for (int key = wave * 132 + lane; key < wave * 132 + 132; key += 64) {
        const f32x4* kr = (const f32x4*)(key < PAST ? kc + (size_t)key * 512 : kn + (size_t)(key - PAST) * 512);
        f32x4 kv[16];
#pragma unroll
        for (int i = 0; i < 16; ++i) kv[i] = kr[i];
        const float ck = cum[key];
#pragma unroll
        for (int qi = 0; qi < 8; ++qi) { float s = 0.f;
#pragma unroll
            for (int i = 0; i < 16; ++i) { const f32x4 q4 = *(const f32x4*)(qs + qi * 64 + 4 * i); s += (q4.x * kv[i].x + q4.y * kv[i].y) + (q4.z * kv[i].z + q4.w * kv[i].w); }
            const int qpos = PAST + 8 * qg + qi;
            S[qi * SKEYS + key] = (key <= qpos) ? s + (cum[qpos] - ck) : -INFINITY; }
    }
    __syncthreads();
    { float mx = -INFINITY; for (int k = lane; k < SKEYS; k += 64) mx = fmaxf(mx, S[wave * SKEYS + k]);
#pragma unroll
      for (int o = 1; o < 64; o <<= 1) mx = fmaxf(mx, __shfl_xor(mx, o));
      float sum = 0.f; for (int k = lane; k < SKEYS; k += 64) { const float p = exp2f(S[wave * SKEYS + k] - mx); S[wave * SKEYS + k] = p; sum += p; }
      sum = wave_sum(sum); if (lane == 0) inv[wave] = 1.0f / sum; }
    __syncthreads();
    { float acc[8];
#pragma unroll
      for (int qi = 0; qi < 8; ++qi) acc[qi] = 0.f;
#pragma unroll 1
      for (int key0 = wave * 132; key0 < wave * 132 + 132; key0 += 12) {
          float vv[12];
#pragma unroll
          for (int j = 0; j < 12; ++j) { const int key = key0 + j; vv[j] = (key < PAST ? vc + (size_t)key * 512 : vn + (size_t)(key - PAST) * 512)[lane]; }
#pragma unroll
          for (int j = 0; j < 12; ++j)
#pragma unroll
              for (int qi = 0; qi < 8; ++qi) acc[qi] += S[qi * SKEYS + key0 + j] * vv[j]; }
#pragma unroll
      for (int qi = 0; qi < 8; ++qi) red[(wave * 8 + qi) * 64 + lane] = acc[qi]; }
    __syncthreads();
    { const int qi = tid >> 6, d = tid & 63; float s = 0.f;
#pragma unroll
      for (int w = 0; w < 8; ++w) s += red[(w * 8 + qi) * 64 + d];
      bf16* AO = (bf16*)(a.ws + WS_AO); AO[((size_t)MP + b * 32 + 8 * qg + qi) * 512 + h * 64 + d] = (bf16)f2bf(s * inv[qi]); }
    __syncthreads();
}

#define XB_TMO      128
#define XB_XCNT(j)  (256  + 64 * (j))
#define XB_XSUB(j)  (1280 + 64 * (j))
#define XB_XGEN(j)  (2304 + 64 * (j))
#define XB_TOP      3328
#define XB_TOPGEN   3392
#define XCD_BAR_WORDS 3456
#define XB_SPIN_CAP (1u << 18)

__device__ __forceinline__ unsigned xb_ld(unsigned* p)              { return __hip_atomic_load(p, __ATOMIC_RELAXED, __HIP_MEMORY_SCOPE_AGENT); }
__device__ __forceinline__ unsigned xb_add(unsigned* p, unsigned v) { return __hip_atomic_fetch_add(p, v, __ATOMIC_RELAXED, __HIP_MEMORY_SCOPE_AGENT); }
__device__ __forceinline__ unsigned xb_xcc_id() { return (unsigned)__builtin_amdgcn_s_getreg((3 << 11) | 20) & 0xFu; }
#define XB_SPIN(cond, bar) do { unsigned _sp = 0; while (cond) { __builtin_amdgcn_s_sleep(1); \
    if ((++_sp & 255u) == 0u) { if (xb_ld(&(bar)[XB_TMO])) break; if (_sp > XB_SPIN_CAP) { atomicAdd(&(bar)[XB_TMO], 1u); break; } } } } while (0)

struct XcdBarrier {
    unsigned* bar; unsigned x;
    volatile LAS unsigned* st;
};

__device__ __forceinline__ XcdBarrier xcd_barrier_post(unsigned* bar, volatile LAS unsigned* st, int wv) {
    XcdBarrier b; b.bar = bar; b.x = xb_xcc_id(); b.st = st;
    if (wv == 0 && lane_id_() == 0) (void)xb_add(&bar[XB_XCNT(b.x)], 1u);
    return b;
}
__device__ __forceinline__ void xcd_barrier_complete(unsigned* bar, unsigned x, unsigned& nloc, unsigned& nx) {
    const unsigned G = gridDim.x * gridDim.y * gridDim.z;
    unsigned sum, cnt, mine, sp = 0u;
    for (;;) {
        sum = 0u; cnt = 0u; mine = 0u;
#pragma unroll
        for (unsigned j = 0; j < 16; ++j) { const unsigned c = xb_ld(&bar[XB_XCNT(j)]); sum += c; cnt += (c > 0u) ? 1u : 0u; mine = (j == x) ? c : mine; }
        if (sum == G) break;
        __builtin_amdgcn_s_sleep(1);
        if ((++sp & 255u) == 0u) { if (xb_ld(&bar[XB_TMO])) break; if (sp > XB_SPIN_CAP) { atomicAdd(&bar[XB_TMO], 1u); break; } }
    }
    nloc = mine > 0u ? mine : 1u; nx = cnt > 0u ? cnt : 1u;
}

__device__ __forceinline__ void xcd_barrier(const XcdBarrier& b, int wv) {
    asm volatile("s_waitcnt vmcnt(0)" ::: "memory");
    __syncthreads();
    if (wv == 0 && lane_id_() == 0) {
        unsigned* bar = b.bar;
        __builtin_amdgcn_s_waitcnt(0);
        unsigned nloc = b.st[0], nx = b.st[1];
        if (nloc == 0u) { xcd_barrier_complete(bar, b.x, nloc, nx); b.st[0] = nloc; b.st[1] = nx; }
        const unsigned old = xb_add(&bar[XB_XSUB(b.x)], 1u);
        const unsigned gen = old / nloc;
        if (old + 1u == (gen + 1u) * nloc) {
            __builtin_amdgcn_fence(__ATOMIC_RELEASE, "agent");
            asm volatile("s_waitcnt vmcnt(0)" ::: "memory");
            const unsigned og = xb_add(&bar[XB_TOP], 1u);
            const unsigned tg = og / nx;
            if (og + 1u == (tg + 1u) * nx) xb_add(&bar[XB_TOPGEN], 1u);
            else XB_SPIN(xb_ld(&bar[XB_TOPGEN]) == tg, bar);
            __builtin_amdgcn_fence(__ATOMIC_ACQUIRE, "agent");
            xb_add(&bar[XB_XGEN(b.x)], 1u);
            asm volatile("s_waitcnt vmcnt(0)" ::: "memory");
        } else {
            XB_SPIN(xb_ld(&bar[XB_XGEN(b.x)]) == gen, bar);
            __builtin_amdgcn_fence(__ATOMIC_ACQUIRE, "agent");
            asm volatile("s_waitcnt vmcnt(0)" ::: "memory");
        }
    }
    __syncthreads();
}

#ifndef SKIPMASK
#define SKIPMASK 0u
#endif
#define PH(n) (((SKIPMASK) >> (n) & 1u) == 0u)
#define GSYNC() do { XcdBarrier b_; b_.bar = (unsigned*)(a.ws + WS_CTL); b_.x = xbar_x; b_.st = MISC + 8; xcd_barrier(b_, wave); } while (0)
__global__ void __launch_bounds__(NTHR, 2) fox_fwd(Args a) {
    extern __shared__ __attribute__((aligned(16))) unsigned char lds[];
    cg::grid_group grid = cg::this_grid();
    const int wave = __builtin_amdgcn_readfirstlane((int)threadIdx.x >> 6);
#define tid ((wave << 6) | lane_id_())
#define lane (lane_id_())
    const int G = gridDim.x, bx = blockIdx.x; const int vcu = (G % 8 == 0) ? (bx % 8) * (G / 8) + bx / 8 : bx;
    const int gw = vcu * NWAVES + wave, NGW = G * NWAVES;
    LAS unsigned char* ldsl = (LAS unsigned char*)lds;
    float* MOD = (float*)(a.ws + WS_MOD); bf16* XN = (bf16*)(a.ws + WS_XN); bf16* ACT = (bf16*)(a.ws + WS_ACT);
    volatile LAS unsigned* MISC = (volatile LAS unsigned*)((LAS unsigned char*)lds + MISC_OFF);
    for (int i = tid; i < LDS_BYTES / 16; i += NTHR) ((v4u*)lds)[i] = (v4u){0u, 0u, 0u, 0u};
    __syncthreads();
    __builtin_amdgcn_fence(__ATOMIC_SEQ_CST, ""); asm volatile("s_waitcnt vmcnt(0) lgkmcnt(0)" ::: "memory");
    const unsigned xbar_x = xcd_barrier_post((unsigned*)(a.ws + WS_CTL), MISC + 8, wave).x;
    grid.sync();
    float* Y = a.out + O_Y;

#ifndef NPASS
#define NPASS 1
#endif
#pragma unroll 1
    for (int pass = 0; pass < NPASS; ++pass) {
    if (pass) GSYNC();
    if (PH(0)) { for (int cb = bx; cb < 256; cb += G) ada_unit(a, lds, cb, tid);
    p0_weights(a, lds, gw, NGW, wave, lane); }
    GSYNC();
    if (PH(1)) norm_phase<false>(a, lds, a.in[0], a.in[1], a.in[9], 0, 1, gw, NGW, tid, lane);
    GSYNC();
    if (PH(2)) { pg8::Gemm g{XN, (const bf16*)(a.ws + WS_WGU1), M, 2 * FF, 1024, 1024}; pg8::StaticOrder S; S.init(M, 2 * FF, G, bx); pg8::EpiUp E{ACT, FF};
      GEMM_PHASE(pg8::EpiUp); }
    GSYNC();
    if (PH(3)) { pg8::EpiRes E{a.in[0], a.in[1], Y, MOD + 2 * 1024, 0.5f};
      { int ksub_ = 256; asm volatile("" : "+s"(ksub_)); pg8::Gemm g2{ACT + (size_t)MP * FF, (const bf16*)(a.ws + WS_WD1), 256, 1024, ksub_, FF}; pg8::SplitOrder S2; S2.init(G, bx); pg8::EpiPartial E2{(float*)(a.ws + WS_PART), 4, 256}; GEMM_PHASE_SPLIT(); }
      { pg8::Gemm g{ACT, (const bf16*)(a.ws + WS_WD1), MP, 1024, FF, FF}; pg8::StaticOrder S; S.init(MP, 1024, G, bx); GEMM_PHASE(pg8::EpiRes); }
      GSYNC();
      if (bx < 32) pg8::reduce_rowgroup<11>((const float*)(a.ws + WS_PART), bx & 3, bx >> 2, E, wave); }
    GSYNC();
    if (PH(4)) norm_phase<true>(a, lds, Y, Y + (size_t)MP * 1024, a.in[13], 3, 4, gw, NGW, tid, lane);
    GSYNC();
    if (PH(5)) { if (G >= 160) { const int u = G - 1 - bx; if (u < 80) scan_unit(a, lds, u, tid); }
                 else for (int u = bx; u < 80; u += G) scan_unit(a, lds, u, tid); }
    if (PH(6)) { pg8::Gemm g{XN, (const bf16*)(a.ws + WS_WIN), M, 2560, 1024, 1024}; pg8::StaticOrder S; S.init(M, 2560, G, bx);
      pg8::EpiIn E{(bf16*)(a.ws + WS_Q), (bf16*)(a.ws + WS_K), (bf16*)(a.ws + WS_V), (bf16*)(a.ws + WS_U), (bf16*)(a.ws + WS_G2), nullptr, nullptr,
                   (float*)(a.ws + WS_G2SS), (float*)(a.ws + WS_QS), a.out + O_KP, a.out + O_KS, a.out + O_VP, a.out + O_VS, a.in[16], a.in[17], attn_body::C2, EPS};
      GEMM_PHASE(pg8::EpiIn); }
    GSYNC();
    if (PH(7)) { const attn_body::bf16* Qb = (const attn_body::bf16*)(a.ws + WS_Q); const attn_body::bf16* Kb = (const attn_body::bf16*)(a.ws + WS_K); const attn_body::bf16* Vb = (const attn_body::bf16*)(a.ws + WS_V);
      attn_body::bf16* Ob = (attn_body::bf16*)(a.ws + WS_AO); const float* CUMP = (const float*)(a.ws + WS_CUMP);
      const int nun = (G == 256) ? 4 : (1024 - bx + G - 1) / G;
      float B2;
      { float mq = fabsf(a.in[16][lane]), mk = fabsf(a.in[17][lane]);
#pragma unroll
        for (int o = 1; o < 64; o <<= 1) { mq = fmaxf(mq, __shfl_xor(mq, o)); mk = fmaxf(mk, __shfl_xor(mk, o)); }
        B2 = 64.0f * mq * mk * attn_body::C2 * 1.01f + 0.5f; }
#pragma unroll 1
      for (int i = 0; i < nun; ++i) { int bh, qb;
          if (G == 256) { const int s = vcu & 15; bh = vcu >> 4; qb = (i == 0) ? s : (i == 1) ? 31 - s : (i == 2) ? 32 + s : 63 - s; } else { const int idx = bx + i * G; bh = idx >> 6; qb = idx & 63; }
          int ts = 0;
          { const float* cl = CUMP + (size_t)bh * SEQ; const float cref = cl[qb * 256]; const int ncand = 4 * qb;
            for (int j0 = 0; j0 < ncand; j0 += 64) { const int j = j0 + lane; const bool sk = (j < ncand) && (cref - cl[64 * j + 63] + 2.0f * B2 < -152.0f); ts += (int)__popcll(__ballot(sk)); }
            ts = __builtin_amdgcn_readfirstlane(ts) & ~1; }
          attn_body::attn_unit<8>(bh >> 3, bh & 7, qb, ts, CUMP + (size_t)bh * SEQ, Qb, Kb, Vb, Ob, (char*)lds, wave);
          }
      __syncthreads(); }
    if (PH(8)) for (int ci = bx; ci < 256; ci += G) gmlp_unit(a, lds, ci, tid, wave, lane);
    if (PH(9)) for (int u = bx; u < 256; u += G) sattn_unit(a, lds, u, tid, wave, lane);
    if (PH(10)) { if (G == 256) { if ((vcu & 15) == 0 && (vcu >> 4) < 8) gmlp_sample_unit(a, lds, vcu >> 4, tid); } else for (int b = bx; b < 8; b += G) gmlp_sample_unit(a, lds, b, tid); }
    GSYNC();
    if (PH(11)) { bf16* T = (bf16*)(a.ws + WS_T1); bf16* T2 = (bf16*)(a.ws + WS_T2); const bf16* WIN = (const bf16*)(a.ws + WS_WIN);
      bf16* TS = T + (size_t)MP * 1024; bf16* T2S = T2 + (size_t)MP * 1024; const bf16* XS = XN + (size_t)MP * 1024;
      float* PARTA = (float*)(a.ws + 2 * MiB); float* PARTB = (float*)(a.ws + 4 * MiB);
      { pg8::Gemm g{(const bf16*)(a.ws + WS_AO) + (size_t)MP * 512, (const bf16*)(a.ws + WS_WPA), 256, 1024, 512, 512}; pg8::StaticOrder S; S.init(256, 1024, G, bx); pg8::EpiMix<0> E{TS, nullptr}; GEMM_PHASE(pg8::EpiMix<0>); }
      { pg8::Gemm g{(const bf16*)(a.ws + WS_AO), (const bf16*)(a.ws + WS_WPA), MP, 1024, 512, 512}; pg8::StaticOrder S; S.init(MP, 1024, G, bx); pg8::EpiMix<0> E{T, nullptr}; GEMM_PHASE(pg8::EpiMix<0>); }
      { int ksub_ = 512; asm volatile("" : "+s"(ksub_)); pg8::Gemm g2{XS, WIN + (size_t)2560 * 1024, 256, 1024, ksub_, 1024}; pg8::SplitOrderT<4, 2, 512> S2; S2.init(G, (bx + G - 8) % G); pg8::EpiPartialT<4, 9> E2{PARTA}; GEMM_PHASE_SPLIT_T(4, 2, 512, 9); }
      { pg8::Gemm g{XN, WIN + (size_t)2560 * 1024, MP, 1024, 1024, 1024}; pg8::StaticOrder S; S.init(MP, 1024, G, bx); pg8::EpiMix<1> E{T, nullptr}; GEMM_PHASE(pg8::EpiMix<1>); }
      { pg8::Gemm g{(const bf16*)(a.ws + WS_BO) + (size_t)MP * 512, (const bf16*)(a.ws + WS_WPB), 256, 1024, 512, 512}; pg8::StaticOrder S; S.init(256, 1024, G, (bx + G - 16) % G); pg8::EpiMix<0> E{T2S, nullptr}; GEMM_PHASE(pg8::EpiMix<0>); }
      { pg8::Gemm g{(const bf16*)(a.ws + WS_BO), (const bf16*)(a.ws + WS_WPB), MP, 1024, 512, 512}; pg8::StaticOrder S; S.init(MP, 1024, G, bx); pg8::EpiMix<0> E{T2, nullptr}; GEMM_PHASE(pg8::EpiMix<0>); }
      { int ksub_ = 512; asm volatile("" : "+s"(ksub_)); pg8::Gemm g2{XS, WIN + (size_t)3584 * 1024, 256, 1024, ksub_, 1024}; pg8::SplitOrderT<4, 2, 512> S2; S2.init(G, (bx + G - 24) % G); pg8::EpiPartialT<4, 9> E2{PARTB}; GEMM_PHASE_SPLIT_T(4, 2, 512, 9); }
      { pg8::Gemm g{XN, WIN + (size_t)3584 * 1024, MP, 1024, 1024, 1024}; pg8::StaticOrder S; S.init(MP, 1024, G, bx); pg8::EpiMix<2> E{T, T2}; GEMM_PHASE(pg8::EpiMix<2>); }
      GSYNC();
      if (bx < 32) { pg8::EpiMix<1> E1{TS, nullptr}; pg8::reduce_rowgroup<2>(PARTA, bx & 3, bx >> 2, E1, wave);
                     pg8::EpiMix<2> E2{TS, T2S}; pg8::reduce_rowgroup<2>(PARTB, bx & 3, bx >> 2, E2, wave); } }
    GSYNC();
    if (PH(13)) { pg8::EpiRes E{Y, Y + (size_t)MP * 1024, Y, MOD + 5 * 1024, 1.0f}; const bf16* M1 = (const bf16*)(a.ws + WS_T1);
      { int ksub_ = 256; asm volatile("" : "+s"(ksub_)); pg8::Gemm g2{M1 + (size_t)MP * 1024, (const bf16*)(a.ws + WS_WOUT), 256, 1024, ksub_, 1024}; pg8::SplitOrderT<4, 4, 256> S2; S2.init(G, bx); pg8::EpiPartialT<4, 8> E2{(float*)(a.ws + WS_PART)}; GEMM_PHASE_SPLIT_T(4, 4, 256, 8); }
      { pg8::Gemm g{M1, (const bf16*)(a.ws + WS_WOUT), MP, 1024, 1024, 1024}; pg8::StaticOrder S; S.init(MP, 1024, G, bx); GEMM_PHASE(pg8::EpiRes); }
      GSYNC();
      if (bx < 32) pg8::reduce_rowgroup<4>((const float*)(a.ws + WS_PART), bx & 3, bx >> 2, E, wave); }
    GSYNC();
    if (PH(14)) norm_phase<false>(a, lds, Y, Y + (size_t)MP * 1024, a.in[24], 6, 7, gw, NGW, tid, lane);
    GSYNC();
    if (PH(15)) { pg8::Gemm g{XN, (const bf16*)(a.ws + WS_WGU2), M, 2 * FF, 1024, 1024}; pg8::StaticOrder S; S.init(M, 2 * FF, G, bx); pg8::EpiUp E{ACT, FF};
      GEMM_PHASE(pg8::EpiUp); }
    GSYNC();
    if (PH(16)) { pg8::EpiRes E{Y, Y + (size_t)MP * 1024, Y, MOD + 8 * 1024, 0.5f};
      { int ksub_ = 256; asm volatile("" : "+s"(ksub_)); pg8::Gemm g2{ACT + (size_t)MP * FF, (const bf16*)(a.ws + WS_WD2), 256, 1024, ksub_, FF}; pg8::SplitOrder S2; S2.init(G, bx); pg8::EpiPartial E2{(float*)(a.ws + WS_PART), 4, 256}; GEMM_PHASE_SPLIT(); }
      { pg8::Gemm g{ACT, (const bf16*)(a.ws + WS_WD2), MP, 1024, FF, FF}; pg8::StaticOrder S; S.init(MP, 1024, G, bx); GEMM_PHASE(pg8::EpiRes); }
      GSYNC();
      if (bx < 32) pg8::reduce_rowgroup<11>((const float*)(a.ws + WS_PART), bx & 3, bx >> 2, E, wave); }
    }
}


#undef tid
#undef lane
extern "C" void kernel_launch(void* const* d_in, const int* in_sizes, int n_in, void* d_out, int out_size, void* d_ws, size_t ws_size, hipStream_t stream) {
    static int grid = 0;
    if (grid == 0) {
        if (n_in != 28 || (size_t)out_size != O_END || ws_size < WS_END || in_sizes[0] != MP * 1024) { fprintf(stderr, "kernel_launch: unexpected shapes (n_in %d out %d ws %zu)\n", n_in, out_size, ws_size); grid = -1; return; }
        int dev = 0, cus = 0, per_cu = 0;
        hipGetDevice(&dev); hipDeviceGetAttribute(&cus, hipDeviceAttributeMultiprocessorCount, dev);
        if (hipFuncSetAttribute((const void*)fox_fwd, hipFuncAttributeMaxDynamicSharedMemorySize, LDS_BYTES) != hipSuccess) { fprintf(stderr, "kernel_launch: hipFuncSetAttribute failed\n"); grid = -1; return; }
        if (hipOccupancyMaxActiveBlocksPerMultiprocessor(&per_cu, (const void*)fox_fwd, NTHR, LDS_BYTES) != hipSuccess || per_cu < 1) { fprintf(stderr, "kernel_launch: occupancy query says %d\n", per_cu); per_cu = 1; }
        (void)hipGetLastError();
        grid = cus * 1;
    }
    if (grid < 0) return;
    if (hipMemsetAsync((char*)d_ws + WS_CTL, 0, CTL_ZERO_BYTES, stream) != hipSuccess) { fprintf(stderr, "kernel_launch: hipMemsetAsync failed\n"); return; }
    Args a{};
    for (int i = 0; i < 28; ++i) a.in[i] = (const float*)d_in[i];
    a.out = (float*)d_out; a.ws = (unsigned char*)d_ws;
    void* args[] = {&a};
    hipError_t e = hipLaunchCooperativeKernel((const void*)fox_fwd, dim3(grid), dim3(NTHR), args, LDS_BYTES, stream);
    if (e != hipSuccess) fprintf(stderr, "cooperative launch failed: %s (grid %d)\n", hipGetErrorString(e), grid);
}
```

```cpp
#include <hip/hip_runtime.h>
#include <hip/hip_cooperative_groups.h>
#include <cstdio>
#include <cstdint>
__device__ __forceinline__ int lane_id_() { return (int)__builtin_amdgcn_mbcnt_hi(~0u, __builtin_amdgcn_mbcnt_lo(~0u, 0u)); }
namespace pg8 {
#define PG8_LAS __attribute__((address_space(3)))
typedef unsigned short bf16_t;
typedef short bf16x8 __attribute__((ext_vector_type(8)));
typedef float f32x4 __attribute__((ext_vector_type(4)));
typedef unsigned u32x4 __attribute__((ext_vector_type(4)));
constexpr int BM = 256, BK = 64, HALF = 128, HTB = HALF * BK * 2  , STAGE_BYTES = 8 * HTB, NXCD = 8, WGM = 8;

__host__ __device__ __forceinline__ int lds_byte(int r, int c) { const int st = (r >> 4) * 2 + (c >> 5), rr = r & 15, cc = c & 31, ob = rr * 64 + cc * 2; return st * 1024 + (ob ^ (((ob >> 9) & 1) << 5)); }
__host__ __device__ __forceinline__ void stage_rc(int b, int& R, int& C) { const int st = b / 1024, sb = b % 1024, swz = sb ^ (((sb >> 9) & 1) << 5); R = (st >> 1) * 16 + swz / 64; C = (st & 1) * 32 + (swz % 64) / 2; }
__host__ __device__ __forceinline__ int perm32(int rho) { const int n = rho >> 4, i = rho & 15; return 8 * (i >> 2) + 4 * n + (i & 3); }

struct Unit { int pm, pn, koff; };
struct Gemm { const bf16_t* A; const bf16_t* Bt; int M, N, K, Kp; };

struct StaticOrder {
    int nM, nN, nwg, G, c;
    __host__ __device__ void init(int M, int N, int G_, int c_) { nM = M / BM; nN = N / BM; nwg = nM * nN; G = G_; c = c_; }
    __host__ __device__ bool next(int i, Unit& u) const {
        const long L = (long)i * G + c; if (L >= nwg) return false;
        int wgid = (int)L; { const int q = nwg / NXCD, r = nwg % NXCD, xcd = wgid % NXCD, off = wgid / NXCD; wgid = (xcd < r ? xcd * (q + 1) : r * (q + 1) + (xcd - r) * q) + off; }
        const int nig = WGM * nN, gid = wgid / nig, fm = gid * WGM, gsz = (nM - fm) < WGM ? (nM - fm) : WGM;
        u.pm = fm + ((wgid % nig) % gsz); u.pn = (wgid % nig) / gsz; u.koff = 0; return true;
    }
    __device__ __forceinline__ void a_ready(const Unit&) const {}
    __device__ __forceinline__ void done(const Unit&) const {}
};

template <int NN, int NS, int KSUB> struct SplitOrderT {
    int G, c;
    __host__ __device__ void init(int G_, int c_) { G = G_; c = c_; }
    __host__ __device__ bool next(int i, Unit& u) const { const int L = i * G + c; if (L >= NN * NS) return false; u.pm = 0; u.pn = L % NN; u.koff = (L / NN) * KSUB; return true; }
    __device__ __forceinline__ void a_ready(const Unit&) const {}
    __device__ __forceinline__ void done(const Unit&) const {}
};
typedef SplitOrderT<4, 11, 256> SplitOrder;
__device__ __forceinline__ unsigned cvt_pk_bf16(float lo, float hi) { unsigned r; asm volatile("v_cvt_pk_bf16_f32 %0, %1, %2" : "=v"(r) : "v"(lo), "v"(hi)); return r; }
typedef float f32x2 __attribute__((ext_vector_type(2)));
__device__ __forceinline__ f32x2 gelu_pk(f32x2 v) {
    const f32x2 av = __builtin_elementwise_abs(v), d = av * 0.2316418882f + 1.0f;
    f32x2 t; t.x = __builtin_amdgcn_rcpf(d.x); t.y = __builtin_amdgcn_rcpf(d.y);
    f32x2 q = t * 0.5307027145f + (-0.7265760135f); q = q * t + 0.7107068705f; q = q * t + (-0.142248368f); q = q * t + 0.127414796f; q = q * t;
    const f32x2 s = (v * v) * (-0.72134752044f);
    f32x2 e; e.x = __builtin_amdgcn_exp2f(s.x); e.y = __builtin_amdgcn_exp2f(s.y);
    const f32x2 m = v * (q * e), r = v - m;
    f32x2 o; o.x = v.x < 0.f ? m.x : r.x; o.y = v.y < 0.f ? m.y : r.y; return o;
}

constexpr int MPROMPT = 32768;
constexpr int NMODC = 9216;
typedef unsigned u32x2v __attribute__((ext_vector_type(2)));
__device__ __forceinline__ float sigm(float x) { return __builtin_amdgcn_rcpf(1.0f + __builtin_amdgcn_exp2f(-1.4426950408889634f * x)); }
__device__ __forceinline__ float gelu_tanh(float x) { const float y = 1.5957691216057308f * (x + 0.044715f * x * x * x); return x * sigm(y); }
__device__ __forceinline__ float bf_lo(unsigned w) { return __uint_as_float(w << 16); }
__device__ __forceinline__ float bf_hi(unsigned w) { return __uint_as_float(w & 0xffff0000u); }
__device__ __forceinline__ int mod_row(int pm, int rloc) { return pm < 128 ? (pm >> 6) : 2 + (rloc >> 5); }

struct EpiUp {
    static constexpr bool PERM = true, AFTER_DRAIN = false;
    bf16_t* ACT; int ldc;
    __device__ __forceinline__ void operator()(const f32x4 (&acc)[2][2][4][2], const Unit& u, int wr, int wc, int fr, int fq) const {
        int fr_ = fr, fq_ = fq; asm volatile("" : "+v"(fr_), "+v"(fq_));
        const int row0 = u.pm * BM + wr * 64 + fr_, ch0 = u.pn * HALF + wc * 32 + 8 * fq_;
#pragma unroll
        for (int ai = 0; ai < 2; ++ai)
#pragma unroll
            for (int m = 0; m < 4; ++m) {
                float o[8];
#pragma unroll
                for (int n = 0; n < 2; ++n)
#pragma unroll
                    for (int i = 0; i < 4; ++i) { const float g = acc[ai][0][m][n][i], up = acc[ai][1][m][n][i]; o[4 * n + i] = g * sigm(g) * up; }
                u32x4 w; w.x = cvt_pk_bf16(o[0], o[1]); w.y = cvt_pk_bf16(o[2], o[3]); w.z = cvt_pk_bf16(o[4], o[5]); w.w = cvt_pk_bf16(o[6], o[7]);
                *(u32x4*)(ACT + (size_t)(row0 + ai * HALF + m * 16) * ldc + ch0) = w;
            }
    }
};
struct EpiRes {
    static constexpr bool PERM = true, AFTER_DRAIN = false;
    const float* resp; const float* ress; float* out; const float* gate; float fac;
    __device__ __forceinline__ void rowgroup(const f32x4 (&v)[2][2], int pn, int ai, int m, int wr, int wc, int fr, int fq) const {
        const int rl = wr * 64 + fr + ai * HALF + m * 16, col0 = pn * BM + wc * 32 + 8 * fq;
        const float* gp = gate + (size_t)(2 + (rl >> 5)) * NMODC + col0; float* obase = out + (size_t)128 * BM * 1024;
#pragma unroll
        for (int bj = 0; bj < 2; ++bj)
#pragma unroll
            for (int n = 0; n < 2; ++n) { const size_t off = (size_t)rl * 1024 + col0 + bj * HALF + 4 * n;
                const f32x4 gv = *(const f32x4*)(gp + bj * HALF + 4 * n), rv = *(const f32x4*)(ress + off);
                *(f32x4*)(obase + off) = rv + (gv * fac) * v[bj][n]; }
    }
    __device__ __forceinline__ void operator()(const f32x4 (&acc)[2][2][4][2], const Unit& u, int wr, int wc, int fr, int fq) const {
        int fr_ = fr, fq_ = fq; asm volatile("" : "+v"(fr_), "+v"(fq_));
        const int rl0 = wr * 64 + fr_, col0 = u.pn * BM + wc * 32 + 8 * fq_;
        const float* rbase = (u.pm < 128) ? resp + (size_t)u.pm * BM * 1024 : ress;
        float* obase = out + (size_t)u.pm * BM * 1024;
#pragma unroll
        for (int ai = 0; ai < 2; ++ai)
#pragma unroll
            for (int m = 0; m < 4; ++m) {
                const int rl = rl0 + ai * HALF + m * 16; const float* gp = gate + (size_t)mod_row(u.pm, rl) * NMODC + col0;
#pragma unroll
                for (int bj = 0; bj < 2; ++bj)
#pragma unroll
                    for (int n = 0; n < 2; ++n) {
                        const size_t off = (size_t)rl * 1024 + col0 + bj * HALF + 4 * n;
                        const f32x4 gv = *(const f32x4*)(gp + bj * HALF + 4 * n), rv = *(const f32x4*)(rbase + off);
                        *(f32x4*)(obase + off) = rv + (gv * fac) * acc[ai][bj][m][n];
                    }
            }
    }
};
struct EpiIn {
    static constexpr bool PERM = true, AFTER_DRAIN = false;
    bf16_t *Q, *K, *V, *U, *G2, *SGA, *SGB; float* G2SS; float* QS;
    float *kout_p, *kout_s, *vout_p, *vout_s;
    const float *gq, *gk; float qscale, eps;
    __device__ __forceinline__ void operator()(const f32x4 (&acc)[2][2][4][2], const Unit& u, int wr, int wc, int fr, int fq) const {
        int fr_ = fr, fq_ = fq; asm volatile("" : "+v"(fr_), "+v"(fq_));
        const int pn = u.pn, rl0 = wr * 64 + fr_; const size_t rg0 = (size_t)u.pm * BM;
        if (pn < 4) {
            const bool isq = pn < 2; const int head = 4 * (pn & 1) + wc; const float* gsrc = isq ? gq : gk;
            f32x4 gv[2][2];
#pragma unroll
            for (int bj = 0; bj < 2; ++bj)
#pragma unroll
                for (int n = 0; n < 2; ++n) { gv[bj][n] = *(const f32x4*)(gsrc + 32 * bj + 8 * fq_ + 4 * n); if (isq) gv[bj][n] = gv[bj][n] * qscale; }
            bf16_t* dst = isq ? Q : K;
#pragma unroll
            for (int ai = 0; ai < 2; ++ai)
#pragma unroll
                for (int m = 0; m < 4; ++m) {
                    float ss = 0.f;
#pragma unroll
                    for (int bj = 0; bj < 2; ++bj)
#pragma unroll
                        for (int n = 0; n < 2; ++n) { const f32x4 x = acc[ai][bj][m][n]; ss += (x[0] * x[0] + x[1] * x[1]) + (x[2] * x[2] + x[3] * x[3]); }
                    ss += __shfl_xor(ss, 16); ss += __shfl_xor(ss, 32);
                    const float rstd = 1.0f / sqrtf(ss * (1.0f / 64.0f) + eps);
                    const int rl = rl0 + ai * HALF + m * 16; const size_t r = rg0 + rl;
#pragma unroll
                    for (int bj = 0; bj < 2; ++bj) {
                        const f32x4 o0 = acc[ai][bj][m][0] * rstd * gv[bj][0], o1 = acc[ai][bj][m][1] * rstd * gv[bj][1];
                        const int c = head * 64 + 32 * bj + 8 * fq_;
                        u32x4 w; w.x = cvt_pk_bf16(o0[0], o0[1]); w.y = cvt_pk_bf16(o0[2], o0[3]); w.z = cvt_pk_bf16(o1[0], o1[1]); w.w = cvt_pk_bf16(o1[2], o1[3]);
                        *(u32x4*)(dst + r * 512 + c) = w;
                        if (isq) { if (u.pm == 128) { float* qp = QS + (size_t)rl * 512 + c; *(f32x4*)qp = o0; *(f32x4*)(qp + 4) = o1; } }
                        else { float* kp = (u.pm < 128) ? kout_p + r * 512 + c : kout_s + (size_t)rl * 512 + c; *(f32x4*)kp = o0; *(f32x4*)(kp + 4) = o1; }
                    }
                    asm volatile("" ::: "memory");
                }
        } else if (pn < 6) {
            const int c0 = (pn - 4) * BM + wc * 32 + 8 * fq_;
#pragma unroll
            for (int ai = 0; ai < 2; ++ai)
#pragma unroll
                for (int m = 0; m < 4; ++m) { const int rl = rl0 + ai * HALF + m * 16; const size_t r = rg0 + rl;
#pragma unroll
                    for (int bj = 0; bj < 2; ++bj) { const f32x4 o0 = acc[ai][bj][m][0], o1 = acc[ai][bj][m][1]; const int c = c0 + bj * HALF;
                        u32x4 w; w.x = cvt_pk_bf16(o0[0], o0[1]); w.y = cvt_pk_bf16(o0[2], o0[3]); w.z = cvt_pk_bf16(o1[0], o1[1]); w.w = cvt_pk_bf16(o1[2], o1[3]);
                        *(u32x4*)(V + r * 512 + c) = w;
                        float* vp = (u.pm < 128) ? vout_p + r * 512 + c : vout_s + (size_t)rl * 512 + c;
                        { *(f32x4*)vp = o0; *(f32x4*)(vp + 4) = o1; } } asm volatile("" ::: "memory"); }
        } else if (pn < 10) {
            const bool isv = pn >= 8; const int t2 = (pn - 6) & 1; const int c0 = t2 * BM + wc * 32 + 8 * fq_; bf16_t* dst = isv ? G2 : U;
#pragma unroll
            for (int ai = 0; ai < 2; ++ai)
#pragma unroll
                for (int m = 0; m < 4; ++m) { const int rl = rl0 + ai * HALF + m * 16; const size_t r = rg0 + rl; float ss = 0.f;
#pragma unroll
                    for (int bj = 0; bj < 2; ++bj) { float o[8];
#pragma unroll
                        for (int n = 0; n < 2; ++n)
#pragma unroll
                            for (int i = 0; i < 4; ++i) { const float g = gelu_tanh(acc[ai][bj][m][n][i]); o[4 * n + i] = g; ss += g * g; }
                        u32x4 w; w.x = cvt_pk_bf16(o[0], o[1]); w.y = cvt_pk_bf16(o[2], o[3]); w.z = cvt_pk_bf16(o[4], o[5]); w.w = cvt_pk_bf16(o[6], o[7]);
                        *(u32x4*)(dst + r * 512 + c0 + bj * HALF) = w; }
                    if (isv) { ss += __shfl_xor(ss, 16); ss += __shfl_xor(ss, 32); if (fq_ == 0) G2SS[r * 8 + t2 * 4 + wc] = ss; } asm volatile("" ::: "memory"); }
        } else {
            const bool isa = pn < 14; const int c0 = ((pn - 10) & 3) * BM + wc * 32 + 8 * fq_; bf16_t* dst = isa ? SGA : SGB;
#pragma unroll
            for (int ai = 0; ai < 2; ++ai)
#pragma unroll
                for (int m = 0; m < 4; ++m) { const size_t r = rg0 + rl0 + ai * HALF + m * 16;
#pragma unroll
                    for (int bj = 0; bj < 2; ++bj) { float o[8];
#pragma unroll
                        for (int n = 0; n < 2; ++n)
#pragma unroll
                            for (int i = 0; i < 4; ++i) o[4 * n + i] = sigm(acc[ai][bj][m][n][i]);
                        u32x4 w; w.x = cvt_pk_bf16(o[0], o[1]); w.y = cvt_pk_bf16(o[2], o[3]); w.z = cvt_pk_bf16(o[4], o[5]); w.w = cvt_pk_bf16(o[6], o[7]);
                        *(u32x4*)(dst + r * 1024 + c0 + bj * HALF) = w;
                        } asm volatile("" ::: "memory"); }
        }
    }
};
struct EpiPartial {
    static constexpr bool PERM = true, AFTER_DRAIN = false;
    float* PART; int nN, Ksub;
    __device__ __forceinline__ void operator()(const f32x4 (&acc)[2][2][4][2], const Unit& u, int wr, int wc, int fr, int fq) const {
        int tid_ = (wr * 4 + wc) * 64 + fq * 16 + fr; asm volatile("" : "+v"(tid_));
        f32x4* dst = (f32x4*)PART + (size_t)((u.koff >> 8) * 4 + u.pn) * 32 * 512 + tid_;
#pragma unroll
        for (int ai = 0; ai < 2; ++ai)
#pragma unroll
            for (int bj = 0; bj < 2; ++bj)
#pragma unroll
                for (int m = 0; m < 4; ++m)
#pragma unroll
                    for (int n = 0; n < 2; ++n) { *dst = acc[ai][bj][m][n]; dst += 512; asm volatile("" : "+v"(dst) :: "memory"); }
        asm volatile("" ::: "memory");
    }
};
template <int NN, int KSHIFT> struct EpiPartialT {
    static constexpr bool PERM = true, AFTER_DRAIN = false;
    float* PART;
    __device__ __forceinline__ void operator()(const f32x4 (&acc)[2][2][4][2], const Unit& u, int wr, int wc, int fr, int fq) const {
        int tid_ = (wr * 4 + wc) * 64 + fq * 16 + fr; asm volatile("" : "+v"(tid_));
        f32x4* dst = (f32x4*)PART + (size_t)((u.koff >> KSHIFT) * NN + u.pn) * 32 * 512 + tid_;
#pragma unroll
        for (int ai = 0; ai < 2; ++ai)
#pragma unroll
            for (int bj = 0; bj < 2; ++bj)
#pragma unroll
                for (int m = 0; m < 4; ++m)
#pragma unroll
                    for (int n = 0; n < 2; ++n) { *dst = acc[ai][bj][m][n]; dst += 512; asm volatile("" : "+v"(dst) :: "memory"); }
    }
};
template <class Epi> __device__ __forceinline__ void reduce_partials(const float* PART, int nN, int nS, int pn, int pm_out, const Epi& E, int wv) {
    int tid = (wv << 6) | lane_id_(); asm volatile("" : "+v"(tid));
    const int wid = __builtin_amdgcn_readfirstlane(tid >> 6), lane = tid & 63, wr = wid >> 2, wc = wid & 3, fr = lane & 15, fq = lane >> 4;
    f32x4 acc[2][2][4][2];
#pragma unroll
    for (int ai = 0; ai < 2; ++ai)
#pragma unroll
        for (int bj = 0; bj < 2; ++bj)
#pragma unroll
            for (int m = 0; m < 4; ++m)
#pragma unroll
                for (int n = 0; n < 2; ++n) acc[ai][bj][m][n] = (f32x4){0.f, 0.f, 0.f, 0.f};
#pragma unroll 1
    for (int s = 0; s < nS; ++s) { const f32x4* src = (const f32x4*)PART + (size_t)(s * nN + pn) * 32 * 512 + tid;
#pragma unroll
        for (int ai = 0; ai < 2; ++ai) {
            f32x4 t[2][4][2];
#pragma unroll
            for (int bj = 0; bj < 2; ++bj)
#pragma unroll
                for (int m = 0; m < 4; ++m)
#pragma unroll
                    for (int n = 0; n < 2; ++n) { t[bj][m][n] = *src; src += 512; asm volatile("" : "+v"(src)); }
#pragma unroll
            for (int bj = 0; bj < 2; ++bj)
#pragma unroll
                for (int m = 0; m < 4; ++m)
#pragma unroll
                    for (int n = 0; n < 2; ++n) acc[ai][bj][m][n] += t[bj][m][n];
            asm volatile("" ::: "memory"); } }
    Unit u; u.pm = pm_out; u.pn = pn; u.koff = 0;
    E(acc, u, wr, wc, fr, fq);
}
template <int NS, class Epi> __device__ __forceinline__ void reduce_rowgroup(const float* PART, int pn, int rg, const Epi& E, int wv) {
    int tid = (wv << 6) | lane_id_(); asm volatile("" : "+v"(tid));
    const int wid = __builtin_amdgcn_readfirstlane(tid >> 6), lane = tid & 63, wr = wid >> 2, wc = wid & 3, fr = lane & 15, fq = lane >> 4;
    const int ai = rg >> 2, m = rg & 3;
    f32x4 t[NS][2][2];
#pragma unroll
    for (int s = 0; s < NS; ++s)
#pragma unroll
        for (int bj = 0; bj < 2; ++bj)
#pragma unroll
            for (int n = 0; n < 2; ++n) t[s][bj][n] = *((const f32x4*)PART + ((size_t)(s * 4 + pn) * 32 + (((ai * 2 + bj) * 4 + m) * 2 + n)) * 512 + tid);
    f32x4 v[2][2];
#pragma unroll
    for (int bj = 0; bj < 2; ++bj)
#pragma unroll
        for (int n = 0; n < 2; ++n) { v[bj][n] = t[0][bj][n];
#pragma unroll
            for (int s = 1; s < NS; ++s) v[bj][n] += t[s][bj][n]; }
    E.rowgroup(v, pn, ai, m, wr, wc, fr, fq);
}
template <int MODE> struct EpiMix {
    static constexpr bool PERM = true, AFTER_DRAIN = false;
    bf16_t* T; const bf16_t* T2;
    __device__ __forceinline__ void one(size_t off, const f32x4 a0, const f32x4 a1) const {
        float o[8] = {a0[0], a0[1], a0[2], a0[3], a1[0], a1[1], a1[2], a1[3]};
        if (MODE >= 1) {
            const u32x4 t = *(const u32x4*)(T + off);
            const float tv[8] = {bf_lo(t.x), bf_hi(t.x), bf_lo(t.y), bf_hi(t.y), bf_lo(t.z), bf_hi(t.z), bf_lo(t.w), bf_hi(t.w)};
            if (MODE == 1) {
#pragma unroll
                for (int i = 0; i < 8; ++i) o[i] = sigm(o[i]) * tv[i];
            } else {
                const u32x4 s2 = *(const u32x4*)(T2 + off);
                const float sv[8] = {bf_lo(s2.x), bf_hi(s2.x), bf_lo(s2.y), bf_hi(s2.y), bf_lo(s2.z), bf_hi(s2.z), bf_lo(s2.w), bf_hi(s2.w)};
#pragma unroll
                for (int i = 0; i < 8; ++i) o[i] = tv[i] + sigm(o[i]) * sv[i];
            }
        }
        u32x4 w; w.x = cvt_pk_bf16(o[0], o[1]); w.y = cvt_pk_bf16(o[2], o[3]); w.z = cvt_pk_bf16(o[4], o[5]); w.w = cvt_pk_bf16(o[6], o[7]);
        *(u32x4*)(T + off) = w;
    }
    __device__ __forceinline__ void operator()(const f32x4 (&acc)[2][2][4][2], const Unit& u, int wr, int wc, int fr, int fq) const {
        int fr_ = fr, fq_ = fq; asm volatile("" : "+v"(fr_), "+v"(fq_));
        const size_t row0 = (size_t)u.pm * BM + wr * 64 + fr_; const int col0 = u.pn * BM + wc * 32 + 8 * fq_;
#pragma unroll
        for (int ai = 0; ai < 2; ++ai)
#pragma unroll
            for (int m = 0; m < 4; ++m) {
#pragma unroll
                for (int bj = 0; bj < 2; ++bj) one((row0 + ai * HALF + m * 16) * 1024 + col0 + bj * HALF, acc[ai][bj][m][0], acc[ai][bj][m][1]);
                asm volatile("" ::: "memory");
            }
    }
    __device__ __forceinline__ void rowgroup(const f32x4 (&v)[2][2], int pn, int ai, int m, int wr, int wc, int fr, int fq) const {
        const size_t row = (size_t)(wr * 64 + fr + ai * HALF + m * 16); const int col0 = pn * BM + wc * 32 + 8 * fq;
#pragma unroll
        for (int bj = 0; bj < 2; ++bj) one(row * 1024 + col0 + bj * HALF, v[bj][0], v[bj][1]);
    }
};
template <class Epi, class Sched, bool ALIGN_EPI = false, bool SP2 = false>
__device__ __forceinline__ void gemm_phase(PG8_LAS unsigned char* lds, const Gemm g, const Sched& S, const Epi& E, int wv) {
    int tid = (wv << 6) | lane_id_(); asm volatile("" : "+v"(tid));
    const int wid = __builtin_amdgcn_readfirstlane(tid >> 6), lane = tid & 63, wr = wid >> 2, wc = wid & 3, fr = lane & 15, fq = lane >> 4;
    const int K = g.Kp, nt = g.K / BK;
    unsigned voffA[2], voffB[2];
#pragma unroll
    for (int i = 0; i < 2; ++i) { int R, C; stage_rc(tid * 16 + i * 8192, R, C); const int Rb = Epi::PERM ? ((R & ~31) + perm32(R & 31)) : R;
        voffA[i] = (unsigned)(R * K + C) * 2u; voffB[i] = (unsigned)(Rb * K + C) * 2u; }
    const size_t kstep = (size_t)(BK * 2);
    const size_t hstep = (size_t)HALF * K * 2;
    const size_t tstep = 2 * hstep;
    const unsigned ldsw = (unsigned)wid * 1024u;
    const int aoff = lds_byte(wr * 64 + fr, fq * 8), boff = lds_byte(wc * 32 + fr, fq * 8);
#define PG8_SA(b, h) (((b) * 2 + (h)) * HTB)
#define PG8_SB(b, h) ((4 + (b) * 2 + (h)) * HTB)
#define PG8_STAGE(bufoff, gbase, voff) do { _Pragma("unroll") for (int _i = 0; _i < 2; ++_i) \
        __builtin_amdgcn_global_load_lds((const unsigned*)((const char*)(gbase) + (voff)[_i]), (PG8_LAS unsigned*)(lds + (bufoff) + ldsw + _i * 8192), 16, 0, 0); } while (0)
#define PG8_LDA(dst, b, h) do { _Pragma("unroll") for (int m = 0; m < 4; ++m) _Pragma("unroll") for (int k = 0; k < 2; ++k) dst[m][k] = *(const PG8_LAS bf16x8*)(lds + PG8_SA(b, h) + aoff + m * 2048 + k * 1024); } while (0)
#define PG8_LDB(dst, b, h) do { _Pragma("unroll") for (int n = 0; n < 2; ++n) _Pragma("unroll") for (int k = 0; k < 2; ++k) dst[n][k] = *(const PG8_LAS bf16x8*)(lds + PG8_SB(b, h) + boff + n * 2048 + k * 1024); } while (0)
#define PG8_MMA(ai, bj, At, Bt) do { __builtin_amdgcn_s_setprio(1); _Pragma("unroll") for (int m = 0; m < 4; ++m) _Pragma("unroll") for (int n = 0; n < 2; ++n) _Pragma("unroll") for (int k = 0; k < 2; ++k) \
        acc[ai][bj][m][n] = __builtin_amdgcn_mfma_f32_16x16x32_bf16(Bt[n][k], At[m][k], acc[ai][bj][m][n], 0, 0, 0); __builtin_amdgcn_s_setprio(0); } while (0)
#define PG8_WAIT_V(n) asm volatile("s_waitcnt vmcnt(" #n ")" ::: "memory")
#define PG8_WAIT_L(n) asm volatile("s_waitcnt lgkmcnt(" #n ")" ::: "memory")
#define PG8_BAR __builtin_amdgcn_s_barrier()
#define PG8_SCHED __builtin_amdgcn_sched_barrier(0)
    Unit cur, nxt; int ui = 0;
    if (!S.next(0, cur)) return;
    f32x4 acc[2][2][4][2];
#pragma unroll
    for (int a = 0; a < 2; ++a)
#pragma unroll
        for (int b = 0; b < 2; ++b)
#pragma unroll
            for (int m = 0; m < 4; ++m)
#pragma unroll
                for (int n = 0; n < 2; ++n) acc[a][b][m][n] = (f32x4){0.f, 0.f, 0.f, 0.f};
    bf16x8 At[4][2], B0[2][2], B1[2][2];
    const char* cA = (const char*)g.A + (size_t)cur.pm * tstep + (size_t)cur.koff * 2; const char* cB = (const char*)g.Bt + (size_t)cur.pn * tstep + (size_t)cur.koff * 2;
    S.a_ready(cur);
    if constexpr (SP2) {
        PG8_STAGE(PG8_SB(0, 0), cB, voffB); PG8_STAGE(PG8_SB(0, 1), cB + hstep, voffB); PG8_STAGE(PG8_SA(0, 0), cA, voffA); PG8_STAGE(PG8_SA(0, 1), cA + hstep, voffA);
        if (wr == 1) PG8_BAR;
        PG8_WAIT_V(2); PG8_BAR;
        PG8_STAGE(PG8_SB(1, 0), cB + kstep, voffB); PG8_STAGE(PG8_SA(1, 0), cA + kstep, voffA); PG8_STAGE(PG8_SB(1, 1), cB + hstep + kstep, voffB);
        PG8_WAIT_V(6); PG8_BAR;
    } else {
        PG8_STAGE(PG8_SB(0, 0), cB, voffB); PG8_STAGE(PG8_SA(0, 0), cA, voffA); PG8_STAGE(PG8_SB(0, 1), cB + hstep, voffB); PG8_STAGE(PG8_SA(0, 1), cA + hstep, voffA);
        if (wr == 1) PG8_BAR;
        PG8_WAIT_V(4); PG8_BAR;
        PG8_STAGE(PG8_SB(1, 0), cB + kstep, voffB); PG8_STAGE(PG8_SA(1, 0), cA + kstep, voffA); PG8_STAGE(PG8_SB(1, 1), cB + hstep + kstep, voffB);
        PG8_WAIT_V(6); PG8_BAR;
    }
    for (;;) {
        const bool has_next = S.next(ui + 1, nxt);
        const char* nA = has_next ? (const char*)g.A + (size_t)nxt.pm * tstep + (size_t)nxt.koff * 2 : cA; const char* nB = has_next ? (const char*)g.Bt + (size_t)nxt.pn * tstep + (size_t)nxt.koff * 2 : cB;
        for (int t = 0; t < nt; t += 2) {
            const bool last = (t == nt - 2);
            const char* a1 = cA + (size_t)(t + 1) * kstep;
            const char* a2 = last ? nA : cA + (size_t)(t + 2) * kstep; const char* b2 = last ? nB : cB + (size_t)(t + 2) * kstep;
            const char* a3 = a2 + kstep; const char* b3 = b2 + kstep;
            if (last && has_next) S.a_ready(nxt);
            if constexpr (SP2) {
            PG8_LDB(B0, 0, 0); PG8_LDB(B1, 0, 1); PG8_SCHED; PG8_LDA(At, 0, 0); PG8_STAGE(PG8_SA(1, 1), a1 + hstep, voffA);
            PG8_WAIT_V(8); PG8_WAIT_L(0); PG8_BAR; PG8_MMA(0, 0, At, B0); PG8_MMA(0, 1, At, B1); PG8_BAR; PG8_SCHED;
            PG8_LDA(At, 0, 1); PG8_STAGE(PG8_SB(0, 0), b2, voffB); PG8_STAGE(PG8_SB(0, 1), b2 + hstep, voffB); PG8_STAGE(PG8_SA(0, 0), a2, voffA);
            PG8_WAIT_V(8); PG8_WAIT_L(0); PG8_BAR; PG8_MMA(1, 0, At, B0); PG8_MMA(1, 1, At, B1); PG8_BAR; PG8_SCHED;
            PG8_LDB(B0, 1, 0); PG8_LDB(B1, 1, 1); PG8_SCHED; PG8_LDA(At, 1, 0); PG8_STAGE(PG8_SA(0, 1), a2 + hstep, voffA);
            PG8_WAIT_V(8); PG8_WAIT_L(0); PG8_BAR; PG8_MMA(0, 0, At, B0); PG8_MMA(0, 1, At, B1); PG8_BAR; PG8_SCHED;
            PG8_LDA(At, 1, 1); PG8_STAGE(PG8_SB(1, 0), b3, voffB); PG8_STAGE(PG8_SB(1, 1), b3 + hstep, voffB); PG8_STAGE(PG8_SA(1, 0), a3, voffA);
            PG8_WAIT_V(8); PG8_WAIT_L(0); PG8_BAR; PG8_MMA(1, 0, At, B0); PG8_MMA(1, 1, At, B1); PG8_BAR; PG8_SCHED;
            } else {
            PG8_LDB(B0, 0, 0); PG8_SCHED; PG8_LDA(At, 0, 0); PG8_STAGE(PG8_SA(1, 1), a1 + hstep, voffA);
            PG8_WAIT_L(8); PG8_BAR; PG8_WAIT_L(0); PG8_MMA(0, 0, At, B0); PG8_BAR; PG8_SCHED;
            PG8_LDB(B1, 0, 1); PG8_STAGE(PG8_SB(0, 0), b2, voffB);
            PG8_BAR; PG8_WAIT_L(0); PG8_MMA(0, 1, At, B1); PG8_BAR;
            PG8_LDA(At, 0, 1); PG8_STAGE(PG8_SA(0, 0), a2, voffA);
            PG8_BAR; PG8_WAIT_L(0); PG8_MMA(1, 0, At, B0); PG8_BAR; PG8_SCHED;
            PG8_STAGE(PG8_SB(0, 1), b2 + hstep, voffB);
            PG8_WAIT_V(6); PG8_BAR; PG8_MMA(1, 1, At, B1); PG8_BAR;
            PG8_LDB(B0, 1, 0); PG8_SCHED; PG8_LDA(At, 1, 0); PG8_STAGE(PG8_SA(0, 1), a2 + hstep, voffA);
            PG8_WAIT_L(8); PG8_BAR; PG8_WAIT_L(0); PG8_MMA(0, 0, At, B0); PG8_BAR; PG8_SCHED;
            PG8_LDB(B1, 1, 1); PG8_STAGE(PG8_SB(1, 0), b3, voffB);
            PG8_BAR; PG8_WAIT_L(0); PG8_MMA(0, 1, At, B1); PG8_BAR;
            PG8_LDA(At, 1, 1); PG8_STAGE(PG8_SA(1, 0), a3, voffA);
            PG8_BAR; PG8_WAIT_L(0); PG8_MMA(1, 0, At, B0); PG8_BAR; PG8_SCHED;
            PG8_STAGE(PG8_SB(1, 1), b3 + hstep, voffB);
            PG8_WAIT_V(6); PG8_BAR; PG8_MMA(1, 1, At, B1); PG8_BAR;
            }
        }
        if constexpr (ALIGN_EPI) { if (wr == 0) PG8_BAR; }
        if constexpr (!Epi::AFTER_DRAIN) { E(acc, cur, wr, wc, fr, fq); S.done(cur); }
        if (!has_next) break;
#pragma unroll
        for (int a = 0; a < 2; ++a)
#pragma unroll
            for (int b = 0; b < 2; ++b)
#pragma unroll
                for (int m = 0; m < 4; ++m)
#pragma unroll
                    for (int n = 0; n < 2; ++n) acc[a][b][m][n] = (f32x4){0.f, 0.f, 0.f, 0.f};
        cur = nxt; cA = nA; cB = nB; ++ui;
        if constexpr (ALIGN_EPI) { if (wr == 1) PG8_BAR; }
    }
    PG8_WAIT_V(0);
    if constexpr (!ALIGN_EPI) { if (wr == 0) PG8_BAR; }
    PG8_BAR;
    if constexpr (Epi::AFTER_DRAIN) { E.fused(acc, cur, wr, wc, fr, fq, lds, wid, lane); S.done(cur); }
#undef PG8_SA
#undef PG8_SB
#undef PG8_STAGE
#undef PG8_LDA
#undef PG8_LDB
#undef PG8_MMA
#undef PG8_WAIT_V
#undef PG8_WAIT_L
#undef PG8_BAR
#undef PG8_SCHED
}

template <class Epi, class Sched>
__device__ __forceinline__ void naive_phase(const Gemm g, const Sched& S, const Epi& E) {
    int tid = threadIdx.x; asm volatile("" : "+v"(tid));
    const int wid = __builtin_amdgcn_readfirstlane(tid >> 6), lane = tid & 63, wr = wid >> 2, wc = wid & 3, fr = lane & 15, fq = lane >> 4;
    Unit u;
#pragma unroll 1
    for (int ui = 0; S.next(ui, u); ++ui) {
        f32x4 acc[2][2][4][2];
#pragma unroll
        for (int ai = 0; ai < 2; ++ai)
#pragma unroll
            for (int m = 0; m < 4; ++m) {
                const bf16_t* arow = g.A + (size_t)(u.pm * BM + ai * HALF + wr * 64 + m * 16 + fr) * g.Kp;
#pragma unroll
                for (int bj = 0; bj < 2; ++bj)
#pragma unroll
                    for (int n = 0; n < 2; ++n)
#pragma unroll
                        for (int i = 0; i < 4; ++i) {
                            const bf16_t* brow = g.Bt + (size_t)(u.pn * BM + bj * HALF + wc * 32 + 8 * fq + 4 * n + i) * g.Kp;
                            float s = 0.f;
#pragma unroll 1
                            for (int k = 0; k < g.K; k += 8) { const u32x4 a = *(const u32x4*)(arow + k), b = *(const u32x4*)(brow + k);
                                s += bf_lo(a.x) * bf_lo(b.x) + bf_hi(a.x) * bf_hi(b.x) + bf_lo(a.y) * bf_lo(b.y) + bf_hi(a.y) * bf_hi(b.y)
                                   + bf_lo(a.z) * bf_lo(b.z) + bf_hi(a.z) * bf_hi(b.z) + bf_lo(a.w) * bf_lo(b.w) + bf_hi(a.w) * bf_hi(b.w); }
                            acc[ai][bj][m][n][i] = s;
                        }
            }
        E(acc, u, wr, wc, fr, fq);
    }
    __syncthreads();
}
}
#include <hip/hip_bf16.h>
#include <cmath>
namespace attn_body {
using bf16=__hip_bfloat16;
using bf16x8=__attribute__((ext_vector_type(8)))short;
using s16x4=__attribute__((ext_vector_type(4)))short;
using f32x16=__attribute__((ext_vector_type(16)))float;
using u32x4=__attribute__((ext_vector_type(4)))unsigned;
using f32x4_t=__attribute__((ext_vector_type(4)))float;
constexpr int BATCH=2,NHEAD=8,SEQ=16384,D=64,DM=NHEAD*D;
constexpr int NW=8,QBLK=32,QB=QBLK*NW,KVBLK=64,NQB=SEQ/QB;
constexpr int ATTN_PITCH=DM, ATTN_UNIT_ROWS=QB;
__device__ __forceinline__ int crow(int r,int hi){return (r&3)+8*(r>>2)+4*hi;}
#define SBAR() __builtin_amdgcn_sched_barrier(0)
__device__ __forceinline__ void cmask(f32x16&p0,f32x16&p1,int jb,int qrel,int hi){
  const float NEG=-INFINITY; int kb=64*jb+4*hi;
  #pragma unroll
  for(int r=0;r<16;++r){int kv=kb+(r&3)+8*(r>>2); if(kv>qrel)p0[r]=NEG; if(kv+32>qrel)p1[r]=NEG;}
}

constexpr int NSLOT=3, SLOTB=8192;
constexpr int LDS_K=0, LDS_V=NSLOT*SLOTB, LDS_WS=2*NSLOT*SLOTB, LDS_OST=LDS_WS+NW*64*4, LDS_BYTES=LDS_OST+NW*4096, LDS_BIAS=LDS_BYTES, LDS_TOTAL=LDS_BIAS+SEQ*4;
constexpr float C2=0.125f*1.4426950408889634f;
__device__ __forceinline__ void glds16(const void*gsrc,unsigned lds_dst){unsigned keep;
  asm volatile("s_mov_b32 %0, m0\n\ts_mov_b32 m0, %2\n\ts_nop 0\n\tglobal_load_lds_dwordx4 %1, off\n\ts_mov_b32 m0, %0":"=&s"(keep):"v"(gsrc),"s"(lds_dst):"memory");}
__device__ __forceinline__ float max3f(float a,float b,float c){float r;asm("v_max3_f32 %0, %1, %2, %3":"=v"(r):"v"(a),"v"(b),"v"(c));return r;}
__device__ __forceinline__ float max2f(float a,float b){float r;asm("v_max_f32_e32 %0, %1, %2":"=v"(r):"v"(a),"v"(b));return r;}
__device__ __forceinline__ float fadd_s(float a,float b){float r;asm("v_add_f32_e32 %0, %1, %2":"=v"(r):"v"(a),"v"(b));return r;}
__device__ __forceinline__ float fsub_s(float a,float b){float r;asm("v_sub_f32_e32 %0, %1, %2":"=v"(r):"v"(a),"v"(b));return r;}
typedef float f32x2_t __attribute__((ext_vector_type(2))); typedef __bf16 bf16x2_t __attribute__((ext_vector_type(2)));
__device__ __forceinline__ unsigned cvtpk_s(float lo,float hi){f32x2_t v={lo,hi};bf16x2_t b=__builtin_convertvector(v,bf16x2_t);return __builtin_bit_cast(unsigned,b);}
#define WAIT_BAR(N) asm volatile("s_waitcnt vmcnt(" #N ") lgkmcnt(0)\n\ts_barrier":::"memory")

__device__ __forceinline__ void qkt(f32x16&p0,f32x16&p1,const char*Kslot,const bf16x8*qr,int r32,int hi){
  const char*kb=Kslot+hi*1024+r32*16;
  #pragma unroll
  for(int d0=0;d0<4;++d0){
    const bf16x8 b0=*reinterpret_cast<const bf16x8*>(kb+d0*2048);
    const bf16x8 b1=*reinterpret_cast<const bf16x8*>(kb+d0*2048+512);
    p0=__builtin_amdgcn_mfma_f32_32x32x16_bf16(b0,qr[d0],p0,0,0,0);p1=__builtin_amdgcn_mfma_f32_32x32x16_bf16(b1,qr[d0],p1,0,0,0);}
}
typedef __attribute__((address_space(3))) const char* lds_cptr;
typedef short v4i16_t __attribute__((ext_vector_type(4)));
__device__ __forceinline__ void kload8(bf16x8*kf,lds_cptr kp){
  kf[0]=*(const __attribute__((address_space(3))) bf16x8*)(kp);      kf[1]=*(const __attribute__((address_space(3))) bf16x8*)(kp+512);
  kf[2]=*(const __attribute__((address_space(3))) bf16x8*)(kp+2048); kf[3]=*(const __attribute__((address_space(3))) bf16x8*)(kp+2560);
  kf[4]=*(const __attribute__((address_space(3))) bf16x8*)(kp+4096); kf[5]=*(const __attribute__((address_space(3))) bf16x8*)(kp+4608);
  kf[6]=*(const __attribute__((address_space(3))) bf16x8*)(kp+6144); kf[7]=*(const __attribute__((address_space(3))) bf16x8*)(kp+6656);
}
__device__ __forceinline__ void kload2(bf16x8*kf,lds_cptr kp,int j){ kf[2*j]=*(const __attribute__((address_space(3))) bf16x8*)(kp+j*2048); kf[2*j+1]=*(const __attribute__((address_space(3))) bf16x8*)(kp+j*2048+512); }
__device__ __forceinline__ s16x4 vtr(lds_cptr p){ return __builtin_bit_cast(s16x4,__builtin_amdgcn_ds_read_tr16_b64_v4i16((__attribute__((address_space(3))) v4i16_t*)p)); }
__device__ __forceinline__ float rowmax(const f32x16&p0,const f32x16&p1){
  float a=max3f(p0[0],p0[1],p1[0]),b=max3f(p0[2],p0[3],p1[1]);a=max3f(a,p1[2],p1[3]);
  #pragma unroll
  for(int r=4;r<16;r+=4){a=max3f(a,p0[r],p0[r+1]);b=max3f(b,p0[r+2],p0[r+3]);a=max3f(a,p1[r],p1[r+1]);b=max3f(b,p1[r+2],p1[r+3]);}
  const float m=max2f(a,b);
  auto rr=__builtin_amdgcn_permlane32_swap(__float_as_uint(m),__float_as_uint(m),false,false);
  return max2f(__uint_as_float(rr[0]),__uint_as_float(rr[1]));
}
__device__ __forceinline__ void pv(f32x16*o,int vb,bf16x8 pa0,bf16x8 pa1,bf16x8 pa2,bf16x8 pa3){
  #pragma unroll
  for(int d0=0;d0<2;++d0){s16x4 lo[4],hi[4];
    #pragma unroll
    for(int ks=0;ks<4;++ks){
      asm volatile("ds_read_b64_tr_b16 %0,%1 offset:%c2":"=&v"(lo[ks]):"v"(vb),"i"(d0*4096+ks*1024):"memory");
      asm volatile("ds_read_b64_tr_b16 %0,%1 offset:%c2":"=&v"(hi[ks]):"v"(vb),"i"(d0*4096+ks*1024+512):"memory");}
    asm volatile("s_waitcnt lgkmcnt(0)":::"memory");SBAR();
    #define PK(k) (bf16x8){lo[k][0],lo[k][1],lo[k][2],lo[k][3],hi[k][0],hi[k][1],hi[k][2],hi[k][3]}
    o[d0]=__builtin_amdgcn_mfma_f32_32x32x16_bf16(pa0,PK(0),o[d0],0,0,0);
    o[d0]=__builtin_amdgcn_mfma_f32_32x32x16_bf16(pa1,PK(1),o[d0],0,0,0);
    o[d0]=__builtin_amdgcn_mfma_f32_32x32x16_bf16(pa2,PK(2),o[d0],0,0,0);
    o[d0]=__builtin_amdgcn_mfma_f32_32x32x16_bf16(pa3,PK(3),o[d0],0,0,0);
    #undef PK
  }
}

#ifndef ATTN_STORE16
#define ATTN_STORE16(p,v) (*(u32x4*)(p)=(v))
#endif
template<int THRL> __device__ __forceinline__ void attn_unit(int b,int h,int qb,int ts,const float*__restrict__ cl2,const bf16*Q,const bf16*__restrict__ K,const bf16*__restrict__ V,bf16*O,char*shm,int wv){
  int tid=(wv<<6)|lane_id_(); asm volatile("":"+v"(tid)); const int lane=tid&63,r32=lane&31,hi=lane>>5; const int wid=__builtin_amdgcn_readfirstlane(tid>>6);
  const long rowbase=(long)b*SEQ; const int q0=qb*QB;
  const bf16*Qw=Q+(rowbase+q0+wid*QBLK)*DM+h*D;
  const bf16*Kh=K+(rowbase+(long)ts*KVBLK)*DM+h*D,*Vh=V+(rowbase+(long)ts*KVBLK)*DM+h*D;
  const unsigned lds0=(unsigned)(uintptr_t)shm;
  float*wsf=(float*)(shm+LDS_WS)+wid*64;
  const bf16*ksrc=Kh+(long)lane*DM+wid*8;
  const bf16*vsrc=Vh+(long)(16*(wid&3)+(lane>>2))*DM+(wid>>2)*32+(lane&3)*8;
  const unsigned kdst=lds0+LDS_K+wid*1024, vdst=lds0+LDS_V+wid*1024;
  #define DMA_K(t,slot) glds16(ksrc+(long)(t)*KVBLK*DM,(unsigned)__builtin_amdgcn_readfirstlane(kdst+(slot)))
  #define DMA_V(t,slot) glds16(vsrc+(long)(t)*KVBLK*DM,(unsigned)__builtin_amdgcn_readfirstlane(vdst+(slot)))
  const int vb0=(int)(lds0+LDS_V)+((lane>>4)&1)*32+(lane&3)*8+(4*hi+((lane&15)>>2))*64;
  const char*Kbase=shm+LDS_K; bf16x8 kf[8];
  const lds_cptr shm3=(lds_cptr)shm; const lds_cptr kp0=shm3+LDS_K+hi*1024+r32*16; const lds_cptr vp0=shm3+LDS_V+((lane>>4)&1)*32+(lane&3)*8+(4*hi+((lane&15)>>2))*64;
  const int NT=(q0+QB)/KVBLK-ts;
  DMA_K(0,0);DMA_V(0,0);DMA_K(1,SLOTB);
  bf16x8 qr[4];
  #pragma unroll
  for(int d0=0;d0<4;++d0)qr[d0]=*reinterpret_cast<const bf16x8*>(&Qw[(long)r32*DM+d0*16+hi*8]);
  float mhat=0.f,l_reg=0.f;f32x16 o[2];o[0]=f32x16{};o[1]=f32x16{};
  typedef __attribute__((address_space(3))) const f32x4_t* lds_f4p; const lds_f4p biasp=(lds_f4p)((lds_cptr)shm+LDS_BIAS)+hi;
  #define BIASINIT(C0,C1,t) do{ _Pragma("unroll") for(int g_=0;g_<4;++g_){ const f32x4_t b0_=biasp[(t)*16+2*g_], b1_=biasp[(t)*16+8+2*g_]; \
      _Pragma("unroll") for(int i_=0;i_<4;++i_){ C0[4*g_+i_]=b0_[i_]-mhat; C1[4*g_+i_]=b1_[i_]-mhat; } } }while(0)
  const int qrel=wid*QBLK+r32;
  #define CMASK(P0,P1,t) do{int jb_=(t)-(NT-4); if(jb_>=0)cmask(P0,P1,jb_,qrel,hi);}while(0)
  bool resc=false;
  #define START(P0,P1) do{ const float rm=rowmax(P0,P1); resc=false; \
    { const float dl=rm; mhat=fadd_s(mhat,dl); \
      _Pragma("unroll") for(int r=0;r<16;++r){P0[r]=fsub_s(P0[r],dl);P1[r]=fsub_s(P1[r],dl);} } \
    _Pragma("unroll") for(int r=0;r<16;++r)P0[r]=__builtin_amdgcn_exp2f(P0[r]); }while(0)
  #define RESC() do{ if(resc){ asm volatile("s_waitcnt lgkmcnt(0)":::"memory"); \
      _Pragma("unroll") for(int d_=0;d_<2;++d_) _Pragma("unroll") for(int r=0;r<16;++r)o[d_][r]*=wsf[crow(r,hi)]; } }while(0)
  f32x16 pA0,pA1,pB0,pB1;
  int sl_prev=0,sl_cur=0,sl_next=SLOTB;
  #define ROT() do{sl_prev=sl_cur;sl_cur=sl_next;sl_next=(sl_next==(NSLOT-1)*SLOTB)?0:sl_next+SLOTB;}while(0)
  {
    const float cref=cl2[q0]; const f32x4_t*src=(const f32x4_t*)(cl2+ts*KVBLK); __attribute__((address_space(3))) f32x4_t*dst=(__attribute__((address_space(3))) f32x4_t*)((__attribute__((address_space(3))) char*)shm+LDS_BIAS);
    for(int i=tid;i<NT*16;i+=NW*64){ const f32x4_t c4=src[i]; dst[i]=(f32x4_t){cref-c4[0],cref-c4[1],cref-c4[2],cref-c4[3]}; } }
  DMA_K(2,2*SLOTB);
  WAIT_BAR(3);
  BIASINIT(pA0,pA1,0); qkt(pA0,pA1,Kbase,qr,r32,hi);asm volatile("s_nop 15\n\ts_nop 7":"+v"(pA0),"+v"(pA1));CMASK(pA0,pA1,0);
  START(pA0,pA1);
  _Pragma("unroll") for(int r=0;r<16;++r)pA1[r]=__builtin_amdgcn_exp2f(pA1[r]);
  WAIT_BAR(0);
  DMA_K(3,0);DMA_V(1,SLOTB);
  ROT();
  kload8(kf,kp0+sl_cur);
  WAIT_BAR(2);
  s16x4 vlo[8],vhi[8]; u32x4 pw0,pw1,pw2,pw3;
  #define PKW(P,B) cvtpk_s(P[B],P[B+1])
  #define PAF(k) __builtin_bit_cast(bf16x8,pw##k)
  #define VFR(i) (bf16x8){vlo[i][0],vlo[i][1],vlo[i][2],vlo[i][3],vhi[i][0],vhi[i][1],vhi[i][2],vhi[i][3]}
  #define PIN(x) asm volatile("":"+v"(x))
  #define MX3(a,b,c) __builtin_fmaxf(__builtin_fmaxf((a),(b)),(c))
  #define GAPA(MF,A0,A1,A2,A3,W0,W1,PW) do{ MF; sacc+=A0; sacc+=A1; sacc+=A2; sacc+=A3; PIN(sacc); W0; W1; PIN(PW); SBAR(); }while(0)
  #define EX(v) __builtin_amdgcn_exp2f(v)
  #define GAPB(MF,X,B) do{ MF; X[B]=EX(X[B]); X[B+1]=EX(X[B+1]); X[B+2]=EX(X[B+2]); X[B+3]=EX(X[B+3]); PIN(X); SBAR(); }while(0)
  #define VRD(i) do{ vlo[i]=vtr(vp_+(((i)>>2)*4096+((i)&3)*1024)); vhi[i]=vtr(vp_+(((i)>>2)*4096+((i)&3)*1024+512)); }while(0)
  #define KRD(G,j) do{ if(G){ kload2(kf,kp0+sl_next,j); SBAR(); } }while(0)
  #define STEP(C0,C1,P0,P1,t,GK,GV,GL) do{ SBAR(); BIASINIT(C0,C1,t); SBAR(); \
    const lds_cptr vp_=vp0+sl_prev; \
    VRD(0); SBAR(); float sacc=(P0[0]+P0[1]); \
    GAPA(C0=__builtin_amdgcn_mfma_f32_32x32x16_bf16(kf[0],qr[0],C0,0,0,0), P0[2],P0[3],P0[4],P0[5],     pw0[0]=PKW(P0,0), pw0[1]=PKW(P0,2), pw0); \
    VRD(4); SBAR(); GAPA(C1=__builtin_amdgcn_mfma_f32_32x32x16_bf16(kf[1],qr[0],C1,0,0,0), P0[6],P0[7],P0[8],P0[9],     pw0[2]=PKW(P0,4), pw0[3]=PKW(P0,6), pw0); \
    VRD(1); SBAR(); GAPA(C0=__builtin_amdgcn_mfma_f32_32x32x16_bf16(kf[2],qr[1],C0,0,0,0),   P0[10],P0[11],P0[12],P0[13], pw1[0]=PKW(P0,8), pw1[1]=PKW(P0,10), pw1); \
    VRD(5); SBAR(); GAPA(C1=__builtin_amdgcn_mfma_f32_32x32x16_bf16(kf[3],qr[1],C1,0,0,0),   P0[14],P0[15],P1[0],P1[1],   pw1[2]=PKW(P0,12),pw1[3]=PKW(P0,14), pw1); \
    VRD(2); SBAR(); GAPA(C0=__builtin_amdgcn_mfma_f32_32x32x16_bf16(kf[4],qr[2],C0,0,0,0),   P1[2],P1[3],P1[4],P1[5],     pw2[0]=PKW(P1,0), pw2[1]=PKW(P1,2), pw2); \
    VRD(6); SBAR(); GAPA(C1=__builtin_amdgcn_mfma_f32_32x32x16_bf16(kf[5],qr[2],C1,0,0,0),   P1[6],P1[7],P1[8],P1[9],     pw2[2]=PKW(P1,4), pw2[3]=PKW(P1,6), pw2); \
    VRD(3); SBAR(); GAPA(C0=__builtin_amdgcn_mfma_f32_32x32x16_bf16(kf[6],qr[3],C0,0,0,0),   P1[10],P1[11],P1[12],P1[13], pw3[0]=PKW(P1,8), pw3[1]=PKW(P1,10), pw3); \
    VRD(7); SBAR(); GAPA(C1=__builtin_amdgcn_mfma_f32_32x32x16_bf16(kf[7],qr[3],C1,0,0,0),   P1[14],P1[15],0.f,0.f,       pw3[2]=PKW(P1,12),pw3[3]=PKW(P1,14), pw3); \
    l_reg+=sacc; \
    if(GK){DMA_K((t)+3,sl_cur);} if(GV){DMA_V((t)+1,sl_next);} \
    CMASK(C0,C1,t); \
    { float a=MX3(C0[0],C0[1],C1[0]),b=MX3(C0[2],C0[3],C1[1]); a=MX3(a,C1[2],C1[3]); \
      _Pragma("unroll") for(int r=4;r<16;r+=4){a=MX3(a,C0[r],C0[r+1]);b=MX3(b,C0[r+2],C0[r+3]);a=MX3(a,C1[r],C1[r+1]);b=MX3(b,C1[r+2],C1[r+3]);} \
      float rm=__builtin_fmaxf(a,b); { auto rr=__builtin_amdgcn_permlane32_swap(__float_as_uint(rm),__float_as_uint(rm),false,false); rm=__builtin_fmaxf(__uint_as_float(rr[0]),__uint_as_float(rr[1])); } \
      resc=false; \
      if(__builtin_expect(__any(rm>(float)THRL),0)){ const float dl=__builtin_fmaxf(rm,0.f); mhat+=dl; \
        _Pragma("unroll") for(int r=0;r<16;++r){C0[r]-=dl;C1[r]-=dl;} \
        const float f=__builtin_amdgcn_exp2f(-dl); l_reg*=f; if(hi==0)wsf[r32]=f; resc=true; } } \
    SBAR(); \
    GAPB(o[0]=__builtin_amdgcn_mfma_f32_32x32x16_bf16(PAF(0),VFR(0),o[0],0,0,0), C0,0); \
    GAPB(o[1]=__builtin_amdgcn_mfma_f32_32x32x16_bf16(PAF(0),VFR(4),o[1],0,0,0), C0,4); \
    KRD(GL,0); GAPB(o[0]=__builtin_amdgcn_mfma_f32_32x32x16_bf16(PAF(1),VFR(1),o[0],0,0,0), C0,8); \
    KRD(GL,1); GAPB(o[1]=__builtin_amdgcn_mfma_f32_32x32x16_bf16(PAF(1),VFR(5),o[1],0,0,0), C0,12); \
    KRD(GL,2); GAPB(o[0]=__builtin_amdgcn_mfma_f32_32x32x16_bf16(PAF(2),VFR(2),o[0],0,0,0), C1,0); \
    KRD(GL,3); GAPB(o[1]=__builtin_amdgcn_mfma_f32_32x32x16_bf16(PAF(2),VFR(6),o[1],0,0,0), C1,4); \
    GAPB(o[0]=__builtin_amdgcn_mfma_f32_32x32x16_bf16(PAF(3),VFR(3),o[0],0,0,0), C1,8); \
    GAPB(o[1]=__builtin_amdgcn_mfma_f32_32x32x16_bf16(PAF(3),VFR(7),o[1],0,0,0), C1,12); \
    }while(0)
  int t=1;
  #undef CMASK
  #define CMASK(P0,P1,t) do{}while(0)
  for(;t+5<NT;t+=2){
    STEP(pB0,pB1,pA0,pA1,t,true,true,true);     WAIT_BAR(2); RESC(); ROT();
    STEP(pA0,pA1,pB0,pB1,t+1,true,true,true);   WAIT_BAR(2); RESC(); ROT();
  }
  #undef CMASK
  #define CMASK(P0,P1,t) do{int jb_=(t)-(NT-4); if(jb_>=0)cmask(P0,P1,jb_,qrel,hi);}while(0)
  #define ENDW(tt) do{ if((tt)+3<NT){WAIT_BAR(2);} else if((tt)+2<NT){WAIT_BAR(1);} else {WAIT_BAR(0);} }while(0)
  for(;t+1<NT;t+=2){
    STEP(pB0,pB1,pA0,pA1,t,(t+3<NT),(t+1<NT),(t+1<NT));       ENDW(t);   RESC(); ROT();
    STEP(pA0,pA1,pB0,pB1,t+1,(t+4<NT),(t+2<NT),(t+2<NT));     ENDW(t+1); RESC(); ROT();
  }
  STEP(pB0,pB1,pA0,pA1,NT-1,false,false,false); RESC();
  { float sacc=pB0[0]+pB0[1]; _Pragma("unroll") for(int r=2;r<16;++r)sacc+=pB0[r]; _Pragma("unroll") for(int r=0;r<16;++r)sacc+=pB1[r]; l_reg+=sacc;
    pw0=(u32x4){PKW(pB0,0),PKW(pB0,2),PKW(pB0,4),PKW(pB0,6)};pw1=(u32x4){PKW(pB0,8),PKW(pB0,10),PKW(pB0,12),PKW(pB0,14)};pw2=(u32x4){PKW(pB1,0),PKW(pB1,2),PKW(pB1,4),PKW(pB1,6)};pw3=(u32x4){PKW(pB1,8),PKW(pB1,10),PKW(pB1,12),PKW(pB1,14)};
    SBAR(); pv(o,vb0+sl_cur,PAF(0),PAF(1),PAF(2),PAF(3)); }
  #undef PKW
  #undef PAF
  #undef VFR
  #undef PIN
  #undef MX3
  #undef GAPA
  #undef GAPB
  #undef EX
  #undef VRD
  #undef KRD
  #undef STEP
  #undef ENDW
  {auto rr=__builtin_amdgcn_permlane32_swap(__float_as_uint(l_reg),__float_as_uint(l_reg),false,false);l_reg=__uint_as_float(rr[0])+__uint_as_float(rr[1]);}
  if(hi==0)wsf[32+r32]=l_reg;asm volatile("s_waitcnt lgkmcnt(0)":::"memory");
  float rli[16];
  #pragma unroll
  for(int r=0;r<16;++r)rli[r]=__builtin_amdgcn_rcpf(wsf[32+crow(r,hi)]);
  bf16*Ow=O+(rowbase+q0+wid*QBLK)*DM+h*D;
  { bf16*stg=(bf16*)(shm+LDS_OST)+wid*2048;
    #pragma unroll
    for(int r=0;r<16;++r){const int orow=crow(r,hi);
      #pragma unroll
      for(int d0=0;d0<2;++d0)stg[orow*64+d0*32+r32]=__float2bfloat16(o[d0][r]*rli[r]);}
    asm volatile("s_waitcnt lgkmcnt(0)":::"memory");
    #pragma unroll
    for(int i=0;i<4;++i){const int row=i*8+(lane>>3),ch=lane&7; const u32x4 v=*(const u32x4*)(stg+row*64+ch*8); ATTN_STORE16(Ow+(long)row*DM+ch*8,v);} }
  asm volatile("s_waitcnt lgkmcnt(0)\n\ts_barrier":::"memory");
  #undef DMA_K
  #undef DMA_V
  #undef CMASK
  #undef BIASINIT
  #undef START
  #undef RESC
  #undef ROT
}
constexpr int ATTN_LDS_BYTES=LDS_BYTES;
struct AttnTensors { const bf16* Q; const bf16* K; const bf16* V; bf16* O; const float* cl2; };
#undef SBAR
#undef WAIT_BAR
}
#define GEMM_PHASE(...) pg8::gemm_phase<__VA_ARGS__, pg8::StaticOrder, PGA, PGS>(ldsl, g, S, E, wave)
#define GEMM_PHASE_SPLIT() pg8::gemm_phase<pg8::EpiPartial, pg8::SplitOrder, PGA, PGS>(ldsl, g2, S2, E2, wave)
#define GEMM_PHASE_SPLIT_T(NN, NS, KSUB, KSH) pg8::gemm_phase<pg8::EpiPartialT<NN, KSH>, pg8::SplitOrderT<NN, NS, KSUB>, PGA, PGS>(ldsl, g2, S2, E2, wave)
#ifndef PGA
#define PGA true
#endif
#ifndef PGS
#define PGS true
#endif
namespace cg = cooperative_groups;
#define LAS __attribute__((address_space(3)))
typedef unsigned short bf16;
typedef unsigned v4u __attribute__((ext_vector_type(4)));
typedef float f32x4 __attribute__((ext_vector_type(4)));
typedef short bf16x8 __attribute__((ext_vector_type(8)));
typedef float f32x16 __attribute__((ext_vector_type(16)));
constexpr int NWAVES = 8, NTHR = 512, NMODC_ = 9216;
constexpr int MP = 32768, MS = 256, M = MP + MS, DM = 1024, FF = 2816, WA = 512, NIN = 4608, INCOLS = 4616, SEQ = 16384, PAST = 1024, DSEQ = 32, SKEYS = PAST + DSEQ;
constexpr float EPS = 1e-6f, LOG2E = 1.4426950408889634f;
constexpr size_t MiB = 1u << 20;
constexpr size_t WS_CTL = 0, CTL_ZERO_BYTES = 65536;
constexpr size_t WS_MOD = 1 * MiB, WS_CUMP = 2 * MiB, WS_CUMS = 3 * MiB, WS_G2SS = 4 * MiB, WS_QS = 6 * MiB, WS_WSP = 7 * MiB;
constexpr size_t WS_WGU1 = 8 * MiB, WS_WD1 = 19 * MiB, WS_WIN = 25 * MiB, WS_WPA = 34 * MiB, WS_WPB = 35 * MiB, WS_WOUT = 36 * MiB, WS_WGU2 = 38 * MiB, WS_WD2 = 49 * MiB;
constexpr size_t WS_XN = 56 * MiB;
constexpr size_t WS_ACT = 121 * MiB;
constexpr size_t QKV_B = (size_t)M * 512 * 2;
constexpr size_t WS_Q = 121 * MiB, WS_K = WS_Q + QKV_B, WS_V = WS_K + QKV_B, WS_U = WS_V + QKV_B, WS_G2 = WS_U + QKV_B;
constexpr size_t WS_AO = WS_Q;
constexpr size_t WS_T1 = WS_U;
constexpr size_t WS_T2 = WS_K;
constexpr size_t WS_BO = 283 * MiB, WS_PART = 300 * MiB, WS_END = 316 * MiB;
static_assert(WS_XN + (size_t)M * 2048 <= WS_ACT && WS_G2 + QKV_B <= WS_BO && WS_BO + QKV_B <= WS_END && WS_ACT + (size_t)M * FF * 2 <= WS_END, "ws map");
constexpr size_t O_Y = 0, O_KP = (size_t)M * 1024, O_VP = O_KP + (size_t)MP * 512, O_FP = O_VP + (size_t)MP * 512, O_KS = O_FP + (size_t)MP * 8, O_VS = O_KS + (size_t)MS * 512,
                 O_FS = O_VS + (size_t)MS * 512, O_GS = O_FS + (size_t)MS * 8, O_END = O_GS + (size_t)MS * 512;
constexpr int LDS_BYTES = 155648, MISC_OFF = LDS_BYTES - 256;
static_assert(attn_body::LDS_TOTAL <= MISC_OFF && pg8::STAGE_BYTES <= LDS_BYTES, "LDS map");

struct Args { const float* in[28]; float* out; unsigned char* ws; };

__device__ __forceinline__ float wave_sum(float v) {
#pragma unroll
    for (int o = 1; o < 64; o <<= 1) v += __shfl_xor(v, o);
    return v;
}
__device__ __forceinline__ unsigned f2bf(float f) { unsigned u = __builtin_bit_cast(unsigned, f); return (u + 0x7fffu + ((u >> 16) & 1u)) >> 16; }
__device__ __forceinline__ unsigned pk2(float lo, float hi) { return f2bf(lo) | (f2bf(hi) << 16); }
__device__ __forceinline__ float bf2f(unsigned short h) { return __uint_as_float((unsigned)h << 16); }

__device__ __forceinline__ void ada_unit(const Args& a, unsigned char* lds, int cb, int tid) {
    asm volatile("" : "+v"(tid));
    float* SC = (float*)lds; float* RED = (float*)(lds + 40960);
    const float* cp = a.in[2]; const float* cs = a.in[3]; const float* w_ada = a.in[7]; const float* b_ada = a.in[8];
    float* MOD = (float*)(a.ws + WS_MOD);
    for (int i = tid; i < 10240; i += NTHR) { const int r = i >> 10, k = i & 1023; const float c = r < 2 ? cp[r * 1024 + k] : cs[(r - 2) * 1024 + k]; SC[i] = c / (1.0f + expf(-c)); }
    __syncthreads();
    if (tid < 504) {
        const int cgp = tid % 9, ks = tid / 9; f32x4 acc[10];
#pragma unroll
        for (int r = 0; r < 10; ++r) acc[r] = (f32x4){0.f, 0.f, 0.f, 0.f};
        for (int k = ks; k < 1024; k += 56) { const f32x4 w = *(const f32x4*)(w_ada + (size_t)k * NMODC_ + 36 * cb + 4 * cgp);
#pragma unroll
            for (int r = 0; r < 10; ++r) acc[r] += w * SC[r * 1024 + k]; }
#pragma unroll
        for (int r = 0; r < 10; ++r) *(f32x4*)(RED + (size_t)tid * 40 + r * 4) = acc[r];
    }
    __syncthreads();
    if (tid < 360) { const int r = tid / 36, c = tid % 36, cgp = c >> 2, i = c & 3; float s = 0.f;
        for (int ks = 0; ks < 56; ++ks) s += RED[(ks * 9 + cgp) * 40 + r * 4 + i];
        MOD[r * NMODC_ + 36 * cb + c] = s + b_ada[36 * cb + c]; }
    __syncthreads();
}
__device__ __forceinline__ void transpose_item(const float* W, int ld, int c0, int K, bf16* WT, int drow0, int k0, float* scr, int lane) {
#pragma unroll 8
    for (int i = 0; i < 32; ++i) { const int kk = 2 * i + (lane >> 5); scr[kk * 33 + (lane & 31)] = W[(size_t)(k0 + kk) * ld + c0 + (lane & 31)]; }
    asm volatile("s_waitcnt lgkmcnt(0)" ::: "memory");
    const int c = lane & 7;
#pragma unroll
    for (int j = 0; j < 4; ++j) { const int n = (lane >> 3) + 8 * j; const float* s = scr + (8 * c) * 33 + n;
        v4u o; o.x = pk2(s[0 * 33], s[1 * 33]); o.y = pk2(s[2 * 33], s[3 * 33]); o.z = pk2(s[4 * 33], s[5 * 33]); o.w = pk2(s[6 * 33], s[7 * 33]);
        *(v4u*)(WT + (size_t)(drow0 + n) * K + k0 + 8 * c) = o; }
    asm volatile("s_waitcnt lgkmcnt(0)" ::: "memory");
}
struct Seg { int in, ld, c0, ncols, K; size_t dst; int drow, mode; };
__device__ const Seg SEGS[13] = {
        {10, FF, 0, FF, 1024, WS_WGU1, 0, 1}, {11, FF, 0, FF, 1024, WS_WGU1, 0, 2}, {12, 1024, 0, 1024, FF, WS_WD1, 0, 0},
        {14, INCOLS, 0, 512, 1024, WS_WIN, 0, 3}, {14, INCOLS, 512, 512, 1024, WS_WIN, 512, 3}, {14, INCOLS, 1024, 512, 1024, WS_WIN, 1024, 0}, {14, INCOLS, 1544, 3072, 1024, WS_WIN, 1536, 0},
        {21, 1024, 0, 1024, 512, WS_WPA, 0, 0}, {22, 1024, 0, 1024, 512, WS_WPB, 0, 0}, {23, 1024, 0, 1024, 1024, WS_WOUT, 0, 0},
        {25, FF, 0, FF, 1024, WS_WGU2, 0, 1}, {26, FF, 0, FF, 1024, WS_WGU2, 0, 2}, {27, 1024, 0, 1024, FF, WS_WD2, 0, 0}};
__device__ __forceinline__ int seg_drow(const Seg& s, int n) {
    if (s.mode == 0) return s.drow + n;
    if (s.mode == 1) return s.drow + 256 * (n >> 7) + (n & 127);
    if (s.mode == 2) return s.drow + 256 * (n >> 7) + 128 + (n & 127);
    const int gs = (n & 255) >> 5; return s.drow + (n & ~255) + 32 * (4 * (gs & 1) + (gs >> 1));
}
__device__ __forceinline__ void p0_weights(const Args& a, unsigned char* lds, int gw, int NGW, int wave, int lane) {
    asm volatile("" : "+v"(lane));
    float* scr = (float*)(lds + wave * 8704);

    int base = 0;
#pragma unroll 1
    for (int si = 0; si < 13; ++si) {
        const Seg s = SEGS[si]; const int nblk = s.ncols / 32, nitems = (s.K / 64) * nblk;
        int first = (gw - base) % NGW; if (first < 0) first += NGW;
        for (int it = first; it < nitems; it += NGW) { const int kb = it / nblk, nb = it % nblk;
            transpose_item(a.in[s.in], s.ld, s.c0 + 32 * nb, s.K, (bf16*)(a.ws + s.dst), seg_drow(s, 32 * nb), 64 * kb, scr, lane); }
        base = (base + nitems) % NGW;
    }
    const float* wsp = a.in[19]; bf16* WSP = (bf16*)(a.ws + WS_WSP);
    for (int i = gw * 64 + lane; i < 4 * 128 * 128; i += NGW * 64) { const int t = (i >> 7) & 127, s2 = i & 127; WSP[i] = (bf16)f2bf(s2 <= t ? wsp[i] : 0.f); }
}
template <bool LOGF> __device__ __forceinline__ void norm_phase(const Args& a, unsigned char* lds, const float* srcp, const float* srcs, const float* g, int ishift, int iscale,
                                                                 int gw, int NGW, int tid, int lane) {
    asm volatile("" : "+v"(tid), "+v"(lane));
    const float* MOD = (const float*)(a.ws + WS_MOD); bf16* XN = (bf16*)(a.ws + WS_XN);
    float* WFt = (float*)lds;
    if (LOGF) { const float* w_in = a.in[14]; for (int i = tid; i < 8192; i += NTHR) { const int k = i >> 3, j = i & 7; WFt[j * 1024 + k] = w_in[(size_t)k * INCOLS + 1536 + j]; } __syncthreads(); }
    int cur = -1; f32x4 gs[4], shv[4], vn[4], vnn[4];
    if (gw < M) { const float* xrow0 = gw < MP ? srcp + (size_t)gw * 1024 : srcs + (size_t)(gw - MP) * 1024;
#pragma unroll
        for (int j = 0; j < 4; ++j) vn[j] = ((const f32x4*)xrow0 + lane)[64 * j]; }
    if (gw + NGW < M) { const int m1 = gw + NGW; const float* xrow1 = m1 < MP ? srcp + (size_t)m1 * 1024 : srcs + (size_t)(m1 - MP) * 1024;
#pragma unroll
        for (int j = 0; j < 4; ++j) vnn[j] = ((const f32x4*)xrow1 + lane)[64 * j]; }
    for (int m = gw; m < M; m += NGW) {
        const int mr = m < MP ? (m >> 14) : 2 + ((m - MP) >> 5);
        if (mr != cur) { cur = mr; const f32x4* g4 = (const f32x4*)g + lane;
            const f32x4* sh4 = (const f32x4*)(MOD + (size_t)mr * 9216 + ishift * 1024) + lane; const f32x4* sc4 = (const f32x4*)(MOD + (size_t)mr * 9216 + iscale * 1024) + lane;
#pragma unroll
            for (int j = 0; j < 4; ++j) { gs[j] = g4[64 * j] * (sc4[64 * j] + 1.0f); shv[j] = sh4[64 * j]; } }
        f32x4 v[4]; float ss = 0.f;
#pragma unroll
        for (int j = 0; j < 4; ++j) { v[j] = vn[j]; vn[j] = vnn[j]; ss += (v[j].x * v[j].x + v[j].y * v[j].y) + (v[j].z * v[j].z + v[j].w * v[j].w); }
        { const int m2 = m + 2 * NGW; if (m2 < M) { const float* xrow2 = m2 < MP ? srcp + (size_t)m2 * 1024 : srcs + (size_t)(m2 - MP) * 1024;
#pragma unroll
            for (int j = 0; j < 4; ++j) vnn[j] = ((const f32x4*)xrow2 + lane)[64 * j]; } }
        const float rstd = 1.0f / sqrtf(wave_sum(ss) * (1.0f / 1024.0f) + EPS);
        unsigned long long* o8 = (unsigned long long*)(XN + (size_t)m * 1024) + lane;
#pragma unroll
        for (int j = 0; j < 4; ++j) { v[j] = (v[j] * rstd) * gs[j] + shv[j];
            o8[64 * j] = (unsigned long long)pk2(v[j].x, v[j].y) | ((unsigned long long)pk2(v[j].z, v[j].w) << 32); }
        if (LOGF) {
            float f[8];
#pragma unroll
            for (int jj = 0; jj < 8; ++jj) { float s = 0.f;
#pragma unroll
                for (int j = 0; j < 4; ++j) { const f32x4 w = *((const f32x4*)(WFt + jj * 1024) + 64 * j + lane); s += (v[j].x * w.x + v[j].y * w.y) + (v[j].z * w.z + v[j].w * w.w); }
                f[jj] = wave_sum(s); }
            float fj = f[0];
#pragma unroll
            for (int jj = 1; jj < 8; ++jj) fj = (lane == jj) ? f[jj] : fj;
            if (lane < 8) { const float x = fj + a.in[15][lane]; const float lf = (x >= 0.f) ? -log1pf(expf(-x)) : x - log1pf(expf(x));
                float* dst = m < MP ? a.out + O_FP + (size_t)m * 8 : a.out + O_FS + (size_t)(m - MP) * 8; dst[lane] = lf; }
        }
    }
}
__device__ __forceinline__ void scan_unit(const Args& a, unsigned char* lds, int unit, int tid) {
    asm volatile("" : "+v"(tid));
    double* tot = (double*)lds;
    if (unit < 16) {
        const int b = unit >> 3, h = unit & 7; const float* lf = a.out + O_FP + ((size_t)b * SEQ) * 8 + h; float* dst = (float*)(a.ws + WS_CUMP) + (size_t)unit * SEQ;
        float x[32]; double s = 0.0;
#pragma unroll
        for (int i = 0; i < 32; ++i) { x[i] = lf[(size_t)(tid * 32 + i) * 8]; s += (double)x[i]; }
        tot[tid] = s; __syncthreads();
        double pre = 0.0; for (int j = 0; j < tid; ++j) pre += tot[j];
#pragma unroll
        for (int i = 0; i < 32; ++i) { pre += (double)x[i]; dst[tid * 32 + i] = (float)(pre * 1.4426950408889634); }
    } else {
        const int bh = unit - 16, b = bh >> 3, h = bh & 7; const float* lfc = a.in[6] + ((size_t)b * PAST) * 8 + h; const float* lfn = a.out + O_FS + ((size_t)b * DSEQ) * 8 + h;
        float* dst = (float*)(a.ws + WS_CUMS) + (size_t)bh * SKEYS;
        float x[3] = {0.f, 0.f, 0.f}; double s = 0.0;
        if (tid < 352) {
#pragma unroll
            for (int i = 0; i < 3; ++i) { const int p = tid * 3 + i; x[i] = p < PAST ? lfc[(size_t)p * 8] : lfn[(size_t)(p - PAST) * 8]; s += (double)x[i]; } }
        tot[tid] = s; __syncthreads();
        if (tid < 352) { double pre = 0.0; for (int j = 0; j < tid; ++j) pre += tot[j];
#pragma unroll
            for (int i = 0; i < 3; ++i) { pre += (double)x[i]; dst[tid * 3 + i] = (float)(pre * 1.4426950408889634); } }
    }
    __syncthreads();
}
__device__ __forceinline__ void gmlp_unit(const Args& a, unsigned char* lds, int ci, int tid, int wave, int lane) {
    asm volatile("" : "+v"(tid), "+v"(lane));
    constexpr int VP = 136;
    bf16* VT = (bf16*)lds; float* rst = (float*)(lds + 128 * VP * 2);
    const bf16* G2 = (const bf16*)(a.ws + WS_G2); const bf16* U = (const bf16*)(a.ws + WS_U); bf16* BO = (bf16*)(a.ws + WS_BO); const bf16* WSP = (const bf16*)(a.ws + WS_WSP);
    const float* G2SS = (const float*)(a.ws + WS_G2SS); const float* gv = a.in[18]; const float* bsp = a.in[20];
    const size_t R0 = (size_t)ci * 128;
    if (tid < 128) { const f32x4* p = (const f32x4*)(G2SS + (R0 + tid) * 8); const f32x4 s0 = p[0], s1 = p[1]; rst[tid] = 1.0f / sqrtf((((s0.x + s0.y) + (s0.z + s0.w)) + ((s1.x + s1.y) + (s1.z + s1.w))) * (1.0f / 512.0f) + EPS); }
    __syncthreads();
    const int r32 = lane & 31, hi = lane >> 5, tb = wave >> 1, dh = wave & 1;
#pragma unroll 1
    for (int g = 0; g < 4; ++g) {
#pragma unroll
        for (int it = 0; it < 4; ++it) { const int q = tid + NTHR * it, s = q & 127, cch = q >> 7;
            const v4u raw = *(const v4u*)(G2 + (R0 + s) * 512 + g * 128 + 8 * cch); const float rs = rst[s];
            const f32x4 g0 = *(const f32x4*)(gv + g * 128 + 8 * cch), g1 = *(const f32x4*)(gv + g * 128 + 8 * cch + 4);
            bf16* col = VT + (8 * cch) * VP + s;
            col[0 * VP] = (bf16)f2bf(pg8::bf_lo(raw.x) * rs * g0.x); col[1 * VP] = (bf16)f2bf(pg8::bf_hi(raw.x) * rs * g0.y); col[2 * VP] = (bf16)f2bf(pg8::bf_lo(raw.y) * rs * g0.z); col[3 * VP] = (bf16)f2bf(pg8::bf_hi(raw.y) * rs * g0.w);
            col[4 * VP] = (bf16)f2bf(pg8::bf_lo(raw.z) * rs * g1.x); col[5 * VP] = (bf16)f2bf(pg8::bf_hi(raw.z) * rs * g1.y); col[6 * VP] = (bf16)f2bf(pg8::bf_lo(raw.w) * rs * g1.z); col[7 * VP] = (bf16)f2bf(pg8::bf_hi(raw.w) * rs * g1.w); }
        bf16x8 af[8];
#pragma unroll
        for (int ks = 0; ks < 8; ++ks) af[ks] = *(const bf16x8*)(WSP + ((size_t)(g * 128 + 32 * tb + r32)) * 128 + 16 * ks + 8 * hi);
        __syncthreads();
        f32x16 acc[2]; acc[0] = f32x16{}; acc[1] = f32x16{};
#pragma unroll
        for (int ks = 0; ks < 8; ++ks) if (ks <= 2 * tb + 1) {
#pragma unroll
            for (int db = 0; db < 2; ++db) { const bf16x8 bfv = *(const bf16x8*)(VT + (64 * dh + 32 * db + r32) * VP + 16 * ks + 8 * hi); acc[db] = __builtin_amdgcn_mfma_f32_32x32x16_bf16(af[ks], bfv, acc[db], 0, 0, 0); }
        }
#pragma unroll
        for (int db = 0; db < 2; ++db)
#pragma unroll
            for (int r = 0; r < 16; ++r) { const int t = 32 * tb + (r & 3) + 8 * (r >> 2) + 4 * hi, ch = g * 128 + 64 * dh + 32 * db + r32; const size_t off = (R0 + t) * 512 + ch;
                const float mixed = acc[db][r] + bsp[g * 128 + t]; BO[off] = (bf16)f2bf(bf2f(U[off]) * mixed); }
        __syncthreads();
    }
}
__device__ __forceinline__ void gmlp_sample_unit(const Args& a, unsigned char* lds, int b, int tid) {
    asm volatile("" : "+v"(tid));
    float* rst = (float*)lds;
    const bf16* G2 = (const bf16*)(a.ws + WS_G2); const bf16* U = (const bf16*)(a.ws + WS_U); bf16* BO = (bf16*)(a.ws + WS_BO);
    const float* G2SS = (const float*)(a.ws + WS_G2SS); const float* wsp = a.in[19]; const float* bsp = a.in[20];
    const size_t R0 = (size_t)MP + b * 32;
    if (tid < 32) { const float* p = G2SS + (R0 + tid) * 8; float s = 0.f; for (int i = 0; i < 8; ++i) s += p[i]; rst[tid] = 1.0f / sqrtf(s * (1.0f / 512.0f) + EPS); }
    __syncthreads();
    const int ch = tid, g = ch >> 7; const float gvv = a.in[18][ch];
    float vb[32];
#pragma unroll
    for (int s = 0; s < 32; ++s) { vb[s] = bf2f(G2[(R0 + s) * 512 + ch]) * rst[s] * gvv; a.out[O_GS + ((size_t)b * 32 + s) * 512 + ch] = vb[s]; }
#pragma unroll
    for (int t = 0; t < 32; ++t) { float mixed = bsp[g * 128 + t]; const float* wrow = wsp + ((size_t)g * 128 + t) * 128;
#pragma unroll
        for (int s = 0; s < 32; ++s) if (s <= t) mixed += wrow[s] * vb[s];
        const size_t off = (R0 + t) * 512 + ch; BO[off] = (bf16)f2bf(bf2f(U[off]) * mixed); }
    __syncthreads();
}
__device__ __forceinline__ void sattn_unit(const Args& a, unsigned char* lds, int unit, int tid, int wave, int lane) {
    asm volatile("" : "+v"(tid), "+v"(lane));
    const int qg = unit & 3, h = (unit >> 2) & 7, b = unit >> 5;
    float* qs = (float*)lds;
    float* S = qs + 512;
    float* red = S + 8 * SKEYS;
    float* inv = red + 4096;
    const float* QS = (const float*)(a.ws + WS_QS); const float* cum = (const float*)(a.ws + WS_CUMS) + (size_t)(b * 8 + h) * SKEYS;
    const float* kc = a.in[4] + ((size_t)b * PAST) * 512 + h * 64; const float* vc = a.in[5] + ((size_t)b * PAST) * 512 + h * 64;
    const float* kn = a.out + O_KS + ((size_t)b * DSEQ) * 512 + h * 64; const float* vn = a.out + O_VS + ((size_t)b * DSEQ) * 512 + h * 64;
    { const int qi = tid >> 6, d = tid & 63; qs[tid] = QS[((size_t)b * 32 + 8 * qg + qi) * 512 + h * 64 + d]; }
    __syncthreads();
    for (int key = wave * 132 + lane; key < wave * 132 + 132; key += 64) {
        const f32x4* kr = (const f32x4*)(key < PAST ? kc + (size_t)key * 512 : kn + (size_t)(key - PAST) * 512);
        f32x4 kv[16];
#pragma unroll
        for (int i = 0; i < 16; ++i) kv[i] = kr[i];
        const float ck = cum[key];
#pragma unroll
        for (int qi = 0; qi < 8; ++qi) { float s = 0.f;
#pragma unroll
            for (int i = 0; i < 16; ++i) { const f32x4 q4 = *(const f32x4*)(qs + qi * 64 + 4 * i); s += (q4.x * kv[i].x + q4.y * kv[i].y) + (q4.z * kv[i].z + q4.w * kv[i].w); }
            const int qpos = PAST + 8 * qg + qi;
            S[qi * SKEYS + key] = (key <= qpos) ? s + (cum[qpos] - ck) : -INFINITY; }
    }
    __syncthreads();
    { float mx = -INFINITY; for (int k = lane; k < SKEYS; k += 64) mx = fmaxf(mx, S[wave * SKEYS + k]);
#pragma unroll
      for (int o = 1; o < 64; o <<= 1) mx = fmaxf(mx, __shfl_xor(mx, o));
      float sum = 0.f; for (int k = lane; k < SKEYS; k += 64) { const float p = exp2f(S[wave * SKEYS + k] - mx); S[wave * SKEYS + k] = p; sum += p; }
      sum = wave_sum(sum); if (lane == 0) inv[wave] = 1.0f / sum; }
    __syncthreads();
    { float acc[8];
#pragma unroll
      for (int qi = 0; qi < 8; ++qi) acc[qi] = 0.f;
#pragma unroll 1
      for (int key0 = wave * 132; key0 < wave * 132 + 132; key0 += 12) {
          float vv[12];
#pragma unroll
          for (int j = 0; j < 12; ++j) { const int key = key0 + j; vv[j] = (key < PAST ? vc + (size_t)key * 512 : vn + (size_t)(key - PAST) * 512)[lane]; }
#pragma unroll
          for (int j = 0; j < 12; ++j)
#pragma unroll
              for (int qi = 0; qi < 8; ++qi) acc[qi] += S[qi * SKEYS + key0 + j] * vv[j]; }
#pragma unroll
      for (int qi = 0; qi < 8; ++qi) red[(wave * 8 + qi) * 64 + lane] = acc[qi]; }
    __syncthreads();
    { const int qi = tid >> 6, d = tid & 63; float s = 0.f;
#pragma unroll
      for (int w = 0; w < 8; ++w) s += red[(w * 8 + qi) * 64 + d];
      bf16* AO = (bf16*)(a.ws + WS_AO); AO[((size_t)MP + b * 32 + 8 * qg + qi) * 512 + h * 64 + d] = (bf16)f2bf(s * inv[qi]); }
    __syncthreads();
}

#define XB_TMO      128
#define XB_XCNT(j)  (256  + 64 * (j))
#define XB_XSUB(j)  (1280 + 64 * (j))
#define XB_XGEN(j)  (2304 + 64 * (j))
#define XB_TOP      3328
#define XB_TOPGEN   3392
#define XCD_BAR_WORDS 3456
#define XB_SPIN_CAP (1u << 18)

__device__ __forceinline__ unsigned xb_ld(unsigned* p)              { return __hip_atomic_load(p, __ATOMIC_RELAXED, __HIP_MEMORY_SCOPE_AGENT); }
__device__ __forceinline__ unsigned xb_add(unsigned* p, unsigned v) { return __hip_atomic_fetch_add(p, v, __ATOMIC_RELAXED, __HIP_MEMORY_SCOPE_AGENT); }
__device__ __forceinline__ unsigned xb_xcc_id() { return (unsigned)__builtin_amdgcn_s_getreg((3 << 11) | 20) & 0xFu; }
#define XB_SPIN(cond, bar) do { unsigned _sp = 0; while (cond) { __builtin_amdgcn_s_sleep(1); \
    if ((++_sp & 255u) == 0u) { if (xb_ld(&(bar)[XB_TMO])) break; if (_sp > XB_SPIN_CAP) { atomicAdd(&(bar)[XB_TMO], 1u); break; } } } } while (0)

struct XcdBarrier {
    unsigned* bar; unsigned x;
    volatile LAS unsigned* st;
};

__device__ __forceinline__ XcdBarrier xcd_barrier_post(unsigned* bar, volatile LAS unsigned* st, int wv) {
    XcdBarrier b; b.bar = bar; b.x = xb_xcc_id(); b.st = st;
    if (wv == 0 && lane_id_() == 0) (void)xb_add(&bar[XB_XCNT(b.x)], 1u);
    return b;
}
__device__ __forceinline__ void xcd_barrier_complete(unsigned* bar, unsigned x, unsigned& nloc, unsigned& nx) {
    const unsigned G = gridDim.x * gridDim.y * gridDim.z;
    unsigned sum, cnt, mine, sp = 0u;
    for (;;) {
        sum = 0u; cnt = 0u; mine = 0u;
#pragma unroll
        for (unsigned j = 0; j < 16; ++j) { const unsigned c = xb_ld(&bar[XB_XCNT(j)]); sum += c; cnt += (c > 0u) ? 1u : 0u; mine = (j == x) ? c : mine; }
        if (sum == G) break;
        __builtin_amdgcn_s_sleep(1);
        if ((++sp & 255u) == 0u) { if (xb_ld(&bar[XB_TMO])) break; if (sp > XB_SPIN_CAP) { atomicAdd(&bar[XB_TMO], 1u); break; } }
    }
    nloc = mine > 0u ? mine : 1u; nx = cnt > 0u ? cnt : 1u;
}

__device__ __forceinline__ void xcd_barrier(const XcdBarrier& b, int wv) {
    asm volatile("s_waitcnt vmcnt(0)" ::: "memory");
    __syncthreads();
    if (wv == 0 && lane_id_() == 0) {
        unsigned* bar = b.bar;
        __builtin_amdgcn_s_waitcnt(0);
        unsigned nloc = b.st[0], nx = b.st[1];
        if (nloc == 0u) { xcd_barrier_complete(bar, b.x, nloc, nx); b.st[0] = nloc; b.st[1] = nx; }
        const unsigned old = xb_add(&bar[XB_XSUB(b.x)], 1u);
        const unsigned gen = old / nloc;
        if (old + 1u == (gen + 1u) * nloc) {
            __builtin_amdgcn_fence(__ATOMIC_RELEASE, "agent");
            asm volatile("s_waitcnt vmcnt(0)" ::: "memory");
            const unsigned og = xb_add(&bar[XB_TOP], 1u);
            const unsigned tg = og / nx;
            if (og + 1u == (tg + 1u) * nx) xb_add(&bar[XB_TOPGEN], 1u);
            else XB_SPIN(xb_ld(&bar[XB_TOPGEN]) == tg, bar);
            __builtin_amdgcn_fence(__ATOMIC_ACQUIRE, "agent");
            xb_add(&bar[XB_XGEN(b.x)], 1u);
            asm volatile("s_waitcnt vmcnt(0)" ::: "memory");
        } else {
            XB_SPIN(xb_ld(&bar[XB_XGEN(b.x)]) == gen, bar);
            __builtin_amdgcn_fence(__ATOMIC_ACQUIRE, "agent");
            asm volatile("s_waitcnt vmcnt(0)" ::: "memory");
        }
    }
    __syncthreads();
}

#ifndef SKIPMASK
#define SKIPMASK 0u
#endif
#define PH(n) (((SKIPMASK) >> (n) & 1u) == 0u)
#define GSYNC() do { XcdBarrier b_; b_.bar = (unsigned*)(a.ws + WS_CTL); b_.x = xbar_x; b_.st = MISC + 8; xcd_barrier(b_, wave); } while (0)
__global__ void __launch_bounds__(NTHR, 2) fox_fwd(Args a) {
    extern __shared__ __attribute__((aligned(16))) unsigned char lds[];
    cg::grid_group grid = cg::this_grid();
    const int wave = __builtin_amdgcn_readfirstlane((int)threadIdx.x >> 6);
#define tid ((wave << 6) | lane_id_())
#define lane (lane_id_())
    const int G = gridDim.x, bx = blockIdx.x; const int vcu = (G % 8 == 0) ? (bx % 8) * (G / 8) + bx / 8 : bx;
    const int gw = vcu * NWAVES + wave, NGW = G * NWAVES;
    LAS unsigned char* ldsl = (LAS unsigned char*)lds;
    float* MOD = (float*)(a.ws + WS_MOD); bf16* XN = (bf16*)(a.ws + WS_XN); bf16* ACT = (bf16*)(a.ws + WS_ACT);
    volatile LAS unsigned* MISC = (volatile LAS unsigned*)((LAS unsigned char*)lds + MISC_OFF);
    for (int i = tid; i < LDS_BYTES / 16; i += NTHR) ((v4u*)lds)[i] = (v4u){0u, 0u, 0u, 0u};
    __syncthreads();
    __builtin_amdgcn_fence(__ATOMIC_SEQ_CST, ""); asm volatile("s_waitcnt vmcnt(0) lgkmcnt(0)" ::: "memory");
    const unsigned xbar_x = xcd_barrier_post((unsigned*)(a.ws + WS_CTL), MISC + 8, wave).x;
    grid.sync();
    float* Y = a.out + O_Y;

#ifndef NPASS
#define NPASS 1
#endif
#pragma unroll 1
    for (int pass = 0; pass < NPASS; ++pass) {
    if (pass) GSYNC();
    if (PH(0)) { for (int cb = bx; cb < 256; cb += G) ada_unit(a, lds, cb, tid);
    p0_weights(a, lds, gw, NGW, wave, lane); }
    GSYNC();
    if (PH(1)) norm_phase<false>(a, lds, a.in[0], a.in[1], a.in[9], 0, 1, gw, NGW, tid, lane);
    GSYNC();
    if (PH(2)) { pg8::Gemm g{XN, (const bf16*)(a.ws + WS_WGU1), M, 2 * FF, 1024, 1024}; pg8::StaticOrder S; S.init(M, 2 * FF, G, bx); pg8::EpiUp E{ACT, FF};
      GEMM_PHASE(pg8::EpiUp); }
    GSYNC();
    if (PH(3)) { pg8::EpiRes E{a.in[0], a.in[1], Y, MOD + 2 * 1024, 0.5f};
      { int ksub_ = 256; asm volatile("" : "+s"(ksub_)); pg8::Gemm g2{ACT + (size_t)MP * FF, (const bf16*)(a.ws + WS_WD1), 256, 1024, ksub_, FF}; pg8::SplitOrder S2; S2.init(G, bx); pg8::EpiPartial E2{(float*)(a.ws + WS_PART), 4, 256}; GEMM_PHASE_SPLIT(); }
      { pg8::Gemm g{ACT, (const bf16*)(a.ws + WS_WD1), MP, 1024, FF, FF}; pg8::StaticOrder S; S.init(MP, 1024, G, bx); GEMM_PHASE(pg8::EpiRes); }
      GSYNC();
      if (bx < 32) pg8::reduce_rowgroup<11>((const float*)(a.ws + WS_PART), bx & 3, bx >> 2, E, wave); }
    GSYNC();
    if (PH(4)) norm_phase<true>(a, lds, Y, Y + (size_t)MP * 1024, a.in[13], 3, 4, gw, NGW, tid, lane);
    GSYNC();
    if (PH(5)) { if (G >= 160) { const int u = G - 1 - bx; if (u < 80) scan_unit(a, lds, u, tid); }
                 else for (int u = bx; u < 80; u += G) scan_unit(a, lds, u, tid); }
    if (PH(6)) { pg8::Gemm g{XN, (const bf16*)(a.ws + WS_WIN), M, 2560, 1024, 1024}; pg8::StaticOrder S; S.init(M, 2560, G, bx);
      pg8::EpiIn E{(bf16*)(a.ws + WS_Q), (bf16*)(a.ws + WS_K), (bf16*)(a.ws + WS_V), (bf16*)(a.ws + WS_U), (bf16*)(a.ws + WS_G2), nullptr, nullptr,
                   (float*)(a.ws + WS_G2SS), (float*)(a.ws + WS_QS), a.out + O_KP, a.out + O_KS, a.out + O_VP, a.out + O_VS, a.in[16], a.in[17], attn_body::C2, EPS};
      GEMM_PHASE(pg8::EpiIn); }
    GSYNC();
    if (PH(7)) { const attn_body::bf16* Qb = (const attn_body::bf16*)(a.ws + WS_Q); const attn_body::bf16* Kb = (const attn_body::bf16*)(a.ws + WS_K); const attn_body::bf16* Vb = (const attn_body::bf16*)(a.ws + WS_V);
      attn_body::bf16* Ob = (attn_body::bf16*)(a.ws + WS_AO); const float* CUMP = (const float*)(a.ws + WS_CUMP);
      const int nun = (G == 256) ? 4 : (1024 - bx + G - 1) / G;
      float B2;
      { float mq = fabsf(a.in[16][lane]), mk = fabsf(a.in[17][lane]);
#pragma unroll
        for (int o = 1; o < 64; o <<= 1) { mq = fmaxf(mq, __shfl_xor(mq, o)); mk = fmaxf(mk, __shfl_xor(mk, o)); }
        B2 = 64.0f * mq * mk * attn_body::C2 * 1.01f + 0.5f; }
#pragma unroll 1
      for (int i = 0; i < nun; ++i) { int bh, qb;
          if (G == 256) { const int s = vcu & 15; bh = vcu >> 4; qb = (i == 0) ? s : (i == 1) ? 31 - s : (i == 2) ? 32 + s : 63 - s; } else { const int idx = bx + i * G; bh = idx >> 6; qb = idx & 63; }
          int ts = 0;
          { const float* cl = CUMP + (size_t)bh * SEQ; const float cref = cl[qb * 256]; const int ncand = 4 * qb;
            float cv[4];
#pragma unroll
            for (int k = 0; k < 4; ++k) { const int j = 64 * k + lane; cv[k] = (j < ncand) ? cl[64 * j + 63] : 0.f; }
#pragma unroll
            for (int k = 0; k < 4; ++k) { const int j = 64 * k + lane; const bool sk = (j < ncand) && (cref - cv[k] + 2.0f * B2 < -152.0f); ts += (int)__popcll(__ballot(sk)); }
            ts = __builtin_amdgcn_readfirstlane(ts) & ~1; }
          attn_body::attn_unit<8>(bh >> 3, bh & 7, qb, ts, CUMP + (size_t)bh * SEQ, Qb, Kb, Vb, Ob, (char*)lds, wave);
          }
      __syncthreads(); }
    if (PH(8)) for (int ci = bx; ci < 256; ci += G) gmlp_unit(a, lds, ci, tid, wave, lane);
    if (PH(9)) for (int u = bx; u < 256; u += G) sattn_unit(a, lds, u, tid, wave, lane);
    if (PH(10)) { if (G == 256) { if ((vcu & 15) == 0 && (vcu >> 4) < 8) gmlp_sample_unit(a, lds, vcu >> 4, tid); } else for (int b = bx; b < 8; b += G) gmlp_sample_unit(a, lds, b, tid); }
    GSYNC();
    if (PH(11)) { bf16* T = (bf16*)(a.ws + WS_T1); bf16* T2 = (bf16*)(a.ws + WS_T2); const bf16* WIN = (const bf16*)(a.ws + WS_WIN);
      bf16* TS = T + (size_t)MP * 1024; bf16* T2S = T2 + (size_t)MP * 1024; const bf16* XS = XN + (size_t)MP * 1024;
      float* PARTA = (float*)(a.ws + 2 * MiB); float* PARTB = (float*)(a.ws + 4 * MiB);
      { pg8::Gemm g{(const bf16*)(a.ws + WS_AO) + (size_t)MP * 512, (const bf16*)(a.ws + WS_WPA), 256, 1024, 512, 512}; pg8::StaticOrder S; S.init(256, 1024, G, bx); pg8::EpiMix<0> E{TS, nullptr}; GEMM_PHASE(pg8::EpiMix<0>); }
      { pg8::Gemm g{(const bf16*)(a.ws + WS_AO), (const bf16*)(a.ws + WS_WPA), MP, 1024, 512, 512}; pg8::StaticOrder S; S.init(MP, 1024, G, bx); pg8::EpiMix<0> E{T, nullptr}; GEMM_PHASE(pg8::EpiMix<0>); }
      { int ksub_ = 512; asm volatile("" : "+s"(ksub_)); pg8::Gemm g2{XS, WIN + (size_t)2560 * 1024, 256, 1024, ksub_, 1024}; pg8::SplitOrderT<4, 2, 512> S2; S2.init(G, (bx + G - 8) % G); pg8::EpiPartialT<4, 9> E2{PARTA}; GEMM_PHASE_SPLIT_T(4, 2, 512, 9); }
      { pg8::Gemm g{XN, WIN + (size_t)2560 * 1024, MP, 1024, 1024, 1024}; pg8::StaticOrder S; S.init(MP, 1024, G, bx); pg8::EpiMix<1> E{T, nullptr}; GEMM_PHASE(pg8::EpiMix<1>); }
      { pg8::Gemm g{(const bf16*)(a.ws + WS_BO) + (size_t)MP * 512, (const bf16*)(a.ws + WS_WPB), 256, 1024, 512, 512}; pg8::StaticOrder S; S.init(256, 1024, G, (bx + G - 16) % G); pg8::EpiMix<0> E{T2S, nullptr}; GEMM_PHASE(pg8::EpiMix<0>); }
      { pg8::Gemm g{(const bf16*)(a.ws + WS_BO), (const bf16*)(a.ws + WS_WPB), MP, 1024, 512, 512}; pg8::StaticOrder S; S.init(MP, 1024, G, bx); pg8::EpiMix<0> E{T2, nullptr}; GEMM_PHASE(pg8::EpiMix<0>); }
      { int ksub_ = 512; asm volatile("" : "+s"(ksub_)); pg8::Gemm g2{XS, WIN + (size_t)3584 * 1024, 256, 1024, ksub_, 1024}; pg8::SplitOrderT<4, 2, 512> S2; S2.init(G, (bx + G - 24) % G); pg8::EpiPartialT<4, 9> E2{PARTB}; GEMM_PHASE_SPLIT_T(4, 2, 512, 9); }
      { pg8::Gemm g{XN, WIN + (size_t)3584 * 1024, MP, 1024, 1024, 1024}; pg8::StaticOrder S; S.init(MP, 1024, G, bx); pg8::EpiMix<2> E{T, T2}; GEMM_PHASE(pg8::EpiMix<2>); }
      GSYNC();
      if (bx < 32) { pg8::EpiMix<1> E1{TS, nullptr}; pg8::reduce_rowgroup<2>(PARTA, bx & 3, bx >> 2, E1, wave);
                     pg8::EpiMix<2> E2{TS, T2S}; pg8::reduce_rowgroup<2>(PARTB, bx & 3, bx >> 2, E2, wave); } }
    GSYNC();
    if (PH(13)) { pg8::EpiRes E{Y, Y + (size_t)MP * 1024, Y, MOD + 5 * 1024, 1.0f}; const bf16* M1 = (const bf16*)(a.ws + WS_T1);
      { int ksub_ = 256; asm volatile("" : "+s"(ksub_)); pg8::Gemm g2{M1 + (size_t)MP * 1024, (const bf16*)(a.ws + WS_WOUT), 256, 1024, ksub_, 1024}; pg8::SplitOrderT<4, 4, 256> S2; S2.init(G, bx); pg8::EpiPartialT<4, 8> E2{(float*)(a.ws + WS_PART)}; GEMM_PHASE_SPLIT_T(4, 4, 256, 8); }
      { pg8::Gemm g{M1, (const bf16*)(a.ws + WS_WOUT), MP, 1024, 1024, 1024}; pg8::StaticOrder S; S.init(MP, 1024, G, bx); GEMM_PHASE(pg8::EpiRes); }
      GSYNC();
      if (bx < 32) pg8::reduce_rowgroup<4>((const float*)(a.ws + WS_PART), bx & 3, bx >> 2, E, wave); }
    GSYNC();
    if (PH(14)) norm_phase<false>(a, lds, Y, Y + (size_t)MP * 1024, a.in[24], 6, 7, gw, NGW, tid, lane);
    GSYNC();
    if (PH(15)) { pg8::Gemm g{XN, (const bf16*)(a.ws + WS_WGU2), M, 2 * FF, 1024, 1024}; pg8::StaticOrder S; S.init(M, 2 * FF, G, bx); pg8::EpiUp E{ACT, FF};
      GEMM_PHASE(pg8::EpiUp); }
    GSYNC();
    if (PH(16)) { pg8::EpiRes E{Y, Y + (size_t)MP * 1024, Y, MOD + 8 * 1024, 0.5f};
      { int ksub_ = 256; asm volatile("" : "+s"(ksub_)); pg8::Gemm g2{ACT + (size_t)MP * FF, (const bf16*)(a.ws + WS_WD2), 256, 1024, ksub_, FF}; pg8::SplitOrder S2; S2.init(G, bx); pg8::EpiPartial E2{(float*)(a.ws + WS_PART), 4, 256}; GEMM_PHASE_SPLIT(); }
      { pg8::Gemm g{ACT, (const bf16*)(a.ws + WS_WD2), MP, 1024, FF, FF}; pg8::StaticOrder S; S.init(MP, 1024, G, bx); GEMM_PHASE(pg8::EpiRes); }
      GSYNC();
      if (bx < 32) pg8::reduce_rowgroup<11>((const float*)(a.ws + WS_PART), bx & 3, bx >> 2, E, wave); }
    }
}


#undef tid
#undef lane
extern "C" void kernel_launch(void* const* d_in, const int* in_sizes, int n_in, void* d_out, int out_size, void* d_ws, size_t ws_size, hipStream_t stream) {
    static int grid = 0;
    if (grid == 0) {
        if (n_in != 28 || (size_t)out_size != O_END || ws_size < WS_END || in_sizes[0] != MP * 1024) { fprintf(stderr, "kernel_launch: unexpected shapes (n_in %d out %d ws %zu)\n", n_in, out_size, ws_size); grid = -1; return; }
        int dev = 0, cus = 0, per_cu = 0;
        hipGetDevice(&dev); hipDeviceGetAttribute(&cus, hipDeviceAttributeMultiprocessorCount, dev);
        if (hipFuncSetAttribute((const void*)fox_fwd, hipFuncAttributeMaxDynamicSharedMemorySize, LDS_BYTES) != hipSuccess) { fprintf(stderr, "kernel_launch: hipFuncSetAttribute failed\n"); grid = -1; return; }
        if (hipOccupancyMaxActiveBlocksPerMultiprocessor(&per_cu, (const void*)fox_fwd, NTHR, LDS_BYTES) != hipSuccess || per_cu < 1) { fprintf(stderr, "kernel_launch: occupancy query says %d\n", per_cu); per_cu = 1; }
        (void)hipGetLastError();
        grid = cus * 1;
    }
    if (grid < 0) return;
    if (hipMemsetAsync((char*)d_ws + WS_CTL, 0, CTL_ZERO_BYTES, stream) != hipSuccess) { fprintf(stderr, "kernel_launch: hipMemsetAsync failed\n"); return; }
    Args a{};
    for (int i = 0; i < 28; ++i) a.in[i] = (const float*)d_in[i];
    a.out = (float*)d_out; a.ws = (unsigned char*)d_ws;
    void* args[] = {&a};
    hipError_t e = hipLaunchCooperativeKernel((const void*)fox_fwd, dim3(grid), dim3(NTHR), args, LDS_BYTES, stream);
    if (e != hipSuccess) fprintf(stderr, "cooperative launch failed: %s (grid %d)\n", hipGetErrorString(e), grid);
}
```

```cpp
#include <hip/hip_runtime.h>
#include <hip/hip_cooperative_groups.h>
#include <cstdio>
#include <cstdint>
__device__ __forceinline__ int lane_id_() { return (int)__builtin_amdgcn_mbcnt_hi(~0u, __builtin_amdgcn_mbcnt_lo(~0u, 0u)); }
namespace pg8 {
#define PG8_LAS __attribute__((address_space(3)))
typedef unsigned short bf16_t;
typedef short bf16x8 __attribute__((ext_vector_type(8)));
typedef float f32x4 __attribute__((ext_vector_type(4)));
typedef unsigned u32x4 __attribute__((ext_vector_type(4)));
constexpr int BM = 256, BK = 64, HALF = 128, HTB = HALF * BK * 2  , STAGE_BYTES = 8 * HTB, NXCD = 8, WGM = 8;

__host__ __device__ __forceinline__ int lds_byte(int r, int c) { const int st = (r >> 4) * 2 + (c >> 5), rr = r & 15, cc = c & 31, ob = rr * 64 + cc * 2; return st * 1024 + (ob ^ (((ob >> 9) & 1) << 5)); }
__host__ __device__ __forceinline__ void stage_rc(int b, int& R, int& C) { const int st = b / 1024, sb = b % 1024, swz = sb ^ (((sb >> 9) & 1) << 5); R = (st >> 1) * 16 + swz / 64; C = (st & 1) * 32 + (swz % 64) / 2; }
__host__ __device__ __forceinline__ int perm32(int rho) { const int n = rho >> 4, i = rho & 15; return 8 * (i >> 2) + 4 * n + (i & 3); }

struct Unit { int pm, pn, koff; };
struct Gemm { const bf16_t* A; const bf16_t* Bt; int M, N, K, Kp; };

struct StaticOrder {
    int nM, nN, nwg, G, c;
    __host__ __device__ void init(int M, int N, int G_, int c_) { nM = M / BM; nN = N / BM; nwg = nM * nN; G = G_; c = c_; }
    __host__ __device__ bool next(int i, Unit& u) const {
        const long L = (long)i * G + c; if (L >= nwg) return false;
        int wgid = (int)L; { const int q = nwg / NXCD, r = nwg % NXCD, xcd = wgid % NXCD, off = wgid / NXCD; wgid = (xcd < r ? xcd * (q + 1) : r * (q + 1) + (xcd - r) * q) + off; }
        const int nig = WGM * nN, gid = wgid / nig, fm = gid * WGM, gsz = (nM - fm) < WGM ? (nM - fm) : WGM;
        u.pm = fm + ((wgid % nig) % gsz); u.pn = (wgid % nig) / gsz; u.koff = 0; return true;
    }
    __device__ __forceinline__ void a_ready(const Unit&) const {}
    __device__ __forceinline__ void done(const Unit&) const {}
};

template <int NN, int NS, int KSUB> struct SplitOrderT {
    int G, c;
    __host__ __device__ void init(int G_, int c_) { G = G_; c = c_; }
    __host__ __device__ bool next(int i, Unit& u) const { const int L = i * G + c; if (L >= NN * NS) return false; u.pm = 0; u.pn = L % NN; u.koff = (L / NN) * KSUB; return true; }
    __device__ __forceinline__ void a_ready(const Unit&) const {}
    __device__ __forceinline__ void done(const Unit&) const {}
};
typedef SplitOrderT<4, 11, 256> SplitOrder;
__device__ __forceinline__ unsigned cvt_pk_bf16(float lo, float hi) { unsigned r; asm volatile("v_cvt_pk_bf16_f32 %0, %1, %2" : "=v"(r) : "v"(lo), "v"(hi)); return r; }
typedef float f32x2 __attribute__((ext_vector_type(2)));
__device__ __forceinline__ f32x2 gelu_pk(f32x2 v) {
    const f32x2 av = __builtin_elementwise_abs(v), d = av * 0.2316418882f + 1.0f;
    f32x2 t; t.x = __builtin_amdgcn_rcpf(d.x); t.y = __builtin_amdgcn_rcpf(d.y);
    f32x2 q = t * 0.5307027145f + (-0.7265760135f); q = q * t + 0.7107068705f; q = q * t + (-0.142248368f); q = q * t + 0.127414796f; q = q * t;
    const f32x2 s = (v * v) * (-0.72134752044f);
    f32x2 e; e.x = __builtin_amdgcn_exp2f(s.x); e.y = __builtin_amdgcn_exp2f(s.y);
    const f32x2 m = v * (q * e), r = v - m;
    f32x2 o; o.x = v.x < 0.f ? m.x : r.x; o.y = v.y < 0.f ? m.y : r.y; return o;
}

constexpr int MPROMPT = 32768;
constexpr int NMODC = 9216;
typedef unsigned u32x2v __attribute__((ext_vector_type(2)));
__device__ __forceinline__ float sigm(float x) { return __builtin_amdgcn_rcpf(1.0f + __builtin_amdgcn_exp2f(-1.4426950408889634f * x)); }
__device__ __forceinline__ float gelu_tanh(float x) { const float y = 1.5957691216057308f * (x + 0.044715f * x * x * x); return x * sigm(y); }
__device__ __forceinline__ float bf_lo(unsigned w) { return __uint_as_float(w << 16); }
__device__ __forceinline__ float bf_hi(unsigned w) { return __uint_as_float(w & 0xffff0000u); }
__device__ __forceinline__ int mod_row(int pm, int rloc) { return pm < 128 ? (pm >> 6) : 2 + (rloc >> 5); }

struct EpiUp {
    static constexpr bool PERM = true, AFTER_DRAIN = false;
    bf16_t* ACT; int ldc;
    __device__ __forceinline__ void operator()(const f32x4 (&acc)[2][2][4][2], const Unit& u, int wr, int wc, int fr, int fq) const {
        int fr_ = fr, fq_ = fq; asm volatile("" : "+v"(fr_), "+v"(fq_));
        const int row0 = u.pm * BM + wr * 64 + fr_, ch0 = u.pn * HALF + wc * 32 + 8 * fq_;
#pragma unroll
        for (int ai = 0; ai < 2; ++ai)
#pragma unroll
            for (int m = 0; m < 4; ++m) {
                float o[8];
#pragma unroll
                for (int n = 0; n < 2; ++n)
#pragma unroll
                    for (int i = 0; i < 4; ++i) { const float g = acc[ai][0][m][n][i], up = acc[ai][1][m][n][i]; o[4 * n + i] = g * sigm(g) * up; }
                u32x4 w; w.x = cvt_pk_bf16(o[0], o[1]); w.y = cvt_pk_bf16(o[2], o[3]); w.z = cvt_pk_bf16(o[4], o[5]); w.w = cvt_pk_bf16(o[6], o[7]);
                *(u32x4*)(ACT + (size_t)(row0 + ai * HALF + m * 16) * ldc + ch0) = w;
            }
    }
};
struct EpiRes {
    static constexpr bool PERM = true, AFTER_DRAIN = false;
    const float* resp; const float* ress; float* out; const float* gate; float fac;
    __device__ __forceinline__ void rowgroup(const f32x4 (&v)[2][2], int pn, int ai, int m, int wr, int wc, int fr, int fq) const {
        const int rl = wr * 64 + fr + ai * HALF + m * 16, col0 = pn * BM + wc * 32 + 8 * fq;
        const float* gp = gate + (size_t)(2 + (rl >> 5)) * NMODC + col0; float* obase = out + (size_t)128 * BM * 1024;
#pragma unroll
        for (int bj = 0; bj < 2; ++bj)
#pragma unroll
            for (int n = 0; n < 2; ++n) { const size_t off = (size_t)rl * 1024 + col0 + bj * HALF + 4 * n;
                const f32x4 gv = *(const f32x4*)(gp + bj * HALF + 4 * n), rv = *(const f32x4*)(ress + off);
                *(f32x4*)(obase + off) = rv + (gv * fac) * v[bj][n]; }
    }
    __device__ __forceinline__ void operator()(const f32x4 (&acc)[2][2][4][2], const Unit& u, int wr, int wc, int fr, int fq) const {
        int fr_ = fr, fq_ = fq; asm volatile("" : "+v"(fr_), "+v"(fq_));
        const int rl0 = wr * 64 + fr_, col0 = u.pn * BM + wc * 32 + 8 * fq_;
        const float* rbase = (u.pm < 128) ? resp + (size_t)u.pm * BM * 1024 : ress;
        float* obase = out + (size_t)u.pm * BM * 1024;
#pragma unroll
        for (int ai = 0; ai < 2; ++ai)
#pragma unroll
            for (int m = 0; m < 4; ++m) {
                const int rl = rl0 + ai * HALF + m * 16; const float* gp = gate + (size_t)mod_row(u.pm, rl) * NMODC + col0;
#pragma unroll
                for (int bj = 0; bj < 2; ++bj)
#pragma unroll
                    for (int n = 0; n < 2; ++n) {
                        const size_t off = (size_t)rl * 1024 + col0 + bj * HALF + 4 * n;
                        const f32x4 gv = *(const f32x4*)(gp + bj * HALF + 4 * n), rv = *(const f32x4*)(rbase + off);
                        *(f32x4*)(obase + off) = rv + (gv * fac) * acc[ai][bj][m][n];
                    }
            }
    }
};
struct EpiIn {
    static constexpr bool PERM = true, AFTER_DRAIN = false;
    bf16_t *Q, *K, *V, *U, *G2, *SGA, *SGB; float* G2SS; float* QS;
    float *kout_p, *kout_s, *vout_p, *vout_s;
    const float *gq, *gk; float qscale, eps;
    __device__ __forceinline__ void operator()(const f32x4 (&acc)[2][2][4][2], const Unit& u, int wr, int wc, int fr, int fq) const {
        int fr_ = fr, fq_ = fq; asm volatile("" : "+v"(fr_), "+v"(fq_));
        const int pn = u.pn, rl0 = wr * 64 + fr_; const size_t rg0 = (size_t)u.pm * BM;
        if (pn < 4) {
            const bool isq = pn < 2; const int head = 4 * (pn & 1) + wc; const float* gsrc = isq ? gq : gk;
            f32x4 gv[2][2];
#pragma unroll
            for (int bj = 0; bj < 2; ++bj)
#pragma unroll
                for (int n = 0; n < 2; ++n) { gv[bj][n] = *(const f32x4*)(gsrc + 32 * bj + 8 * fq_ + 4 * n); if (isq) gv[bj][n] = gv[bj][n] * qscale; }
            bf16_t* dst = isq ? Q : K;
#pragma unroll
            for (int ai = 0; ai < 2; ++ai)
#pragma unroll
                for (int m = 0; m < 4; ++m) {
                    float ss = 0.f;
#pragma unroll
                    for (int bj = 0; bj < 2; ++bj)
#pragma unroll
                        for (int n = 0; n < 2; ++n) { const f32x4 x = acc[ai][bj][m][n]; ss += (x[0] * x[0] + x[1] * x[1]) + (x[2] * x[2] + x[3] * x[3]); }
                    ss += __shfl_xor(ss, 16); ss += __shfl_xor(ss, 32);
                    const float rstd = 1.0f / sqrtf(ss * (1.0f / 64.0f) + eps);
                    const int rl = rl0 + ai * HALF + m * 16; const size_t r = rg0 + rl;
#pragma unroll
                    for (int bj = 0; bj < 2; ++bj) {
                        const f32x4 o0 = acc[ai][bj][m][0] * rstd * gv[bj][0], o1 = acc[ai][bj][m][1] * rstd * gv[bj][1];
                        const int c = head * 64 + 32 * bj + 8 * fq_;
                        u32x4 w; w.x = cvt_pk_bf16(o0[0], o0[1]); w.y = cvt_pk_bf16(o0[2], o0[3]); w.z = cvt_pk_bf16(o1[0], o1[1]); w.w = cvt_pk_bf16(o1[2], o1[3]);
                        *(u32x4*)(dst + r * 512 + c) = w;
                        if (isq) { if (u.pm == 128) { float* qp = QS + (size_t)rl * 512 + c; *(f32x4*)qp = o0; *(f32x4*)(qp + 4) = o1; } }
                        else { float* kp = (u.pm < 128) ? kout_p + r * 512 + c : kout_s + (size_t)rl * 512 + c; *(f32x4*)kp = o0; *(f32x4*)(kp + 4) = o1; }
                    }
                    asm volatile("" ::: "memory");
                }
        } else if (pn < 6) {
            const int c0 = (pn - 4) * BM + wc * 32 + 8 * fq_;
#pragma unroll
            for (int ai = 0; ai < 2; ++ai)
#pragma unroll
                for (int m = 0; m < 4; ++m) { const int rl = rl0 + ai * HALF + m * 16; const size_t r = rg0 + rl;
#pragma unroll
                    for (int bj = 0; bj < 2; ++bj) { const f32x4 o0 = acc[ai][bj][m][0], o1 = acc[ai][bj][m][1]; const int c = c0 + bj * HALF;
                        u32x4 w; w.x = cvt_pk_bf16(o0[0], o0[1]); w.y = cvt_pk_bf16(o0[2], o0[3]); w.z = cvt_pk_bf16(o1[0], o1[1]); w.w = cvt_pk_bf16(o1[2], o1[3]);
                        *(u32x4*)(V + r * 512 + c) = w;
                        float* vp = (u.pm < 128) ? vout_p + r * 512 + c : vout_s + (size_t)rl * 512 + c;
                        { *(f32x4*)vp = o0; *(f32x4*)(vp + 4) = o1; } } asm volatile("" ::: "memory"); }
        } else if (pn < 10) {
            const bool isv = pn >= 8; const int t2 = (pn - 6) & 1; const int c0 = t2 * BM + wc * 32 + 8 * fq_; bf16_t* dst = isv ? G2 : U;
#pragma unroll
            for (int ai = 0; ai < 2; ++ai)
#pragma unroll
                for (int m = 0; m < 4; ++m) { const int rl = rl0 + ai * HALF + m * 16; const size_t r = rg0 + rl; float ss = 0.f;
#pragma unroll
                    for (int bj = 0; bj < 2; ++bj) { float o[8];
#pragma unroll
                        for (int n = 0; n < 2; ++n)
#pragma unroll
                            for (int i = 0; i < 4; ++i) { const float g = gelu_tanh(acc[ai][bj][m][n][i]); o[4 * n + i] = g; ss += g * g; }
                        u32x4 w; w.x = cvt_pk_bf16(o[0], o[1]); w.y = cvt_pk_bf16(o[2], o[3]); w.z = cvt_pk_bf16(o[4], o[5]); w.w = cvt_pk_bf16(o[6], o[7]);
                        *(u32x4*)(dst + r * 512 + c0 + bj * HALF) = w; }
                    if (isv) { ss += __shfl_xor(ss, 16); ss += __shfl_xor(ss, 32); if (fq_ == 0) G2SS[r * 8 + t2 * 4 + wc] = ss; } asm volatile("" ::: "memory"); }
        } else {
            const bool isa = pn < 14; const int c0 = ((pn - 10) & 3) * BM + wc * 32 + 8 * fq_; bf16_t* dst = isa ? SGA : SGB;
#pragma unroll
            for (int ai = 0; ai < 2; ++ai)
#pragma unroll
                for (int m = 0; m < 4; ++m) { const size_t r = rg0 + rl0 + ai * HALF + m * 16;
#pragma unroll
                    for (int bj = 0; bj < 2; ++bj) { float o[8];
#pragma unroll
                        for (int n = 0; n < 2; ++n)
#pragma unroll
                            for (int i = 0; i < 4; ++i) o[4 * n + i] = sigm(acc[ai][bj][m][n][i]);
                        u32x4 w; w.x = cvt_pk_bf16(o[0], o[1]); w.y = cvt_pk_bf16(o[2], o[3]); w.z = cvt_pk_bf16(o[4], o[5]); w.w = cvt_pk_bf16(o[6], o[7]);
                        *(u32x4*)(dst + r * 1024 + c0 + bj * HALF) = w;
                        } asm volatile("" ::: "memory"); }
        }
    }
};
struct EpiPartial {
    static constexpr bool PERM = true, AFTER_DRAIN = false;
    float* PART; int nN, Ksub;
    __device__ __forceinline__ void operator()(const f32x4 (&acc)[2][2][4][2], const Unit& u, int wr, int wc, int fr, int fq) const {
        int tid_ = (wr * 4 + wc) * 64 + fq * 16 + fr; asm volatile("" : "+v"(tid_));
        f32x4* dst = (f32x4*)PART + (size_t)((u.koff >> 8) * 4 + u.pn) * 32 * 512 + tid_;
#pragma unroll
        for (int ai = 0; ai < 2; ++ai)
#pragma unroll
            for (int bj = 0; bj < 2; ++bj)
#pragma unroll
                for (int m = 0; m < 4; ++m)
#pragma unroll
                    for (int n = 0; n < 2; ++n) { *dst = acc[ai][bj][m][n]; dst += 512; asm volatile("" : "+v"(dst) :: "memory"); }
        asm volatile("" ::: "memory");
    }
};
template <int NN, int KSHIFT> struct EpiPartialT {
    static constexpr bool PERM = true, AFTER_DRAIN = false;
    float* PART;
    __device__ __forceinline__ void operator()(const f32x4 (&acc)[2][2][4][2], const Unit& u, int wr, int wc, int fr, int fq) const {
        int tid_ = (wr * 4 + wc) * 64 + fq * 16 + fr; asm volatile("" : "+v"(tid_));
        f32x4* dst = (f32x4*)PART + (size_t)((u.koff >> KSHIFT) * NN + u.pn) * 32 * 512 + tid_;
#pragma unroll
        for (int ai = 0; ai < 2; ++ai)
#pragma unroll
            for (int bj = 0; bj < 2; ++bj)
#pragma unroll
                for (int m = 0; m < 4; ++m)
#pragma unroll
                    for (int n = 0; n < 2; ++n) { *dst = acc[ai][bj][m][n]; dst += 512; asm volatile("" : "+v"(dst) :: "memory"); }
    }
};
template <class Epi> __device__ __forceinline__ void reduce_partials(const float* PART, int nN, int nS, int pn, int pm_out, const Epi& E, int wv) {
    int tid = (wv << 6) | lane_id_(); asm volatile("" : "+v"(tid));
    const int wid = __builtin_amdgcn_readfirstlane(tid >> 6), lane = tid & 63, wr = wid >> 2, wc = wid & 3, fr = lane & 15, fq = lane >> 4;
    f32x4 acc[2][2][4][2];
#pragma unroll
    for (int ai = 0; ai < 2; ++ai)
#pragma unroll
        for (int bj = 0; bj < 2; ++bj)
#pragma unroll
            for (int m = 0; m < 4; ++m)
#pragma unroll
                for (int n = 0; n < 2; ++n) acc[ai][bj][m][n] = (f32x4){0.f, 0.f, 0.f, 0.f};
#pragma unroll 1
    for (int s = 0; s < nS; ++s) { const f32x4* src = (const f32x4*)PART + (size_t)(s * nN + pn) * 32 * 512 + tid;
#pragma unroll
        for (int ai = 0; ai < 2; ++ai) {
            f32x4 t[2][4][2];
#pragma unroll
            for (int bj = 0; bj < 2; ++bj)
#pragma unroll
                for (int m = 0; m < 4; ++m)
#pragma unroll
                    for (int n = 0; n < 2; ++n) { t[bj][m][n] = *src; src += 512; asm volatile("" : "+v"(src)); }
#pragma unroll
            for (int bj = 0; bj < 2; ++bj)
#pragma unroll
                for (int m = 0; m < 4; ++m)
#pragma unroll
                    for (int n = 0; n < 2; ++n) acc[ai][bj][m][n] += t[bj][m][n];
            asm volatile("" ::: "memory"); } }
    Unit u; u.pm = pm_out; u.pn = pn; u.koff = 0;
    E(acc, u, wr, wc, fr, fq);
}
template <int NS, class Epi> __device__ __forceinline__ void reduce_rowgroup(const float* PART, int pn, int rg, const Epi& E, int wv) {
    int tid = (wv << 6) | lane_id_(); asm volatile("" : "+v"(tid));
    const int wid = __builtin_amdgcn_readfirstlane(tid >> 6), lane = tid & 63, wr = wid >> 2, wc = wid & 3, fr = lane & 15, fq = lane >> 4;
    const int ai = rg >> 2, m = rg & 3;
    f32x4 t[NS][2][2];
#pragma unroll
    for (int s = 0; s < NS; ++s)
#pragma unroll
        for (int bj = 0; bj < 2; ++bj)
#pragma unroll
            for (int n = 0; n < 2; ++n) t[s][bj][n] = *((const f32x4*)PART + ((size_t)(s * 4 + pn) * 32 + (((ai * 2 + bj) * 4 + m) * 2 + n)) * 512 + tid);
    f32x4 v[2][2];
#pragma unroll
    for (int bj = 0; bj < 2; ++bj)
#pragma unroll
        for (int n = 0; n < 2; ++n) { v[bj][n] = t[0][bj][n];
#pragma unroll
            for (int s = 1; s < NS; ++s) v[bj][n] += t[s][bj][n]; }
    E.rowgroup(v, pn, ai, m, wr, wc, fr, fq);
}
template <int MODE> struct EpiMix {
    static constexpr bool PERM = true, AFTER_DRAIN = false;
    bf16_t* T; const bf16_t* T2;
    __device__ __forceinline__ void one(size_t off, const f32x4 a0, const f32x4 a1) const {
        float o[8] = {a0[0], a0[1], a0[2], a0[3], a1[0], a1[1], a1[2], a1[3]};
        if (MODE >= 1) {
            const u32x4 t = *(const u32x4*)(T + off);
            const float tv[8] = {bf_lo(t.x), bf_hi(t.x), bf_lo(t.y), bf_hi(t.y), bf_lo(t.z), bf_hi(t.z), bf_lo(t.w), bf_hi(t.w)};
            if (MODE == 1) {
#pragma unroll
                for (int i = 0; i < 8; ++i) o[i] = sigm(o[i]) * tv[i];
            } else {
                const u32x4 s2 = *(const u32x4*)(T2 + off);
                const float sv[8] = {bf_lo(s2.x), bf_hi(s2.x), bf_lo(s2.y), bf_hi(s2.y), bf_lo(s2.z), bf_hi(s2.z), bf_lo(s2.w), bf_hi(s2.w)};
#pragma unroll
                for (int i = 0; i < 8; ++i) o[i] = tv[i] + sigm(o[i]) * sv[i];
            }
        }
        u32x4 w; w.x = cvt_pk_bf16(o[0], o[1]); w.y = cvt_pk_bf16(o[2], o[3]); w.z = cvt_pk_bf16(o[4], o[5]); w.w = cvt_pk_bf16(o[6], o[7]);
        *(u32x4*)(T + off) = w;
    }
    __device__ __forceinline__ void operator()(const f32x4 (&acc)[2][2][4][2], const Unit& u, int wr, int wc, int fr, int fq) const {
        int fr_ = fr, fq_ = fq; asm volatile("" : "+v"(fr_), "+v"(fq_));
        const size_t row0 = (size_t)u.pm * BM + wr * 64 + fr_; const int col0 = u.pn * BM + wc * 32 + 8 * fq_;
#pragma unroll
        for (int ai = 0; ai < 2; ++ai)
#pragma unroll
            for (int m = 0; m < 4; ++m) {
#pragma unroll
                for (int bj = 0; bj < 2; ++bj) one((row0 + ai * HALF + m * 16) * 1024 + col0 + bj * HALF, acc[ai][bj][m][0], acc[ai][bj][m][1]);
                asm volatile("" ::: "memory");
            }
    }
    __device__ __forceinline__ void rowgroup(const f32x4 (&v)[2][2], int pn, int ai, int m, int wr, int wc, int fr, int fq) const {
        const size_t row = (size_t)(wr * 64 + fr + ai * HALF + m * 16); const int col0 = pn * BM + wc * 32 + 8 * fq;
#pragma unroll
        for (int bj = 0; bj < 2; ++bj) one(row * 1024 + col0 + bj * HALF, v[bj][0], v[bj][1]);
    }
};
template <class Epi, class Sched, bool ALIGN_EPI = false, bool SP2 = false>
__device__ __forceinline__ void gemm_phase(PG8_LAS unsigned char* lds, const Gemm g, const Sched& S, const Epi& E, int wv) {
    int tid = (wv << 6) | lane_id_(); asm volatile("" : "+v"(tid));
    const int wid = __builtin_amdgcn_readfirstlane(tid >> 6), lane = tid & 63, wr = wid >> 2, wc = wid & 3, fr = lane & 15, fq = lane >> 4;
    const int K = g.Kp, nt = g.K / BK;
    unsigned voffA[2], voffB[2];
#pragma unroll
    for (int i = 0; i < 2; ++i) { int R, C; stage_rc(tid * 16 + i * 8192, R, C); const int Rb = Epi::PERM ? ((R & ~31) + perm32(R & 31)) : R;
        voffA[i] = (unsigned)(R * K + C) * 2u; voffB[i] = (unsigned)(Rb * K + C) * 2u; }
    const size_t kstep = (size_t)(BK * 2);
    const size_t hstep = (size_t)HALF * K * 2;
    const size_t tstep = 2 * hstep;
    const unsigned ldsw = (unsigned)wid * 1024u;
    const int aoff = lds_byte(wr * 64 + fr, fq * 8), boff = lds_byte(wc * 32 + fr, fq * 8);
#define PG8_SA(b, h) (((b) * 2 + (h)) * HTB)
#define PG8_SB(b, h) ((4 + (b) * 2 + (h)) * HTB)
#define PG8_STAGE(bufoff, gbase, voff) do { _Pragma("unroll") for (int _i = 0; _i < 2; ++_i) \
        __builtin_amdgcn_global_load_lds((const unsigned*)((const char*)(gbase) + (voff)[_i]), (PG8_LAS unsigned*)(lds + (bufoff) + ldsw + _i * 8192), 16, 0, 0); } while (0)
#define PG8_LDA(dst, b, h) do { _Pragma("unroll") for (int m = 0; m < 4; ++m) _Pragma("unroll") for (int k = 0; k < 2; ++k) dst[m][k] = *(const PG8_LAS bf16x8*)(lds + PG8_SA(b, h) + aoff + m * 2048 + k * 1024); } while (0)
#define PG8_LDB(dst, b, h) do { _Pragma("unroll") for (int n = 0; n < 2; ++n) _Pragma("unroll") for (int k = 0; k < 2; ++k) dst[n][k] = *(const PG8_LAS bf16x8*)(lds + PG8_SB(b, h) + boff + n * 2048 + k * 1024); } while (0)
#define PG8_MMA(ai, bj, At, Bt) do { __builtin_amdgcn_s_setprio(1); _Pragma("unroll") for (int m = 0; m < 4; ++m) _Pragma("unroll") for (int n = 0; n < 2; ++n) _Pragma("unroll") for (int k = 0; k < 2; ++k) \
        acc[ai][bj][m][n] = __builtin_amdgcn_mfma_f32_16x16x32_bf16(Bt[n][k], At[m][k], acc[ai][bj][m][n], 0, 0, 0); __builtin_amdgcn_s_setprio(0); } while (0)
#define PG8_WAIT_V(n) asm volatile("s_waitcnt vmcnt(" #n ")" ::: "memory")
#define PG8_WAIT_L(n) asm volatile("s_waitcnt lgkmcnt(" #n ")" ::: "memory")
#define PG8_BAR __builtin_amdgcn_s_barrier()
#define PG8_SCHED __builtin_amdgcn_sched_barrier(0)
    Unit cur, nxt; int ui = 0;
    if (!S.next(0, cur)) return;
    f32x4 acc[2][2][4][2];
#pragma unroll
    for (int a = 0; a < 2; ++a)
#pragma unroll
        for (int b = 0; b < 2; ++b)
#pragma unroll
            for (int m = 0; m < 4; ++m)
#pragma unroll
                for (int n = 0; n < 2; ++n) acc[a][b][m][n] = (f32x4){0.f, 0.f, 0.f, 0.f};
    bf16x8 At[4][2], B0[2][2], B1[2][2];
    const char* cA = (const char*)g.A + (size_t)cur.pm * tstep + (size_t)cur.koff * 2; const char* cB = (const char*)g.Bt + (size_t)cur.pn * tstep + (size_t)cur.koff * 2;
    S.a_ready(cur);
    if constexpr (SP2) {
        PG8_STAGE(PG8_SB(0, 0), cB, voffB); PG8_STAGE(PG8_SB(0, 1), cB + hstep, voffB); PG8_STAGE(PG8_SA(0, 0), cA, voffA); PG8_STAGE(PG8_SA(0, 1), cA + hstep, voffA);
        if (wr == 1) PG8_BAR;
        PG8_WAIT_V(2); PG8_BAR;
        PG8_STAGE(PG8_SB(1, 0), cB + kstep, voffB); PG8_STAGE(PG8_SA(1, 0), cA + kstep, voffA); PG8_STAGE(PG8_SB(1, 1), cB + hstep + kstep, voffB);
        PG8_WAIT_V(6); PG8_BAR;
    } else {
        PG8_STAGE(PG8_SB(0, 0), cB, voffB); PG8_STAGE(PG8_SA(0, 0), cA, voffA); PG8_STAGE(PG8_SB(0, 1), cB + hstep, voffB); PG8_STAGE(PG8_SA(0, 1), cA + hstep, voffA);
        if (wr == 1) PG8_BAR;
        PG8_WAIT_V(4); PG8_BAR;
        PG8_STAGE(PG8_SB(1, 0), cB + kstep, voffB); PG8_STAGE(PG8_SA(1, 0), cA + kstep, voffA); PG8_STAGE(PG8_SB(1, 1), cB + hstep + kstep, voffB);
        PG8_WAIT_V(6); PG8_BAR;
    }
    for (;;) {
        const bool has_next = S.next(ui + 1, nxt);
        const char* nA = has_next ? (const char*)g.A + (size_t)nxt.pm * tstep + (size_t)nxt.koff * 2 : cA; const char* nB = has_next ? (const char*)g.Bt + (size_t)nxt.pn * tstep + (size_t)nxt.koff * 2 : cB;
        for (int t = 0; t < nt; t += 2) {
            const bool last = (t == nt - 2);
            const char* a1 = cA + (size_t)(t + 1) * kstep;
            const char* a2 = last ? nA : cA + (size_t)(t + 2) * kstep; const char* b2 = last ? nB : cB + (size_t)(t + 2) * kstep;
            const char* a3 = a2 + kstep; const char* b3 = b2 + kstep;
            if (last && has_next) S.a_ready(nxt);
            if constexpr (SP2) {
            PG8_LDB(B0, 0, 0); PG8_LDB(B1, 0, 1); PG8_SCHED; PG8_LDA(At, 0, 0); PG8_STAGE(PG8_SA(1, 1), a1 + hstep, voffA);
            PG8_WAIT_V(8); PG8_WAIT_L(0); PG8_BAR; PG8_MMA(0, 0, At, B0); PG8_MMA(0, 1, At, B1); PG8_BAR; PG8_SCHED;
            PG8_LDA(At, 0, 1); PG8_STAGE(PG8_SB(0, 0), b2, voffB); PG8_STAGE(PG8_SB(0, 1), b2 + hstep, voffB); PG8_STAGE(PG8_SA(0, 0), a2, voffA);
            PG8_WAIT_V(8); PG8_WAIT_L(0); PG8_BAR; PG8_MMA(1, 0, At, B0); PG8_MMA(1, 1, At, B1); PG8_BAR; PG8_SCHED;
            PG8_LDB(B0, 1, 0); PG8_LDB(B1, 1, 1); PG8_SCHED; PG8_LDA(At, 1, 0); PG8_STAGE(PG8_SA(0, 1), a2 + hstep, voffA);
            PG8_WAIT_V(8); PG8_WAIT_L(0); PG8_BAR; PG8_MMA(0, 0, At, B0); PG8_MMA(0, 1, At, B1); PG8_BAR; PG8_SCHED;
            PG8_LDA(At, 1, 1); PG8_STAGE(PG8_SB(1, 0), b3, voffB); PG8_STAGE(PG8_SB(1, 1), b3 + hstep, voffB); PG8_STAGE(PG8_SA(1, 0), a3, voffA);
            PG8_WAIT_V(8); PG8_WAIT_L(0); PG8_BAR; PG8_MMA(1, 0, At, B0); PG8_MMA(1, 1, At, B1); PG8_BAR; PG8_SCHED;
            } else {
            PG8_LDB(B0, 0, 0); PG8_SCHED; PG8_LDA(At, 0, 0); PG8_STAGE(PG8_SA(1, 1), a1 + hstep, voffA);
            PG8_WAIT_L(8); PG8_BAR; PG8_WAIT_L(0); PG8_MMA(0, 0, At, B0); PG8_BAR; PG8_SCHED;
            PG8_LDB(B1, 0, 1); PG8_STAGE(PG8_SB(0, 0), b2, voffB);
            PG8_BAR; PG8_WAIT_L(0); PG8_MMA(0, 1, At, B1); PG8_BAR;
            PG8_LDA(At, 0, 1); PG8_STAGE(PG8_SA(0, 0), a2, voffA);
            PG8_BAR; PG8_WAIT_L(0); PG8_MMA(1, 0, At, B0); PG8_BAR; PG8_SCHED;
            PG8_STAGE(PG8_SB(0, 1), b2 + hstep, voffB);
            PG8_WAIT_V(6); PG8_BAR; PG8_MMA(1, 1, At, B1); PG8_BAR;
            PG8_LDB(B0, 1, 0); PG8_SCHED; PG8_LDA(At, 1, 0); PG8_STAGE(PG8_SA(0, 1), a2 + hstep, voffA);
            PG8_WAIT_L(8); PG8_BAR; PG8_WAIT_L(0); PG8_MMA(0, 0, At, B0); PG8_BAR; PG8_SCHED;
            PG8_LDB(B1, 1, 1); PG8_STAGE(PG8_SB(1, 0), b3, voffB);
            PG8_BAR; PG8_WAIT_L(0); PG8_MMA(0, 1, At, B1); PG8_BAR;
            PG8_LDA(At, 1, 1); PG8_STAGE(PG8_SA(1, 0), a3, voffA);
            PG8_BAR; PG8_WAIT_L(0); PG8_MMA(1, 0, At, B0); PG8_BAR; PG8_SCHED;
            PG8_STAGE(PG8_SB(1, 1), b3 + hstep, voffB);
            PG8_WAIT_V(6); PG8_BAR; PG8_MMA(1, 1, At, B1); PG8_BAR;
            }
        }
        if constexpr (ALIGN_EPI) { if (wr == 0) PG8_BAR; }
        if constexpr (!Epi::AFTER_DRAIN) { E(acc, cur, wr, wc, fr, fq); S.done(cur); }
        if (!has_next) break;
#pragma unroll
        for (int a = 0; a < 2; ++a)
#pragma unroll
            for (int b = 0; b < 2; ++b)
#pragma unroll
                for (int m = 0; m < 4; ++m)
#pragma unroll
                    for (int n = 0; n < 2; ++n) acc[a][b][m][n] = (f32x4){0.f, 0.f, 0.f, 0.f};
        cur = nxt; cA = nA; cB = nB; ++ui;
        if constexpr (ALIGN_EPI) { if (wr == 1) PG8_BAR; }
    }
    PG8_WAIT_V(0);
    if constexpr (!ALIGN_EPI) { if (wr == 0) PG8_BAR; }
    PG8_BAR;
    if constexpr (Epi::AFTER_DRAIN) { E.fused(acc, cur, wr, wc, fr, fq, lds, wid, lane); S.done(cur); }
#undef PG8_SA
#undef PG8_SB
#undef PG8_STAGE
#undef PG8_LDA
#undef PG8_LDB
#undef PG8_MMA
#undef PG8_WAIT_V
#undef PG8_WAIT_L
#undef PG8_BAR
#undef PG8_SCHED
}

template <class Epi, class Sched>
__device__ __forceinline__ void naive_phase(const Gemm g, const Sched& S, const Epi& E) {
    int tid = threadIdx.x; asm volatile("" : "+v"(tid));
    const int wid = __builtin_amdgcn_readfirstlane(tid >> 6), lane = tid & 63, wr = wid >> 2, wc = wid & 3, fr = lane & 15, fq = lane >> 4;
    Unit u;
#pragma unroll 1
    for (int ui = 0; S.next(ui, u); ++ui) {
        f32x4 acc[2][2][4][2];
#pragma unroll
        for (int ai = 0; ai < 2; ++ai)
#pragma unroll
            for (int m = 0; m < 4; ++m) {
                const bf16_t* arow = g.A + (size_t)(u.pm * BM + ai * HALF + wr * 64 + m * 16 + fr) * g.Kp;
#pragma unroll
                for (int bj = 0; bj < 2; ++bj)
#pragma unroll
                    for (int n = 0; n < 2; ++n)
#pragma unroll
                        for (int i = 0; i < 4; ++i) {
                            const bf16_t* brow = g.Bt + (size_t)(u.pn * BM + bj * HALF + wc * 32 + 8 * fq + 4 * n + i) * g.Kp;
                            float s = 0.f;
#pragma unroll 1
                            for (int k = 0; k < g.K; k += 8) { const u32x4 a = *(const u32x4*)(arow + k), b = *(const u32x4*)(brow + k);
                                s += bf_lo(a.x) * bf_lo(b.x) + bf_hi(a.x) * bf_hi(b.x) + bf_lo(a.y) * bf_lo(b.y) + bf_hi(a.y) * bf_hi(b.y)
                                   + bf_lo(a.z) * bf_lo(b.z) + bf_hi(a.z) * bf_hi(b.z) + bf_lo(a.w) * bf_lo(b.w) + bf_hi(a.w) * bf_hi(b.w); }
                            acc[ai][bj][m][n][i] = s;
                        }
            }
        E(acc, u, wr, wc, fr, fq);
    }
    __syncthreads();
}
}
#include <hip/hip_bf16.h>
#include <cmath>
namespace attn_body {
using bf16=__hip_bfloat16;
using bf16x8=__attribute__((ext_vector_type(8)))short;
using s16x4=__attribute__((ext_vector_type(4)))short;
using f32x16=__attribute__((ext_vector_type(16)))float;
using u32x4=__attribute__((ext_vector_type(4)))unsigned;
using f32x4_t=__attribute__((ext_vector_type(4)))float;
constexpr int BATCH=2,NHEAD=8,SEQ=16384,D=64,DM=NHEAD*D;
constexpr int NW=8,QBLK=32,QB=QBLK*NW,KVBLK=64,NQB=SEQ/QB;
constexpr int ATTN_PITCH=DM, ATTN_UNIT_ROWS=QB;
__device__ __forceinline__ int crow(int r,int hi){return (r&3)+8*(r>>2)+4*hi;}
#define SBAR() __builtin_amdgcn_sched_barrier(0)
__device__ __forceinline__ void cmask(f32x16&p0,f32x16&p1,int jb,int qrel,int hi){
  const float NEG=-INFINITY; int kb=64*jb+4*hi;
  #pragma unroll
  for(int r=0;r<16;++r){int kv=kb+(r&3)+8*(r>>2); if(kv>qrel)p0[r]=NEG; if(kv+32>qrel)p1[r]=NEG;}
}

constexpr int NSLOT=3, SLOTB=8192;
constexpr int LDS_K=0, LDS_V=NSLOT*SLOTB, LDS_WS=2*NSLOT*SLOTB, LDS_OST=LDS_WS+NW*64*4, LDS_BYTES=LDS_OST+NW*4096, LDS_BIAS=LDS_BYTES, LDS_TOTAL=LDS_BIAS+SEQ*4;
constexpr float C2=0.125f*1.4426950408889634f;
__device__ __forceinline__ void glds16(const void*gsrc,unsigned lds_dst){unsigned keep;
  asm volatile("s_mov_b32 %0, m0\n\ts_mov_b32 m0, %2\n\ts_nop 0\n\tglobal_load_lds_dwordx4 %1, off\n\ts_mov_b32 m0, %0":"=&s"(keep):"v"(gsrc),"s"(lds_dst):"memory");}
__device__ __forceinline__ float max3f(float a,float b,float c){float r;asm("v_max3_f32 %0, %1, %2, %3":"=v"(r):"v"(a),"v"(b),"v"(c));return r;}
__device__ __forceinline__ float max2f(float a,float b){float r;asm("v_max_f32_e32 %0, %1, %2":"=v"(r):"v"(a),"v"(b));return r;}
__device__ __forceinline__ float fadd_s(float a,float b){float r;asm("v_add_f32_e32 %0, %1, %2":"=v"(r):"v"(a),"v"(b));return r;}
__device__ __forceinline__ float fsub_s(float a,float b){float r;asm("v_sub_f32_e32 %0, %1, %2":"=v"(r):"v"(a),"v"(b));return r;}
typedef float f32x2_t __attribute__((ext_vector_type(2))); typedef __bf16 bf16x2_t __attribute__((ext_vector_type(2)));
__device__ __forceinline__ unsigned cvtpk_s(float lo,float hi){f32x2_t v={lo,hi};bf16x2_t b=__builtin_convertvector(v,bf16x2_t);return __builtin_bit_cast(unsigned,b);}
#define WAIT_BAR(N) asm volatile("s_waitcnt vmcnt(" #N ") lgkmcnt(0)\n\ts_barrier":::"memory")

__device__ __forceinline__ void qkt(f32x16&p0,f32x16&p1,const char*Kslot,const bf16x8*qr,int r32,int hi){
  const char*kb=Kslot+hi*1024+r32*16;
  #pragma unroll
  for(int d0=0;d0<4;++d0){
    const bf16x8 b0=*reinterpret_cast<const bf16x8*>(kb+d0*2048);
    const bf16x8 b1=*reinterpret_cast<const bf16x8*>(kb+d0*2048+512);
    p0=__builtin_amdgcn_mfma_f32_32x32x16_bf16(b0,qr[d0],p0,0,0,0);p1=__builtin_amdgcn_mfma_f32_32x32x16_bf16(b1,qr[d0],p1,0,0,0);}
}
typedef __attribute__((address_space(3))) const char* lds_cptr;
typedef short v4i16_t __attribute__((ext_vector_type(4)));
__device__ __forceinline__ void kload8(bf16x8*kf,lds_cptr kp){
  kf[0]=*(const __attribute__((address_space(3))) bf16x8*)(kp);      kf[1]=*(const __attribute__((address_space(3))) bf16x8*)(kp+512);
  kf[2]=*(const __attribute__((address_space(3))) bf16x8*)(kp+2048); kf[3]=*(const __attribute__((address_space(3))) bf16x8*)(kp+2560);
  kf[4]=*(const __attribute__((address_space(3))) bf16x8*)(kp+4096); kf[5]=*(const __attribute__((address_space(3))) bf16x8*)(kp+4608);
  kf[6]=*(const __attribute__((address_space(3))) bf16x8*)(kp+6144); kf[7]=*(const __attribute__((address_space(3))) bf16x8*)(kp+6656);
}
__device__ __forceinline__ void kload2(bf16x8*kf,lds_cptr kp,int j){ kf[2*j]=*(const __attribute__((address_space(3))) bf16x8*)(kp+j*2048); kf[2*j+1]=*(const __attribute__((address_space(3))) bf16x8*)(kp+j*2048+512); }
__device__ __forceinline__ s16x4 vtr(lds_cptr p){ return __builtin_bit_cast(s16x4,__builtin_amdgcn_ds_read_tr16_b64_v4i16((__attribute__((address_space(3))) v4i16_t*)p)); }
__device__ __forceinline__ float rowmax(const f32x16&p0,const f32x16&p1){
  float a=max3f(p0[0],p0[1],p1[0]),b=max3f(p0[2],p0[3],p1[1]);a=max3f(a,p1[2],p1[3]);
  #pragma unroll
  for(int r=4;r<16;r+=4){a=max3f(a,p0[r],p0[r+1]);b=max3f(b,p0[r+2],p0[r+3]);a=max3f(a,p1[r],p1[r+1]);b=max3f(b,p1[r+2],p1[r+3]);}
  const float m=max2f(a,b);
  auto rr=__builtin_amdgcn_permlane32_swap(__float_as_uint(m),__float_as_uint(m),false,false);
  return max2f(__uint_as_float(rr[0]),__uint_as_float(rr[1]));
}
__device__ __forceinline__ void pv(f32x16*o,int vb,bf16x8 pa0,bf16x8 pa1,bf16x8 pa2,bf16x8 pa3){
  #pragma unroll
  for(int d0=0;d0<2;++d0){s16x4 lo[4],hi[4];
    #pragma unroll
    for(int ks=0;ks<4;++ks){
      asm volatile("ds_read_b64_tr_b16 %0,%1 offset:%c2":"=&v"(lo[ks]):"v"(vb),"i"(d0*4096+ks*1024):"memory");
      asm volatile("ds_read_b64_tr_b16 %0,%1 offset:%c2":"=&v"(hi[ks]):"v"(vb),"i"(d0*4096+ks*1024+512):"memory");}
    asm volatile("s_waitcnt lgkmcnt(0)":::"memory");SBAR();
    #define PK(k) (bf16x8){lo[k][0],lo[k][1],lo[k][2],lo[k][3],hi[k][0],hi[k][1],hi[k][2],hi[k][3]}
    o[d0]=__builtin_amdgcn_mfma_f32_32x32x16_bf16(pa0,PK(0),o[d0],0,0,0);
    o[d0]=__builtin_amdgcn_mfma_f32_32x32x16_bf16(pa1,PK(1),o[d0],0,0,0);
    o[d0]=__builtin_amdgcn_mfma_f32_32x32x16_bf16(pa2,PK(2),o[d0],0,0,0);
    o[d0]=__builtin_amdgcn_mfma_f32_32x32x16_bf16(pa3,PK(3),o[d0],0,0,0);
    #undef PK
  }
}

#ifndef ATTN_STORE16
#define ATTN_STORE16(p,v) (*(u32x4*)(p)=(v))
#endif
template<int THRL> __device__ __forceinline__ void attn_unit(int b,int h,int qb,int ts,const float*__restrict__ cl2,const bf16*Q,const bf16*__restrict__ K,const bf16*__restrict__ V,bf16*O,char*shm,int wv){
  int tid=(wv<<6)|lane_id_(); asm volatile("":"+v"(tid)); const int lane=tid&63,r32=lane&31,hi=lane>>5; const int wid=__builtin_amdgcn_readfirstlane(tid>>6);
  const long rowbase=(long)b*SEQ; const int q0=qb*QB;
  const bf16*Qw=Q+(rowbase+q0+wid*QBLK)*DM+h*D;
  const bf16*Kh=K+(rowbase+(long)ts*KVBLK)*DM+h*D,*Vh=V+(rowbase+(long)ts*KVBLK)*DM+h*D;
  const unsigned lds0=(unsigned)(uintptr_t)shm;
  float*wsf=(float*)(shm+LDS_WS)+wid*64;
  const bf16*ksrc=Kh+(long)lane*DM+wid*8;
  const bf16*vsrc=Vh+(long)(16*(wid&3)+(lane>>2))*DM+(wid>>2)*32+(lane&3)*8;
  const unsigned kdst=lds0+LDS_K+wid*1024, vdst=lds0+LDS_V+wid*1024;
  #define DMA_K(t,slot) glds16(ksrc+(long)(t)*KVBLK*DM,(unsigned)__builtin_amdgcn_readfirstlane(kdst+(slot)))
  #define DMA_V(t,slot) glds16(vsrc+(long)(t)*KVBLK*DM,(unsigned)__builtin_amdgcn_readfirstlane(vdst+(slot)))
  const int vb0=(int)(lds0+LDS_V)+((lane>>4)&1)*32+(lane&3)*8+(4*hi+((lane&15)>>2))*64;
  const char*Kbase=shm+LDS_K; bf16x8 kf[8];
  const lds_cptr shm3=(lds_cptr)shm; const lds_cptr kp0=shm3+LDS_K+hi*1024+r32*16; const lds_cptr vp0=shm3+LDS_V+((lane>>4)&1)*32+(lane&3)*8+(4*hi+((lane&15)>>2))*64;
  const int NT=(q0+QB)/KVBLK-ts;
  DMA_K(0,0);DMA_V(0,0);DMA_K(1,SLOTB);
  bf16x8 qr[4];
  #pragma unroll
  for(int d0=0;d0<4;++d0)qr[d0]=*reinterpret_cast<const bf16x8*>(&Qw[(long)r32*DM+d0*16+hi*8]);
  float mhat=0.f,l_reg=0.f;f32x16 o[2];o[0]=f32x16{};o[1]=f32x16{};
  typedef __attribute__((address_space(3))) const f32x4_t* lds_f4p; const lds_f4p biasp=(lds_f4p)((lds_cptr)shm+LDS_BIAS)+hi;
  #define BIASINIT(C0,C1,t) do{ _Pragma("unroll") for(int g_=0;g_<4;++g_){ const f32x4_t b0_=biasp[(t)*16+2*g_], b1_=biasp[(t)*16+8+2*g_]; \
      _Pragma("unroll") for(int i_=0;i_<4;++i_){ C0[4*g_+i_]=b0_[i_]-mhat; C1[4*g_+i_]=b1_[i_]-mhat; } } }while(0)
  const int qrel=wid*QBLK+r32;
  #define CMASK(P0,P1,t) do{int jb_=(t)-(NT-4); if(jb_>=0)cmask(P0,P1,jb_,qrel,hi);}while(0)
  bool resc=false;
  #define START(P0,P1) do{ const float rm=rowmax(P0,P1); resc=false; \
    { const float dl=rm; mhat=fadd_s(mhat,dl); \
      _Pragma("unroll") for(int r=0;r<16;++r){P0[r]=fsub_s(P0[r],dl);P1[r]=fsub_s(P1[r],dl);} } \
    _Pragma("unroll") for(int r=0;r<16;++r)P0[r]=__builtin_amdgcn_exp2f(P0[r]); }while(0)
  #define RESC() do{ if(resc){ asm volatile("s_waitcnt lgkmcnt(0)":::"memory"); \
      _Pragma("unroll") for(int d_=0;d_<2;++d_) _Pragma("unroll") for(int r=0;r<16;++r)o[d_][r]*=wsf[crow(r,hi)]; } }while(0)
  f32x16 pA0,pA1,pB0,pB1;
  int sl_prev=0,sl_cur=0,sl_next=SLOTB;
  #define ROT() do{sl_prev=sl_cur;sl_cur=sl_next;sl_next=(sl_next==(NSLOT-1)*SLOTB)?0:sl_next+SLOTB;}while(0)
  {
    const float cref=cl2[q0]; const f32x4_t*src=(const f32x4_t*)(cl2+ts*KVBLK); __attribute__((address_space(3))) f32x4_t*dst=(__attribute__((address_space(3))) f32x4_t*)((__attribute__((address_space(3))) char*)shm+LDS_BIAS);
    for(int i=tid;i<NT*16;i+=NW*64){ const f32x4_t c4=src[i]; dst[i]=(f32x4_t){cref-c4[0],cref-c4[1],cref-c4[2],cref-c4[3]}; } }
  DMA_K(2,2*SLOTB);
  WAIT_BAR(3);
  BIASINIT(pA0,pA1,0); qkt(pA0,pA1,Kbase,qr,r32,hi);asm volatile("s_nop 15\n\ts_nop 7":"+v"(pA0),"+v"(pA1));CMASK(pA0,pA1,0);
  START(pA0,pA1);
  _Pragma("unroll") for(int r=0;r<16;++r)pA1[r]=__builtin_amdgcn_exp2f(pA1[r]);
  WAIT_BAR(0);
  DMA_K(3,0);DMA_V(1,SLOTB);
  ROT();
  kload8(kf,kp0+sl_cur);
  WAIT_BAR(2);
  s16x4 vlo[8],vhi[8]; u32x4 pw0,pw1,pw2,pw3;
  #define PKW(P,B) cvtpk_s(P[B],P[B+1])
  #define PAF(k) __builtin_bit_cast(bf16x8,pw##k)
  #define VFR(i) (bf16x8){vlo[i][0],vlo[i][1],vlo[i][2],vlo[i][3],vhi[i][0],vhi[i][1],vhi[i][2],vhi[i][3]}
  #define PIN(x) asm volatile("":"+v"(x))
  #define MX3(a,b,c) __builtin_fmaxf(__builtin_fmaxf((a),(b)),(c))
  #define GAPA(MF,A0,A1,A2,A3,W0,W1,PW) do{ MF; sacc+=A0; sacc+=A1; sacc+=A2; sacc+=A3; PIN(sacc); W0; W1; PIN(PW); SBAR(); }while(0)
  #define EX(v) __builtin_amdgcn_exp2f(v)
  #define GAPB(MF,X,B) do{ MF; X[B]=EX(X[B]); X[B+1]=EX(X[B+1]); X[B+2]=EX(X[B+2]); X[B+3]=EX(X[B+3]); PIN(X); SBAR(); }while(0)
  #define VRD(i) do{ vlo[i]=vtr(vp_+(((i)>>2)*4096+((i)&3)*1024)); vhi[i]=vtr(vp_+(((i)>>2)*4096+((i)&3)*1024+512)); }while(0)
  #define KRD(G,j) do{ if(G){ kload2(kf,kp0+sl_next,j); SBAR(); } }while(0)
  #define STEP(C0,C1,P0,P1,t,GK,GV,GL) do{ SBAR(); BIASINIT(C0,C1,t); SBAR(); \
    const lds_cptr vp_=vp0+sl_prev; \
    VRD(0); SBAR(); float sacc=(P0[0]+P0[1]); \
    GAPA(C0=__builtin_amdgcn_mfma_f32_32x32x16_bf16(kf[0],qr[0],C0,0,0,0), P0[2],P0[3],P0[4],P0[5],     pw0[0]=PKW(P0,0), pw0[1]=PKW(P0,2), pw0); \
    VRD(4); SBAR(); GAPA(C1=__builtin_amdgcn_mfma_f32_32x32x16_bf16(kf[1],qr[0],C1,0,0,0), P0[6],P0[7],P0[8],P0[9],     pw0[2]=PKW(P0,4), pw0[3]=PKW(P0,6), pw0); \
    VRD(1); SBAR(); GAPA(C0=__builtin_amdgcn_mfma_f32_32x32x16_bf16(kf[2],qr[1],C0,0,0,0),   P0[10],P0[11],P0[12],P0[13], pw1[0]=PKW(P0,8), pw1[1]=PKW(P0,10), pw1); \
    VRD(5); SBAR(); GAPA(C1=__builtin_amdgcn_mfma_f32_32x32x16_bf16(kf[3],qr[1],C1,0,0,0),   P0[14],P0[15],P1[0],P1[1],   pw1[2]=PKW(P0,12),pw1[3]=PKW(P0,14), pw1); \
    VRD(2); SBAR(); GAPA(C0=__builtin_amdgcn_mfma_f32_32x32x16_bf16(kf[4],qr[2],C0,0,0,0),   P1[2],P1[3],P1[4],P1[5],     pw2[0]=PKW(P1,0), pw2[1]=PKW(P1,2), pw2); \
    VRD(6); SBAR(); GAPA(C1=__builtin_amdgcn_mfma_f32_32x32x16_bf16(kf[5],qr[2],C1,0,0,0),   P1[6],P1[7],P1[8],P1[9],     pw2[2]=PKW(P1,4), pw2[3]=PKW(P1,6), pw2); \
    VRD(3); SBAR(); GAPA(C0=__builtin_amdgcn_mfma_f32_32x32x16_bf16(kf[6],qr[3],C0,0,0,0),   P1[10],P1[11],P1[12],P1[13], pw3[0]=PKW(P1,8), pw3[1]=PKW(P1,10), pw3); \
    VRD(7); SBAR(); GAPA(C1=__builtin_amdgcn_mfma_f32_32x32x16_bf16(kf[7],qr[3],C1,0,0,0),   P1[14],P1[15],0.f,0.f,       pw3[2]=PKW(P1,12),pw3[3]=PKW(P1,14), pw3); \
    l_reg+=sacc; \
    if(GK){DMA_K((t)+3,sl_cur);} if(GV){DMA_V((t)+1,sl_next);} \
    CMASK(C0,C1,t); \
    { float a=MX3(C0[0],C0[1],C1[0]),b=MX3(C0[2],C0[3],C1[1]); a=MX3(a,C1[2],C1[3]); \
      _Pragma("unroll") for(int r=4;r<16;r+=4){a=MX3(a,C0[r],C0[r+1]);b=MX3(b,C0[r+2],C0[r+3]);a=MX3(a,C1[r],C1[r+1]);b=MX3(b,C1[r+2],C1[r+3]);} \
      float rm=__builtin_fmaxf(a,b); { auto rr=__builtin_amdgcn_permlane32_swap(__float_as_uint(rm),__float_as_uint(rm),false,false); rm=__builtin_fmaxf(__uint_as_float(rr[0]),__uint_as_float(rr[1])); } \
      resc=false; \
      if(__builtin_expect(__any(rm>(float)THRL),0)){ const float dl=__builtin_fmaxf(rm,0.f); mhat+=dl; \
        _Pragma("unroll") for(int r=0;r<16;++r){C0[r]-=dl;C1[r]-=dl;} \
        const float f=__builtin_amdgcn_exp2f(-dl); l_reg*=f; if(hi==0)wsf[r32]=f; resc=true; } } \
    SBAR(); \
    GAPB(o[0]=__builtin_amdgcn_mfma_f32_32x32x16_bf16(PAF(0),VFR(0),o[0],0,0,0), C0,0); \
    GAPB(o[1]=__builtin_amdgcn_mfma_f32_32x32x16_bf16(PAF(0),VFR(4),o[1],0,0,0), C0,4); \
    KRD(GL,0); GAPB(o[0]=__builtin_amdgcn_mfma_f32_32x32x16_bf16(PAF(1),VFR(1),o[0],0,0,0), C0,8); \
    KRD(GL,1); GAPB(o[1]=__builtin_amdgcn_mfma_f32_32x32x16_bf16(PAF(1),VFR(5),o[1],0,0,0), C0,12); \
    KRD(GL,2); GAPB(o[0]=__builtin_amdgcn_mfma_f32_32x32x16_bf16(PAF(2),VFR(2),o[0],0,0,0), C1,0); \
    KRD(GL,3); GAPB(o[1]=__builtin_amdgcn_mfma_f32_32x32x16_bf16(PAF(2),VFR(6),o[1],0,0,0), C1,4); \
    GAPB(o[0]=__builtin_amdgcn_mfma_f32_32x32x16_bf16(PAF(3),VFR(3),o[0],0,0,0), C1,8); \
    GAPB(o[1]=__builtin_amdgcn_mfma_f32_32x32x16_bf16(PAF(3),VFR(7),o[1],0,0,0), C1,12); \
    }while(0)
  int t=1;
  #undef CMASK
  #define CMASK(P0,P1,t) do{}while(0)
  for(;t+5<NT;t+=2){
    STEP(pB0,pB1,pA0,pA1,t,true,true,true);     WAIT_BAR(2); RESC(); ROT();
    STEP(pA0,pA1,pB0,pB1,t+1,true,true,true);   WAIT_BAR(2); RESC(); ROT();
  }
  #undef CMASK
  #define CMASK(P0,P1,t) do{int jb_=(t)-(NT-4); if(jb_>=0)cmask(P0,P1,jb_,qrel,hi);}while(0)
  #define ENDW(tt) do{ if((tt)+3<NT){WAIT_BAR(2);} else if((tt)+2<NT){WAIT_BAR(1);} else {WAIT_BAR(0);} }while(0)
  for(;t+1<NT;t+=2){
    STEP(pB0,pB1,pA0,pA1,t,(t+3<NT),(t+1<NT),(t+1<NT));       ENDW(t);   RESC(); ROT();
    STEP(pA0,pA1,pB0,pB1,t+1,(t+4<NT),(t+2<NT),(t+2<NT));     ENDW(t+1); RESC(); ROT();
  }
  STEP(pB0,pB1,pA0,pA1,NT-1,false,false,false); RESC();
  { float sacc=pB0[0]+pB0[1]; _Pragma("unroll") for(int r=2;r<16;++r)sacc+=pB0[r]; _Pragma("unroll") for(int r=0;r<16;++r)sacc+=pB1[r]; l_reg+=sacc;
    pw0=(u32x4){PKW(pB0,0),PKW(pB0,2),PKW(pB0,4),PKW(pB0,6)};pw1=(u32x4){PKW(pB0,8),PKW(pB0,10),PKW(pB0,12),PKW(pB0,14)};pw2=(u32x4){PKW(pB1,0),PKW(pB1,2),PKW(pB1,4),PKW(pB1,6)};pw3=(u32x4){PKW(pB1,8),PKW(pB1,10),PKW(pB1,12),PKW(pB1,14)};
    SBAR(); pv(o,vb0+sl_cur,PAF(0),PAF(1),PAF(2),PAF(3)); }
  #undef PKW
  #undef PAF
  #undef VFR
  #undef PIN
  #undef MX3
  #undef GAPA
  #undef GAPB
  #undef EX
  #undef VRD
  #undef KRD
  #undef STEP
  #undef ENDW
  {auto rr=__builtin_amdgcn_permlane32_swap(__float_as_uint(l_reg),__float_as_uint(l_reg),false,false);l_reg=__uint_as_float(rr[0])+__uint_as_float(rr[1]);}
  if(hi==0)wsf[32+r32]=l_reg;asm volatile("s_waitcnt lgkmcnt(0)":::"memory");
  float rli[16];
  #pragma unroll
  for(int r=0;r<16;++r)rli[r]=__builtin_amdgcn_rcpf(wsf[32+crow(r,hi)]);
  bf16*Ow=O+(rowbase+q0+wid*QBLK)*DM+h*D;
  { bf16*stg=(bf16*)(shm+LDS_OST)+wid*2048;
    #pragma unroll
    for(int r=0;r<16;++r){const int orow=crow(r,hi);
      #pragma unroll
      for(int d0=0;d0<2;++d0)stg[orow*64+d0*32+r32]=__float2bfloat16(o[d0][r]*rli[r]);}
    asm volatile("s_waitcnt lgkmcnt(0)":::"memory");
    #pragma unroll
    for(int i=0;i<4;++i){const int row=i*8+(lane>>3),ch=lane&7; const u32x4 v=*(const u32x4*)(stg+row*64+ch*8); ATTN_STORE16(Ow+(long)row*DM+ch*8,v);} }
  asm volatile("s_waitcnt lgkmcnt(0)\n\ts_barrier":::"memory");
  #undef DMA_K
  #undef DMA_V
  #undef CMASK
  #undef BIASINIT
  #undef START
  #undef RESC
  #undef ROT
}
constexpr int ATTN_LDS_BYTES=LDS_BYTES;
struct AttnTensors { const bf16* Q; const bf16* K; const bf16* V; bf16* O; const float* cl2; };
#undef SBAR
#undef WAIT_BAR
}
#define GEMM_PHASE(...) pg8::gemm_phase<__VA_ARGS__, pg8::StaticOrder, PGA, PGS>(ldsl, g, S, E, wave)
#define GEMM_PHASE_SPLIT() pg8::gemm_phase<pg8::EpiPartial, pg8::SplitOrder, PGA, PGS>(ldsl, g2, S2, E2, wave)
#define GEMM_PHASE_SPLIT_T(NN, NS, KSUB, KSH) pg8::gemm_phase<pg8::EpiPartialT<NN, KSH>, pg8::SplitOrderT<NN, NS, KSUB>, PGA, PGS>(ldsl, g2, S2, E2, wave)
#ifndef PGA
#define PGA true
#endif
#ifndef PGS
#define PGS true
#endif
namespace cg = cooperative_groups;
#define LAS __attribute__((address_space(3)))
typedef unsigned short bf16;
typedef unsigned v4u __attribute__((ext_vector_type(4)));
typedef float f32x4 __attribute__((ext_vector_type(4)));
typedef short bf16x8 __attribute__((ext_vector_type(8)));
typedef float f32x16 __attribute__((ext_vector_type(16)));
constexpr int NWAVES = 8, NTHR = 512, NMODC_ = 9216;
constexpr int MP = 32768, MS = 256, M = MP + MS, DM = 1024, FF = 2816, WA = 512, NIN = 4608, INCOLS = 4616, SEQ = 16384, PAST = 1024, DSEQ = 32, SKEYS = PAST + DSEQ;
constexpr float EPS = 1e-6f, LOG2E = 1.4426950408889634f;
constexpr size_t MiB = 1u << 20;
constexpr size_t WS_CTL = 0, CTL_ZERO_BYTES = 65536;
constexpr size_t WS_MOD = 1 * MiB, WS_CUMP = 2 * MiB, WS_CUMS = 3 * MiB, WS_G2SS = 4 * MiB, WS_QS = 6 * MiB, WS_WSP = 7 * MiB;
constexpr size_t WS_WGU1 = 8 * MiB, WS_WD1 = 19 * MiB, WS_WIN = 25 * MiB, WS_WPA = 34 * MiB, WS_WPB = 35 * MiB, WS_WOUT = 36 * MiB, WS_WGU2 = 38 * MiB, WS_WD2 = 49 * MiB;
constexpr size_t WS_XN = 56 * MiB;
constexpr size_t WS_ACT = 121 * MiB;
constexpr size_t QKV_B = (size_t)M * 512 * 2;
constexpr size_t WS_Q = 121 * MiB, WS_K = WS_Q + QKV_B, WS_V = WS_K + QKV_B, WS_U = WS_V + QKV_B, WS_G2 = WS_U + QKV_B;
constexpr size_t WS_AO = WS_Q;
constexpr size_t WS_T1 = WS_U;
constexpr size_t WS_T2 = WS_K;
constexpr size_t WS_BO = 283 * MiB, WS_PART = 300 * MiB, WS_END = 316 * MiB;
static_assert(WS_XN + (size_t)M * 2048 <= WS_ACT && WS_G2 + QKV_B <= WS_BO && WS_BO + QKV_B <= WS_END && WS_ACT + (size_t)M * FF * 2 <= WS_END, "ws map");
constexpr size_t O_Y = 0, O_KP = (size_t)M * 1024, O_VP = O_KP + (size_t)MP * 512, O_FP = O_VP + (size_t)MP * 512, O_KS = O_FP + (size_t)MP * 8, O_VS = O_KS + (size_t)MS * 512,
                 O_FS = O_VS + (size_t)MS * 512, O_GS = O_FS + (size_t)MS * 8, O_END = O_GS + (size_t)MS * 512;
constexpr int LDS_BYTES = 155648, MISC_OFF = LDS_BYTES - 256;
static_assert(attn_body::LDS_TOTAL <= MISC_OFF && pg8::STAGE_BYTES <= LDS_BYTES, "LDS map");

struct Args { const float* in[28]; float* out; unsigned char* ws; };

__device__ __forceinline__ float wave_sum(float v) {
#pragma unroll
    for (int o = 1; o < 64; o <<= 1) v += __shfl_xor(v, o);
    return v;
}
__device__ __forceinline__ unsigned f2bf(float f) { unsigned u = __builtin_bit_cast(unsigned, f); return (u + 0x7fffu + ((u >> 16) & 1u)) >> 16; }
__device__ __forceinline__ unsigned pk2(float lo, float hi) { return f2bf(lo) | (f2bf(hi) << 16); }
__device__ __forceinline__ float bf2f(unsigned short h) { return __uint_as_float((unsigned)h << 16); }

__device__ __forceinline__ void ada_unit(const Args& a, unsigned char* lds, int cb, int tid) {
    asm volatile("" : "+v"(tid));
    float* SC = (float*)lds; float* RED = (float*)(lds + 40960);
    const float* cp = a.in[2]; const float* cs = a.in[3]; const float* w_ada = a.in[7]; const float* b_ada = a.in[8];
    float* MOD = (float*)(a.ws + WS_MOD);
    for (int i = tid; i < 10240; i += NTHR) { const int r = i >> 10, k = i & 1023; const float c = r < 2 ? cp[r * 1024 + k] : cs[(r - 2) * 1024 + k]; SC[i] = c / (1.0f + expf(-c)); }
    __syncthreads();
    if (tid < 504) {
        const int cgp = tid % 9, ks = tid / 9; f32x4 acc[10];
#pragma unroll
        for (int r = 0; r < 10; ++r) acc[r] = (f32x4){0.f, 0.f, 0.f, 0.f};
        for (int k = ks; k < 1024; k += 56) { const f32x4 w = *(const f32x4*)(w_ada + (size_t)k * NMODC_ + 36 * cb + 4 * cgp);
#pragma unroll
            for (int r = 0; r < 10; ++r) acc[r] += w * SC[r * 1024 + k]; }
#pragma unroll
        for (int r = 0; r < 10; ++r) *(f32x4*)(RED + (size_t)tid * 40 + r * 4) = acc[r];
    }
    __syncthreads();
    if (tid < 360) { const int r = tid / 36, c = tid % 36, cgp = c >> 2, i = c & 3; float s = 0.f;
        for (int ks = 0; ks < 56; ++ks) s += RED[(ks * 9 + cgp) * 40 + r * 4 + i];
        MOD[r * NMODC_ + 36 * cb + c] = s + b_ada[36 * cb + c]; }
    __syncthreads();
}
__device__ __forceinline__ void transpose_item(const float* W, int ld, int c0, int K, bf16* WT, int drow0, int k0, float* scr, int lane) {
#pragma unroll 8
    for (int i = 0; i < 32; ++i) { const int kk = 2 * i + (lane >> 5); scr[kk * 33 + (lane & 31)] = W[(size_t)(k0 + kk) * ld + c0 + (lane & 31)]; }
    asm volatile("s_waitcnt lgkmcnt(0)" ::: "memory");
    const int c = lane & 7;
#pragma unroll
    for (int j = 0; j < 4; ++j) { const int n = (lane >> 3) + 8 * j; const float* s = scr + (8 * c) * 33 + n;
        v4u o; o.x = pk2(s[0 * 33], s[1 * 33]); o.y = pk2(s[2 * 33], s[3 * 33]); o.z = pk2(s[4 * 33], s[5 * 33]); o.w = pk2(s[6 * 33], s[7 * 33]);
        *(v4u*)(WT + (size_t)(drow0 + n) * K + k0 + 8 * c) = o; }
    asm volatile("s_waitcnt lgkmcnt(0)" ::: "memory");
}
struct Seg { int in, ld, c0, ncols, K; size_t dst; int drow, mode; };
__device__ const Seg SEGS[13] = {
        {10, FF, 0, FF, 1024, WS_WGU1, 0, 1}, {11, FF, 0, FF, 1024, WS_WGU1, 0, 2}, {12, 1024, 0, 1024, FF, WS_WD1, 0, 0},
        {14, INCOLS, 0, 512, 1024, WS_WIN, 0, 3}, {14, INCOLS, 512, 512, 1024, WS_WIN, 512, 3}, {14, INCOLS, 1024, 512, 1024, WS_WIN, 1024, 0}, {14, INCOLS, 1544, 3072, 1024, WS_WIN, 1536, 0},
        {21, 1024, 0, 1024, 512, WS_WPA, 0, 0}, {22, 1024, 0, 1024, 512, WS_WPB, 0, 0}, {23, 1024, 0, 1024, 1024, WS_WOUT, 0, 0},
        {25, FF, 0, FF, 1024, WS_WGU2, 0, 1}, {26, FF, 0, FF, 1024, WS_WGU2, 0, 2}, {27, 1024, 0, 1024, FF, WS_WD2, 0, 0}};
__device__ __forceinline__ int seg_drow(const Seg& s, int n) {
    if (s.mode == 0) return s.drow + n;
    if (s.mode == 1) return s.drow + 256 * (n >> 7) + (n & 127);
    if (s.mode == 2) return s.drow + 256 * (n >> 7) + 128 + (n & 127);
    const int gs = (n & 255) >> 5; return s.drow + (n & ~255) + 32 * (4 * (gs & 1) + (gs >> 1));
}
__device__ __forceinline__ void p0_weights(const Args& a, unsigned char* lds, int gw, int NGW, int wave, int lane) {
    asm volatile("" : "+v"(lane));
    float* scr = (float*)(lds + wave * 8704);

    int base = 0;
#pragma unroll 1
    for (int si = 0; si < 13; ++si) {
        const Seg s = SEGS[si]; const int nblk = s.ncols / 32, nitems = (s.K / 64) * nblk;
        int first = (gw - base) % NGW; if (first < 0) first += NGW;
        for (int it = first; it < nitems; it += NGW) { const int kb = it / nblk, nb = it % nblk;
            transpose_item(a.in[s.in], s.ld, s.c0 + 32 * nb, s.K, (bf16*)(a.ws + s.dst), seg_drow(s, 32 * nb), 64 * kb, scr, lane); }
        base = (base + nitems) % NGW;
    }
    const float* wsp = a.in[19]; bf16* WSP = (bf16*)(a.ws + WS_WSP);
    for (int i = gw * 64 + lane; i < 4 * 128 * 128; i += NGW * 64) { const int t = (i >> 7) & 127, s2 = i & 127; WSP[i] = (bf16)f2bf(s2 <= t ? wsp[i] : 0.f); }
}
template <bool LOGF> __device__ __forceinline__ void norm_phase(const Args& a, unsigned char* lds, const float* srcp, const float* srcs, const float* g, int ishift, int iscale,
                                                                 int gw, int NGW, int tid, int lane) {
    asm volatile("" : "+v"(tid), "+v"(lane));
    const float* MOD = (const float*)(a.ws + WS_MOD); bf16* XN = (bf16*)(a.ws + WS_XN);
    float* WFt = (float*)lds;
    if (LOGF) { const float* w_in = a.in[14]; for (int i = tid; i < 8192; i += NTHR) { const int k = i >> 3, j = i & 7; WFt[j * 1024 + k] = w_in[(size_t)k * INCOLS + 1536 + j]; } __syncthreads(); }
    int cur = -1; f32x4 gs[4], shv[4], vn[4], vnn[4];
    if (gw < M) { const float* xrow0 = gw < MP ? srcp + (size_t)gw * 1024 : srcs + (size_t)(gw - MP) * 1024;
#pragma unroll
        for (int j = 0; j < 4; ++j) vn[j] = ((const f32x4*)xrow0 + lane)[64 * j]; }
    if (gw + NGW < M) { const int m1 = gw + NGW; const float* xrow1 = m1 < MP ? srcp + (size_t)m1 * 1024 : srcs + (size_t)(m1 - MP) * 1024;
#pragma unroll
        for (int j = 0; j < 4; ++j) vnn[j] = ((const f32x4*)xrow1 + lane)[64 * j]; }
    for (int m = gw; m < M; m += NGW) {
        const int mr = m < MP ? (m >> 14) : 2 + ((m - MP) >> 5);
        if (mr != cur) { cur = mr; const f32x4* g4 = (const f32x4*)g + lane;
            const f32x4* sh4 = (const f32x4*)(MOD + (size_t)mr * 9216 + ishift * 1024) + lane; const f32x4* sc4 = (const f32x4*)(MOD + (size_t)mr * 9216 + iscale * 1024) + lane;
#pragma unroll
            for (int j = 0; j < 4; ++j) { gs[j] = g4[64 * j] * (sc4[64 * j] + 1.0f); shv[j] = sh4[64 * j]; } }
        f32x4 v[4]; float ss = 0.f;
#pragma unroll
        for (int j = 0; j < 4; ++j) { v[j] = vn[j]; vn[j] = vnn[j]; ss += (v[j].x * v[j].x + v[j].y * v[j].y) + (v[j].z * v[j].z + v[j].w * v[j].w); }
        { const int m2 = m + 2 * NGW; if (m2 < M) { const float* xrow2 = m2 < MP ? srcp + (size_t)m2 * 1024 : srcs + (size_t)(m2 - MP) * 1024;
#pragma unroll
            for (int j = 0; j < 4; ++j) vnn[j] = ((const f32x4*)xrow2 + lane)[64 * j]; } }
        const float rstd = 1.0f / sqrtf(wave_sum(ss) * (1.0f / 1024.0f) + EPS);
        unsigned long long* o8 = (unsigned long long*)(XN + (size_t)m * 1024) + lane;
#pragma unroll
        for (int j = 0; j < 4; ++j) { v[j] = (v[j] * rstd) * gs[j] + shv[j];
            o8[64 * j] = (unsigned long long)pk2(v[j].x, v[j].y) | ((unsigned long long)pk2(v[j].z, v[j].w) << 32); }
        if (LOGF) {
            float f[8];
#pragma unroll
            for (int jj = 0; jj < 8; ++jj) { float s = 0.f;
#pragma unroll
                for (int j = 0; j < 4; ++j) { const f32x4 w = *((const f32x4*)(WFt + jj * 1024) + 64 * j + lane); s += (v[j].x * w.x + v[j].y * w.y) + (v[j].z * w.z + v[j].w * w.w); }
                f[jj] = wave_sum(s); }
            float fj = f[0];
#pragma unroll
            for (int jj = 1; jj < 8; ++jj) fj = (lane == jj) ? f[jj] : fj;
            if (lane < 8) { const float x = fj + a.in[15][lane]; const float lf = (x >= 0.f) ? -log1pf(expf(-x)) : x - log1pf(expf(x));
                float* dst = m < MP ? a.out + O_FP + (size_t)m * 8 : a.out + O_FS + (size_t)(m - MP) * 8; dst[lane] = lf; }
        }
    }
}
__device__ __forceinline__ void scan_unit(const Args& a, unsigned char* lds, int unit, int tid) {
    asm volatile("" : "+v"(tid));
    double* tot = (double*)lds;
    if (unit < 16) {
        const int b = unit >> 3, h = unit & 7; const float* lf = a.out + O_FP + ((size_t)b * SEQ) * 8 + h; float* dst = (float*)(a.ws + WS_CUMP) + (size_t)unit * SEQ;
        float x[32]; double s = 0.0;
#pragma unroll
        for (int i = 0; i < 32; ++i) { x[i] = lf[(size_t)(tid * 32 + i) * 8]; s += (double)x[i]; }
        tot[tid] = s; __syncthreads();
        double pre = 0.0; for (int j = 0; j < tid; ++j) pre += tot[j];
#pragma unroll
        for (int i = 0; i < 32; ++i) { pre += (double)x[i]; dst[tid * 32 + i] = (float)(pre * 1.4426950408889634); }
    } else {
        const int bh = unit - 16, b = bh >> 3, h = bh & 7; const float* lfc = a.in[6] + ((size_t)b * PAST) * 8 + h; const float* lfn = a.out + O_FS + ((size_t)b * DSEQ) * 8 + h;
        float* dst = (float*)(a.ws + WS_CUMS) + (size_t)bh * SKEYS;
        float x[3] = {0.f, 0.f, 0.f}; double s = 0.0;
        if (tid < 352) {
#pragma unroll
            for (int i = 0; i < 3; ++i) { const int p = tid * 3 + i; x[i] = p < PAST ? lfc[(size_t)p * 8] : lfn[(size_t)(p - PAST) * 8]; s += (double)x[i]; } }
        tot[tid] = s; __syncthreads();
        if (tid < 352) { double pre = 0.0; for (int j = 0; j < tid; ++j) pre += tot[j];
#pragma unroll
            for (int i = 0; i < 3; ++i) { pre += (double)x[i]; dst[tid * 3 + i] = (float)(pre * 1.4426950408889634); } }
    }
    __syncthreads();
}
__device__ __forceinline__ void gmlp_unit(const Args& a, unsigned char* lds, int ci, int tid, int wave, int lane) {
    asm volatile("" : "+v"(tid), "+v"(lane));
    constexpr int VP = 136;
    bf16* VT = (bf16*)lds; float* rst = (float*)(lds + 128 * VP * 2);
    const bf16* G2 = (const bf16*)(a.ws + WS_G2); const bf16* U = (const bf16*)(a.ws + WS_U); bf16* BO = (bf16*)(a.ws + WS_BO); const bf16* WSP = (const bf16*)(a.ws + WS_WSP);
    const float* G2SS = (const float*)(a.ws + WS_G2SS); const float* gv = a.in[18]; const float* bsp = a.in[20];
    const size_t R0 = (size_t)ci * 128;
    if (tid < 128) { const f32x4* p = (const f32x4*)(G2SS + (R0 + tid) * 8); const f32x4 s0 = p[0], s1 = p[1]; rst[tid] = 1.0f / sqrtf((((s0.x + s0.y) + (s0.z + s0.w)) + ((s1.x + s1.y) + (s1.z + s1.w))) * (1.0f / 512.0f) + EPS); }
    __syncthreads();
    const int r32 = lane & 31, hi = lane >> 5, tb = wave >> 1, dh = wave & 1;
#pragma unroll 1
    for (int g = 0; g < 4; ++g) {
#pragma unroll
        for (int it = 0; it < 4; ++it) { const int q = tid + NTHR * it, s = q & 127, cch = q >> 7;
            const v4u raw = *(const v4u*)(G2 + (R0 + s) * 512 + g * 128 + 8 * cch); const float rs = rst[s];
            const f32x4 g0 = *(const f32x4*)(gv + g * 128 + 8 * cch), g1 = *(const f32x4*)(gv + g * 128 + 8 * cch + 4);
            bf16* col = VT + (8 * cch) * VP + s;
            col[0 * VP] = (bf16)f2bf(pg8::bf_lo(raw.x) * rs * g0.x); col[1 * VP] = (bf16)f2bf(pg8::bf_hi(raw.x) * rs * g0.y); col[2 * VP] = (bf16)f2bf(pg8::bf_lo(raw.y) * rs * g0.z); col[3 * VP] = (bf16)f2bf(pg8::bf_hi(raw.y) * rs * g0.w);
            col[4 * VP] = (bf16)f2bf(pg8::bf_lo(raw.z) * rs * g1.x); col[5 * VP] = (bf16)f2bf(pg8::bf_hi(raw.z) * rs * g1.y); col[6 * VP] = (bf16)f2bf(pg8::bf_lo(raw.w) * rs * g1.z); col[7 * VP] = (bf16)f2bf(pg8::bf_hi(raw.w) * rs * g1.w); }
        bf16x8 af[8];
#pragma unroll
        for (int ks = 0; ks < 8; ++ks) af[ks] = *(const bf16x8*)(WSP + ((size_t)(g * 128 + 32 * tb + r32)) * 128 + 16 * ks + 8 * hi);
        __syncthreads();
        f32x16 acc[2]; acc[0] = f32x16{}; acc[1] = f32x16{};
#pragma unroll
        for (int ks = 0; ks < 8; ++ks) if (ks <= 2 * tb + 1) {
#pragma unroll
            for (int db = 0; db < 2; ++db) { const bf16x8 bfv = *(const bf16x8*)(VT + (64 * dh + 32 * db + r32) * VP + 16 * ks + 8 * hi); acc[db] = __builtin_amdgcn_mfma_f32_32x32x16_bf16(af[ks], bfv, acc[db], 0, 0, 0); }
        }
        { unsigned short uu[2][16]; float bb[16];
#pragma unroll
          for (int r = 0; r < 16; ++r) { const int t = 32 * tb + (r & 3) + 8 * (r >> 2) + 4 * hi; bb[r] = bsp[g * 128 + t];
#pragma unroll
              for (int db = 0; db < 2; ++db) uu[db][r] = U[(R0 + t) * 512 + g * 128 + 64 * dh + 32 * db + r32]; }
#pragma unroll
          for (int db = 0; db < 2; ++db)
#pragma unroll
              for (int r = 0; r < 16; ++r) { const int t = 32 * tb + (r & 3) + 8 * (r >> 2) + 4 * hi, ch = g * 128 + 64 * dh + 32 * db + r32; const size_t off = (R0 + t) * 512 + ch;
                  BO[off] = (bf16)f2bf(bf2f(uu[db][r]) * (acc[db][r] + bb[r])); } }
        __syncthreads();
    }
}
__device__ __forceinline__ void gmlp_sample_unit(const Args& a, unsigned char* lds, int b, int tid) {
    asm volatile("" : "+v"(tid));
    float* rst = (float*)lds;
    const bf16* G2 = (const bf16*)(a.ws + WS_G2); const bf16* U = (const bf16*)(a.ws + WS_U); bf16* BO = (bf16*)(a.ws + WS_BO);
    const float* G2SS = (const float*)(a.ws + WS_G2SS); const float* wsp = a.in[19]; const float* bsp = a.in[20];
    const size_t R0 = (size_t)MP + b * 32;
    if (tid < 32) { const float* p = G2SS + (R0 + tid) * 8; float s = 0.f; for (int i = 0; i < 8; ++i) s += p[i]; rst[tid] = 1.0f / sqrtf(s * (1.0f / 512.0f) + EPS); }
    __syncthreads();
    const int ch = tid, g = ch >> 7; const float gvv = a.in[18][ch];
    float vb[32];
#pragma unroll
    for (int s = 0; s < 32; ++s) { vb[s] = bf2f(G2[(R0 + s) * 512 + ch]) * rst[s] * gvv; a.out[O_GS + ((size_t)b * 32 + s) * 512 + ch] = vb[s]; }
#pragma unroll
    for (int t = 0; t < 32; ++t) { float mixed = bsp[g * 128 + t]; const float* wrow = wsp + ((size_t)g * 128 + t) * 128;
#pragma unroll
        for (int s = 0; s < 32; ++s) if (s <= t) mixed += wrow[s] * vb[s];
        const size_t off = (R0 + t) * 512 + ch; BO[off] = (bf16)f2bf(bf2f(U[off]) * mixed); }
    __syncthreads();
}
__device__ __forceinline__ void sattn_unit(const Args& a, unsigned char* lds, int unit, int tid, int wave, int lane) {
    asm volatile("" : "+v"(tid), "+v"(lane));
    const int qg = unit & 3, h = (unit >> 2) & 7, b = unit >> 5;
    float* qs = (float*)lds;
    float* S = qs + 512;
    float* red = S + 8 * SKEYS;
    float* inv = red + 4096;
    const float* QS = (const float*)(a.ws + WS_QS); const float* cum = (const float*)(a.ws + WS_CUMS) + (size_t)(b * 8 + h) * SKEYS;
    const float* kc = a.in[4] + ((size_t)b * PAST) * 512 + h * 64; const float* vc = a.in[5] + ((size_t)b * PAST) * 512 + h * 64;
    const float* kn = a.out + O_KS + ((size_t)b * DSEQ) * 512 + h * 64; const float* vn = a.out + O_VS + ((size_t)b * DSEQ) * 512 + h * 64;
    { const int qi = tid >> 6, d = tid & 63; qs[tid] = QS[((size_t)b * 32 + 8 * qg + qi) * 512 + h * 64 + d]; }
    __syncthreads();
    for (int key = wave * 132 + lane; key < wave * 132 + 132; key += 64) {
        const f32x4* kr = (const f32x4*)(key < PAST ? kc + (size_t)key * 512 : kn + (size_t)(key - PAST) * 512);
        f32x4 kv[16];
#pragma unroll
        for (int i = 0; i < 16; ++i) kv[i] = kr[i];
        const float ck = cum[key];
#pragma unroll
        for (int qi = 0; qi < 8; ++qi) { float s = 0.f;
#pragma unroll
            for (int i = 0; i < 16; ++i) { const f32x4 q4 = *(const f32x4*)(qs + qi * 64 + 4 * i); s += (q4.x * kv[i].x + q4.y * kv[i].y) + (q4.z * kv[i].z + q4.w * kv[i].w); }
            const int qpos = PAST + 8 * qg + qi;
            S[qi * SKEYS + key] = (key <= qpos) ? s + (cum[qpos] - ck) : -INFINITY; }
    }
    __syncthreads();
    { float mx = -INFINITY; for (int k = lane; k < SKEYS; k += 64) mx = fmaxf(mx, S[wave * SKEYS + k]);
#pragma unroll
      for (int o = 1; o < 64; o <<= 1) mx = fmaxf(mx, __shfl_xor(mx, o));
      float sum = 0.f; for (int k = lane; k < SKEYS; k += 64) { const float p = exp2f(S[wave * SKEYS + k] - mx); S[wave * SKEYS + k] = p; sum += p; }
      sum = wave_sum(sum); if (lane == 0) inv[wave] = 1.0f / sum; }
    __syncthreads();
    { float acc[8];
#pragma unroll
      for (int qi = 0; qi < 8; ++qi) acc[qi] = 0.f;
#pragma unroll 1
      for (int key0 = wave * 132; key0 < wave * 132 + 132; key0 += 12) {
          float vv[12];
#pragma unroll
          for (int j = 0; j < 12; ++j) { const int key = key0 + j; vv[j] = (key < PAST ? vc + (size_t)key * 512 : vn + (size_t)(key - PAST) * 512)[lane]; }
#pragma unroll
          for (int j = 0; j < 12; ++j)
#pragma unroll
              for (int qi = 0; qi < 8; ++qi) acc[qi] += S[qi * SKEYS + key0 + j] * vv[j]; }
#pragma unroll
      for (int qi = 0; qi < 8; ++qi) red[(wave * 8 + qi) * 64 + lane] = acc[qi]; }
    __syncthreads();
    { const int qi = tid >> 6, d = tid & 63; float s = 0.f;
#pragma unroll
      for (int w = 0; w < 8; ++w) s += red[(w * 8 + qi) * 64 + d];
      bf16* AO = (bf16*)(a.ws + WS_AO); AO[((size_t)MP + b * 32 + 8 * qg + qi) * 512 + h * 64 + d] = (bf16)f2bf(s * inv[qi]); }
    __syncthreads();
}

#define XB_TMO      128
#define XB_XCNT(j)  (256  + 64 * (j))
#define XB_XSUB(j)  (1280 + 64 * (j))
#define XB_XGEN(j)  (2304 + 64 * (j))
#define XB_TOP      3328
#define XB_TOPGEN   3392
#define XCD_BAR_WORDS 3456
#define XB_SPIN_CAP (1u << 18)

__device__ __forceinline__ unsigned xb_ld(unsigned* p)              { return __hip_atomic_load(p, __ATOMIC_RELAXED, __HIP_MEMORY_SCOPE_AGENT); }
__device__ __forceinline__ unsigned xb_add(unsigned* p, unsigned v) { return __hip_atomic_fetch_add(p, v, __ATOMIC_RELAXED, __HIP_MEMORY_SCOPE_AGENT); }
__device__ __forceinline__ unsigned xb_xcc_id() { return (unsigned)__builtin_amdgcn_s_getreg((3 << 11) | 20) & 0xFu; }
#define XB_SPIN(cond, bar) do { unsigned _sp = 0; while (cond) { __builtin_amdgcn_s_sleep(1); \
    if ((++_sp & 255u) == 0u) { if (xb_ld(&(bar)[XB_TMO])) break; if (_sp > XB_SPIN_CAP) { atomicAdd(&(bar)[XB_TMO], 1u); break; } } } } while (0)

struct XcdBarrier {
    unsigned* bar; unsigned x;
    volatile LAS unsigned* st;
};

__device__ __forceinline__ XcdBarrier xcd_barrier_post(unsigned* bar, volatile LAS unsigned* st, int wv) {
    XcdBarrier b; b.bar = bar; b.x = xb_xcc_id(); b.st = st;
    if (wv == 0 && lane_id_() == 0) (void)xb_add(&bar[XB_XCNT(b.x)], 1u);
    return b;
}
__device__ __forceinline__ void xcd_barrier_complete(unsigned* bar, unsigned x, unsigned& nloc, unsigned& nx) {
    const unsigned G = gridDim.x * gridDim.y * gridDim.z;
    unsigned sum, cnt, mine, sp = 0u;
    for (;;) {
        sum = 0u; cnt = 0u; mine = 0u;
#pragma unroll
        for (unsigned j = 0; j < 16; ++j) { const unsigned c = xb_ld(&bar[XB_XCNT(j)]); sum += c; cnt += (c > 0u) ? 1u : 0u; mine = (j == x) ? c : mine; }
        if (sum == G) break;
        __builtin_amdgcn_s_sleep(1);
        if ((++sp & 255u) == 0u) { if (xb_ld(&bar[XB_TMO])) break; if (sp > XB_SPIN_CAP) { atomicAdd(&bar[XB_TMO], 1u); break; } }
    }
    nloc = mine > 0u ? mine : 1u; nx = cnt > 0u ? cnt : 1u;
}

__device__ __forceinline__ void xcd_barrier(const XcdBarrier& b, int wv) {
    asm volatile("s_waitcnt vmcnt(0)" ::: "memory");
    __syncthreads();
    if (wv == 0 && lane_id_() == 0) {
        unsigned* bar = b.bar;
        __builtin_amdgcn_s_waitcnt(0);
        unsigned nloc = b.st[0], nx = b.st[1];
        if (nloc == 0u) { xcd_barrier_complete(bar, b.x, nloc, nx); b.st[0] = nloc; b.st[1] = nx; }
        const unsigned old = xb_add(&bar[XB_XSUB(b.x)], 1u);
        const unsigned gen = old / nloc;
        if (old + 1u == (gen + 1u) * nloc) {
            __builtin_amdgcn_fence(__ATOMIC_RELEASE, "agent");
            asm volatile("s_waitcnt vmcnt(0)" ::: "memory");
            const unsigned og = xb_add(&bar[XB_TOP], 1u);
            const unsigned tg = og / nx;
            if (og + 1u == (tg + 1u) * nx) xb_add(&bar[XB_TOPGEN], 1u);
            else XB_SPIN(xb_ld(&bar[XB_TOPGEN]) == tg, bar);
            __builtin_amdgcn_fence(__ATOMIC_ACQUIRE, "agent");
            xb_add(&bar[XB_XGEN(b.x)], 1u);
            asm volatile("s_waitcnt vmcnt(0)" ::: "memory");
        } else {
            XB_SPIN(xb_ld(&bar[XB_XGEN(b.x)]) == gen, bar);
            __builtin_amdgcn_fence(__ATOMIC_ACQUIRE, "agent");
            asm volatile("s_waitcnt vmcnt(0)" ::: "memory");
        }
    }
    __syncthreads();
}

#ifndef SKIPMASK
#define SKIPMASK 0u
#endif
#define PH(n) (((SKIPMASK) >> (n) & 1u) == 0u)
#define GSYNC() do { XcdBarrier b_; b_.bar = (unsigned*)(a.ws + WS_CTL); b_.x = xbar_x; b_.st = MISC + 8; xcd_barrier(b_, wave); } while (0)
__global__ void __launch_bounds__(NTHR, 2) fox_fwd(Args a) {
    extern __shared__ __attribute__((aligned(16))) unsigned char lds[];
    cg::grid_group grid = cg::this_grid();
    const int wave = __builtin_amdgcn_readfirstlane((int)threadIdx.x >> 6);
#define tid ((wave << 6) | lane_id_())
#define lane (lane_id_())
    const int G = gridDim.x, bx = blockIdx.x; const int vcu = (G % 8 == 0) ? (bx % 8) * (G / 8) + bx / 8 : bx;
    const int gw = vcu * NWAVES + wave, NGW = G * NWAVES;
    LAS unsigned char* ldsl = (LAS unsigned char*)lds;
    float* MOD = (float*)(a.ws + WS_MOD); bf16* XN = (bf16*)(a.ws + WS_XN); bf16* ACT = (bf16*)(a.ws + WS_ACT);
    volatile LAS unsigned* MISC = (volatile LAS unsigned*)((LAS unsigned char*)lds + MISC_OFF);
    for (int i = tid; i < LDS_BYTES / 16; i += NTHR) ((v4u*)lds)[i] = (v4u){0u, 0u, 0u, 0u};
    __syncthreads();
    __builtin_amdgcn_fence(__ATOMIC_SEQ_CST, ""); asm volatile("s_waitcnt vmcnt(0) lgkmcnt(0)" ::: "memory");
    const unsigned xbar_x = xcd_barrier_post((unsigned*)(a.ws + WS_CTL), MISC + 8, wave).x;
    grid.sync();
    float* Y = a.out + O_Y;

#ifndef NPASS
#define NPASS 1
#endif
#pragma unroll 1
    for (int pass = 0; pass < NPASS; ++pass) {
    if (pass) GSYNC();
    if (PH(0)) { for (int cb = bx; cb < 256; cb += G) ada_unit(a, lds, cb, tid);
    p0_weights(a, lds, gw, NGW, wave, lane); }
    GSYNC();
    if (PH(1)) norm_phase<false>(a, lds, a.in[0], a.in[1], a.in[9], 0, 1, gw, NGW, tid, lane);
    GSYNC();
    if (PH(2)) { pg8::Gemm g{XN, (const bf16*)(a.ws + WS_WGU1), M, 2 * FF, 1024, 1024}; pg8::StaticOrder S; S.init(M, 2 * FF, G, bx); pg8::EpiUp E{ACT, FF};
      GEMM_PHASE(pg8::EpiUp); }
    GSYNC();
    if (PH(3)) { pg8::EpiRes E{a.in[0], a.in[1], Y, MOD + 2 * 1024, 0.5f};
      { int ksub_ = 256; asm volatile("" : "+s"(ksub_)); pg8::Gemm g2{ACT + (size_t)MP * FF, (const bf16*)(a.ws + WS_WD1), 256, 1024, ksub_, FF}; pg8::SplitOrder S2; S2.init(G, bx); pg8::EpiPartial E2{(float*)(a.ws + WS_PART), 4, 256}; GEMM_PHASE_SPLIT(); }
      { pg8::Gemm g{ACT, (const bf16*)(a.ws + WS_WD1), MP, 1024, FF, FF}; pg8::StaticOrder S; S.init(MP, 1024, G, bx); GEMM_PHASE(pg8::EpiRes); }
      GSYNC();
      if (bx < 32) pg8::reduce_rowgroup<11>((const float*)(a.ws + WS_PART), bx & 3, bx >> 2, E, wave); }
    GSYNC();
    if (PH(4)) norm_phase<true>(a, lds, Y, Y + (size_t)MP * 1024, a.in[13], 3, 4, gw, NGW, tid, lane);
    GSYNC();
    if (PH(5)) { if (G >= 160) { const int u = G - 1 - bx; if (u < 80) scan_unit(a, lds, u, tid); }
                 else for (int u = bx; u < 80; u += G) scan_unit(a, lds, u, tid); }
    if (PH(6)) { pg8::Gemm g{XN, (const bf16*)(a.ws + WS_WIN), M, 2560, 1024, 1024}; pg8::StaticOrder S; S.init(M, 2560, G, bx);
      pg8::EpiIn E{(bf16*)(a.ws + WS_Q), (bf16*)(a.ws + WS_K), (bf16*)(a.ws + WS_V), (bf16*)(a.ws + WS_U), (bf16*)(a.ws + WS_G2), nullptr, nullptr,
                   (float*)(a.ws + WS_G2SS), (float*)(a.ws + WS_QS), a.out + O_KP, a.out + O_KS, a.out + O_VP, a.out + O_VS, a.in[16], a.in[17], attn_body::C2, EPS};
      GEMM_PHASE(pg8::EpiIn); }
    GSYNC();
    if (PH(7)) { const attn_body::bf16* Qb = (const attn_body::bf16*)(a.ws + WS_Q); const attn_body::bf16* Kb = (const attn_body::bf16*)(a.ws + WS_K); const attn_body::bf16* Vb = (const attn_body::bf16*)(a.ws + WS_V);
      attn_body::bf16* Ob = (attn_body::bf16*)(a.ws + WS_AO); const float* CUMP = (const float*)(a.ws + WS_CUMP);
      const int nun = (G == 256) ? 4 : (1024 - bx + G - 1) / G;
      float B2;
      { float mq = fabsf(a.in[16][lane]), mk = fabsf(a.in[17][lane]);
#pragma unroll
        for (int o = 1; o < 64; o <<= 1) { mq = fmaxf(mq, __shfl_xor(mq, o)); mk = fmaxf(mk, __shfl_xor(mk, o)); }
        B2 = 64.0f * mq * mk * attn_body::C2 * 1.01f + 0.5f; }
#pragma unroll 1
      for (int i = 0; i < nun; ++i) { int bh, qb;
          if (G == 256) { const int s = vcu & 15; bh = vcu >> 4; qb = (i == 0) ? s : (i == 1) ? 31 - s : (i == 2) ? 32 + s : 63 - s; } else { const int idx = bx + i * G; bh = idx >> 6; qb = idx & 63; }
          int ts = 0;
          { const float* cl = CUMP + (size_t)bh * SEQ; const float cref = cl[qb * 256]; const int ncand = 4 * qb;
            float cv[4];
#pragma unroll
            for (int k = 0; k < 4; ++k) { const int j = 64 * k + lane; cv[k] = (j < ncand) ? cl[64 * j + 63] : 0.f; }
#pragma unroll
            for (int k = 0; k < 4; ++k) { const int j = 64 * k + lane; const bool sk = (j < ncand) && (cref - cv[k] + 2.0f * B2 < -152.0f); ts += (int)__popcll(__ballot(sk)); }
            ts = __builtin_amdgcn_readfirstlane(ts) & ~1; }
          attn_body::attn_unit<8>(bh >> 3, bh & 7, qb, ts, CUMP + (size_t)bh * SEQ, Qb, Kb, Vb, Ob, (char*)lds, wave);
          }
      __syncthreads(); }
    if (PH(8)) for (int ci = bx; ci < 256; ci += G) gmlp_unit(a, lds, ci, tid, wave, lane);
    if (PH(9)) for (int u = bx; u < 256; u += G) sattn_unit(a, lds, u, tid, wave, lane);
    if (PH(10)) { if (G == 256) { if ((vcu & 15) == 0 && (vcu >> 4) < 8) gmlp_sample_unit(a, lds, vcu >> 4, tid); } else for (int b = bx; b < 8; b += G) gmlp_sample_unit(a, lds, b, tid); }
    GSYNC();
    if (PH(11)) { bf16* T = (bf16*)(a.ws + WS_T1); bf16* T2 = (bf16*)(a.ws + WS_T2); const bf16* WIN = (const bf16*)(a.ws + WS_WIN);
      bf16* TS = T + (size_t)MP * 1024; bf16* T2S = T2 + (size_t)MP * 1024; const bf16* XS = XN + (size_t)MP * 1024;
      float* PARTA = (float*)(a.ws + 2 * MiB); float* PARTB = (float*)(a.ws + 4 * MiB);
      { pg8::Gemm g{(const bf16*)(a.ws + WS_AO) + (size_t)MP * 512, (const bf16*)(a.ws + WS_WPA), 256, 1024, 512, 512}; pg8::StaticOrder S; S.init(256, 1024, G, bx); pg8::EpiMix<0> E{TS, nullptr}; GEMM_PHASE(pg8::EpiMix<0>); }
      { pg8::Gemm g{(const bf16*)(a.ws + WS_AO), (const bf16*)(a.ws + WS_WPA), MP, 1024, 512, 512}; pg8::StaticOrder S; S.init(MP, 1024, G, bx); pg8::EpiMix<0> E{T, nullptr}; GEMM_PHASE(pg8::EpiMix<0>); }
      { int ksub_ = 512; asm volatile("" : "+s"(ksub_)); pg8::Gemm g2{XS, WIN + (size_t)2560 * 1024, 256, 1024, ksub_, 1024}; pg8::SplitOrderT<4, 2, 512> S2; S2.init(G, (bx + G - 8) % G); pg8::EpiPartialT<4, 9> E2{PARTA}; GEMM_PHASE_SPLIT_T(4, 2, 512, 9); }
      { pg8::Gemm g{XN, WIN + (size_t)2560 * 1024, MP, 1024, 1024, 1024}; pg8::StaticOrder S; S.init(MP, 1024, G, bx); pg8::EpiMix<1> E{T, nullptr}; GEMM_PHASE(pg8::EpiMix<1>); }
      { pg8::Gemm g{(const bf16*)(a.ws + WS_BO) + (size_t)MP * 512, (const bf16*)(a.ws + WS_WPB), 256, 1024, 512, 512}; pg8::StaticOrder S; S.init(256, 1024, G, (bx + G - 16) % G); pg8::EpiMix<0> E{T2S, nullptr}; GEMM_PHASE(pg8::EpiMix<0>); }
      { pg8::Gemm g{(const bf16*)(a.ws + WS_BO), (const bf16*)(a.ws + WS_WPB), MP, 1024, 512, 512}; pg8::StaticOrder S; S.init(MP, 1024, G, bx); pg8::EpiMix<0> E{T2, nullptr}; GEMM_PHASE(pg8::EpiMix<0>); }
      { int ksub_ = 512; asm volatile("" : "+s"(ksub_)); pg8::Gemm g2{XS, WIN + (size_t)3584 * 1024, 256, 1024, ksub_, 1024}; pg8::SplitOrderT<4, 2, 512> S2; S2.init(G, (bx + G - 24) % G); pg8::EpiPartialT<4, 9> E2{PARTB}; GEMM_PHASE_SPLIT_T(4, 2, 512, 9); }
      { pg8::Gemm g{XN, WIN + (size_t)3584 * 1024, MP, 1024, 1024, 1024}; pg8::StaticOrder S; S.init(MP, 1024, G, bx); pg8::EpiMix<2> E{T, T2}; GEMM_PHASE(pg8::EpiMix<2>); }
      GSYNC();
      if (bx < 32) { pg8::EpiMix<1> E1{TS, nullptr}; pg8::reduce_rowgroup<2>(PARTA, bx & 3, bx >> 2, E1, wave);
                     pg8::EpiMix<2> E2{TS, T2S}; pg8::reduce_rowgroup<2>(PARTB, bx & 3, bx >> 2, E2, wave); } }
    GSYNC();
    if (PH(13)) { pg8::EpiRes E{Y, Y + (size_t)MP * 1024, Y, MOD + 5 * 1024, 1.0f}; const bf16* M1 = (const bf16*)(a.ws + WS_T1);
      { int ksub_ = 256; asm volatile("" : "+s"(ksub_)); pg8::Gemm g2{M1 + (size_t)MP * 1024, (const bf16*)(a.ws + WS_WOUT), 256, 1024, ksub_, 1024}; pg8::SplitOrderT<4, 4, 256> S2; S2.init(G, bx); pg8::EpiPartialT<4, 8> E2{(float*)(a.ws + WS_PART)}; GEMM_PHASE_SPLIT_T(4, 4, 256, 8); }
      { pg8::Gemm g{M1, (const bf16*)(a.ws + WS_WOUT), MP, 1024, 1024, 1024}; pg8::StaticOrder S; S.init(MP, 1024, G, bx); GEMM_PHASE(pg8::EpiRes); }
      GSYNC();
      if (bx < 32) pg8::reduce_rowgroup<4>((const float*)(a.ws + WS_PART), bx & 3, bx >> 2, E, wave); }
    GSYNC();
    if (PH(14)) norm_phase<false>(a, lds, Y, Y + (size_t)MP * 1024, a.in[24], 6, 7, gw, NGW, tid, lane);
    GSYNC();
    if (PH(15)) { pg8::Gemm g{XN, (const bf16*)(a.ws + WS_WGU2), M, 2 * FF, 1024, 1024}; pg8::StaticOrder S; S.init(M, 2 * FF, G, bx); pg8::EpiUp E{ACT, FF};
      GEMM_PHASE(pg8::EpiUp); }
    GSYNC();
    if (PH(16)) { pg8::EpiRes E{Y, Y + (size_t)MP * 1024, Y, MOD + 8 * 1024, 0.5f};
      { int ksub_ = 256; asm volatile("" : "+s"(ksub_)); pg8::Gemm g2{ACT + (size_t)MP * FF, (const bf16*)(a.ws + WS_WD2), 256, 1024, ksub_, FF}; pg8::SplitOrder S2; S2.init(G, bx); pg8::EpiPartial E2{(float*)(a.ws + WS_PART), 4, 256}; GEMM_PHASE_SPLIT(); }
      { pg8::Gemm g{ACT, (const bf16*)(a.ws + WS_WD2), MP, 1024, FF, FF}; pg8::StaticOrder S; S.init(MP, 1024, G, bx); GEMM_PHASE(pg8::EpiRes); }
      GSYNC();
      if (bx < 32) pg8::reduce_rowgroup<11>((const float*)(a.ws + WS_PART), bx & 3, bx >> 2, E, wave); }
    }
}


#undef tid
#undef lane
extern "C" void kernel_launch(void* const* d_in, const int* in_sizes, int n_in, void* d_out, int out_size, void* d_ws, size_t ws_size, hipStream_t stream) {
    static int grid = 0;
    if (grid == 0) {
        if (n_in != 28 || (size_t)out_size != O_END || ws_size < WS_END || in_sizes[0] != MP * 1024) { fprintf(stderr, "kernel_launch: unexpected shapes (n_in %d out %d ws %zu)\n", n_in, out_size, ws_size); grid = -1; return; }
        int dev = 0, cus = 0, per_cu = 0;
        hipGetDevice(&dev); hipDeviceGetAttribute(&cus, hipDeviceAttributeMultiprocessorCount, dev);
        if (hipFuncSetAttribute((const void*)fox_fwd, hipFuncAttributeMaxDynamicSharedMemorySize, LDS_BYTES) != hipSuccess) { fprintf(stderr, "kernel_launch: hipFuncSetAttribute failed\n"); grid = -1; return; }
        if (hipOccupancyMaxActiveBlocksPerMultiprocessor(&per_cu, (const void*)fox_fwd, NTHR, LDS_BYTES) != hipSuccess || per_cu < 1) { fprintf(stderr, "kernel_launch: occupancy query says %d\n", per_cu); per_cu = 1; }
        (void)hipGetLastError();
        grid = cus * 1;
    }
    if (grid < 0) return;
    if (hipMemsetAsync((char*)d_ws + WS_CTL, 0, CTL_ZERO_BYTES, stream) != hipSuccess) { fprintf(stderr, "kernel_launch: hipMemsetAsync failed\n"); return; }
    Args a{};
    for (int i = 0; i < 28; ++i) a.in[i] = (const float*)d_in[i];
    a.out = (float*)d_out; a.ws = (unsigned char*)d_ws;
    void* args[] = {&a};
    hipError_t e = hipLaunchCooperativeKernel((const void*)fox_fwd, dim3(grid), dim3(NTHR), args, LDS_BYTES, stream);
    if (e != hipSuccess) fprintf(stderr, "cooperative launch failed: %s (grid %d)\n", hipGetErrorString(e), grid);
}
```

```cpp
#include <hip/hip_runtime.h>
#include <hip/hip_cooperative_groups.h>
#include <cstdio>
#include <cstdint>
__device__ __forceinline__ int lane_id_() { return (int)__builtin_amdgcn_mbcnt_hi(~0u, __builtin_amdgcn_mbcnt_lo(~0u, 0u)); }
namespace pg8 {
#define PG8_LAS __attribute__((address_space(3)))
typedef unsigned short bf16_t;
typedef short bf16x8 __attribute__((ext_vector_type(8)));
typedef float f32x4 __attribute__((ext_vector_type(4)));
typedef unsigned u32x4 __attribute__((ext_vector_type(4)));
constexpr int BM = 256, BK = 64, HALF = 128, HTB = HALF * BK * 2  , STAGE_BYTES = 8 * HTB, NXCD = 8, WGM = 8;

__host__ __device__ __forceinline__ int lds_byte(int r, int c) { const int st = (r >> 4) * 2 + (c >> 5), rr = r & 15, cc = c & 31, ob = rr * 64 + cc * 2; return st * 1024 + (ob ^ (((ob >> 9) & 1) << 5)); }
__host__ __device__ __forceinline__ void stage_rc(int b, int& R, int& C) { const int st = b / 1024, sb = b % 1024, swz = sb ^ (((sb >> 9) & 1) << 5); R = (st >> 1) * 16 + swz / 64; C = (st & 1) * 32 + (swz % 64) / 2; }
__host__ __device__ __forceinline__ int perm32(int rho) { const int n = rho >> 4, i = rho & 15; return 8 * (i >> 2) + 4 * n + (i & 3); }

struct Unit { int pm, pn, koff; };
struct Gemm { const bf16_t* A; const bf16_t* Bt; int M, N, K, Kp; };

struct StaticOrder {
    int nM, nN, nwg, G, c;
    __host__ __device__ void init(int M, int N, int G_, int c_) { nM = M / BM; nN = N / BM; nwg = nM * nN; G = G_; c = c_; }
    __host__ __device__ bool next(int i, Unit& u) const {
        const long L = (long)i * G + c; if (L >= nwg) return false;
        int wgid = (int)L; { const int q = nwg / NXCD, r = nwg % NXCD, xcd = wgid % NXCD, off = wgid / NXCD; wgid = (xcd < r ? xcd * (q + 1) : r * (q + 1) + (xcd - r) * q) + off; }
        const int nig = WGM * nN, gid = wgid / nig, fm = gid * WGM, gsz = (nM - fm) < WGM ? (nM - fm) : WGM;
        u.pm = fm + ((wgid % nig) % gsz); u.pn = (wgid % nig) / gsz; u.koff = 0; return true;
    }
    __device__ __forceinline__ void a_ready(const Unit&) const {}
    __device__ __forceinline__ void done(const Unit&) const {}
};

template <int NN, int NS, int KSUB> struct SplitOrderT {
    int G, c;
    __host__ __device__ void init(int G_, int c_) { G = G_; c = c_; }
    __host__ __device__ bool next(int i, Unit& u) const { const int L = i * G + c; if (L >= NN * NS) return false; u.pm = 0; u.pn = L % NN; u.koff = (L / NN) * KSUB; return true; }
    __device__ __forceinline__ void a_ready(const Unit&) const {}
    __device__ __forceinline__ void done(const Unit&) const {}
};
typedef SplitOrderT<4, 11, 256> SplitOrder;
__device__ __forceinline__ unsigned cvt_pk_bf16(float lo, float hi) { unsigned r; asm volatile("v_cvt_pk_bf16_f32 %0, %1, %2" : "=v"(r) : "v"(lo), "v"(hi)); return r; }
typedef float f32x2 __attribute__((ext_vector_type(2)));
__device__ __forceinline__ f32x2 gelu_pk(f32x2 v) {
    const f32x2 av = __builtin_elementwise_abs(v), d = av * 0.2316418882f + 1.0f;
    f32x2 t; t.x = __builtin_amdgcn_rcpf(d.x); t.y = __builtin_amdgcn_rcpf(d.y);
    f32x2 q = t * 0.5307027145f + (-0.7265760135f); q = q * t + 0.7107068705f; q = q * t + (-0.142248368f); q = q * t + 0.127414796f; q = q * t;
    const f32x2 s = (v * v) * (-0.72134752044f);
    f32x2 e; e.x = __builtin_amdgcn_exp2f(s.x); e.y = __builtin_amdgcn_exp2f(s.y);
    const f32x2 m = v * (q * e), r = v - m;
    f32x2 o; o.x = v.x < 0.f ? m.x : r.x; o.y = v.y < 0.f ? m.y : r.y; return o;
}

constexpr int MPROMPT = 32768;
constexpr int NMODC = 9216;
typedef unsigned u32x2v __attribute__((ext_vector_type(2)));
__device__ __forceinline__ float sigm(float x) { return __builtin_amdgcn_rcpf(1.0f + __builtin_amdgcn_exp2f(-1.4426950408889634f * x)); }
__device__ __forceinline__ float gelu_tanh(float x) { const float y = 1.5957691216057308f * (x + 0.044715f * x * x * x); return x * sigm(y); }
__device__ __forceinline__ float bf_lo(unsigned w) { return __uint_as_float(w << 16); }
__device__ __forceinline__ float bf_hi(unsigned w) { return __uint_as_float(w & 0xffff0000u); }
__device__ __forceinline__ int mod_row(int pm, int rloc) { return pm < 128 ? (pm >> 6) : 2 + (rloc >> 5); }

struct EpiUp {
    static constexpr bool PERM = true, AFTER_DRAIN = false;
    bf16_t* ACT; int ldc;
    __device__ __forceinline__ void operator()(const f32x4 (&acc)[2][2][4][2], const Unit& u, int wr, int wc, int fr, int fq) const {
        int fr_ = fr, fq_ = fq; asm volatile("" : "+v"(fr_), "+v"(fq_));
        const int row0 = u.pm * BM + wr * 64 + fr_, ch0 = u.pn * HALF + wc * 32 + 8 * fq_;
#pragma unroll
        for (int ai = 0; ai < 2; ++ai)
#pragma unroll
            for (int m = 0; m < 4; ++m) {
                float o[8];
#pragma unroll
                for (int n = 0; n < 2; ++n)
#pragma unroll
                    for (int i = 0; i < 4; ++i) { const float g = acc[ai][0][m][n][i], up = acc[ai][1][m][n][i]; o[4 * n + i] = g * sigm(g) * up; }
                u32x4 w; w.x = cvt_pk_bf16(o[0], o[1]); w.y = cvt_pk_bf16(o[2], o[3]); w.z = cvt_pk_bf16(o[4], o[5]); w.w = cvt_pk_bf16(o[6], o[7]);
                *(u32x4*)(ACT + (size_t)(row0 + ai * HALF + m * 16) * ldc + ch0) = w;
            }
    }
};
struct EpiRes {
    static constexpr bool PERM = true, AFTER_DRAIN = false;
    const float* resp; const float* ress; float* out; const float* gate; float fac;
    __device__ __forceinline__ void rowgroup(const f32x4 (&v)[2][2], int pn, int ai, int m, int wr, int wc, int fr, int fq) const {
        const int rl = wr * 64 + fr + ai * HALF + m * 16, col0 = pn * BM + wc * 32 + 8 * fq;
        const float* gp = gate + (size_t)(2 + (rl >> 5)) * NMODC + col0; float* obase = out + (size_t)128 * BM * 1024;
#pragma unroll
        for (int bj = 0; bj < 2; ++bj)
#pragma unroll
            for (int n = 0; n < 2; ++n) { const size_t off = (size_t)rl * 1024 + col0 + bj * HALF + 4 * n;
                const f32x4 gv = *(const f32x4*)(gp + bj * HALF + 4 * n), rv = *(const f32x4*)(ress + off);
                *(f32x4*)(obase + off) = rv + (gv * fac) * v[bj][n]; }
    }
    __device__ __forceinline__ void operator()(const f32x4 (&acc)[2][2][4][2], const Unit& u, int wr, int wc, int fr, int fq) const {
        int fr_ = fr, fq_ = fq; asm volatile("" : "+v"(fr_), "+v"(fq_));
        const int rl0 = wr * 64 + fr_, col0 = u.pn * BM + wc * 32 + 8 * fq_;
        const float* rbase = (u.pm < 128) ? resp + (size_t)u.pm * BM * 1024 : ress;
        float* obase = out + (size_t)u.pm * BM * 1024;
#pragma unroll
        for (int ai = 0; ai < 2; ++ai)
#pragma unroll
            for (int m = 0; m < 4; ++m) {
                const int rl = rl0 + ai * HALF + m * 16; const float* gp = gate + (size_t)mod_row(u.pm, rl) * NMODC + col0;
                f32x4 gv4[2][2], rv4[2][2];
#pragma unroll
                for (int bj = 0; bj < 2; ++bj)
#pragma unroll
                    for (int n = 0; n < 2; ++n) { gv4[bj][n] = *(const f32x4*)(gp + bj * HALF + 4 * n); rv4[bj][n] = *(const f32x4*)(rbase + (size_t)rl * 1024 + col0 + bj * HALF + 4 * n); }
#pragma unroll
                for (int bj = 0; bj < 2; ++bj)
#pragma unroll
                    for (int n = 0; n < 2; ++n) *(f32x4*)(obase + (size_t)rl * 1024 + col0 + bj * HALF + 4 * n) = rv4[bj][n] + (gv4[bj][n] * fac) * acc[ai][bj][m][n];
            }
    }
};
struct EpiIn {
    static constexpr bool PERM = true, AFTER_DRAIN = false;
    bf16_t *Q, *K, *V, *U, *G2, *SGA, *SGB; float* G2SS; float* QS;
    float *kout_p, *kout_s, *vout_p, *vout_s;
    const float *gq, *gk; float qscale, eps;
    __device__ __forceinline__ void operator()(const f32x4 (&acc)[2][2][4][2], const Unit& u, int wr, int wc, int fr, int fq) const {
        int fr_ = fr, fq_ = fq; asm volatile("" : "+v"(fr_), "+v"(fq_));
        const int pn = u.pn, rl0 = wr * 64 + fr_; const size_t rg0 = (size_t)u.pm * BM;
        if (pn < 4) {
            const bool isq = pn < 2; const int head = 4 * (pn & 1) + wc; const float* gsrc = isq ? gq : gk;
            f32x4 gv[2][2];
#pragma unroll
            for (int bj = 0; bj < 2; ++bj)
#pragma unroll
                for (int n = 0; n < 2; ++n) { gv[bj][n] = *(const f32x4*)(gsrc + 32 * bj + 8 * fq_ + 4 * n); if (isq) gv[bj][n] = gv[bj][n] * qscale; }
            bf16_t* dst = isq ? Q : K;
#pragma unroll
            for (int ai = 0; ai < 2; ++ai)
#pragma unroll
                for (int m = 0; m < 4; ++m) {
                    float ss = 0.f;
#pragma unroll
                    for (int bj = 0; bj < 2; ++bj)
#pragma unroll
                        for (int n = 0; n < 2; ++n) { const f32x4 x = acc[ai][bj][m][n]; ss += (x[0] * x[0] + x[1] * x[1]) + (x[2] * x[2] + x[3] * x[3]); }
                    ss += __shfl_xor(ss, 16); ss += __shfl_xor(ss, 32);
                    const float rstd = 1.0f / sqrtf(ss * (1.0f / 64.0f) + eps);
                    const int rl = rl0 + ai * HALF + m * 16; const size_t r = rg0 + rl;
#pragma unroll
                    for (int bj = 0; bj < 2; ++bj) {
                        const f32x4 o0 = acc[ai][bj][m][0] * rstd * gv[bj][0], o1 = acc[ai][bj][m][1] * rstd * gv[bj][1];
                        const int c = head * 64 + 32 * bj + 8 * fq_;
                        u32x4 w; w.x = cvt_pk_bf16(o0[0], o0[1]); w.y = cvt_pk_bf16(o0[2], o0[3]); w.z = cvt_pk_bf16(o1[0], o1[1]); w.w = cvt_pk_bf16(o1[2], o1[3]);
                        *(u32x4*)(dst + r * 512 + c) = w;
                        if (isq) { if (u.pm == 128) { float* qp = QS + (size_t)rl * 512 + c; *(f32x4*)qp = o0; *(f32x4*)(qp + 4) = o1; } }
                        else { float* kp = (u.pm < 128) ? kout_p + r * 512 + c : kout_s + (size_t)rl * 512 + c; *(f32x4*)kp = o0; *(f32x4*)(kp + 4) = o1; }
                    }
                    asm volatile("" ::: "memory");
                }
        } else if (pn < 6) {
            const int c0 = (pn - 4) * BM + wc * 32 + 8 * fq_;
#pragma unroll
            for (int ai = 0; ai < 2; ++ai)
#pragma unroll
                for (int m = 0; m < 4; ++m) { const int rl = rl0 + ai * HALF + m * 16; const size_t r = rg0 + rl;
#pragma unroll
                    for (int bj = 0; bj < 2; ++bj) { const f32x4 o0 = acc[ai][bj][m][0], o1 = acc[ai][bj][m][1]; const int c = c0 + bj * HALF;
                        u32x4 w; w.x = cvt_pk_bf16(o0[0], o0[1]); w.y = cvt_pk_bf16(o0[2], o0[3]); w.z = cvt_pk_bf16(o1[0], o1[1]); w.w = cvt_pk_bf16(o1[2], o1[3]);
                        *(u32x4*)(V + r * 512 + c) = w;
                        float* vp = (u.pm < 128) ? vout_p + r * 512 + c : vout_s + (size_t)rl * 512 + c;
                        { *(f32x4*)vp = o0; *(f32x4*)(vp + 4) = o1; } } asm volatile("" ::: "memory"); }
        } else if (pn < 10) {
            const bool isv = pn >= 8; const int t2 = (pn - 6) & 1; const int c0 = t2 * BM + wc * 32 + 8 * fq_; bf16_t* dst = isv ? G2 : U;
#pragma unroll
            for (int ai = 0; ai < 2; ++ai)
#pragma unroll
                for (int m = 0; m < 4; ++m) { const int rl = rl0 + ai * HALF + m * 16; const size_t r = rg0 + rl; float ss = 0.f;
#pragma unroll
                    for (int bj = 0; bj < 2; ++bj) { float o[8];
#pragma unroll
                        for (int n = 0; n < 2; ++n)
#pragma unroll
                            for (int i = 0; i < 4; ++i) { const float g = gelu_tanh(acc[ai][bj][m][n][i]); o[4 * n + i] = g; ss += g * g; }
                        u32x4 w; w.x = cvt_pk_bf16(o[0], o[1]); w.y = cvt_pk_bf16(o[2], o[3]); w.z = cvt_pk_bf16(o[4], o[5]); w.w = cvt_pk_bf16(o[6], o[7]);
                        *(u32x4*)(dst + r * 512 + c0 + bj * HALF) = w; }
                    if (isv) { ss += __shfl_xor(ss, 16); ss += __shfl_xor(ss, 32); if (fq_ == 0) G2SS[r * 8 + t2 * 4 + wc] = ss; } asm volatile("" ::: "memory"); }
        } else {
            const bool isa = pn < 14; const int c0 = ((pn - 10) & 3) * BM + wc * 32 + 8 * fq_; bf16_t* dst = isa ? SGA : SGB;
#pragma unroll
            for (int ai = 0; ai < 2; ++ai)
#pragma unroll
                for (int m = 0; m < 4; ++m) { const size_t r = rg0 + rl0 + ai * HALF + m * 16;
#pragma unroll
                    for (int bj = 0; bj < 2; ++bj) { float o[8];
#pragma unroll
                        for (int n = 0; n < 2; ++n)
#pragma unroll
                            for (int i = 0; i < 4; ++i) o[4 * n + i] = sigm(acc[ai][bj][m][n][i]);
                        u32x4 w; w.x = cvt_pk_bf16(o[0], o[1]); w.y = cvt_pk_bf16(o[2], o[3]); w.z = cvt_pk_bf16(o[4], o[5]); w.w = cvt_pk_bf16(o[6], o[7]);
                        *(u32x4*)(dst + r * 1024 + c0 + bj * HALF) = w;
                        } asm volatile("" ::: "memory"); }
        }
    }
};
struct EpiPartial {
    static constexpr bool PERM = true, AFTER_DRAIN = false;
    float* PART; int nN, Ksub;
    __device__ __forceinline__ void operator()(const f32x4 (&acc)[2][2][4][2], const Unit& u, int wr, int wc, int fr, int fq) const {
        int tid_ = (wr * 4 + wc) * 64 + fq * 16 + fr; asm volatile("" : "+v"(tid_));
        f32x4* dst = (f32x4*)PART + (size_t)((u.koff >> 8) * 4 + u.pn) * 32 * 512 + tid_;
#pragma unroll
        for (int ai = 0; ai < 2; ++ai)
#pragma unroll
            for (int bj = 0; bj < 2; ++bj)
#pragma unroll
                for (int m = 0; m < 4; ++m)
#pragma unroll
                    for (int n = 0; n < 2; ++n) { *dst = acc[ai][bj][m][n]; dst += 512; asm volatile("" : "+v"(dst) :: "memory"); }
        asm volatile("" ::: "memory");
    }
};
template <int NN, int KSHIFT> struct EpiPartialT {
    static constexpr bool PERM = true, AFTER_DRAIN = false;
    float* PART;
    __device__ __forceinline__ void operator()(const f32x4 (&acc)[2][2][4][2], const Unit& u, int wr, int wc, int fr, int fq) const {
        int tid_ = (wr * 4 + wc) * 64 + fq * 16 + fr; asm volatile("" : "+v"(tid_));
        f32x4* dst = (f32x4*)PART + (size_t)((u.koff >> KSHIFT) * NN + u.pn) * 32 * 512 + tid_;
#pragma unroll
        for (int ai = 0; ai < 2; ++ai)
#pragma unroll
            for (int bj = 0; bj < 2; ++bj)
#pragma unroll
                for (int m = 0; m < 4; ++m)
#pragma unroll
                    for (int n = 0; n < 2; ++n) { *dst = acc[ai][bj][m][n]; dst += 512; asm volatile("" : "+v"(dst) :: "memory"); }
    }
};
template <class Epi> __device__ __forceinline__ void reduce_partials(const float* PART, int nN, int nS, int pn, int pm_out, const Epi& E, int wv) {
    int tid = (wv << 6) | lane_id_(); asm volatile("" : "+v"(tid));
    const int wid = __builtin_amdgcn_readfirstlane(tid >> 6), lane = tid & 63, wr = wid >> 2, wc = wid & 3, fr = lane & 15, fq = lane >> 4;
    f32x4 acc[2][2][4][2];
#pragma unroll
    for (int ai = 0; ai < 2; ++ai)
#pragma unroll
        for (int bj = 0; bj < 2; ++bj)
#pragma unroll
            for (int m = 0; m < 4; ++m)
#pragma unroll
                for (int n = 0; n < 2; ++n) acc[ai][bj][m][n] = (f32x4){0.f, 0.f, 0.f, 0.f};
#pragma unroll 1
    for (int s = 0; s < nS; ++s) { const f32x4* src = (const f32x4*)PART + (size_t)(s * nN + pn) * 32 * 512 + tid;
#pragma unroll
        for (int ai = 0; ai < 2; ++ai) {
            f32x4 t[2][4][2];
#pragma unroll
            for (int bj = 0; bj < 2; ++bj)
#pragma unroll
                for (int m = 0; m < 4; ++m)
#pragma unroll
                    for (int n = 0; n < 2; ++n) { t[bj][m][n] = *src; src += 512; asm volatile("" : "+v"(src)); }
#pragma unroll
            for (int bj = 0; bj < 2; ++bj)
#pragma unroll
                for (int m = 0; m < 4; ++m)
#pragma unroll
                    for (int n = 0; n < 2; ++n) acc[ai][bj][m][n] += t[bj][m][n];
            asm volatile("" ::: "memory"); } }
    Unit u; u.pm = pm_out; u.pn = pn; u.koff = 0;
    E(acc, u, wr, wc, fr, fq);
}
template <int NS, class Epi> __device__ __forceinline__ void reduce_rowgroup(const float* PART, int pn, int rg, const Epi& E, int wv) {
    int tid = (wv << 6) | lane_id_(); asm volatile("" : "+v"(tid));
    const int wid = __builtin_amdgcn_readfirstlane(tid >> 6), lane = tid & 63, wr = wid >> 2, wc = wid & 3, fr = lane & 15, fq = lane >> 4;
    const int ai = rg >> 2, m = rg & 3;
    f32x4 t[NS][2][2];
#pragma unroll
    for (int s = 0; s < NS; ++s)
#pragma unroll
        for (int bj = 0; bj < 2; ++bj)
#pragma unroll
            for (int n = 0; n < 2; ++n) t[s][bj][n] = *((const f32x4*)PART + ((size_t)(s * 4 + pn) * 32 + (((ai * 2 + bj) * 4 + m) * 2 + n)) * 512 + tid);
    f32x4 v[2][2];
#pragma unroll
    for (int bj = 0; bj < 2; ++bj)
#pragma unroll
        for (int n = 0; n < 2; ++n) { v[bj][n] = t[0][bj][n];
#pragma unroll
            for (int s = 1; s < NS; ++s) v[bj][n] += t[s][bj][n]; }
    E.rowgroup(v, pn, ai, m, wr, wc, fr, fq);
}
template <int MODE> struct EpiMix {
    static constexpr bool PERM = true, AFTER_DRAIN = false;
    bf16_t* T; const bf16_t* T2;
    __device__ __forceinline__ void one(size_t off, const f32x4 a0, const f32x4 a1) const {
        float o[8] = {a0[0], a0[1], a0[2], a0[3], a1[0], a1[1], a1[2], a1[3]};
        if (MODE >= 1) {
            const u32x4 t = *(const u32x4*)(T + off);
            const float tv[8] = {bf_lo(t.x), bf_hi(t.x), bf_lo(t.y), bf_hi(t.y), bf_lo(t.z), bf_hi(t.z), bf_lo(t.w), bf_hi(t.w)};
            if (MODE == 1) {
#pragma unroll
                for (int i = 0; i < 8; ++i) o[i] = sigm(o[i]) * tv[i];
            } else {
                const u32x4 s2 = *(const u32x4*)(T2 + off);
                const float sv[8] = {bf_lo(s2.x), bf_hi(s2.x), bf_lo(s2.y), bf_hi(s2.y), bf_lo(s2.z), bf_hi(s2.z), bf_lo(s2.w), bf_hi(s2.w)};
#pragma unroll
                for (int i = 0; i < 8; ++i) o[i] = tv[i] + sigm(o[i]) * sv[i];
            }
        }
        u32x4 w; w.x = cvt_pk_bf16(o[0], o[1]); w.y = cvt_pk_bf16(o[2], o[3]); w.z = cvt_pk_bf16(o[4], o[5]); w.w = cvt_pk_bf16(o[6], o[7]);
        *(u32x4*)(T + off) = w;
    }
    __device__ __forceinline__ void operator()(const f32x4 (&acc)[2][2][4][2], const Unit& u, int wr, int wc, int fr, int fq) const {
        int fr_ = fr, fq_ = fq; asm volatile("" : "+v"(fr_), "+v"(fq_));
        const size_t row0 = (size_t)u.pm * BM + wr * 64 + fr_; const int col0 = u.pn * BM + wc * 32 + 8 * fq_;
#pragma unroll
        for (int ai = 0; ai < 2; ++ai)
#pragma unroll
            for (int m = 0; m < 4; ++m) {
#pragma unroll
                for (int bj = 0; bj < 2; ++bj) one((row0 + ai * HALF + m * 16) * 1024 + col0 + bj * HALF, acc[ai][bj][m][0], acc[ai][bj][m][1]);
                asm volatile("" ::: "memory");
            }
    }
    __device__ __forceinline__ void rowgroup(const f32x4 (&v)[2][2], int pn, int ai, int m, int wr, int wc, int fr, int fq) const {
        const size_t row = (size_t)(wr * 64 + fr + ai * HALF + m * 16); const int col0 = pn * BM + wc * 32 + 8 * fq;
#pragma unroll
        for (int bj = 0; bj < 2; ++bj) one(row * 1024 + col0 + bj * HALF, v[bj][0], v[bj][1]);
    }
};
template <class Epi, class Sched, bool ALIGN_EPI = false, bool SP2 = false>
__device__ __forceinline__ void gemm_phase(PG8_LAS unsigned char* lds, const Gemm g, const Sched& S, const Epi& E, int wv) {
    int tid = (wv << 6) | lane_id_(); asm volatile("" : "+v"(tid));
    const int wid = __builtin_amdgcn_readfirstlane(tid >> 6), lane = tid & 63, wr = wid >> 2, wc = wid & 3, fr = lane & 15, fq = lane >> 4;
    const int K = g.Kp, nt = g.K / BK;
    unsigned voffA[2], voffB[2];
#pragma unroll
    for (int i = 0; i < 2; ++i) { int R, C; stage_rc(tid * 16 + i * 8192, R, C); const int Rb = Epi::PERM ? ((R & ~31) + perm32(R & 31)) : R;
        voffA[i] = (unsigned)(R * K + C) * 2u; voffB[i] = (unsigned)(Rb * K + C) * 2u; }
    const size_t kstep = (size_t)(BK * 2);
    const size_t hstep = (size_t)HALF * K * 2;
    const size_t tstep = 2 * hstep;
    const unsigned ldsw = (unsigned)wid * 1024u;
    const int aoff = lds_byte(wr * 64 + fr, fq * 8), boff = lds_byte(wc * 32 + fr, fq * 8);
#define PG8_SA(b, h) (((b) * 2 + (h)) * HTB)
#define PG8_SB(b, h) ((4 + (b) * 2 + (h)) * HTB)
#define PG8_STAGE(bufoff, gbase, voff) do { _Pragma("unroll") for (int _i = 0; _i < 2; ++_i) \
        __builtin_amdgcn_global_load_lds((const unsigned*)((const char*)(gbase) + (voff)[_i]), (PG8_LAS unsigned*)(lds + (bufoff) + ldsw + _i * 8192), 16, 0, 0); } while (0)
#define PG8_LDA(dst, b, h) do { _Pragma("unroll") for (int m = 0; m < 4; ++m) _Pragma("unroll") for (int k = 0; k < 2; ++k) dst[m][k] = *(const PG8_LAS bf16x8*)(lds + PG8_SA(b, h) + aoff + m * 2048 + k * 1024); } while (0)
#define PG8_LDB(dst, b, h) do { _Pragma("unroll") for (int n = 0; n < 2; ++n) _Pragma("unroll") for (int k = 0; k < 2; ++k) dst[n][k] = *(const PG8_LAS bf16x8*)(lds + PG8_SB(b, h) + boff + n * 2048 + k * 1024); } while (0)
#define PG8_MMA(ai, bj, At, Bt) do { __builtin_amdgcn_s_setprio(1); _Pragma("unroll") for (int m = 0; m < 4; ++m) _Pragma("unroll") for (int n = 0; n < 2; ++n) _Pragma("unroll") for (int k = 0; k < 2; ++k) \
        acc[ai][bj][m][n] = __builtin_amdgcn_mfma_f32_16x16x32_bf16(Bt[n][k], At[m][k], acc[ai][bj][m][n], 0, 0, 0); __builtin_amdgcn_s_setprio(0); } while (0)
#define PG8_WAIT_V(n) asm volatile("s_waitcnt vmcnt(" #n ")" ::: "memory")
#define PG8_WAIT_L(n) asm volatile("s_waitcnt lgkmcnt(" #n ")" ::: "memory")
#define PG8_BAR __builtin_amdgcn_s_barrier()
#define PG8_SCHED __builtin_amdgcn_sched_barrier(0)
    Unit cur, nxt; int ui = 0;
    if (!S.next(0, cur)) return;
    f32x4 acc[2][2][4][2];
#pragma unroll
    for (int a = 0; a < 2; ++a)
#pragma unroll
        for (int b = 0; b < 2; ++b)
#pragma unroll
            for (int m = 0; m < 4; ++m)
#pragma unroll
                for (int n = 0; n < 2; ++n) acc[a][b][m][n] = (f32x4){0.f, 0.f, 0.f, 0.f};
    bf16x8 At[4][2], B0[2][2], B1[2][2];
    const char* cA = (const char*)g.A + (size_t)cur.pm * tstep + (size_t)cur.koff * 2; const char* cB = (const char*)g.Bt + (size_t)cur.pn * tstep + (size_t)cur.koff * 2;
    S.a_ready(cur);
    if constexpr (SP2) {
        PG8_STAGE(PG8_SB(0, 0), cB, voffB); PG8_STAGE(PG8_SB(0, 1), cB + hstep, voffB); PG8_STAGE(PG8_SA(0, 0), cA, voffA); PG8_STAGE(PG8_SA(0, 1), cA + hstep, voffA);
        if (wr == 1) PG8_BAR;
        PG8_WAIT_V(2); PG8_BAR;
        PG8_STAGE(PG8_SB(1, 0), cB + kstep, voffB); PG8_STAGE(PG8_SA(1, 0), cA + kstep, voffA); PG8_STAGE(PG8_SB(1, 1), cB + hstep + kstep, voffB);
        PG8_WAIT_V(6); PG8_BAR;
    } else {
        PG8_STAGE(PG8_SB(0, 0), cB, voffB); PG8_STAGE(PG8_SA(0, 0), cA, voffA); PG8_STAGE(PG8_SB(0, 1), cB + hstep, voffB); PG8_STAGE(PG8_SA(0, 1), cA + hstep, voffA);
        if (wr == 1) PG8_BAR;
        PG8_WAIT_V(4); PG8_BAR;
        PG8_STAGE(PG8_SB(1, 0), cB + kstep, voffB); PG8_STAGE(PG8_SA(1, 0), cA + kstep, voffA); PG8_STAGE(PG8_SB(1, 1), cB + hstep + kstep, voffB);
        PG8_WAIT_V(6); PG8_BAR;
    }
    for (;;) {
        const bool has_next = S.next(ui + 1, nxt);
        const char* nA = has_next ? (const char*)g.A + (size_t)nxt.pm * tstep + (size_t)nxt.koff * 2 : cA; const char* nB = has_next ? (const char*)g.Bt + (size_t)nxt.pn * tstep + (size_t)nxt.koff * 2 : cB;
        for (int t = 0; t < nt; t += 2) {
            const bool last = (t == nt - 2);
            const char* a1 = cA + (size_t)(t + 1) * kstep;
            const char* a2 = last ? nA : cA + (size_t)(t + 2) * kstep; const char* b2 = last ? nB : cB + (size_t)(t + 2) * kstep;
            const char* a3 = a2 + kstep; const char* b3 = b2 + kstep;
            if (last && has_next) S.a_ready(nxt);
            if constexpr (SP2) {
            PG8_LDB(B0, 0, 0); PG8_LDB(B1, 0, 1); PG8_SCHED; PG8_LDA(At, 0, 0); PG8_STAGE(PG8_SA(1, 1), a1 + hstep, voffA);
            PG8_WAIT_V(8); PG8_WAIT_L(0); PG8_BAR; PG8_MMA(0, 0, At, B0); PG8_MMA(0, 1, At, B1); PG8_BAR; PG8_SCHED;
            PG8_LDA(At, 0, 1); PG8_STAGE(PG8_SB(0, 0), b2, voffB); PG8_STAGE(PG8_SB(0, 1), b2 + hstep, voffB); PG8_STAGE(PG8_SA(0, 0), a2, voffA);
            PG8_WAIT_V(8); PG8_WAIT_L(0); PG8_BAR; PG8_MMA(1, 0, At, B0); PG8_MMA(1, 1, At, B1); PG8_BAR; PG8_SCHED;
            PG8_LDB(B0, 1, 0); PG8_LDB(B1, 1, 1); PG8_SCHED; PG8_LDA(At, 1, 0); PG8_STAGE(PG8_SA(0, 1), a2 + hstep, voffA);
            PG8_WAIT_V(8); PG8_WAIT_L(0); PG8_BAR; PG8_MMA(0, 0, At, B0); PG8_MMA(0, 1, At, B1); PG8_BAR; PG8_SCHED;
            PG8_LDA(At, 1, 1); PG8_STAGE(PG8_SB(1, 0), b3, voffB); PG8_STAGE(PG8_SB(1, 1), b3 + hstep, voffB); PG8_STAGE(PG8_SA(1, 0), a3, voffA);
            PG8_WAIT_V(8); PG8_WAIT_L(0); PG8_BAR; PG8_MMA(1, 0, At, B0); PG8_MMA(1, 1, At, B1); PG8_BAR; PG8_SCHED;
            } else {
            PG8_LDB(B0, 0, 0); PG8_SCHED; PG8_LDA(At, 0, 0); PG8_STAGE(PG8_SA(1, 1), a1 + hstep, voffA);
            PG8_WAIT_L(8); PG8_BAR; PG8_WAIT_L(0); PG8_MMA(0, 0, At, B0); PG8_BAR; PG8_SCHED;
            PG8_LDB(B1, 0, 1); PG8_STAGE(PG8_SB(0, 0), b2, voffB);
            PG8_BAR; PG8_WAIT_L(0); PG8_MMA(0, 1, At, B1); PG8_BAR;
            PG8_LDA(At, 0, 1); PG8_STAGE(PG8_SA(0, 0), a2, voffA);
            PG8_BAR; PG8_WAIT_L(0); PG8_MMA(1, 0, At, B0); PG8_BAR; PG8_SCHED;
            PG8_STAGE(PG8_SB(0, 1), b2 + hstep, voffB);
            PG8_WAIT_V(6); PG8_BAR; PG8_MMA(1, 1, At, B1); PG8_BAR;
            PG8_LDB(B0, 1, 0); PG8_SCHED; PG8_LDA(At, 1, 0); PG8_STAGE(PG8_SA(0, 1), a2 + hstep, voffA);
            PG8_WAIT_L(8); PG8_BAR; PG8_WAIT_L(0); PG8_MMA(0, 0, At, B0); PG8_BAR; PG8_SCHED;
            PG8_LDB(B1, 1, 1); PG8_STAGE(PG8_SB(1, 0), b3, voffB);
            PG8_BAR; PG8_WAIT_L(0); PG8_MMA(0, 1, At, B1); PG8_BAR;
            PG8_LDA(At, 1, 1); PG8_STAGE(PG8_SA(1, 0), a3, voffA);
            PG8_BAR; PG8_WAIT_L(0); PG8_MMA(1, 0, At, B0); PG8_BAR; PG8_SCHED;
            PG8_STAGE(PG8_SB(1, 1), b3 + hstep, voffB);
            PG8_WAIT_V(6); PG8_BAR; PG8_MMA(1, 1, At, B1); PG8_BAR;
            }
        }
        if constexpr (ALIGN_EPI) { if (wr == 0) PG8_BAR; }
        if constexpr (!Epi::AFTER_DRAIN) { E(acc, cur, wr, wc, fr, fq); S.done(cur); }
        if (!has_next) break;
#pragma unroll
        for (int a = 0; a < 2; ++a)
#pragma unroll
            for (int b = 0; b < 2; ++b)
#pragma unroll
                for (int m = 0; m < 4; ++m)
#pragma unroll
                    for (int n = 0; n < 2; ++n) acc[a][b][m][n] = (f32x4){0.f, 0.f, 0.f, 0.f};
        cur = nxt; cA = nA; cB = nB; ++ui;
        if constexpr (ALIGN_EPI) { if (wr == 1) PG8_BAR; }
    }
    PG8_WAIT_V(0);
    if constexpr (!ALIGN_EPI) { if (wr == 0) PG8_BAR; }
    PG8_BAR;
    if constexpr (Epi::AFTER_DRAIN) { E.fused(acc, cur, wr, wc, fr, fq, lds, wid, lane); S.done(cur); }
#undef PG8_SA
#undef PG8_SB
#undef PG8_STAGE
#undef PG8_LDA
#undef PG8_LDB
#undef PG8_MMA
#undef PG8_WAIT_V
#undef PG8_WAIT_L
#undef PG8_BAR
#undef PG8_SCHED
}

template <class Epi, class Sched>
__device__ __forceinline__ void naive_phase(const Gemm g, const Sched& S, const Epi& E) {
    int tid = threadIdx.x; asm volatile("" : "+v"(tid));
    const int wid = __builtin_amdgcn_readfirstlane(tid >> 6), lane = tid & 63, wr = wid >> 2, wc = wid & 3, fr = lane & 15, fq = lane >> 4;
    Unit u;
#pragma unroll 1
    for (int ui = 0; S.next(ui, u); ++ui) {
        f32x4 acc[2][2][4][2];
#pragma unroll
        for (int ai = 0; ai < 2; ++ai)
#pragma unroll
            for (int m = 0; m < 4; ++m) {
                const bf16_t* arow = g.A + (size_t)(u.pm * BM + ai * HALF + wr * 64 + m * 16 + fr) * g.Kp;
#pragma unroll
                for (int bj = 0; bj < 2; ++bj)
#pragma unroll
                    for (int n = 0; n < 2; ++n)
#pragma unroll
                        for (int i = 0; i < 4; ++i) {
                            const bf16_t* brow = g.Bt + (size_t)(u.pn * BM + bj * HALF + wc * 32 + 8 * fq + 4 * n + i) * g.Kp;
                            float s = 0.f;
#pragma unroll 1
                            for (int k = 0; k < g.K; k += 8) { const u32x4 a = *(const u32x4*)(arow + k), b = *(const u32x4*)(brow + k);
                                s += bf_lo(a.x) * bf_lo(b.x) + bf_hi(a.x) * bf_hi(b.x) + bf_lo(a.y) * bf_lo(b.y) + bf_hi(a.y) * bf_hi(b.y)
                                   + bf_lo(a.z) * bf_lo(b.z) + bf_hi(a.z) * bf_hi(b.z) + bf_lo(a.w) * bf_lo(b.w) + bf_hi(a.w) * bf_hi(b.w); }
                            acc[ai][bj][m][n][i] = s;
                        }
            }
        E(acc, u, wr, wc, fr, fq);
    }
    __syncthreads();
}
}
#include <hip/hip_bf16.h>
#include <cmath>
namespace attn_body {
using bf16=__hip_bfloat16;
using bf16x8=__attribute__((ext_vector_type(8)))short;
using s16x4=__attribute__((ext_vector_type(4)))short;
using f32x16=__attribute__((ext_vector_type(16)))float;
using u32x4=__attribute__((ext_vector_type(4)))unsigned;
using f32x4_t=__attribute__((ext_vector_type(4)))float;
constexpr int BATCH=2,NHEAD=8,SEQ=16384,D=64,DM=NHEAD*D;
constexpr int NW=8,QBLK=32,QB=QBLK*NW,KVBLK=64,NQB=SEQ/QB;
constexpr int ATTN_PITCH=DM, ATTN_UNIT_ROWS=QB;
__device__ __forceinline__ int crow(int r,int hi){return (r&3)+8*(r>>2)+4*hi;}
#define SBAR() __builtin_amdgcn_sched_barrier(0)
__device__ __forceinline__ void cmask(f32x16&p0,f32x16&p1,int jb,int qrel,int hi){
  const float NEG=-INFINITY; int kb=64*jb+4*hi;
  #pragma unroll
  for(int r=0;r<16;++r){int kv=kb+(r&3)+8*(r>>2); if(kv>qrel)p0[r]=NEG; if(kv+32>qrel)p1[r]=NEG;}
}

constexpr int NSLOT=3, SLOTB=8192;
constexpr int LDS_K=0, LDS_V=NSLOT*SLOTB, LDS_WS=2*NSLOT*SLOTB, LDS_OST=LDS_WS+NW*64*4, LDS_BYTES=LDS_OST+NW*4096, LDS_BIAS=LDS_BYTES, LDS_TOTAL=LDS_BIAS+SEQ*4;
constexpr float C2=0.125f*1.4426950408889634f;
__device__ __forceinline__ void glds16(const void*gsrc,unsigned lds_dst){unsigned keep;
  asm volatile("s_mov_b32 %0, m0\n\ts_mov_b32 m0, %2\n\ts_nop 0\n\tglobal_load_lds_dwordx4 %1, off\n\ts_mov_b32 m0, %0":"=&s"(keep):"v"(gsrc),"s"(lds_dst):"memory");}
__device__ __forceinline__ float max3f(float a,float b,float c){float r;asm("v_max3_f32 %0, %1, %2, %3":"=v"(r):"v"(a),"v"(b),"v"(c));return r;}
__device__ __forceinline__ float max2f(float a,float b){float r;asm("v_max_f32_e32 %0, %1, %2":"=v"(r):"v"(a),"v"(b));return r;}
__device__ __forceinline__ float fadd_s(float a,float b){float r;asm("v_add_f32_e32 %0, %1, %2":"=v"(r):"v"(a),"v"(b));return r;}
__device__ __forceinline__ float fsub_s(float a,float b){float r;asm("v_sub_f32_e32 %0, %1, %2":"=v"(r):"v"(a),"v"(b));return r;}
typedef float f32x2_t __attribute__((ext_vector_type(2))); typedef __bf16 bf16x2_t __attribute__((ext_vector_type(2)));
__device__ __forceinline__ unsigned cvtpk_s(float lo,float hi){f32x2_t v={lo,hi};bf16x2_t b=__builtin_convertvector(v,bf16x2_t);return __builtin_bit_cast(unsigned,b);}
#define WAIT_BAR(N) asm volatile("s_waitcnt vmcnt(" #N ") lgkmcnt(0)\n\ts_barrier":::"memory")

__device__ __forceinline__ void qkt(f32x16&p0,f32x16&p1,const char*Kslot,const bf16x8*qr,int r32,int hi){
  const char*kb=Kslot+hi*1024+r32*16;
  #pragma unroll
  for(int d0=0;d0<4;++d0){
    const bf16x8 b0=*reinterpret_cast<const bf16x8*>(kb+d0*2048);
    const bf16x8 b1=*reinterpret_cast<const bf16x8*>(kb+d0*2048+512);
    p0=__builtin_amdgcn_mfma_f32_32x32x16_bf16(b0,qr[d0],p0,0,0,0);p1=__builtin_amdgcn_mfma_f32_32x32x16_bf16(b1,qr[d0],p1,0,0,0);}
}
typedef __attribute__((address_space(3))) const char* lds_cptr;
typedef short v4i16_t __attribute__((ext_vector_type(4)));
__device__ __forceinline__ void kload8(bf16x8*kf,lds_cptr kp){
  kf[0]=*(const __attribute__((address_space(3))) bf16x8*)(kp);      kf[1]=*(const __attribute__((address_space(3))) bf16x8*)(kp+512);
  kf[2]=*(const __attribute__((address_space(3))) bf16x8*)(kp+2048); kf[3]=*(const __attribute__((address_space(3))) bf16x8*)(kp+2560);
  kf[4]=*(const __attribute__((address_space(3))) bf16x8*)(kp+4096); kf[5]=*(const __attribute__((address_space(3))) bf16x8*)(kp+4608);
  kf[6]=*(const __attribute__((address_space(3))) bf16x8*)(kp+6144); kf[7]=*(const __attribute__((address_space(3))) bf16x8*)(kp+6656);
}
__device__ __forceinline__ void kload2(bf16x8*kf,lds_cptr kp,int j){ kf[2*j]=*(const __attribute__((address_space(3))) bf16x8*)(kp+j*2048); kf[2*j+1]=*(const __attribute__((address_space(3))) bf16x8*)(kp+j*2048+512); }
__device__ __forceinline__ s16x4 vtr(lds_cptr p){ return __builtin_bit_cast(s16x4,__builtin_amdgcn_ds_read_tr16_b64_v4i16((__attribute__((address_space(3))) v4i16_t*)p)); }
__device__ __forceinline__ float rowmax(const f32x16&p0,const f32x16&p1){
  float a=max3f(p0[0],p0[1],p1[0]),b=max3f(p0[2],p0[3],p1[1]);a=max3f(a,p1[2],p1[3]);
  #pragma unroll
  for(int r=4;r<16;r+=4){a=max3f(a,p0[r],p0[r+1]);b=max3f(b,p0[r+2],p0[r+3]);a=max3f(a,p1[r],p1[r+1]);b=max3f(b,p1[r+2],p1[r+3]);}
  const float m=max2f(a,b);
  auto rr=__builtin_amdgcn_permlane32_swap(__float_as_uint(m),__float_as_uint(m),false,false);
  return max2f(__uint_as_float(rr[0]),__uint_as_float(rr[1]));
}
__device__ __forceinline__ void pv(f32x16*o,int vb,bf16x8 pa0,bf16x8 pa1,bf16x8 pa2,bf16x8 pa3){
  #pragma unroll
  for(int d0=0;d0<2;++d0){s16x4 lo[4],hi[4];
    #pragma unroll
    for(int ks=0;ks<4;++ks){
      asm volatile("ds_read_b64_tr_b16 %0,%1 offset:%c2":"=&v"(lo[ks]):"v"(vb),"i"(d0*4096+ks*1024):"memory");
      asm volatile("ds_read_b64_tr_b16 %0,%1 offset:%c2":"=&v"(hi[ks]):"v"(vb),"i"(d0*4096+ks*1024+512):"memory");}
    asm volatile("s_waitcnt lgkmcnt(0)":::"memory");SBAR();
    #define PK(k) (bf16x8){lo[k][0],lo[k][1],lo[k][2],lo[k][3],hi[k][0],hi[k][1],hi[k][2],hi[k][3]}
    o[d0]=__builtin_amdgcn_mfma_f32_32x32x16_bf16(pa0,PK(0),o[d0],0,0,0);
    o[d0]=__builtin_amdgcn_mfma_f32_32x32x16_bf16(pa1,PK(1),o[d0],0,0,0);
    o[d0]=__builtin_amdgcn_mfma_f32_32x32x16_bf16(pa2,PK(2),o[d0],0,0,0);
    o[d0]=__builtin_amdgcn_mfma_f32_32x32x16_bf16(pa3,PK(3),o[d0],0,0,0);
    #undef PK
  }
}

#ifndef ATTN_STORE16
#define ATTN_STORE16(p,v) (*(u32x4*)(p)=(v))
#endif
template<int THRL> __device__ __forceinline__ void attn_unit(int b,int h,int qb,int ts,const float*__restrict__ cl2,const bf16*Q,const bf16*__restrict__ K,const bf16*__restrict__ V,bf16*O,char*shm,int wv){
  int tid=(wv<<6)|lane_id_(); asm volatile("":"+v"(tid)); const int lane=tid&63,r32=lane&31,hi=lane>>5; const int wid=__builtin_amdgcn_readfirstlane(tid>>6);
  const long rowbase=(long)b*SEQ; const int q0=qb*QB;
  const bf16*Qw=Q+(rowbase+q0+wid*QBLK)*DM+h*D;
  const bf16*Kh=K+(rowbase+(long)ts*KVBLK)*DM+h*D,*Vh=V+(rowbase+(long)ts*KVBLK)*DM+h*D;
  const unsigned lds0=(unsigned)(uintptr_t)shm;
  float*wsf=(float*)(shm+LDS_WS)+wid*64;
  const bf16*ksrc=Kh+(long)lane*DM+wid*8;
  const bf16*vsrc=Vh+(long)(16*(wid&3)+(lane>>2))*DM+(wid>>2)*32+(lane&3)*8;
  const unsigned kdst=lds0+LDS_K+wid*1024, vdst=lds0+LDS_V+wid*1024;
  #define DMA_K(t,slot) glds16(ksrc+(long)(t)*KVBLK*DM,(unsigned)__builtin_amdgcn_readfirstlane(kdst+(slot)))
  #define DMA_V(t,slot) glds16(vsrc+(long)(t)*KVBLK*DM,(unsigned)__builtin_amdgcn_readfirstlane(vdst+(slot)))
  const int vb0=(int)(lds0+LDS_V)+((lane>>4)&1)*32+(lane&3)*8+(4*hi+((lane&15)>>2))*64;
  const char*Kbase=shm+LDS_K; bf16x8 kf[8];
  const lds_cptr shm3=(lds_cptr)shm; const lds_cptr kp0=shm3+LDS_K+hi*1024+r32*16; const lds_cptr vp0=shm3+LDS_V+((lane>>4)&1)*32+(lane&3)*8+(4*hi+((lane&15)>>2))*64;
  const int NT=(q0+QB)/KVBLK-ts;
  DMA_K(0,0);DMA_V(0,0);DMA_K(1,SLOTB);
  bf16x8 qr[4];
  #pragma unroll
  for(int d0=0;d0<4;++d0)qr[d0]=*reinterpret_cast<const bf16x8*>(&Qw[(long)r32*DM+d0*16+hi*8]);
  float mhat=0.f,l_reg=0.f;f32x16 o[2];o[0]=f32x16{};o[1]=f32x16{};
  typedef __attribute__((address_space(3))) const f32x4_t* lds_f4p; const lds_f4p biasp=(lds_f4p)((lds_cptr)shm+LDS_BIAS)+hi;
  #define BIASINIT(C0,C1,t) do{ _Pragma("unroll") for(int g_=0;g_<4;++g_){ const f32x4_t b0_=biasp[(t)*16+2*g_], b1_=biasp[(t)*16+8+2*g_]; \
      _Pragma("unroll") for(int i_=0;i_<4;++i_){ C0[4*g_+i_]=b0_[i_]-mhat; C1[4*g_+i_]=b1_[i_]-mhat; } } }while(0)
  const int qrel=wid*QBLK+r32;
  #define CMASK(P0,P1,t) do{int jb_=(t)-(NT-4); if(jb_>=0)cmask(P0,P1,jb_,qrel,hi);}while(0)
  bool resc=false;
  #define START(P0,P1) do{ const float rm=rowmax(P0,P1); resc=false; \
    { const float dl=rm; mhat=fadd_s(mhat,dl); \
      _Pragma("unroll") for(int r=0;r<16;++r){P0[r]=fsub_s(P0[r],dl);P1[r]=fsub_s(P1[r],dl);} } \
    _Pragma("unroll") for(int r=0;r<16;++r)P0[r]=__builtin_amdgcn_exp2f(P0[r]); }while(0)
  #define RESC() do{ if(resc){ asm volatile("s_waitcnt lgkmcnt(0)":::"memory"); \
      _Pragma("unroll") for(int d_=0;d_<2;++d_) _Pragma("unroll") for(int r=0;r<16;++r)o[d_][r]*=wsf[crow(r,hi)]; } }while(0)
  f32x16 pA0,pA1,pB0,pB1;
  int sl_prev=0,sl_cur=0,sl_next=SLOTB;
  #define ROT() do{sl_prev=sl_cur;sl_cur=sl_next;sl_next=(sl_next==(NSLOT-1)*SLOTB)?0:sl_next+SLOTB;}while(0)
  {
    const float cref=cl2[q0]; const f32x4_t*src=(const f32x4_t*)(cl2+ts*KVBLK); __attribute__((address_space(3))) f32x4_t*dst=(__attribute__((address_space(3))) f32x4_t*)((__attribute__((address_space(3))) char*)shm+LDS_BIAS);
    for(int i=tid;i<NT*16;i+=NW*64){ const f32x4_t c4=src[i]; dst[i]=(f32x4_t){cref-c4[0],cref-c4[1],cref-c4[2],cref-c4[3]}; } }
  DMA_K(2,2*SLOTB);
  WAIT_BAR(3);
  BIASINIT(pA0,pA1,0); qkt(pA0,pA1,Kbase,qr,r32,hi);asm volatile("s_nop 15\n\ts_nop 7":"+v"(pA0),"+v"(pA1));CMASK(pA0,pA1,0);
  START(pA0,pA1);
  _Pragma("unroll") for(int r=0;r<16;++r)pA1[r]=__builtin_amdgcn_exp2f(pA1[r]);
  WAIT_BAR(0);
  DMA_K(3,0);DMA_V(1,SLOTB);
  ROT();
  kload8(kf,kp0+sl_cur);
  WAIT_BAR(2);
  s16x4 vlo[8],vhi[8]; u32x4 pw0,pw1,pw2,pw3;
  #define PKW(P,B) cvtpk_s(P[B],P[B+1])
  #define PAF(k) __builtin_bit_cast(bf16x8,pw##k)
  #define VFR(i) (bf16x8){vlo[i][0],vlo[i][1],vlo[i][2],vlo[i][3],vhi[i][0],vhi[i][1],vhi[i][2],vhi[i][3]}
  #define PIN(x) asm volatile("":"+v"(x))
  #define MX3(a,b,c) __builtin_fmaxf(__builtin_fmaxf((a),(b)),(c))
  #define GAPA(MF,A0,A1,A2,A3,W0,W1,PW) do{ MF; sacc+=A0; sacc+=A1; sacc+=A2; sacc+=A3; PIN(sacc); W0; W1; PIN(PW); SBAR(); }while(0)
  #define EX(v) __builtin_amdgcn_exp2f(v)
  #define GAPB(MF,X,B) do{ MF; X[B]=EX(X[B]); X[B+1]=EX(X[B+1]); X[B+2]=EX(X[B+2]); X[B+3]=EX(X[B+3]); PIN(X); SBAR(); }while(0)
  #define VRD(i) do{ vlo[i]=vtr(vp_+(((i)>>2)*4096+((i)&3)*1024)); vhi[i]=vtr(vp_+(((i)>>2)*4096+((i)&3)*1024+512)); }while(0)
  #define KRD(G,j) do{ if(G){ kload2(kf,kp0+sl_next,j); SBAR(); } }while(0)
  #define STEP(C0,C1,P0,P1,t,GK,GV,GL) do{ SBAR(); BIASINIT(C0,C1,t); SBAR(); \
    const lds_cptr vp_=vp0+sl_prev; \
    VRD(0); SBAR(); float sacc=(P0[0]+P0[1]); \
    GAPA(C0=__builtin_amdgcn_mfma_f32_32x32x16_bf16(kf[0],qr[0],C0,0,0,0), P0[2],P0[3],P0[4],P0[5],     pw0[0]=PKW(P0,0), pw0[1]=PKW(P0,2), pw0); \
    VRD(4); SBAR(); GAPA(C1=__builtin_amdgcn_mfma_f32_32x32x16_bf16(kf[1],qr[0],C1,0,0,0), P0[6],P0[7],P0[8],P0[9],     pw0[2]=PKW(P0,4), pw0[3]=PKW(P0,6), pw0); \
    VRD(1); SBAR(); GAPA(C0=__builtin_amdgcn_mfma_f32_32x32x16_bf16(kf[2],qr[1],C0,0,0,0),   P0[10],P0[11],P0[12],P0[13], pw1[0]=PKW(P0,8), pw1[1]=PKW(P0,10), pw1); \
    VRD(5); SBAR(); GAPA(C1=__builtin_amdgcn_mfma_f32_32x32x16_bf16(kf[3],qr[1],C1,0,0,0),   P0[14],P0[15],P1[0],P1[1],   pw1[2]=PKW(P0,12),pw1[3]=PKW(P0,14), pw1); \
    VRD(2); SBAR(); GAPA(C0=__builtin_amdgcn_mfma_f32_32x32x16_bf16(kf[4],qr[2],C0,0,0,0),   P1[2],P1[3],P1[4],P1[5],     pw2[0]=PKW(P1,0), pw2[1]=PKW(P1,2), pw2); \
    VRD(6); SBAR(); GAPA(C1=__builtin_amdgcn_mfma_f32_32x32x16_bf16(kf[5],qr[2],C1,0,0,0),   P1[6],P1[7],P1[8],P1[9],     pw2[2]=PKW(P1,4), pw2[3]=PKW(P1,6), pw2); \
    VRD(3); SBAR(); GAPA(C0=__builtin_amdgcn_mfma_f32_32x32x16_bf16(kf[6],qr[3],C0,0,0,0),   P1[10],P1[11],P1[12],P1[13], pw3[0]=PKW(P1,8), pw3[1]=PKW(P1,10), pw3); \
    VRD(7); SBAR(); GAPA(C1=__builtin_amdgcn_mfma_f32_32x32x16_bf16(kf[7],qr[3],C1,0,0,0),   P1[14],P1[15],0.f,0.f,       pw3[2]=PKW(P1,12),pw3[3]=PKW(P1,14), pw3); \
    l_reg+=sacc; \
    if(GK){DMA_K((t)+3,sl_cur);} if(GV){DMA_V((t)+1,sl_next);} \
    CMASK(C0,C1,t); \
    { float a=MX3(C0[0],C0[1],C1[0]),b=MX3(C0[2],C0[3],C1[1]); a=MX3(a,C1[2],C1[3]); \
      _Pragma("unroll") for(int r=4;r<16;r+=4){a=MX3(a,C0[r],C0[r+1]);b=MX3(b,C0[r+2],C0[r+3]);a=MX3(a,C1[r],C1[r+1]);b=MX3(b,C1[r+2],C1[r+3]);} \
      float rm=__builtin_fmaxf(a,b); { auto rr=__builtin_amdgcn_permlane32_swap(__float_as_uint(rm),__float_as_uint(rm),false,false); rm=__builtin_fmaxf(__uint_as_float(rr[0]),__uint_as_float(rr[1])); } \
      resc=false; \
      if(__builtin_expect(__any(rm>(float)THRL),0)){ const float dl=__builtin_fmaxf(rm,0.f); mhat+=dl; \
        _Pragma("unroll") for(int r=0;r<16;++r){C0[r]-=dl;C1[r]-=dl;} \
        const float f=__builtin_amdgcn_exp2f(-dl); l_reg*=f; if(hi==0)wsf[r32]=f; resc=true; } } \
    SBAR(); \
    GAPB(o[0]=__builtin_amdgcn_mfma_f32_32x32x16_bf16(PAF(0),VFR(0),o[0],0,0,0), C0,0); \
    GAPB(o[1]=__builtin_amdgcn_mfma_f32_32x32x16_bf16(PAF(0),VFR(4),o[1],0,0,0), C0,4); \
    KRD(GL,0); GAPB(o[0]=__builtin_amdgcn_mfma_f32_32x32x16_bf16(PAF(1),VFR(1),o[0],0,0,0), C0,8); \
    KRD(GL,1); GAPB(o[1]=__builtin_amdgcn_mfma_f32_32x32x16_bf16(PAF(1),VFR(5),o[1],0,0,0), C0,12); \
    KRD(GL,2); GAPB(o[0]=__builtin_amdgcn_mfma_f32_32x32x16_bf16(PAF(2),VFR(2),o[0],0,0,0), C1,0); \
    KRD(GL,3); GAPB(o[1]=__builtin_amdgcn_mfma_f32_32x32x16_bf16(PAF(2),VFR(6),o[1],0,0,0), C1,4); \
    GAPB(o[0]=__builtin_amdgcn_mfma_f32_32x32x16_bf16(PAF(3),VFR(3),o[0],0,0,0), C1,8); \
    GAPB(o[1]=__builtin_amdgcn_mfma_f32_32x32x16_bf16(PAF(3),VFR(7),o[1],0,0,0), C1,12); \
    }while(0)
  int t=1;
  #undef CMASK
  #define CMASK(P0,P1,t) do{}while(0)
  for(;t+5<NT;t+=2){
    STEP(pB0,pB1,pA0,pA1,t,true,true,true);     WAIT_BAR(2); RESC(); ROT();
    STEP(pA0,pA1,pB0,pB1,t+1,true,true,true);   WAIT_BAR(2); RESC(); ROT();
  }
  #undef CMASK
  #define CMASK(P0,P1,t) do{int jb_=(t)-(NT-4); if(jb_>=0)cmask(P0,P1,jb_,qrel,hi);}while(0)
  #define ENDW(tt) do{ if((tt)+3<NT){WAIT_BAR(2);} else if((tt)+2<NT){WAIT_BAR(1);} else {WAIT_BAR(0);} }while(0)
  for(;t+1<NT;t+=2){
    STEP(pB0,pB1,pA0,pA1,t,(t+3<NT),(t+1<NT),(t+1<NT));       ENDW(t);   RESC(); ROT();
    STEP(pA0,pA1,pB0,pB1,t+1,(t+4<NT),(t+2<NT),(t+2<NT));     ENDW(t+1); RESC(); ROT();
  }
  STEP(pB0,pB1,pA0,pA1,NT-1,false,false,false); RESC();
  { float sacc=pB0[0]+pB0[1]; _Pragma("unroll") for(int r=2;r<16;++r)sacc+=pB0[r]; _Pragma("unroll") for(int r=0;r<16;++r)sacc+=pB1[r]; l_reg+=sacc;
    pw0=(u32x4){PKW(pB0,0),PKW(pB0,2),PKW(pB0,4),PKW(pB0,6)};pw1=(u32x4){PKW(pB0,8),PKW(pB0,10),PKW(pB0,12),PKW(pB0,14)};pw2=(u32x4){PKW(pB1,0),PKW(pB1,2),PKW(pB1,4),PKW(pB1,6)};pw3=(u32x4){PKW(pB1,8),PKW(pB1,10),PKW(pB1,12),PKW(pB1,14)};
    SBAR(); pv(o,vb0+sl_cur,PAF(0),PAF(1),PAF(2),PAF(3)); }
  #undef PKW
  #undef PAF
  #undef VFR
  #undef PIN
  #undef MX3
  #undef GAPA
  #undef GAPB
  #undef EX
  #undef VRD
  #undef KRD
  #undef STEP
  #undef ENDW
  {auto rr=__builtin_amdgcn_permlane32_swap(__float_as_uint(l_reg),__float_as_uint(l_reg),false,false);l_reg=__uint_as_float(rr[0])+__uint_as_float(rr[1]);}
  if(hi==0)wsf[32+r32]=l_reg;asm volatile("s_waitcnt lgkmcnt(0)":::"memory");
  float rli[16];
  #pragma unroll
  for(int r=0;r<16;++r)rli[r]=__builtin_amdgcn_rcpf(wsf[32+crow(r,hi)]);
  bf16*Ow=O+(rowbase+q0+wid*QBLK)*DM+h*D;
  { bf16*stg=(bf16*)(shm+LDS_OST)+wid*2048;
    #pragma unroll
    for(int r=0;r<16;++r){const int orow=crow(r,hi);
      #pragma unroll
      for(int d0=0;d0<2;++d0)stg[orow*64+d0*32+r32]=__float2bfloat16(o[d0][r]*rli[r]);}
    asm volatile("s_waitcnt lgkmcnt(0)":::"memory");
    #pragma unroll
    for(int i=0;i<4;++i){const int row=i*8+(lane>>3),ch=lane&7; const u32x4 v=*(const u32x4*)(stg+row*64+ch*8); ATTN_STORE16(Ow+(long)row*DM+ch*8,v);} }
  asm volatile("s_waitcnt lgkmcnt(0)\n\ts_barrier":::"memory");
  #undef DMA_K
  #undef DMA_V
  #undef CMASK
  #undef BIASINIT
  #undef START
  #undef RESC
  #undef ROT
}
constexpr int ATTN_LDS_BYTES=LDS_BYTES;
struct AttnTensors { const bf16* Q; const bf16* K; const bf16* V; bf16* O; const float* cl2; };
#undef SBAR
#undef WAIT_BAR
}
#define GEMM_PHASE(...) pg8::gemm_phase<__VA_ARGS__, pg8::StaticOrder, PGA, PGS>(ldsl, g, S, E, wave)
#define GEMM_PHASE_SPLIT() pg8::gemm_phase<pg8::EpiPartial, pg8::SplitOrder, PGA, PGS>(ldsl, g2, S2, E2, wave)
#define GEMM_PHASE_SPLIT_T(NN, NS, KSUB, KSH) pg8::gemm_phase<pg8::EpiPartialT<NN, KSH>, pg8::SplitOrderT<NN, NS, KSUB>, PGA, PGS>(ldsl, g2, S2, E2, wave)
#ifndef PGA
#define PGA true
#endif
#ifndef PGS
#define PGS true
#endif
namespace cg = cooperative_groups;
#define LAS __attribute__((address_space(3)))
typedef unsigned short bf16;
typedef unsigned v4u __attribute__((ext_vector_type(4)));
typedef float f32x4 __attribute__((ext_vector_type(4)));
typedef short bf16x8 __attribute__((ext_vector_type(8)));
typedef float f32x16 __attribute__((ext_vector_type(16)));
constexpr int NWAVES = 8, NTHR = 512, NMODC_ = 9216;
constexpr int MP = 32768, MS = 256, M = MP + MS, DM = 1024, FF = 2816, WA = 512, NIN = 4608, INCOLS = 4616, SEQ = 16384, PAST = 1024, DSEQ = 32, SKEYS = PAST + DSEQ;
constexpr float EPS = 1e-6f, LOG2E = 1.4426950408889634f;
constexpr size_t MiB = 1u << 20;
constexpr size_t WS_CTL = 0, CTL_ZERO_BYTES = 65536;
constexpr size_t WS_MOD = 1 * MiB, WS_CUMP = 2 * MiB, WS_CUMS = 3 * MiB, WS_G2SS = 4 * MiB, WS_QS = 6 * MiB, WS_WSP = 7 * MiB;
constexpr size_t WS_WGU1 = 8 * MiB, WS_WD1 = 19 * MiB, WS_WIN = 25 * MiB, WS_WPA = 34 * MiB, WS_WPB = 35 * MiB, WS_WOUT = 36 * MiB, WS_WGU2 = 38 * MiB, WS_WD2 = 49 * MiB;
constexpr size_t WS_XN = 56 * MiB;
constexpr size_t WS_ACT = 121 * MiB;
constexpr size_t QKV_B = (size_t)M * 512 * 2;
constexpr size_t WS_Q = 121 * MiB, WS_K = WS_Q + QKV_B, WS_V = WS_K + QKV_B, WS_U = WS_V + QKV_B, WS_G2 = WS_U + QKV_B;
constexpr size_t WS_AO = WS_Q;
constexpr size_t WS_T1 = WS_U;
constexpr size_t WS_T2 = WS_K;
constexpr size_t WS_BO = 283 * MiB, WS_PART = 300 * MiB, WS_END = 316 * MiB;
static_assert(WS_XN + (size_t)M * 2048 <= WS_ACT && WS_G2 + QKV_B <= WS_BO && WS_BO + QKV_B <= WS_END && WS_ACT + (size_t)M * FF * 2 <= WS_END, "ws map");
constexpr size_t O_Y = 0, O_KP = (size_t)M * 1024, O_VP = O_KP + (size_t)MP * 512, O_FP = O_VP + (size_t)MP * 512, O_KS = O_FP + (size_t)MP * 8, O_VS = O_KS + (size_t)MS * 512,
                 O_FS = O_VS + (size_t)MS * 512, O_GS = O_FS + (size_t)MS * 8, O_END = O_GS + (size_t)MS * 512;
constexpr int LDS_BYTES = 155648, MISC_OFF = LDS_BYTES - 256;
static_assert(attn_body::LDS_TOTAL <= MISC_OFF && pg8::STAGE_BYTES <= LDS_BYTES, "LDS map");

struct Args { const float* in[28]; float* out; unsigned char* ws; };

__device__ __forceinline__ float wave_sum(float v) {
#pragma unroll
    for (int o = 1; o < 64; o <<= 1) v += __shfl_xor(v, o);
    return v;
}
__device__ __forceinline__ unsigned f2bf(float f) { unsigned u = __builtin_bit_cast(unsigned, f); return (u + 0x7fffu + ((u >> 16) & 1u)) >> 16; }
__device__ __forceinline__ unsigned pk2(float lo, float hi) { return f2bf(lo) | (f2bf(hi) << 16); }
__device__ __forceinline__ float bf2f(unsigned short h) { return __uint_as_float((unsigned)h << 16); }

__device__ __forceinline__ void ada_unit(const Args& a, unsigned char* lds, int cb, int tid) {
    asm volatile("" : "+v"(tid));
    float* SC = (float*)lds; float* RED = (float*)(lds + 40960);
    const float* cp = a.in[2]; const float* cs = a.in[3]; const float* w_ada = a.in[7]; const float* b_ada = a.in[8];
    float* MOD = (float*)(a.ws + WS_MOD);
    for (int i = tid; i < 10240; i += NTHR) { const int r = i >> 10, k = i & 1023; const float c = r < 2 ? cp[r * 1024 + k] : cs[(r - 2) * 1024 + k]; SC[i] = c / (1.0f + expf(-c)); }
    __syncthreads();
    if (tid < 504) {
        const int cgp = tid % 9, ks = tid / 9; f32x4 acc[10];
#pragma unroll
        for (int r = 0; r < 10; ++r) acc[r] = (f32x4){0.f, 0.f, 0.f, 0.f};
        for (int k = ks; k < 1024; k += 56) { const f32x4 w = *(const f32x4*)(w_ada + (size_t)k * NMODC_ + 36 * cb + 4 * cgp);
#pragma unroll
            for (int r = 0; r < 10; ++r) acc[r] += w * SC[r * 1024 + k]; }
#pragma unroll
        for (int r = 0; r < 10; ++r) *(f32x4*)(RED + (size_t)tid * 40 + r * 4) = acc[r];
    }
    __syncthreads();
    if (tid < 360) { const int r = tid / 36, c = tid % 36, cgp = c >> 2, i = c & 3; float s = 0.f;
        for (int ks = 0; ks < 56; ++ks) s += RED[(ks * 9 + cgp) * 40 + r * 4 + i];
        MOD[r * NMODC_ + 36 * cb + c] = s + b_ada[36 * cb + c]; }
    __syncthreads();
}
__device__ __forceinline__ void transpose_item(const float* W, int ld, int c0, int K, bf16* WT, int drow0, int k0, float* scr, int lane) {
#pragma unroll 8
    for (int i = 0; i < 32; ++i) { const int kk = 2 * i + (lane >> 5); scr[kk * 33 + (lane & 31)] = W[(size_t)(k0 + kk) * ld + c0 + (lane & 31)]; }
    asm volatile("s_waitcnt lgkmcnt(0)" ::: "memory");
    const int c = lane & 7;
#pragma unroll
    for (int j = 0; j < 4; ++j) { const int n = (lane >> 3) + 8 * j; const float* s = scr + (8 * c) * 33 + n;
        v4u o; o.x = pk2(s[0 * 33], s[1 * 33]); o.y = pk2(s[2 * 33], s[3 * 33]); o.z = pk2(s[4 * 33], s[5 * 33]); o.w = pk2(s[6 * 33], s[7 * 33]);
        *(v4u*)(WT + (size_t)(drow0 + n) * K + k0 + 8 * c) = o; }
    asm volatile("s_waitcnt lgkmcnt(0)" ::: "memory");
}
struct Seg { int in, ld, c0, ncols, K; size_t dst; int drow, mode; };
__device__ const Seg SEGS[13] = {
        {10, FF, 0, FF, 1024, WS_WGU1, 0, 1}, {11, FF, 0, FF, 1024, WS_WGU1, 0, 2}, {12, 1024, 0, 1024, FF, WS_WD1, 0, 0},
        {14, INCOLS, 0, 512, 1024, WS_WIN, 0, 3}, {14, INCOLS, 512, 512, 1024, WS_WIN, 512, 3}, {14, INCOLS, 1024, 512, 1024, WS_WIN, 1024, 0}, {14, INCOLS, 1544, 3072, 1024, WS_WIN, 1536, 0},
        {21, 1024, 0, 1024, 512, WS_WPA, 0, 0}, {22, 1024, 0, 1024, 512, WS_WPB, 0, 0}, {23, 1024, 0, 1024, 1024, WS_WOUT, 0, 0},
        {25, FF, 0, FF, 1024, WS_WGU2, 0, 1}, {26, FF, 0, FF, 1024, WS_WGU2, 0, 2}, {27, 1024, 0, 1024, FF, WS_WD2, 0, 0}};
__device__ __forceinline__ int seg_drow(const Seg& s, int n) {
    if (s.mode == 0) return s.drow + n;
    if (s.mode == 1) return s.drow + 256 * (n >> 7) + (n & 127);
    if (s.mode == 2) return s.drow + 256 * (n >> 7) + 128 + (n & 127);
    const int gs = (n & 255) >> 5; return s.drow + (n & ~255) + 32 * (4 * (gs & 1) + (gs >> 1));
}
__device__ __forceinline__ void p0_weights(const Args& a, unsigned char* lds, int gw, int NGW, int wave, int lane) {
    asm volatile("" : "+v"(lane));
    float* scr = (float*)(lds + wave * 8704);

    int base = 0;
#pragma unroll 1
    for (int si = 0; si < 13; ++si) {
        const Seg s = SEGS[si]; const int nblk = s.ncols / 32, nitems = (s.K / 64) * nblk;
        int first = (gw - base) % NGW; if (first < 0) first += NGW;
        for (int it = first; it < nitems; it += NGW) { const int kb = it / nblk, nb = it % nblk;
            transpose_item(a.in[s.in], s.ld, s.c0 + 32 * nb, s.K, (bf16*)(a.ws + s.dst), seg_drow(s, 32 * nb), 64 * kb, scr, lane); }
        base = (base + nitems) % NGW;
    }
    const float* wsp = a.in[19]; bf16* WSP = (bf16*)(a.ws + WS_WSP);
    for (int i = gw * 64 + lane; i < 4 * 128 * 128; i += NGW * 64) { const int t = (i >> 7) & 127, s2 = i & 127; WSP[i] = (bf16)f2bf(s2 <= t ? wsp[i] : 0.f); }
}
template <bool LOGF> __device__ __forceinline__ void norm_phase(const Args& a, unsigned char* lds, const float* srcp, const float* srcs, const float* g, int ishift, int iscale,
                                                                 int gw, int NGW, int tid, int lane) {
    asm volatile("" : "+v"(tid), "+v"(lane));
    const float* MOD = (const float*)(a.ws + WS_MOD); bf16* XN = (bf16*)(a.ws + WS_XN);
    float* WFt = (float*)lds;
    if (LOGF) { const float* w_in = a.in[14]; for (int i = tid; i < 8192; i += NTHR) { const int k = i >> 3, j = i & 7; WFt[j * 1024 + k] = w_in[(size_t)k * INCOLS + 1536 + j]; } __syncthreads(); }
    int cur = -1; f32x4 gs[4], shv[4], vn[4], vnn[4];
    if (gw < M) { const float* xrow0 = gw < MP ? srcp + (size_t)gw * 1024 : srcs + (size_t)(gw - MP) * 1024;
#pragma unroll
        for (int j = 0; j < 4; ++j) vn[j] = ((const f32x4*)xrow0 + lane)[64 * j]; }
    if (gw + NGW < M) { const int m1 = gw + NGW; const float* xrow1 = m1 < MP ? srcp + (size_t)m1 * 1024 : srcs + (size_t)(m1 - MP) * 1024;
#pragma unroll
        for (int j = 0; j < 4; ++j) vnn[j] = ((const f32x4*)xrow1 + lane)[64 * j]; }
    for (int m = gw; m < M; m += NGW) {
        const int mr = m < MP ? (m >> 14) : 2 + ((m - MP) >> 5);
        if (mr != cur) { cur = mr; const f32x4* g4 = (const f32x4*)g + lane;
            const f32x4* sh4 = (const f32x4*)(MOD + (size_t)mr * 9216 + ishift * 1024) + lane; const f32x4* sc4 = (const f32x4*)(MOD + (size_t)mr * 9216 + iscale * 1024) + lane;
#pragma unroll
            for (int j = 0; j < 4; ++j) { gs[j] = g4[64 * j] * (sc4[64 * j] + 1.0f); shv[j] = sh4[64 * j]; } }
        f32x4 v[4]; float ss = 0.f;
#pragma unroll
        for (int j = 0; j < 4; ++j) { v[j] = vn[j]; vn[j] = vnn[j]; ss += (v[j].x * v[j].x + v[j].y * v[j].y) + (v[j].z * v[j].z + v[j].w * v[j].w); }
        { const int m2 = m + 2 * NGW; if (m2 < M) { const float* xrow2 = m2 < MP ? srcp + (size_t)m2 * 1024 : srcs + (size_t)(m2 - MP) * 1024;
#pragma unroll
            for (int j = 0; j < 4; ++j) vnn[j] = ((const f32x4*)xrow2 + lane)[64 * j]; } }
        const float rstd = 1.0f / sqrtf(wave_sum(ss) * (1.0f / 1024.0f) + EPS);
        unsigned long long* o8 = (unsigned long long*)(XN + (size_t)m * 1024) + lane;
#pragma unroll
        for (int j = 0; j < 4; ++j) { v[j] = (v[j] * rstd) * gs[j] + shv[j];
            o8[64 * j] = (unsigned long long)pk2(v[j].x, v[j].y) | ((unsigned long long)pk2(v[j].z, v[j].w) << 32); }
        if (LOGF) {
            float f[8];
#pragma unroll
            for (int jj = 0; jj < 8; ++jj) { float s = 0.f;
#pragma unroll
                for (int j = 0; j < 4; ++j) { const f32x4 w = *((const f32x4*)(WFt + jj * 1024) + 64 * j + lane); s += (v[j].x * w.x + v[j].y * w.y) + (v[j].z * w.z + v[j].w * w.w); }
                f[jj] = wave_sum(s); }
            float fj = f[0];
#pragma unroll
            for (int jj = 1; jj < 8; ++jj) fj = (lane == jj) ? f[jj] : fj;
            if (lane < 8) { const float x = fj + a.in[15][lane]; const float lf = (x >= 0.f) ? -log1pf(expf(-x)) : x - log1pf(expf(x));
                float* dst = m < MP ? a.out + O_FP + (size_t)m * 8 : a.out + O_FS + (size_t)(m - MP) * 8; dst[lane] = lf; }
        }
    }
}
__device__ __forceinline__ void scan_unit(const Args& a, unsigned char* lds, int unit, int tid) {
    asm volatile("" : "+v"(tid));
    double* tot = (double*)lds;
    if (unit < 16) {
        const int b = unit >> 3, h = unit & 7; const float* lf = a.out + O_FP + ((size_t)b * SEQ) * 8 + h; float* dst = (float*)(a.ws + WS_CUMP) + (size_t)unit * SEQ;
        float x[32]; double s = 0.0;
#pragma unroll
        for (int i = 0; i < 32; ++i) { x[i] = lf[(size_t)(tid * 32 + i) * 8]; s += (double)x[i]; }
        tot[tid] = s; __syncthreads();
        double pre = 0.0; for (int j = 0; j < tid; ++j) pre += tot[j];
#pragma unroll
        for (int i = 0; i < 32; ++i) { pre += (double)x[i]; dst[tid * 32 + i] = (float)(pre * 1.4426950408889634); }
    } else {
        const int bh = unit - 16, b = bh >> 3, h = bh & 7; const float* lfc = a.in[6] + ((size_t)b * PAST) * 8 + h; const float* lfn = a.out + O_FS + ((size_t)b * DSEQ) * 8 + h;
        float* dst = (float*)(a.ws + WS_CUMS) + (size_t)bh * SKEYS;
        float x[3] = {0.f, 0.f, 0.f}; double s = 0.0;
        if (tid < 352) {
#pragma unroll
            for (int i = 0; i < 3; ++i) { const int p = tid * 3 + i; x[i] = p < PAST ? lfc[(size_t)p * 8] : lfn[(size_t)(p - PAST) * 8]; s += (double)x[i]; } }
        tot[tid] = s; __syncthreads();
        if (tid < 352) { double pre = 0.0; for (int j = 0; j < tid; ++j) pre += tot[j];
#pragma unroll
            for (int i = 0; i < 3; ++i) { pre += (double)x[i]; dst[tid * 3 + i] = (float)(pre * 1.4426950408889634); } }
    }
    __syncthreads();
}
__device__ __forceinline__ void gmlp_unit(const Args& a, unsigned char* lds, int ci, int tid, int wave, int lane) {
    asm volatile("" : "+v"(tid), "+v"(lane));
    constexpr int VP = 136;
    bf16* VT = (bf16*)lds; float* rst = (float*)(lds + 128 * VP * 2);
    const bf16* G2 = (const bf16*)(a.ws + WS_G2); const bf16* U = (const bf16*)(a.ws + WS_U); bf16* BO = (bf16*)(a.ws + WS_BO); const bf16* WSP = (const bf16*)(a.ws + WS_WSP);
    const float* G2SS = (const float*)(a.ws + WS_G2SS); const float* gv = a.in[18]; const float* bsp = a.in[20];
    const size_t R0 = (size_t)ci * 128;
    if (tid < 128) { const f32x4* p = (const f32x4*)(G2SS + (R0 + tid) * 8); const f32x4 s0 = p[0], s1 = p[1]; rst[tid] = 1.0f / sqrtf((((s0.x + s0.y) + (s0.z + s0.w)) + ((s1.x + s1.y) + (s1.z + s1.w))) * (1.0f / 512.0f) + EPS); }
    __syncthreads();
    const int r32 = lane & 31, hi = lane >> 5, tb = wave >> 1, dh = wave & 1;
#pragma unroll 1
    for (int g = 0; g < 4; ++g) {
#pragma unroll
        for (int it = 0; it < 4; ++it) { const int q = tid + NTHR * it, s = q & 127, cch = q >> 7;
            const v4u raw = *(const v4u*)(G2 + (R0 + s) * 512 + g * 128 + 8 * cch); const float rs = rst[s];
            const f32x4 g0 = *(const f32x4*)(gv + g * 128 + 8 * cch), g1 = *(const f32x4*)(gv + g * 128 + 8 * cch + 4);
            bf16* col = VT + (8 * cch) * VP + s;
            col[0 * VP] = (bf16)f2bf(pg8::bf_lo(raw.x) * rs * g0.x); col[1 * VP] = (bf16)f2bf(pg8::bf_hi(raw.x) * rs * g0.y); col[2 * VP] = (bf16)f2bf(pg8::bf_lo(raw.y) * rs * g0.z); col[3 * VP] = (bf16)f2bf(pg8::bf_hi(raw.y) * rs * g0.w);
            col[4 * VP] = (bf16)f2bf(pg8::bf_lo(raw.z) * rs * g1.x); col[5 * VP] = (bf16)f2bf(pg8::bf_hi(raw.z) * rs * g1.y); col[6 * VP] = (bf16)f2bf(pg8::bf_lo(raw.w) * rs * g1.z); col[7 * VP] = (bf16)f2bf(pg8::bf_hi(raw.w) * rs * g1.w); }
        bf16x8 af[8];
#pragma unroll
        for (int ks = 0; ks < 8; ++ks) af[ks] = *(const bf16x8*)(WSP + ((size_t)(g * 128 + 32 * tb + r32)) * 128 + 16 * ks + 8 * hi);
        __syncthreads();
        f32x16 acc[2]; acc[0] = f32x16{}; acc[1] = f32x16{};
#pragma unroll
        for (int ks = 0; ks < 8; ++ks) if (ks <= 2 * tb + 1) {
#pragma unroll
            for (int db = 0; db < 2; ++db) { const bf16x8 bfv = *(const bf16x8*)(VT + (64 * dh + 32 * db + r32) * VP + 16 * ks + 8 * hi); acc[db] = __builtin_amdgcn_mfma_f32_32x32x16_bf16(af[ks], bfv, acc[db], 0, 0, 0); }
        }
        { unsigned short uu[2][16]; float bb[16];
#pragma unroll
          for (int r = 0; r < 16; ++r) { const int t = 32 * tb + (r & 3) + 8 * (r >> 2) + 4 * hi; bb[r] = bsp[g * 128 + t];
#pragma unroll
              for (int db = 0; db < 2; ++db) uu[db][r] = U[(R0 + t) * 512 + g * 128 + 64 * dh + 32 * db + r32]; }
#pragma unroll
          for (int db = 0; db < 2; ++db)
#pragma unroll
              for (int r = 0; r < 16; ++r) { const int t = 32 * tb + (r & 3) + 8 * (r >> 2) + 4 * hi, ch = g * 128 + 64 * dh + 32 * db + r32; const size_t off = (R0 + t) * 512 + ch;
                  BO[off] = (bf16)f2bf(bf2f(uu[db][r]) * (acc[db][r] + bb[r])); } }
        __syncthreads();
    }
}
__device__ __forceinline__ void gmlp_sample_unit(const Args& a, unsigned char* lds, int b, int tid) {
    asm volatile("" : "+v"(tid));
    float* rst = (float*)lds;
    const bf16* G2 = (const bf16*)(a.ws + WS_G2); const bf16* U = (const bf16*)(a.ws + WS_U); bf16* BO = (bf16*)(a.ws + WS_BO);
    const float* G2SS = (const float*)(a.ws + WS_G2SS); const float* wsp = a.in[19]; const float* bsp = a.in[20];
    const size_t R0 = (size_t)MP + b * 32;
    if (tid < 32) { const float* p = G2SS + (R0 + tid) * 8; float s = 0.f; for (int i = 0; i < 8; ++i) s += p[i]; rst[tid] = 1.0f / sqrtf(s * (1.0f / 512.0f) + EPS); }
    __syncthreads();
    const int ch = tid, g = ch >> 7; const float gvv = a.in[18][ch];
    float vb[32];
#pragma unroll
    for (int s = 0; s < 32; ++s) { vb[s] = bf2f(G2[(R0 + s) * 512 + ch]) * rst[s] * gvv; a.out[O_GS + ((size_t)b * 32 + s) * 512 + ch] = vb[s]; }
#pragma unroll
    for (int t = 0; t < 32; ++t) { float mixed = bsp[g * 128 + t]; const float* wrow = wsp + ((size_t)g * 128 + t) * 128;
#pragma unroll
        for (int s = 0; s < 32; ++s) if (s <= t) mixed += wrow[s] * vb[s];
        const size_t off = (R0 + t) * 512 + ch; BO[off] = (bf16)f2bf(bf2f(U[off]) * mixed); }
    __syncthreads();
}
__device__ __forceinline__ void sattn_unit(const Args& a, unsigned char* lds, int unit, int tid, int wave, int lane) {
    asm volatile("" : "+v"(tid), "+v"(lane));
    const int qg = unit & 3, h = (unit >> 2) & 7, b = unit >> 5;
    float* qs = (float*)lds;
    float* S = qs + 512;
    float* red = S + 8 * SKEYS;
    float* inv = red + 4096;
    const float* QS = (const float*)(a.ws + WS_QS); const float* cum = (const float*)(a.ws + WS_CUMS) + (size_t)(b * 8 + h) * SKEYS;
    const float* kc = a.in[4] + ((size_t)b * PAST) * 512 + h * 64; const float* vc = a.in[5] + ((size_t)b * PAST) * 512 + h * 64;
    const float* kn = a.out + O_KS + ((size_t)b * DSEQ) * 512 + h * 64; const float* vn = a.out + O_VS + ((size_t)b * DSEQ) * 512 + h * 64;
    { const int qi = tid >> 6, d = tid & 63; qs[tid] = QS[((size_t)b * 32 + 8 * qg + qi) * 512 + h * 64 + d]; }
    __syncthreads();
    for (int key = wave * 132 + lane; key < wave * 132 + 132; key += 64) {
        const f32x4* kr = (const f32x4*)(key < PAST ? kc + (size_t)key * 512 : kn + (size_t)(key - PAST) * 512);
        f32x4 kv[16];
#pragma unroll
        for (int i = 0; i < 16; ++i) kv[i] = kr[i];
        const float ck = cum[key];
#pragma unroll
        for (int qi = 0; qi < 8; ++qi) { float s = 0.f;
#pragma unroll
            for (int i = 0; i < 16; ++i) { const f32x4 q4 = *(const f32x4*)(qs + qi * 64 + 4 * i); s += (q4.x * kv[i].x + q4.y * kv[i].y) + (q4.z * kv[i].z + q4.w * kv[i].w); }
            const int qpos = PAST + 8 * qg + qi;
            S[qi * SKEYS + key] = (key <= qpos) ? s + (cum[qpos] - ck) : -INFINITY; }
    }
    __syncthreads();
    { float mx = -INFINITY; for (int k = lane; k < SKEYS; k += 64) mx = fmaxf(mx, S[wave * SKEYS + k]);
#pragma unroll
      for (int o = 1; o < 64; o <<= 1) mx = fmaxf(mx, __shfl_xor(mx, o));
      float sum = 0.f; for (int k = lane; k < SKEYS; k += 64) { const float p = exp2f(S[wave * SKEYS + k] - mx); S[wave * SKEYS + k] = p; sum += p; }
      sum = wave_sum(sum); if (lane == 0) inv[wave] = 1.0f / sum; }
    __syncthreads();
    { float acc[8];
#pragma unroll
      for (int qi = 0; qi < 8; ++qi) acc[qi] = 0.f;
#pragma unroll 1
      for (int key0 = wave * 132; key0 < wave * 132 + 132; key0 += 12) {
          float vv[12];
#pragma unroll
          for (int j = 0; j < 12; ++j) { const int key = key0 + j; vv[j] = (key < PAST ? vc + (size_t)key * 512 : vn + (size_t)(key - PAST) * 512)[lane]; }
#pragma unroll
          for (int j = 0; j < 12; ++j)
#pragma unroll
              for (int qi = 0; qi < 8; ++qi) acc[qi] += S[qi * SKEYS + key0 + j] * vv[j]; }
#pragma unroll
      for (int qi = 0; qi < 8; ++qi) red[(wave * 8 + qi) * 64 + lane] = acc[qi]; }
    __syncthreads();
    { const int qi = tid >> 6, d = tid & 63; float s = 0.f;
#pragma unroll
      for (int w = 0; w < 8; ++w) s += red[(w * 8 + qi) * 64 + d];
      bf16* AO = (bf16*)(a.ws + WS_AO); AO[((size_t)MP + b * 32 + 8 * qg + qi) * 512 + h * 64 + d] = (bf16)f2bf(s * inv[qi]); }
    __syncthreads();
}

#define XB_TMO      128
#define XB_XCNT(j)  (256  + 64 * (j))
#define XB_XSUB(j)  (1280 + 64 * (j))
#define XB_XGEN(j)  (2304 + 64 * (j))
#define XB_TOP      3328
#define XB_TOPGEN   3392
#define XCD_BAR_WORDS 3456
#define XB_SPIN_CAP (1u << 18)

__device__ __forceinline__ unsigned xb_ld(unsigned* p)              { return __hip_atomic_load(p, __ATOMIC_RELAXED, __HIP_MEMORY_SCOPE_AGENT); }
__device__ __forceinline__ unsigned xb_add(unsigned* p, unsigned v) { return __hip_atomic_fetch_add(p, v, __ATOMIC_RELAXED, __HIP_MEMORY_SCOPE_AGENT); }
__device__ __forceinline__ unsigned xb_xcc_id() { return (unsigned)__builtin_amdgcn_s_getreg((3 << 11) | 20) & 0xFu; }
#define XB_SPIN(cond, bar) do { unsigned _sp = 0; while (cond) { __builtin_amdgcn_s_sleep(1); \
    if ((++_sp & 255u) == 0u) { if (xb_ld(&(bar)[XB_TMO])) break; if (_sp > XB_SPIN_CAP) { atomicAdd(&(bar)[XB_TMO], 1u); break; } } } } while (0)

struct XcdBarrier {
    unsigned* bar; unsigned x;
    volatile LAS unsigned* st;
};

__device__ __forceinline__ XcdBarrier xcd_barrier_post(unsigned* bar, volatile LAS unsigned* st, int wv) {
    XcdBarrier b; b.bar = bar; b.x = xb_xcc_id(); b.st = st;
    if (wv == 0 && lane_id_() == 0) (void)xb_add(&bar[XB_XCNT(b.x)], 1u);
    return b;
}
__device__ __forceinline__ void xcd_barrier_complete(unsigned* bar, unsigned x, unsigned& nloc, unsigned& nx) {
    const unsigned G = gridDim.x * gridDim.y * gridDim.z;
    unsigned sum, cnt, mine, sp = 0u;
    for (;;) {
        sum = 0u; cnt = 0u; mine = 0u;
#pragma unroll
        for (unsigned j = 0; j < 16; ++j) { const unsigned c = xb_ld(&bar[XB_XCNT(j)]); sum += c; cnt += (c > 0u) ? 1u : 0u; mine = (j == x) ? c : mine; }
        if (sum == G) break;
        __builtin_amdgcn_s_sleep(1);
        if ((++sp & 255u) == 0u) { if (xb_ld(&bar[XB_TMO])) break; if (sp > XB_SPIN_CAP) { atomicAdd(&bar[XB_TMO], 1u); break; } }
    }
    nloc = mine > 0u ? mine : 1u; nx = cnt > 0u ? cnt : 1u;
}

__device__ __forceinline__ void xcd_barrier(const XcdBarrier& b, int wv) {
    asm volatile("s_waitcnt vmcnt(0)" ::: "memory");
    __syncthreads();
    if (wv == 0 && lane_id_() == 0) {
        unsigned* bar = b.bar;
        __builtin_amdgcn_s_waitcnt(0);
        unsigned nloc = b.st[0], nx = b.st[1];
        if (nloc == 0u) { xcd_barrier_complete(bar, b.x, nloc, nx); b.st[0] = nloc; b.st[1] = nx; }
        const unsigned old = xb_add(&bar[XB_XSUB(b.x)], 1u);
        const unsigned gen = old / nloc;
        if (old + 1u == (gen + 1u) * nloc) {
            __builtin_amdgcn_fence(__ATOMIC_RELEASE, "agent");
            asm volatile("s_waitcnt vmcnt(0)" ::: "memory");
            const unsigned og = xb_add(&bar[XB_TOP], 1u);
            const unsigned tg = og / nx;
            if (og + 1u == (tg + 1u) * nx) xb_add(&bar[XB_TOPGEN], 1u);
            else XB_SPIN(xb_ld(&bar[XB_TOPGEN]) == tg, bar);
            __builtin_amdgcn_fence(__ATOMIC_ACQUIRE, "agent");
            xb_add(&bar[XB_XGEN(b.x)], 1u);
            asm volatile("s_waitcnt vmcnt(0)" ::: "memory");
        } else {
            XB_SPIN(xb_ld(&bar[XB_XGEN(b.x)]) == gen, bar);
            __builtin_amdgcn_fence(__ATOMIC_ACQUIRE, "agent");
            asm volatile("s_waitcnt vmcnt(0)" ::: "memory");
        }
    }
    __syncthreads();
}

#ifndef SKIPMASK
#define SKIPMASK 0u
#endif
#define PH(n) (((SKIPMASK) >> (n) & 1u) == 0u)
#define GSYNC() do { XcdBarrier b_; b_.bar = (unsigned*)(a.ws + WS_CTL); b_.x = xbar_x; b_.st = MISC + 8; xcd_barrier(b_, wave); } while (0)
__global__ void __launch_bounds__(NTHR, 2) fox_fwd(Args a) {
    extern __shared__ __attribute__((aligned(16))) unsigned char lds[];
    cg::grid_group grid = cg::this_grid();
    const int wave = __builtin_amdgcn_readfirstlane((int)threadIdx.x >> 6);
#define tid ((wave << 6) | lane_id_())
#define lane (lane_id_())
    const int G = gridDim.x, bx = blockIdx.x; const int vcu = (G % 8 == 0) ? (bx % 8) * (G / 8) + bx / 8 : bx;
    const int gw = vcu * NWAVES + wave, NGW = G * NWAVES;
    LAS unsigned char* ldsl = (LAS unsigned char*)lds;
    float* MOD = (float*)(a.ws + WS_MOD); bf16* XN = (bf16*)(a.ws + WS_XN); bf16* ACT = (bf16*)(a.ws + WS_ACT);
    volatile LAS unsigned* MISC = (volatile LAS unsigned*)((LAS unsigned char*)lds + MISC_OFF);
    for (int i = tid; i < LDS_BYTES / 16; i += NTHR) ((v4u*)lds)[i] = (v4u){0u, 0u, 0u, 0u};
    __syncthreads();
    __builtin_amdgcn_fence(__ATOMIC_SEQ_CST, ""); asm volatile("s_waitcnt vmcnt(0) lgkmcnt(0)" ::: "memory");
    const unsigned xbar_x = xcd_barrier_post((unsigned*)(a.ws + WS_CTL), MISC + 8, wave).x;
    grid.sync();
    float* Y = a.out + O_Y;

#ifndef NPASS
#define NPASS 1
#endif
#pragma unroll 1
    for (int pass = 0; pass < NPASS; ++pass) {
    if (pass) GSYNC();
    if (PH(0)) { for (int cb = bx; cb < 256; cb += G) ada_unit(a, lds, cb, tid);
    p0_weights(a, lds, gw, NGW, wave, lane); }
    GSYNC();
    if (PH(1)) norm_phase<false>(a, lds, a.in[0], a.in[1], a.in[9], 0, 1, gw, NGW, tid, lane);
    GSYNC();
    if (PH(2)) { pg8::Gemm g{XN, (const bf16*)(a.ws + WS_WGU1), M, 2 * FF, 1024, 1024}; pg8::StaticOrder S; S.init(M, 2 * FF, G, bx); pg8::EpiUp E{ACT, FF};
      GEMM_PHASE(pg8::EpiUp); }
    GSYNC();
    if (PH(3)) { pg8::EpiRes E{a.in[0], a.in[1], Y, MOD + 2 * 1024, 0.5f};
      { int ksub_ = 256; asm volatile("" : "+s"(ksub_)); pg8::Gemm g2{ACT + (size_t)MP * FF, (const bf16*)(a.ws + WS_WD1), 256, 1024, ksub_, FF}; pg8::SplitOrder S2; S2.init(G, bx); pg8::EpiPartial E2{(float*)(a.ws + WS_PART), 4, 256}; GEMM_PHASE_SPLIT(); }
      { pg8::Gemm g{ACT, (const bf16*)(a.ws + WS_WD1), MP, 1024, FF, FF}; pg8::StaticOrder S; S.init(MP, 1024, G, bx); GEMM_PHASE(pg8::EpiRes); }
      GSYNC();
      if (bx < 32) pg8::reduce_rowgroup<11>((const float*)(a.ws + WS_PART), bx & 3, bx >> 2, E, wave); }
    GSYNC();
    if (PH(4)) norm_phase<true>(a, lds, Y, Y + (size_t)MP * 1024, a.in[13], 3, 4, gw, NGW, tid, lane);
    GSYNC();
    if (PH(5)) { if (G >= 160) { const int u = G - 1 - bx; if (u < 80) scan_unit(a, lds, u, tid); }
                 else for (int u = bx; u < 80; u += G) scan_unit(a, lds, u, tid); }
    if (PH(6)) { pg8::Gemm g{XN, (const bf16*)(a.ws + WS_WIN), M, 2560, 1024, 1024}; pg8::StaticOrder S; S.init(M, 2560, G, bx);
      pg8::EpiIn E{(bf16*)(a.ws + WS_Q), (bf16*)(a.ws + WS_K), (bf16*)(a.ws + WS_V), (bf16*)(a.ws + WS_U), (bf16*)(a.ws + WS_G2), nullptr, nullptr,
                   (float*)(a.ws + WS_G2SS), (float*)(a.ws + WS_QS), a.out + O_KP, a.out + O_KS, a.out + O_VP, a.out + O_VS, a.in[16], a.in[17], attn_body::C2, EPS};
      GEMM_PHASE(pg8::EpiIn); }
    GSYNC();
    if (PH(7)) { const attn_body::bf16* Qb = (const attn_body::bf16*)(a.ws + WS_Q); const attn_body::bf16* Kb = (const attn_body::bf16*)(a.ws + WS_K); const attn_body::bf16* Vb = (const attn_body::bf16*)(a.ws + WS_V);
      attn_body::bf16* Ob = (attn_body::bf16*)(a.ws + WS_AO); const float* CUMP = (const float*)(a.ws + WS_CUMP);
      const int nun = (G == 256) ? 4 : (1024 - bx + G - 1) / G;
      float B2;
      { float mq = fabsf(a.in[16][lane]), mk = fabsf(a.in[17][lane]);
#pragma unroll
        for (int o = 1; o < 64; o <<= 1) { mq = fmaxf(mq, __shfl_xor(mq, o)); mk = fmaxf(mk, __shfl_xor(mk, o)); }
        B2 = 64.0f * mq * mk * attn_body::C2 * 1.01f + 0.5f; }
#pragma unroll 1
      for (int i = 0; i < nun; ++i) { int bh, qb;
          if (G == 256) { const int s = vcu & 15; bh = vcu >> 4; qb = (i == 0) ? s : (i == 1) ? 31 - s : (i == 2) ? 32 + s : 63 - s; } else { const int idx = bx + i * G; bh = idx >> 6; qb = idx & 63; }
          int ts = 0;
          { const float* cl = CUMP + (size_t)bh * SEQ; const float cref = cl[qb * 256]; const int ncand = 4 * qb;
            float cv[4];
#pragma unroll
            for (int k = 0; k < 4; ++k) { const int j = 64 * k + lane; cv[k] = (j < ncand) ? cl[64 * j + 63] : 0.f; }
#pragma unroll
            for (int k = 0; k < 4; ++k) { const int j = 64 * k + lane; const bool sk = (j < ncand) && (cref - cv[k] + 2.0f * B2 < -152.0f); ts += (int)__popcll(__ballot(sk)); }
            ts = __builtin_amdgcn_readfirstlane(ts) & ~1; }
          attn_body::attn_unit<8>(bh >> 3, bh & 7, qb, ts, CUMP + (size_t)bh * SEQ, Qb, Kb, Vb, Ob, (char*)lds, wave);
          }
      __syncthreads(); }
    if (PH(8)) for (int ci = bx; ci < 256; ci += G) gmlp_unit(a, lds, ci, tid, wave, lane);
    if (PH(9)) for (int u = bx; u < 256; u += G) sattn_unit(a, lds, u, tid, wave, lane);
    if (PH(10)) { if (G == 256) { if ((vcu & 15) == 0 && (vcu >> 4) < 8) gmlp_sample_unit(a, lds, vcu >> 4, tid); } else for (int b = bx; b < 8; b += G) gmlp_sample_unit(a, lds, b, tid); }
    GSYNC();
    if (PH(11)) { bf16* T = (bf16*)(a.ws + WS_T1); bf16* T2 = (bf16*)(a.ws + WS_T2); const bf16* WIN = (const bf16*)(a.ws + WS_WIN);
      bf16* TS = T + (size_t)MP * 1024; bf16* T2S = T2 + (size_t)MP * 1024; const bf16* XS = XN + (size_t)MP * 1024;
      float* PARTA = (float*)(a.ws + 2 * MiB); float* PARTB = (float*)(a.ws + 4 * MiB);
      { pg8::Gemm g{(const bf16*)(a.ws + WS_AO) + (size_t)MP * 512, (const bf16*)(a.ws + WS_WPA), 256, 1024, 512, 512}; pg8::StaticOrder S; S.init(256, 1024, G, bx); pg8::EpiMix<0> E{TS, nullptr}; GEMM_PHASE(pg8::EpiMix<0>); }
      { pg8::Gemm g{(const bf16*)(a.ws + WS_AO), (const bf16*)(a.ws + WS_WPA), MP, 1024, 512, 512}; pg8::StaticOrder S; S.init(MP, 1024, G, bx); pg8::EpiMix<0> E{T, nullptr}; GEMM_PHASE(pg8::EpiMix<0>); }
      { int ksub_ = 512; asm volatile("" : "+s"(ksub_)); pg8::Gemm g2{XS, WIN + (size_t)2560 * 1024, 256, 1024, ksub_, 1024}; pg8::SplitOrderT<4, 2, 512> S2; S2.init(G, (bx + G - 8) % G); pg8::EpiPartialT<4, 9> E2{PARTA}; GEMM_PHASE_SPLIT_T(4, 2, 512, 9); }
      { pg8::Gemm g{XN, WIN + (size_t)2560 * 1024, MP, 1024, 1024, 1024}; pg8::StaticOrder S; S.init(MP, 1024, G, bx); pg8::EpiMix<1> E{T, nullptr}; GEMM_PHASE(pg8::EpiMix<1>); }
      { pg8::Gemm g{(const bf16*)(a.ws + WS_BO) + (size_t)MP * 512, (const bf16*)(a.ws + WS_WPB), 256, 1024, 512, 512}; pg8::StaticOrder S; S.init(256, 1024, G, (bx + G - 16) % G); pg8::EpiMix<0> E{T2S, nullptr}; GEMM_PHASE(pg8::EpiMix<0>); }
      { pg8::Gemm g{(const bf16*)(a.ws + WS_BO), (const bf16*)(a.ws + WS_WPB), MP, 1024, 512, 512}; pg8::StaticOrder S; S.init(MP, 1024, G, bx); pg8::EpiMix<0> E{T2, nullptr}; GEMM_PHASE(pg8::EpiMix<0>); }
      { int ksub_ = 512; asm volatile("" : "+s"(ksub_)); pg8::Gemm g2{XS, WIN + (size_t)3584 * 1024, 256, 1024, ksub_, 1024}; pg8::SplitOrderT<4, 2, 512> S2; S2.init(G, (bx + G - 24) % G); pg8::EpiPartialT<4, 9> E2{PARTB}; GEMM_PHASE_SPLIT_T(4, 2, 512, 9); }
      { pg8::Gemm g{XN, WIN + (size_t)3584 * 1024, MP, 1024, 1024, 1024}; pg8::StaticOrder S; S.init(MP, 1024, G, bx); pg8::EpiMix<2> E{T, T2}; GEMM_PHASE(pg8::EpiMix<2>); }
      GSYNC();
      if (bx < 32) { pg8::EpiMix<1> E1{TS, nullptr}; pg8::reduce_rowgroup<2>(PARTA, bx & 3, bx >> 2, E1, wave);
                     pg8::EpiMix<2> E2{TS, T2S}; pg8::reduce_rowgroup<2>(PARTB, bx & 3, bx >> 2, E2, wave); } }
    GSYNC();
    if (PH(13)) { pg8::EpiRes E{Y, Y + (size_t)MP * 1024, Y, MOD + 5 * 1024, 1.0f}; const bf16* M1 = (const bf16*)(a.ws + WS_T1);
      { int ksub_ = 256; asm volatile("" : "+s"(ksub_)); pg8::Gemm g2{M1 + (size_t)MP * 1024, (const bf16*)(a.ws + WS_WOUT), 256, 1024, ksub_, 1024}; pg8::SplitOrderT<4, 4, 256> S2; S2.init(G, bx); pg8::EpiPartialT<4, 8> E2{(float*)(a.ws + WS_PART)}; GEMM_PHASE_SPLIT_T(4, 4, 256, 8); }
      { pg8::Gemm g{M1, (const bf16*)(a.ws + WS_WOUT), MP, 1024, 1024, 1024}; pg8::StaticOrder S; S.init(MP, 1024, G, bx); GEMM_PHASE(pg8::EpiRes); }
      GSYNC();
      if (bx < 32) pg8::reduce_rowgroup<4>((const float*)(a.ws + WS_PART), bx & 3, bx >> 2, E, wave); }
    GSYNC();
    if (PH(14)) norm_phase<false>(a, lds, Y, Y + (size_t)MP * 1024, a.in[24], 6, 7, gw, NGW, tid, lane);
    GSYNC();
    if (PH(15)) { pg8::Gemm g{XN, (const bf16*)(a.ws + WS_WGU2), M, 2 * FF, 1024, 1024}; pg8::StaticOrder S; S.init(M, 2 * FF, G, bx); pg8::EpiUp E{ACT, FF};
      GEMM_PHASE(pg8::EpiUp); }
    GSYNC();
    if (PH(16)) { pg8::EpiRes E{Y, Y + (size_t)MP * 1024, Y, MOD + 8 * 1024, 0.5f};
      { int ksub_ = 256; asm volatile("" : "+s"(ksub_)); pg8::Gemm g2{ACT + (size_t)MP * FF, (const bf16*)(a.ws + WS_WD2), 256, 1024, ksub_, FF}; pg8::SplitOrder S2; S2.init(G, bx); pg8::EpiPartial E2{(float*)(a.ws + WS_PART), 4, 256}; GEMM_PHASE_SPLIT(); }
      { pg8::Gemm g{ACT, (const bf16*)(a.ws + WS_WD2), MP, 1024, FF, FF}; pg8::StaticOrder S; S.init(MP, 1024, G, bx); GEMM_PHASE(pg8::EpiRes); }
      GSYNC();
      if (bx < 32) pg8::reduce_rowgroup<11>((const float*)(a.ws + WS_PART), bx & 3, bx >> 2, E, wave); }
    }
}


#undef tid
#undef lane
extern "C" void kernel_launch(void* const* d_in, const int* in_sizes, int n_in, void* d_out, int out_size, void* d_ws, size_t ws_size, hipStream_t stream) {
    static int grid = 0;
    if (grid == 0) {
        if (n_in != 28 || (size_t)out_size != O_END || ws_size < WS_END || in_sizes[0] != MP * 1024) { fprintf(stderr, "kernel_launch: unexpected shapes (n_in %d out %d ws %zu)\n", n_in, out_size, ws_size); grid = -1; return; }
        int dev = 0, cus = 0, per_cu = 0;
        hipGetDevice(&dev); hipDeviceGetAttribute(&cus, hipDeviceAttributeMultiprocessorCount, dev);
        if (hipFuncSetAttribute((const void*)fox_fwd, hipFuncAttributeMaxDynamicSharedMemorySize, LDS_BYTES) != hipSuccess) { fprintf(stderr, "kernel_launch: hipFuncSetAttribute failed\n"); grid = -1; return; }
        if (hipOccupancyMaxActiveBlocksPerMultiprocessor(&per_cu, (const void*)fox_fwd, NTHR, LDS_BYTES) != hipSuccess || per_cu < 1) { fprintf(stderr, "kernel_launch: occupancy query says %d\n", per_cu); per_cu = 1; }
        (void)hipGetLastError();
        grid = cus * 1;
    }
    if (grid < 0) return;
    if (hipMemsetAsync((char*)d_ws + WS_CTL, 0, CTL_ZERO_BYTES, stream) != hipSuccess) { fprintf(stderr, "kernel_launch: hipMemsetAsync failed\n"); return; }
    Args a{};
    for (int i = 0; i < 28; ++i) a.in[i] = (const float*)d_in[i];
    a.out = (float*)d_out; a.ws = (unsigned char*)d_ws;
    void* args[] = {&a};
    hipError_t e = hipLaunchCooperativeKernel((const void*)fox_fwd, dim3(grid), dim3(NTHR), args, LDS_BYTES, stream);
    if (e != hipSuccess) fprintf(stderr, "cooperative launch failed: %s (grid %d)\n", hipGetErrorString(e), grid);
}
```

```cpp
#include <hip/hip_runtime.h>
#include <hip/hip_cooperative_groups.h>
#include <cstdio>
#include <cstdint>
__device__ __forceinline__ int lane_id_() { return (int)__builtin_amdgcn_mbcnt_hi(~0u, __builtin_amdgcn_mbcnt_lo(~0u, 0u)); }
namespace pg8 {
#define PG8_LAS __attribute__((address_space(3)))
typedef unsigned short bf16_t;
typedef short bf16x8 __attribute__((ext_vector_type(8)));
typedef float f32x4 __attribute__((ext_vector_type(4)));
typedef unsigned u32x4 __attribute__((ext_vector_type(4)));
constexpr int BM = 256, BK = 64, HALF = 128, HTB = HALF * BK * 2  , STAGE_BYTES = 8 * HTB, NXCD = 8, WGM = 8;

__host__ __device__ __forceinline__ int lds_byte(int r, int c) { const int st = (r >> 4) * 2 + (c >> 5), rr = r & 15, cc = c & 31, ob = rr * 64 + cc * 2; return st * 1024 + (ob ^ (((ob >> 9) & 1) << 5)); }
__host__ __device__ __forceinline__ void stage_rc(int b, int& R, int& C) { const int st = b / 1024, sb = b % 1024, swz = sb ^ (((sb >> 9) & 1) << 5); R = (st >> 1) * 16 + swz / 64; C = (st & 1) * 32 + (swz % 64) / 2; }
__host__ __device__ __forceinline__ int perm32(int rho) { const int n = rho >> 4, i = rho & 15; return 8 * (i >> 2) + 4 * n + (i & 3); }

struct Unit { int pm, pn, koff; };
struct Gemm { const bf16_t* A; const bf16_t* Bt; int M, N, K, Kp; };

struct StaticOrder {
    int nM, nN, nwg, G, c;
    __host__ __device__ void init(int M, int N, int G_, int c_) { nM = M / BM; nN = N / BM; nwg = nM * nN; G = G_; c = c_; }
    __host__ __device__ bool next(int i, Unit& u) const {
        const long L = (long)i * G + c; if (L >= nwg) return false;
        int wgid = (int)L; { const int q = nwg / NXCD, r = nwg % NXCD, xcd = wgid % NXCD, off = wgid / NXCD; wgid = (xcd < r ? xcd * (q + 1) : r * (q + 1) + (xcd - r) * q) + off; }
        const int nig = WGM * nN, gid = wgid / nig, fm = gid * WGM, gsz = (nM - fm) < WGM ? (nM - fm) : WGM;
        u.pm = fm + ((wgid % nig) % gsz); u.pn = (wgid % nig) / gsz; u.koff = 0; return true;
    }
    __device__ __forceinline__ void a_ready(const Unit&) const {}
    __device__ __forceinline__ void done(const Unit&) const {}
};

template <int NN, int NS, int KSUB> struct SplitOrderT {
    int G, c;
    __host__ __device__ void init(int G_, int c_) { G = G_; c = c_; }
    __host__ __device__ bool next(int i, Unit& u) const { const int L = i * G + c; if (L >= NN * NS) return false; u.pm = 0; u.pn = L % NN; u.koff = (L / NN) * KSUB; return true; }
    __device__ __forceinline__ void a_ready(const Unit&) const {}
    __device__ __forceinline__ void done(const Unit&) const {}
};
typedef SplitOrderT<4, 11, 256> SplitOrder;
__device__ __forceinline__ unsigned cvt_pk_bf16(float lo, float hi) { unsigned r; asm volatile("v_cvt_pk_bf16_f32 %0, %1, %2" : "=v"(r) : "v"(lo), "v"(hi)); return r; }
typedef float f32x2 __attribute__((ext_vector_type(2)));
__device__ __forceinline__ f32x2 gelu_pk(f32x2 v) {
    const f32x2 av = __builtin_elementwise_abs(v), d = av * 0.2316418882f + 1.0f;
    f32x2 t; t.x = __builtin_amdgcn_rcpf(d.x); t.y = __builtin_amdgcn_rcpf(d.y);
    f32x2 q = t * 0.5307027145f + (-0.7265760135f); q = q * t + 0.7107068705f; q = q * t + (-0.142248368f); q = q * t + 0.127414796f; q = q * t;
    const f32x2 s = (v * v) * (-0.72134752044f);
    f32x2 e; e.x = __builtin_amdgcn_exp2f(s.x); e.y = __builtin_amdgcn_exp2f(s.y);
    const f32x2 m = v * (q * e), r = v - m;
    f32x2 o; o.x = v.x < 0.f ? m.x : r.x; o.y = v.y < 0.f ? m.y : r.y; return o;
}

constexpr int MPROMPT = 32768;
constexpr int NMODC = 9216;
typedef unsigned u32x2v __attribute__((ext_vector_type(2)));
__device__ __forceinline__ float sigm(float x) { return __builtin_amdgcn_rcpf(1.0f + __builtin_amdgcn_exp2f(-1.4426950408889634f * x)); }
__device__ __forceinline__ float gelu_tanh(float x) { const float y = 1.5957691216057308f * (x + 0.044715f * x * x * x); return x * sigm(y); }
__device__ __forceinline__ float bf_lo(unsigned w) { return __uint_as_float(w << 16); }
__device__ __forceinline__ float bf_hi(unsigned w) { return __uint_as_float(w & 0xffff0000u); }
__device__ __forceinline__ int mod_row(int pm, int rloc) { return pm < 128 ? (pm >> 6) : 2 + (rloc >> 5); }

struct EpiUp {
    static constexpr bool PERM = true, AFTER_DRAIN = false;
    bf16_t* ACT; int ldc;
    __device__ __forceinline__ void operator()(const f32x4 (&acc)[2][2][4][2], const Unit& u, int wr, int wc, int fr, int fq) const {
        int fr_ = fr, fq_ = fq; asm volatile("" : "+v"(fr_), "+v"(fq_));
        const int row0 = u.pm * BM + wr * 64 + fr_, ch0 = u.pn * HALF + wc * 32 + 8 * fq_;
#pragma unroll
        for (int ai = 0; ai < 2; ++ai)
#pragma unroll
            for (int m = 0; m < 4; ++m) {
                float o[8];
#pragma unroll
                for (int n = 0; n < 2; ++n)
#pragma unroll
                    for (int i = 0; i < 4; ++i) { const float g = acc[ai][0][m][n][i], up = acc[ai][1][m][n][i]; o[4 * n + i] = g * sigm(g) * up; }
                u32x4 w; w.x = cvt_pk_bf16(o[0], o[1]); w.y = cvt_pk_bf16(o[2], o[3]); w.z = cvt_pk_bf16(o[4], o[5]); w.w = cvt_pk_bf16(o[6], o[7]);
                *(u32x4*)(ACT + (size_t)(row0 + ai * HALF + m * 16) * ldc + ch0) = w;
            }
    }
};
struct EpiRes {
    static constexpr bool PERM = true, AFTER_DRAIN = false;
    const float* resp; const float* ress; float* out; const float* gate; float fac;
    __device__ __forceinline__ void rowgroup(const f32x4 (&v)[2][2], int pn, int ai, int m, int wr, int wc, int fr, int fq) const {
        const int rl = wr * 64 + fr + ai * HALF + m * 16, col0 = pn * BM + wc * 32 + 8 * fq;
        const float* gp = gate + (size_t)(2 + (rl >> 5)) * NMODC + col0; float* obase = out + (size_t)128 * BM * 1024;
#pragma unroll
        for (int bj = 0; bj < 2; ++bj)
#pragma unroll
            for (int n = 0; n < 2; ++n) { const size_t off = (size_t)rl * 1024 + col0 + bj * HALF + 4 * n;
                const f32x4 gv = *(const f32x4*)(gp + bj * HALF + 4 * n), rv = *(const f32x4*)(ress + off);
                *(f32x4*)(obase + off) = rv + (gv * fac) * v[bj][n]; }
    }
    __device__ __forceinline__ void operator()(const f32x4 (&acc)[2][2][4][2], const Unit& u, int wr, int wc, int fr, int fq) const {
        int fr_ = fr, fq_ = fq; asm volatile("" : "+v"(fr_), "+v"(fq_));
        const int rl0 = wr * 64 + fr_, col0 = u.pn * BM + wc * 32 + 8 * fq_;
        const float* rbase = (u.pm < 128) ? resp + (size_t)u.pm * BM * 1024 : ress;
        float* obase = out + (size_t)u.pm * BM * 1024;
#pragma unroll
        for (int ai = 0; ai < 2; ++ai)
#pragma unroll
            for (int m = 0; m < 4; ++m) {
                const int rl = rl0 + ai * HALF + m * 16; const float* gp = gate + (size_t)mod_row(u.pm, rl) * NMODC + col0;
                f32x4 gv4[2][2], rv4[2][2];
#pragma unroll
                for (int bj = 0; bj < 2; ++bj)
#pragma unroll
                    for (int n = 0; n < 2; ++n) { gv4[bj][n] = *(const f32x4*)(gp + bj * HALF + 4 * n); rv4[bj][n] = *(const f32x4*)(rbase + (size_t)rl * 1024 + col0 + bj * HALF + 4 * n); }
#pragma unroll
                for (int bj = 0; bj < 2; ++bj)
#pragma unroll
                    for (int n = 0; n < 2; ++n) *(f32x4*)(obase + (size_t)rl * 1024 + col0 + bj * HALF + 4 * n) = rv4[bj][n] + (gv4[bj][n] * fac) * acc[ai][bj][m][n];
            }
    }
};
struct EpiIn {
    static constexpr bool PERM = true, AFTER_DRAIN = false;
    bf16_t *Q, *K, *V, *U, *G2, *SGA, *SGB; float* G2SS; float* QS;
    float *kout_p, *kout_s, *vout_p, *vout_s;
    const float *gq, *gk; float qscale, eps;
    __device__ __forceinline__ void operator()(const f32x4 (&acc)[2][2][4][2], const Unit& u, int wr, int wc, int fr, int fq) const {
        int fr_ = fr, fq_ = fq; asm volatile("" : "+v"(fr_), "+v"(fq_));
        const int pn = u.pn, rl0 = wr * 64 + fr_; const size_t rg0 = (size_t)u.pm * BM;
        if (pn < 4) {
            const bool isq = pn < 2; const int head = 4 * (pn & 1) + wc; const float* gsrc = isq ? gq : gk;
            f32x4 gv[2][2];
#pragma unroll
            for (int bj = 0; bj < 2; ++bj)
#pragma unroll
                for (int n = 0; n < 2; ++n) { gv[bj][n] = *(const f32x4*)(gsrc + 32 * bj + 8 * fq_ + 4 * n); if (isq) gv[bj][n] = gv[bj][n] * qscale; }
            bf16_t* dst = isq ? Q : K;
#pragma unroll
            for (int ai = 0; ai < 2; ++ai)
#pragma unroll
                for (int m = 0; m < 4; ++m) {
                    float ss = 0.f;
#pragma unroll
                    for (int bj = 0; bj < 2; ++bj)
#pragma unroll
                        for (int n = 0; n < 2; ++n) { const f32x4 x = acc[ai][bj][m][n]; ss += (x[0] * x[0] + x[1] * x[1]) + (x[2] * x[2] + x[3] * x[3]); }
                    ss += __shfl_xor(ss, 16); ss += __shfl_xor(ss, 32);
                    const float rstd = 1.0f / sqrtf(ss * (1.0f / 64.0f) + eps);
                    const int rl = rl0 + ai * HALF + m * 16; const size_t r = rg0 + rl;
#pragma unroll
                    for (int bj = 0; bj < 2; ++bj) {
                        const f32x4 o0 = acc[ai][bj][m][0] * rstd * gv[bj][0], o1 = acc[ai][bj][m][1] * rstd * gv[bj][1];
                        const int c = head * 64 + 32 * bj + 8 * fq_;
                        u32x4 w; w.x = cvt_pk_bf16(o0[0], o0[1]); w.y = cvt_pk_bf16(o0[2], o0[3]); w.z = cvt_pk_bf16(o1[0], o1[1]); w.w = cvt_pk_bf16(o1[2], o1[3]);
                        *(u32x4*)(dst + r * 512 + c) = w;
                        if (isq) { if (u.pm == 128) { float* qp = QS + (size_t)rl * 512 + c; *(f32x4*)qp = o0; *(f32x4*)(qp + 4) = o1; } }
                        else { float* kp = (u.pm < 128) ? kout_p + r * 512 + c : kout_s + (size_t)rl * 512 + c; *(f32x4*)kp = o0; *(f32x4*)(kp + 4) = o1; }
                    }
                    asm volatile("" ::: "memory");
                }
        } else if (pn < 6) {
            const int c0 = (pn - 4) * BM + wc * 32 + 8 * fq_;
#pragma unroll
            for (int ai = 0; ai < 2; ++ai)
#pragma unroll
                for (int m = 0; m < 4; ++m) { const int rl = rl0 + ai * HALF + m * 16; const size_t r = rg0 + rl;
#pragma unroll
                    for (int bj = 0; bj < 2; ++bj) { const f32x4 o0 = acc[ai][bj][m][0], o1 = acc[ai][bj][m][1]; const int c = c0 + bj * HALF;
                        u32x4 w; w.x = cvt_pk_bf16(o0[0], o0[1]); w.y = cvt_pk_bf16(o0[2], o0[3]); w.z = cvt_pk_bf16(o1[0], o1[1]); w.w = cvt_pk_bf16(o1[2], o1[3]);
                        *(u32x4*)(V + r * 512 + c) = w;
                        float* vp = (u.pm < 128) ? vout_p + r * 512 + c : vout_s + (size_t)rl * 512 + c;
                        { *(f32x4*)vp = o0; *(f32x4*)(vp + 4) = o1; } } asm volatile("" ::: "memory"); }
        } else if (pn < 10) {
            const bool isv = pn >= 8; const int t2 = (pn - 6) & 1; const int c0 = t2 * BM + wc * 32 + 8 * fq_; bf16_t* dst = isv ? G2 : U;
#pragma unroll
            for (int ai = 0; ai < 2; ++ai)
#pragma unroll
                for (int m = 0; m < 4; ++m) { const int rl = rl0 + ai * HALF + m * 16; const size_t r = rg0 + rl; float ss = 0.f;
#pragma unroll
                    for (int bj = 0; bj < 2; ++bj) { float o[8];
#pragma unroll
                        for (int n = 0; n < 2; ++n)
#pragma unroll
                            for (int i = 0; i < 4; ++i) { const float g = gelu_tanh(acc[ai][bj][m][n][i]); o[4 * n + i] = g; ss += g * g; }
                        u32x4 w; w.x = cvt_pk_bf16(o[0], o[1]); w.y = cvt_pk_bf16(o[2], o[3]); w.z = cvt_pk_bf16(o[4], o[5]); w.w = cvt_pk_bf16(o[6], o[7]);
                        *(u32x4*)(dst + r * 512 + c0 + bj * HALF) = w; }
                    if (isv) { ss += __shfl_xor(ss, 16); ss += __shfl_xor(ss, 32); if (fq_ == 0) G2SS[r * 8 + t2 * 4 + wc] = ss; } asm volatile("" ::: "memory"); }
        } else {
            const bool isa = pn < 14; const int c0 = ((pn - 10) & 3) * BM + wc * 32 + 8 * fq_; bf16_t* dst = isa ? SGA : SGB;
#pragma unroll
            for (int ai = 0; ai < 2; ++ai)
#pragma unroll
                for (int m = 0; m < 4; ++m) { const size_t r = rg0 + rl0 + ai * HALF + m * 16;
#pragma unroll
                    for (int bj = 0; bj < 2; ++bj) { float o[8];
#pragma unroll
                        for (int n = 0; n < 2; ++n)
#pragma unroll
                            for (int i = 0; i < 4; ++i) o[4 * n + i] = sigm(acc[ai][bj][m][n][i]);
                        u32x4 w; w.x = cvt_pk_bf16(o[0], o[1]); w.y = cvt_pk_bf16(o[2], o[3]); w.z = cvt_pk_bf16(o[4], o[5]); w.w = cvt_pk_bf16(o[6], o[7]);
                        *(u32x4*)(dst + r * 1024 + c0 + bj * HALF) = w;
                        } asm volatile("" ::: "memory"); }
        }
    }
};
struct EpiPartial {
    static constexpr bool PERM = true, AFTER_DRAIN = false;
    float* PART; int nN, Ksub;
    __device__ __forceinline__ void operator()(const f32x4 (&acc)[2][2][4][2], const Unit& u, int wr, int wc, int fr, int fq) const {
        int tid_ = (wr * 4 + wc) * 64 + fq * 16 + fr; asm volatile("" : "+v"(tid_));
        f32x4* dst = (f32x4*)PART + (size_t)((u.koff >> 8) * 4 + u.pn) * 32 * 512 + tid_;
#pragma unroll
        for (int ai = 0; ai < 2; ++ai)
#pragma unroll
            for (int bj = 0; bj < 2; ++bj)
#pragma unroll
                for (int m = 0; m < 4; ++m)
#pragma unroll
                    for (int n = 0; n < 2; ++n) { *dst = acc[ai][bj][m][n]; dst += 512; asm volatile("" : "+v"(dst) :: "memory"); }
        asm volatile("" ::: "memory");
    }
};
template <int NN, int KSHIFT> struct EpiPartialT {
    static constexpr bool PERM = true, AFTER_DRAIN = false;
    float* PART;
    __device__ __forceinline__ void operator()(const f32x4 (&acc)[2][2][4][2], const Unit& u, int wr, int wc, int fr, int fq) const {
        int tid_ = (wr * 4 + wc) * 64 + fq * 16 + fr; asm volatile("" : "+v"(tid_));
        f32x4* dst = (f32x4*)PART + (size_t)((u.koff >> KSHIFT) * NN + u.pn) * 32 * 512 + tid_;
#pragma unroll
        for (int ai = 0; ai < 2; ++ai)
#pragma unroll
            for (int bj = 0; bj < 2; ++bj)
#pragma unroll
                for (int m = 0; m < 4; ++m)
#pragma unroll
                    for (int n = 0; n < 2; ++n) { *dst = acc[ai][bj][m][n]; dst += 512; asm volatile("" : "+v"(dst) :: "memory"); }
    }
};
template <class Epi> __device__ __forceinline__ void reduce_partials(const float* PART, int nN, int nS, int pn, int pm_out, const Epi& E, int wv) {
    int tid = (wv << 6) | lane_id_(); asm volatile("" : "+v"(tid));
    const int wid = __builtin_amdgcn_readfirstlane(tid >> 6), lane = tid & 63, wr = wid >> 2, wc = wid & 3, fr = lane & 15, fq = lane >> 4;
    f32x4 acc[2][2][4][2];
#pragma unroll
    for (int ai = 0; ai < 2; ++ai)
#pragma unroll
        for (int bj = 0; bj < 2; ++bj)
#pragma unroll
            for (int m = 0; m < 4; ++m)
#pragma unroll
                for (int n = 0; n < 2; ++n) acc[ai][bj][m][n] = (f32x4){0.f, 0.f, 0.f, 0.f};
#pragma unroll 1
    for (int s = 0; s < nS; ++s) { const f32x4* src = (const f32x4*)PART + (size_t)(s * nN + pn) * 32 * 512 + tid;
#pragma unroll
        for (int ai = 0; ai < 2; ++ai) {
            f32x4 t[2][4][2];
#pragma unroll
            for (int bj = 0; bj < 2; ++bj)
#pragma unroll
                for (int m = 0; m < 4; ++m)
#pragma unroll
                    for (int n = 0; n < 2; ++n) { t[bj][m][n] = *src; src += 512; asm volatile("" : "+v"(src)); }
#pragma unroll
            for (int bj = 0; bj < 2; ++bj)
#pragma unroll
                for (int m = 0; m < 4; ++m)
#pragma unroll
                    for (int n = 0; n < 2; ++n) acc[ai][bj][m][n] += t[bj][m][n];
            asm volatile("" ::: "memory"); } }
    Unit u; u.pm = pm_out; u.pn = pn; u.koff = 0;
    E(acc, u, wr, wc, fr, fq);
}
template <int NS, class Epi> __device__ __forceinline__ void reduce_rowgroup(const float* PART, int pn, int rg, const Epi& E, int wv) {
    int tid = (wv << 6) | lane_id_(); asm volatile("" : "+v"(tid));
    const int wid = __builtin_amdgcn_readfirstlane(tid >> 6), lane = tid & 63, wr = wid >> 2, wc = wid & 3, fr = lane & 15, fq = lane >> 4;
    const int ai = rg >> 2, m = rg & 3;
    f32x4 t[NS][2][2];
#pragma unroll
    for (int s = 0; s < NS; ++s)
#pragma unroll
        for (int bj = 0; bj < 2; ++bj)
#pragma unroll
            for (int n = 0; n < 2; ++n) t[s][bj][n] = *((const f32x4*)PART + ((size_t)(s * 4 + pn) * 32 + (((ai * 2 + bj) * 4 + m) * 2 + n)) * 512 + tid);
    f32x4 v[2][2];
#pragma unroll
    for (int bj = 0; bj < 2; ++bj)
#pragma unroll
        for (int n = 0; n < 2; ++n) { v[bj][n] = t[0][bj][n];
#pragma unroll
            for (int s = 1; s < NS; ++s) v[bj][n] += t[s][bj][n]; }
    E.rowgroup(v, pn, ai, m, wr, wc, fr, fq);
}
template <int MODE> struct EpiMix {
    static constexpr bool PERM = true, AFTER_DRAIN = false;
    bf16_t* T; const bf16_t* T2;
    __device__ __forceinline__ void one(size_t off, const f32x4 a0, const f32x4 a1) const {
        float o[8] = {a0[0], a0[1], a0[2], a0[3], a1[0], a1[1], a1[2], a1[3]};
        if (MODE >= 1) {
            const u32x4 t = *(const u32x4*)(T + off);
            const float tv[8] = {bf_lo(t.x), bf_hi(t.x), bf_lo(t.y), bf_hi(t.y), bf_lo(t.z), bf_hi(t.z), bf_lo(t.w), bf_hi(t.w)};
            if (MODE == 1) {
#pragma unroll
                for (int i = 0; i < 8; ++i) o[i] = sigm(o[i]) * tv[i];
            } else {
                const u32x4 s2 = *(const u32x4*)(T2 + off);
                const float sv[8] = {bf_lo(s2.x), bf_hi(s2.x), bf_lo(s2.y), bf_hi(s2.y), bf_lo(s2.z), bf_hi(s2.z), bf_lo(s2.w), bf_hi(s2.w)};
#pragma unroll
                for (int i = 0; i < 8; ++i) o[i] = tv[i] + sigm(o[i]) * sv[i];
            }
        }
        u32x4 w; w.x = cvt_pk_bf16(o[0], o[1]); w.y = cvt_pk_bf16(o[2], o[3]); w.z = cvt_pk_bf16(o[4], o[5]); w.w = cvt_pk_bf16(o[6], o[7]);
        *(u32x4*)(T + off) = w;
    }
    __device__ __forceinline__ void two(size_t off, const f32x4 a0, const f32x4 a1, const u32x4 t, const u32x4 s2) const {
        float o[8] = {a0[0], a0[1], a0[2], a0[3], a1[0], a1[1], a1[2], a1[3]};
        const float tv[8] = {bf_lo(t.x), bf_hi(t.x), bf_lo(t.y), bf_hi(t.y), bf_lo(t.z), bf_hi(t.z), bf_lo(t.w), bf_hi(t.w)};
        if (MODE == 1) {
#pragma unroll
            for (int i = 0; i < 8; ++i) o[i] = sigm(o[i]) * tv[i];
        } else {
            const float sv[8] = {bf_lo(s2.x), bf_hi(s2.x), bf_lo(s2.y), bf_hi(s2.y), bf_lo(s2.z), bf_hi(s2.z), bf_lo(s2.w), bf_hi(s2.w)};
#pragma unroll
            for (int i = 0; i < 8; ++i) o[i] = tv[i] + sigm(o[i]) * sv[i];
        }
        u32x4 w; w.x = cvt_pk_bf16(o[0], o[1]); w.y = cvt_pk_bf16(o[2], o[3]); w.z = cvt_pk_bf16(o[4], o[5]); w.w = cvt_pk_bf16(o[6], o[7]);
        *(u32x4*)(T + off) = w;
    }
    __device__ __forceinline__ void operator()(const f32x4 (&acc)[2][2][4][2], const Unit& u, int wr, int wc, int fr, int fq) const {
        int fr_ = fr, fq_ = fq; asm volatile("" : "+v"(fr_), "+v"(fq_));
        const size_t row0 = (size_t)u.pm * BM + wr * 64 + fr_; const int col0 = u.pn * BM + wc * 32 + 8 * fq_;
#pragma unroll
        for (int ai = 0; ai < 2; ++ai)
#pragma unroll
            for (int m = 0; m < 4; ++m) {
                const size_t off0 = (row0 + ai * HALF + m * 16) * 1024 + col0;
                if (MODE >= 1) {
                    const u32x4 ta = *(const u32x4*)(T + off0), tb = *(const u32x4*)(T + off0 + HALF);
                    u32x4 sa = ta, sb = tb; if (MODE == 2) { sa = *(const u32x4*)(T2 + off0); sb = *(const u32x4*)(T2 + off0 + HALF); }
                    two(off0, acc[ai][0][m][0], acc[ai][0][m][1], ta, sa); two(off0 + HALF, acc[ai][1][m][0], acc[ai][1][m][1], tb, sb);
                } else {
#pragma unroll
                    for (int bj = 0; bj < 2; ++bj) one(off0 + bj * HALF, acc[ai][bj][m][0], acc[ai][bj][m][1]);
                }
                asm volatile("" ::: "memory");
            }
    }
    __device__ __forceinline__ void rowgroup(const f32x4 (&v)[2][2], int pn, int ai, int m, int wr, int wc, int fr, int fq) const {
        const size_t row = (size_t)(wr * 64 + fr + ai * HALF + m * 16); const int col0 = pn * BM + wc * 32 + 8 * fq;
#pragma unroll
        for (int bj = 0; bj < 2; ++bj) one(row * 1024 + col0 + bj * HALF, v[bj][0], v[bj][1]);
    }
};
template <class Epi, class Sched, bool ALIGN_EPI = false, bool SP2 = false>
__device__ __forceinline__ void gemm_phase(PG8_LAS unsigned char* lds, const Gemm g, const Sched& S, const Epi& E, int wv) {
    int tid = (wv << 6) | lane_id_(); asm volatile("" : "+v"(tid));
    const int wid = __builtin_amdgcn_readfirstlane(tid >> 6), lane = tid & 63, wr = wid >> 2, wc = wid & 3, fr = lane & 15, fq = lane >> 4;
    const int K = g.Kp, nt = g.K / BK;
    unsigned voffA[2], voffB[2];
#pragma unroll
    for (int i = 0; i < 2; ++i) { int R, C; stage_rc(tid * 16 + i * 8192, R, C); const int Rb = Epi::PERM ? ((R & ~31) + perm32(R & 31)) : R;
        voffA[i] = (unsigned)(R * K + C) * 2u; voffB[i] = (unsigned)(Rb * K + C) * 2u; }
    const size_t kstep = (size_t)(BK * 2);
    const size_t hstep = (size_t)HALF * K * 2;
    const size_t tstep = 2 * hstep;
    const unsigned ldsw = (unsigned)wid * 1024u;
    const int aoff = lds_byte(wr * 64 + fr, fq * 8), boff = lds_byte(wc * 32 + fr, fq * 8);
#define PG8_SA(b, h) (((b) * 2 + (h)) * HTB)
#define PG8_SB(b, h) ((4 + (b) * 2 + (h)) * HTB)
#define PG8_STAGE(bufoff, gbase, voff) do { _Pragma("unroll") for (int _i = 0; _i < 2; ++_i) \
        __builtin_amdgcn_global_load_lds((const unsigned*)((const char*)(gbase) + (voff)[_i]), (PG8_LAS unsigned*)(lds + (bufoff) + ldsw + _i * 8192), 16, 0, 0); } while (0)
#define PG8_LDA(dst, b, h) do { _Pragma("unroll") for (int m = 0; m < 4; ++m) _Pragma("unroll") for (int k = 0; k < 2; ++k) dst[m][k] = *(const PG8_LAS bf16x8*)(lds + PG8_SA(b, h) + aoff + m * 2048 + k * 1024); } while (0)
#define PG8_LDB(dst, b, h) do { _Pragma("unroll") for (int n = 0; n < 2; ++n) _Pragma("unroll") for (int k = 0; k < 2; ++k) dst[n][k] = *(const PG8_LAS bf16x8*)(lds + PG8_SB(b, h) + boff + n * 2048 + k * 1024); } while (0)
#define PG8_MMA(ai, bj, At, Bt) do { __builtin_amdgcn_s_setprio(1); _Pragma("unroll") for (int m = 0; m < 4; ++m) _Pragma("unroll") for (int n = 0; n < 2; ++n) _Pragma("unroll") for (int k = 0; k < 2; ++k) \
        acc[ai][bj][m][n] = __builtin_amdgcn_mfma_f32_16x16x32_bf16(Bt[n][k], At[m][k], acc[ai][bj][m][n], 0, 0, 0); __builtin_amdgcn_s_setprio(0); } while (0)
#define PG8_WAIT_V(n) asm volatile("s_waitcnt vmcnt(" #n ")" ::: "memory")
#define PG8_WAIT_L(n) asm volatile("s_waitcnt lgkmcnt(" #n ")" ::: "memory")
#define PG8_BAR __builtin_amdgcn_s_barrier()
#define PG8_SCHED __builtin_amdgcn_sched_barrier(0)
    Unit cur, nxt; int ui = 0;
    if (!S.next(0, cur)) return;
    f32x4 acc[2][2][4][2];
#pragma unroll
    for (int a = 0; a < 2; ++a)
#pragma unroll
        for (int b = 0; b < 2; ++b)
#pragma unroll
            for (int m = 0; m < 4; ++m)
#pragma unroll
                for (int n = 0; n < 2; ++n) acc[a][b][m][n] = (f32x4){0.f, 0.f, 0.f, 0.f};
    bf16x8 At[4][2], B0[2][2], B1[2][2];
    const char* cA = (const char*)g.A + (size_t)cur.pm * tstep + (size_t)cur.koff * 2; const char* cB = (const char*)g.Bt + (size_t)cur.pn * tstep + (size_t)cur.koff * 2;
    S.a_ready(cur);
    if constexpr (SP2) {
        PG8_STAGE(PG8_SB(0, 0), cB, voffB); PG8_STAGE(PG8_SB(0, 1), cB + hstep, voffB); PG8_STAGE(PG8_SA(0, 0), cA, voffA); PG8_STAGE(PG8_SA(0, 1), cA + hstep, voffA);
        if (wr == 1) PG8_BAR;
        PG8_WAIT_V(2); PG8_BAR;
        PG8_STAGE(PG8_SB(1, 0), cB + kstep, voffB); PG8_STAGE(PG8_SA(1, 0), cA + kstep, voffA); PG8_STAGE(PG8_SB(1, 1), cB + hstep + kstep, voffB);
        PG8_WAIT_V(6); PG8_BAR;
    } else {
        PG8_STAGE(PG8_SB(0, 0), cB, voffB); PG8_STAGE(PG8_SA(0, 0), cA, voffA); PG8_STAGE(PG8_SB(0, 1), cB + hstep, voffB); PG8_STAGE(PG8_SA(0, 1), cA + hstep, voffA);
        if (wr == 1) PG8_BAR;
        PG8_WAIT_V(4); PG8_BAR;
        PG8_STAGE(PG8_SB(1, 0), cB + kstep, voffB); PG8_STAGE(PG8_SA(1, 0), cA + kstep, voffA); PG8_STAGE(PG8_SB(1, 1), cB + hstep + kstep, voffB);
        PG8_WAIT_V(6); PG8_BAR;
    }
    for (;;) {
        const bool has_next = S.next(ui + 1, nxt);
        const char* nA = has_next ? (const char*)g.A + (size_t)nxt.pm * tstep + (size_t)nxt.koff * 2 : cA; const char* nB = has_next ? (const char*)g.Bt + (size_t)nxt.pn * tstep + (size_t)nxt.koff * 2 : cB;
        for (int t = 0; t < nt; t += 2) {
            const bool last = (t == nt - 2);
            const char* a1 = cA + (size_t)(t + 1) * kstep;
            const char* a2 = last ? nA : cA + (size_t)(t + 2) * kstep; const char* b2 = last ? nB : cB + (size_t)(t + 2) * kstep;
            const char* a3 = a2 + kstep; const char* b3 = b2 + kstep;
            if (last && has_next) S.a_ready(nxt);
            if constexpr (SP2) {
            PG8_LDB(B0, 0, 0); PG8_LDB(B1, 0, 1); PG8_SCHED; PG8_LDA(At, 0, 0); PG8_STAGE(PG8_SA(1, 1), a1 + hstep, voffA);
            PG8_WAIT_V(8); PG8_WAIT_L(0); PG8_BAR; PG8_MMA(0, 0, At, B0); PG8_MMA(0, 1, At, B1); PG8_BAR; PG8_SCHED;
            PG8_LDA(At, 0, 1); PG8_STAGE(PG8_SB(0, 0), b2, voffB); PG8_STAGE(PG8_SB(0, 1), b2 + hstep, voffB); PG8_STAGE(PG8_SA(0, 0), a2, voffA);
            PG8_WAIT_V(8); PG8_WAIT_L(0); PG8_BAR; PG8_MMA(1, 0, At, B0); PG8_MMA(1, 1, At, B1); PG8_BAR; PG8_SCHED;
            PG8_LDB(B0, 1, 0); PG8_LDB(B1, 1, 1); PG8_SCHED; PG8_LDA(At, 1, 0); PG8_STAGE(PG8_SA(0, 1), a2 + hstep, voffA);
            PG8_WAIT_V(8); PG8_WAIT_L(0); PG8_BAR; PG8_MMA(0, 0, At, B0); PG8_MMA(0, 1, At, B1); PG8_BAR; PG8_SCHED;
            PG8_LDA(At, 1, 1); PG8_STAGE(PG8_SB(1, 0), b3, voffB); PG8_STAGE(PG8_SB(1, 1), b3 + hstep, voffB); PG8_STAGE(PG8_SA(1, 0), a3, voffA);
            PG8_WAIT_V(8); PG8_WAIT_L(0); PG8_BAR; PG8_MMA(1, 0, At, B0); PG8_MMA(1, 1, At, B1); PG8_BAR; PG8_SCHED;
            } else {
            PG8_LDB(B0, 0, 0); PG8_SCHED; PG8_LDA(At, 0, 0); PG8_STAGE(PG8_SA(1, 1), a1 + hstep, voffA);
            PG8_WAIT_L(8); PG8_BAR; PG8_WAIT_L(0); PG8_MMA(0, 0, At, B0); PG8_BAR; PG8_SCHED;
            PG8_LDB(B1, 0, 1); PG8_STAGE(PG8_SB(0, 0), b2, voffB);
            PG8_BAR; PG8_WAIT_L(0); PG8_MMA(0, 1, At, B1); PG8_BAR;
            PG8_LDA(At, 0, 1); PG8_STAGE(PG8_SA(0, 0), a2, voffA);
            PG8_BAR; PG8_WAIT_L(0); PG8_MMA(1, 0, At, B0); PG8_BAR; PG8_SCHED;
            PG8_STAGE(PG8_SB(0, 1), b2 + hstep, voffB);
            PG8_WAIT_V(6); PG8_BAR; PG8_MMA(1, 1, At, B1); PG8_BAR;
            PG8_LDB(B0, 1, 0); PG8_SCHED; PG8_LDA(At, 1, 0); PG8_STAGE(PG8_SA(0, 1), a2 + hstep, voffA);
            PG8_WAIT_L(8); PG8_BAR; PG8_WAIT_L(0); PG8_MMA(0, 0, At, B0); PG8_BAR; PG8_SCHED;
            PG8_LDB(B1, 1, 1); PG8_STAGE(PG8_SB(1, 0), b3, voffB);
            PG8_BAR; PG8_WAIT_L(0); PG8_MMA(0, 1, At, B1); PG8_BAR;
            PG8_LDA(At, 1, 1); PG8_STAGE(PG8_SA(1, 0), a3, voffA);
            PG8_BAR; PG8_WAIT_L(0); PG8_MMA(1, 0, At, B0); PG8_BAR; PG8_SCHED;
            PG8_STAGE(PG8_SB(1, 1), b3 + hstep, voffB);
            PG8_WAIT_V(6); PG8_BAR; PG8_MMA(1, 1, At, B1); PG8_BAR;
            }
        }
        if constexpr (ALIGN_EPI) { if (wr == 0) PG8_BAR; }
        if constexpr (!Epi::AFTER_DRAIN) { E(acc, cur, wr, wc, fr, fq); S.done(cur); }
        if (!has_next) break;
#pragma unroll
        for (int a = 0; a < 2; ++a)
#pragma unroll
            for (int b = 0; b < 2; ++b)
#pragma unroll
                for (int m = 0; m < 4; ++m)
#pragma unroll
                    for (int n = 0; n < 2; ++n) acc[a][b][m][n] = (f32x4){0.f, 0.f, 0.f, 0.f};
        cur = nxt; cA = nA; cB = nB; ++ui;
        if constexpr (ALIGN_EPI) { if (wr == 1) PG8_BAR; }
    }
    PG8_WAIT_V(0);
    if constexpr (!ALIGN_EPI) { if (wr == 0) PG8_BAR; }
    PG8_BAR;
    if constexpr (Epi::AFTER_DRAIN) { E.fused(acc, cur, wr, wc, fr, fq, lds, wid, lane); S.done(cur); }
#undef PG8_SA
#undef PG8_SB
#undef PG8_STAGE
#undef PG8_LDA
#undef PG8_LDB
#undef PG8_MMA
#undef PG8_WAIT_V
#undef PG8_WAIT_L
#undef PG8_BAR
#undef PG8_SCHED
}

template <class Epi, class Sched>
__device__ __forceinline__ void naive_phase(const Gemm g, const Sched& S, const Epi& E) {
    int tid = threadIdx.x; asm volatile("" : "+v"(tid));
    const int wid = __builtin_amdgcn_readfirstlane(tid >> 6), lane = tid & 63, wr = wid >> 2, wc = wid & 3, fr = lane & 15, fq = lane >> 4;
    Unit u;
#pragma unroll 1
    for (int ui = 0; S.next(ui, u); ++ui) {
        f32x4 acc[2][2][4][2];
#pragma unroll
        for (int ai = 0; ai < 2; ++ai)
#pragma unroll
            for (int m = 0; m < 4; ++m) {
                const bf16_t* arow = g.A + (size_t)(u.pm * BM + ai * HALF + wr * 64 + m * 16 + fr) * g.Kp;
#pragma unroll
                for (int bj = 0; bj < 2; ++bj)
#pragma unroll
                    for (int n = 0; n < 2; ++n)
#pragma unroll
                        for (int i = 0; i < 4; ++i) {
                            const bf16_t* brow = g.Bt + (size_t)(u.pn * BM + bj * HALF + wc * 32 + 8 * fq + 4 * n + i) * g.Kp;
                            float s = 0.f;
#pragma unroll 1
                            for (int k = 0; k < g.K; k += 8) { const u32x4 a = *(const u32x4*)(arow + k), b = *(const u32x4*)(brow + k);
                                s += bf_lo(a.x) * bf_lo(b.x) + bf_hi(a.x) * bf_hi(b.x) + bf_lo(a.y) * bf_lo(b.y) + bf_hi(a.y) * bf_hi(b.y)
                                   + bf_lo(a.z) * bf_lo(b.z) + bf_hi(a.z) * bf_hi(b.z) + bf_lo(a.w) * bf_lo(b.w) + bf_hi(a.w) * bf_hi(b.w); }
                            acc[ai][bj][m][n][i] = s;
                        }
            }
        E(acc, u, wr, wc, fr, fq);
    }
    __syncthreads();
}
}
#include <hip/hip_bf16.h>
#include <cmath>
namespace attn_body {
using bf16=__hip_bfloat16;
using bf16x8=__attribute__((ext_vector_type(8)))short;
using s16x4=__attribute__((ext_vector_type(4)))short;
using f32x16=__attribute__((ext_vector_type(16)))float;
using u32x4=__attribute__((ext_vector_type(4)))unsigned;
using f32x4_t=__attribute__((ext_vector_type(4)))float;
constexpr int BATCH=2,NHEAD=8,SEQ=16384,D=64,DM=NHEAD*D;
constexpr int NW=8,QBLK=32,QB=QBLK*NW,KVBLK=64,NQB=SEQ/QB;
constexpr int ATTN_PITCH=DM, ATTN_UNIT_ROWS=QB;
__device__ __forceinline__ int crow(int r,int hi){return (r&3)+8*(r>>2)+4*hi;}
#define SBAR() __builtin_amdgcn_sched_barrier(0)
__device__ __forceinline__ void cmask(f32x16&p0,f32x16&p1,int jb,int qrel,int hi){
  const float NEG=-INFINITY; int kb=64*jb+4*hi;
  #pragma unroll
  for(int r=0;r<16;++r){int kv=kb+(r&3)+8*(r>>2); if(kv>qrel)p0[r]=NEG; if(kv+32>qrel)p1[r]=NEG;}
}

constexpr int NSLOT=3, SLOTB=8192;
constexpr int LDS_K=0, LDS_V=NSLOT*SLOTB, LDS_WS=2*NSLOT*SLOTB, LDS_OST=LDS_WS+NW*64*4, LDS_BYTES=LDS_OST+NW*4096, LDS_BIAS=LDS_BYTES, LDS_TOTAL=LDS_BIAS+SEQ*4;
constexpr float C2=0.125f*1.4426950408889634f;
__device__ __forceinline__ void glds16(const void*gsrc,unsigned lds_dst){unsigned keep;
  asm volatile("s_mov_b32 %0, m0\n\ts_mov_b32 m0, %2\n\ts_nop 0\n\tglobal_load_lds_dwordx4 %1, off\n\ts_mov_b32 m0, %0":"=&s"(keep):"v"(gsrc),"s"(lds_dst):"memory");}
__device__ __forceinline__ float max3f(float a,float b,float c){float r;asm("v_max3_f32 %0, %1, %2, %3":"=v"(r):"v"(a),"v"(b),"v"(c));return r;}
__device__ __forceinline__ float max2f(float a,float b){float r;asm("v_max_f32_e32 %0, %1, %2":"=v"(r):"v"(a),"v"(b));return r;}
__device__ __forceinline__ float fadd_s(float a,float b){float r;asm("v_add_f32_e32 %0, %1, %2":"=v"(r):"v"(a),"v"(b));return r;}
__device__ __forceinline__ float fsub_s(float a,float b){float r;asm("v_sub_f32_e32 %0, %1, %2":"=v"(r):"v"(a),"v"(b));return r;}
typedef float f32x2_t __attribute__((ext_vector_type(2))); typedef __bf16 bf16x2_t __attribute__((ext_vector_type(2)));
__device__ __forceinline__ unsigned cvtpk_s(float lo,float hi){f32x2_t v={lo,hi};bf16x2_t b=__builtin_convertvector(v,bf16x2_t);return __builtin_bit_cast(unsigned,b);}
#define WAIT_BAR(N) asm volatile("s_waitcnt vmcnt(" #N ") lgkmcnt(0)\n\ts_barrier":::"memory")

__device__ __forceinline__ void qkt(f32x16&p0,f32x16&p1,const char*Kslot,const bf16x8*qr,int r32,int hi){
  const char*kb=Kslot+hi*1024+r32*16;
  #pragma unroll
  for(int d0=0;d0<4;++d0){
    const bf16x8 b0=*reinterpret_cast<const bf16x8*>(kb+d0*2048);
    const bf16x8 b1=*reinterpret_cast<const bf16x8*>(kb+d0*2048+512);
    p0=__builtin_amdgcn_mfma_f32_32x32x16_bf16(b0,qr[d0],p0,0,0,0);p1=__builtin_amdgcn_mfma_f32_32x32x16_bf16(b1,qr[d0],p1,0,0,0);}
}
typedef __attribute__((address_space(3))) const char* lds_cptr;
typedef short v4i16_t __attribute__((ext_vector_type(4)));
__device__ __forceinline__ void kload8(bf16x8*kf,lds_cptr kp){
  kf[0]=*(const __attribute__((address_space(3))) bf16x8*)(kp);      kf[1]=*(const __attribute__((address_space(3))) bf16x8*)(kp+512);
  kf[2]=*(const __attribute__((address_space(3))) bf16x8*)(kp+2048); kf[3]=*(const __attribute__((address_space(3))) bf16x8*)(kp+2560);
  kf[4]=*(const __attribute__((address_space(3))) bf16x8*)(kp+4096); kf[5]=*(const __attribute__((address_space(3))) bf16x8*)(kp+4608);
  kf[6]=*(const __attribute__((address_space(3))) bf16x8*)(kp+6144); kf[7]=*(const __attribute__((address_space(3))) bf16x8*)(kp+6656);
}
__device__ __forceinline__ void kload2(bf16x8*kf,lds_cptr kp,int j){ kf[2*j]=*(const __attribute__((address_space(3))) bf16x8*)(kp+j*2048); kf[2*j+1]=*(const __attribute__((address_space(3))) bf16x8*)(kp+j*2048+512); }
__device__ __forceinline__ s16x4 vtr(lds_cptr p){ return __builtin_bit_cast(s16x4,__builtin_amdgcn_ds_read_tr16_b64_v4i16((__attribute__((address_space(3))) v4i16_t*)p)); }
__device__ __forceinline__ float rowmax(const f32x16&p0,const f32x16&p1){
  float a=max3f(p0[0],p0[1],p1[0]),b=max3f(p0[2],p0[3],p1[1]);a=max3f(a,p1[2],p1[3]);
  #pragma unroll
  for(int r=4;r<16;r+=4){a=max3f(a,p0[r],p0[r+1]);b=max3f(b,p0[r+2],p0[r+3]);a=max3f(a,p1[r],p1[r+1]);b=max3f(b,p1[r+2],p1[r+3]);}
  const float m=max2f(a,b);
  auto rr=__builtin_amdgcn_permlane32_swap(__float_as_uint(m),__float_as_uint(m),false,false);
  return max2f(__uint_as_float(rr[0]),__uint_as_float(rr[1]));
}
__device__ __forceinline__ void pv(f32x16*o,int vb,bf16x8 pa0,bf16x8 pa1,bf16x8 pa2,bf16x8 pa3){
  #pragma unroll
  for(int d0=0;d0<2;++d0){s16x4 lo[4],hi[4];
    #pragma unroll
    for(int ks=0;ks<4;++ks){
      asm volatile("ds_read_b64_tr_b16 %0,%1 offset:%c2":"=&v"(lo[ks]):"v"(vb),"i"(d0*4096+ks*1024):"memory");
      asm volatile("ds_read_b64_tr_b16 %0,%1 offset:%c2":"=&v"(hi[ks]):"v"(vb),"i"(d0*4096+ks*1024+512):"memory");}
    asm volatile("s_waitcnt lgkmcnt(0)":::"memory");SBAR();
    #define PK(k) (bf16x8){lo[k][0],lo[k][1],lo[k][2],lo[k][3],hi[k][0],hi[k][1],hi[k][2],hi[k][3]}
    o[d0]=__builtin_amdgcn_mfma_f32_32x32x16_bf16(pa0,PK(0),o[d0],0,0,0);
    o[d0]=__builtin_amdgcn_mfma_f32_32x32x16_bf16(pa1,PK(1),o[d0],0,0,0);
    o[d0]=__builtin_amdgcn_mfma_f32_32x32x16_bf16(pa2,PK(2),o[d0],0,0,0);
    o[d0]=__builtin_amdgcn_mfma_f32_32x32x16_bf16(pa3,PK(3),o[d0],0,0,0);
    #undef PK
  }
}

#ifndef ATTN_STORE16
#define ATTN_STORE16(p,v) (*(u32x4*)(p)=(v))
#endif
template<int THRL> __device__ __forceinline__ void attn_unit(int b,int h,int qb,int ts,const float*__restrict__ cl2,const bf16*Q,const bf16*__restrict__ K,const bf16*__restrict__ V,bf16*O,char*shm,int wv){
  int tid=(wv<<6)|lane_id_(); asm volatile("":"+v"(tid)); const int lane=tid&63,r32=lane&31,hi=lane>>5; const int wid=__builtin_amdgcn_readfirstlane(tid>>6);
  const long rowbase=(long)b*SEQ; const int q0=qb*QB;
  const bf16*Qw=Q+(rowbase+q0+wid*QBLK)*DM+h*D;
  const bf16*Kh=K+(rowbase+(long)ts*KVBLK)*DM+h*D,*Vh=V+(rowbase+(long)ts*KVBLK)*DM+h*D;
  const unsigned lds0=(unsigned)(uintptr_t)shm;
  float*wsf=(float*)(shm+LDS_WS)+wid*64;
  const bf16*ksrc=Kh+(long)lane*DM+wid*8;
  const bf16*vsrc=Vh+(long)(16*(wid&3)+(lane>>2))*DM+(wid>>2)*32+(lane&3)*8;
  const unsigned kdst=lds0+LDS_K+wid*1024, vdst=lds0+LDS_V+wid*1024;
  #define DMA_K(t,slot) glds16(ksrc+(long)(t)*KVBLK*DM,(unsigned)__builtin_amdgcn_readfirstlane(kdst+(slot)))
  #define DMA_V(t,slot) glds16(vsrc+(long)(t)*KVBLK*DM,(unsigned)__builtin_amdgcn_readfirstlane(vdst+(slot)))
  const int vb0=(int)(lds0+LDS_V)+((lane>>4)&1)*32+(lane&3)*8+(4*hi+((lane&15)>>2))*64;
  const char*Kbase=shm+LDS_K; bf16x8 kf[8];
  const lds_cptr shm3=(lds_cptr)shm; const lds_cptr kp0=shm3+LDS_K+hi*1024+r32*16; const lds_cptr vp0=shm3+LDS_V+((lane>>4)&1)*32+(lane&3)*8+(4*hi+((lane&15)>>2))*64;
  const int NT=(q0+QB)/KVBLK-ts;
  DMA_K(0,0);DMA_V(0,0);DMA_K(1,SLOTB);
  bf16x8 qr[4];
  #pragma unroll
  for(int d0=0;d0<4;++d0)qr[d0]=*reinterpret_cast<const bf16x8*>(&Qw[(long)r32*DM+d0*16+hi*8]);
  float mhat=0.f,l_reg=0.f;f32x16 o[2];o[0]=f32x16{};o[1]=f32x16{};
  typedef __attribute__((address_space(3))) const f32x4_t* lds_f4p; const lds_f4p biasp=(lds_f4p)((lds_cptr)shm+LDS_BIAS)+hi;
  #define BIASINIT(C0,C1,t) do{ _Pragma("unroll") for(int g_=0;g_<4;++g_){ const f32x4_t b0_=biasp[(t)*16+2*g_], b1_=biasp[(t)*16+8+2*g_]; \
      _Pragma("unroll") for(int i_=0;i_<4;++i_){ C0[4*g_+i_]=b0_[i_]-mhat; C1[4*g_+i_]=b1_[i_]-mhat; } } }while(0)
  const int qrel=wid*QBLK+r32;
  #define CMASK(P0,P1,t) do{int jb_=(t)-(NT-4); if(jb_>=0)cmask(P0,P1,jb_,qrel,hi);}while(0)
  bool resc=false;
  #define START(P0,P1) do{ const float rm=rowmax(P0,P1); resc=false; \
    { const float dl=rm; mhat=fadd_s(mhat,dl); \
      _Pragma("unroll") for(int r=0;r<16;++r){P0[r]=fsub_s(P0[r],dl);P1[r]=fsub_s(P1[r],dl);} } \
    _Pragma("unroll") for(int r=0;r<16;++r)P0[r]=__builtin_amdgcn_exp2f(P0[r]); }while(0)
  #define RESC() do{ if(resc){ asm volatile("s_waitcnt lgkmcnt(0)":::"memory"); \
      _Pragma("unroll") for(int d_=0;d_<2;++d_) _Pragma("unroll") for(int r=0;r<16;++r)o[d_][r]*=wsf[crow(r,hi)]; } }while(0)
  f32x16 pA0,pA1,pB0,pB1;
  int sl_prev=0,sl_cur=0,sl_next=SLOTB;
  #define ROT() do{sl_prev=sl_cur;sl_cur=sl_next;sl_next=(sl_next==(NSLOT-1)*SLOTB)?0:sl_next+SLOTB;}while(0)
  {
    const float cref=cl2[q0]; const f32x4_t*src=(const f32x4_t*)(cl2+ts*KVBLK); __attribute__((address_space(3))) f32x4_t*dst=(__attribute__((address_space(3))) f32x4_t*)((__attribute__((address_space(3))) char*)shm+LDS_BIAS);
    for(int i=tid;i<NT*16;i+=NW*64){ const f32x4_t c4=src[i]; dst[i]=(f32x4_t){cref-c4[0],cref-c4[1],cref-c4[2],cref-c4[3]}; } }
  DMA_K(2,2*SLOTB);
  WAIT_BAR(3);
  BIASINIT(pA0,pA1,0); qkt(pA0,pA1,Kbase,qr,r32,hi);asm volatile("s_nop 15\n\ts_nop 7":"+v"(pA0),"+v"(pA1));CMASK(pA0,pA1,0);
  START(pA0,pA1);
  _Pragma("unroll") for(int r=0;r<16;++r)pA1[r]=__builtin_amdgcn_exp2f(pA1[r]);
  WAIT_BAR(0);
  DMA_K(3,0);DMA_V(1,SLOTB);
  ROT();
  kload8(kf,kp0+sl_cur);
  WAIT_BAR(2);
  s16x4 vlo[8],vhi[8]; u32x4 pw0,pw1,pw2,pw3;
  #define PKW(P,B) cvtpk_s(P[B],P[B+1])
  #define PAF(k) __builtin_bit_cast(bf16x8,pw##k)
  #define VFR(i) (bf16x8){vlo[i][0],vlo[i][1],vlo[i][2],vlo[i][3],vhi[i][0],vhi[i][1],vhi[i][2],vhi[i][3]}
  #define PIN(x) asm volatile("":"+v"(x))
  #define MX3(a,b,c) __builtin_fmaxf(__builtin_fmaxf((a),(b)),(c))
  #define GAPA(MF,A0,A1,A2,A3,W0,W1,PW) do{ MF; sacc+=A0; sacc+=A1; sacc+=A2; sacc+=A3; PIN(sacc); W0; W1; PIN(PW); SBAR(); }while(0)
  #define EX(v) __builtin_amdgcn_exp2f(v)
  #define GAPB(MF,X,B) do{ MF; X[B]=EX(X[B]); X[B+1]=EX(X[B+1]); X[B+2]=EX(X[B+2]); X[B+3]=EX(X[B+3]); PIN(X); SBAR(); }while(0)
  #define VRD(i) do{ vlo[i]=vtr(vp_+(((i)>>2)*4096+((i)&3)*1024)); vhi[i]=vtr(vp_+(((i)>>2)*4096+((i)&3)*1024+512)); }while(0)
  #define KRD(G,j) do{ if(G){ kload2(kf,kp0+sl_next,j); SBAR(); } }while(0)
  #define STEP(C0,C1,P0,P1,t,GK,GV,GL) do{ SBAR(); BIASINIT(C0,C1,t); SBAR(); \
    const lds_cptr vp_=vp0+sl_prev; \
    VRD(0); SBAR(); float sacc=(P0[0]+P0[1]); \
    GAPA(C0=__builtin_amdgcn_mfma_f32_32x32x16_bf16(kf[0],qr[0],C0,0,0,0), P0[2],P0[3],P0[4],P0[5],     pw0[0]=PKW(P0,0), pw0[1]=PKW(P0,2), pw0); \
    VRD(4); SBAR(); GAPA(C1=__builtin_amdgcn_mfma_f32_32x32x16_bf16(kf[1],qr[0],C1,0,0,0), P0[6],P0[7],P0[8],P0[9],     pw0[2]=PKW(P0,4), pw0[3]=PKW(P0,6), pw0); \
    VRD(1); SBAR(); GAPA(C0=__builtin_amdgcn_mfma_f32_32x32x16_bf16(kf[2],qr[1],C0,0,0,0),   P0[10],P0[11],P0[12],P0[13], pw1[0]=PKW(P0,8), pw1[1]=PKW(P0,10), pw1); \
    VRD(5); SBAR(); GAPA(C1=__builtin_amdgcn_mfma_f32_32x32x16_bf16(kf[3],qr[1],C1,0,0,0),   P0[14],P0[15],P1[0],P1[1],   pw1[2]=PKW(P0,12),pw1[3]=PKW(P0,14), pw1); \
    VRD(2); SBAR(); GAPA(C0=__builtin_amdgcn_mfma_f32_32x32x16_bf16(kf[4],qr[2],C0,0,0,0),   P1[2],P1[3],P1[4],P1[5],     pw2[0]=PKW(P1,0), pw2[1]=PKW(P1,2), pw2); \
    VRD(6); SBAR(); GAPA(C1=__builtin_amdgcn_mfma_f32_32x32x16_bf16(kf[5],qr[2],C1,0,0,0),   P1[6],P1[7],P1[8],P1[9],     pw2[2]=PKW(P1,4), pw2[3]=PKW(P1,6), pw2); \
    VRD(3); SBAR(); GAPA(C0=__builtin_amdgcn_mfma_f32_32x32x16_bf16(kf[6],qr[3],C0,0,0,0),   P1[10],P1[11],P1[12],P1[13], pw3[0]=PKW(P1,8), pw3[1]=PKW(P1,10), pw3); \
    VRD(7); SBAR(); GAPA(C1=__builtin_amdgcn_mfma_f32_32x32x16_bf16(kf[7],qr[3],C1,0,0,0),   P1[14],P1[15],0.f,0.f,       pw3[2]=PKW(P1,12),pw3[3]=PKW(P1,14), pw3); \
    l_reg+=sacc; \
    if(GK){DMA_K((t)+3,sl_cur);} if(GV){DMA_V((t)+1,sl_next);} \
    CMASK(C0,C1,t); \
    { float a=MX3(C0[0],C0[1],C1[0]),b=MX3(C0[2],C0[3],C1[1]); a=MX3(a,C1[2],C1[3]); \
      _Pragma("unroll") for(int r=4;r<16;r+=4){a=MX3(a,C0[r],C0[r+1]);b=MX3(b,C0[r+2],C0[r+3]);a=MX3(a,C1[r],C1[r+1]);b=MX3(b,C1[r+2],C1[r+3]);} \
      float rm=__builtin_fmaxf(a,b); { auto rr=__builtin_amdgcn_permlane32_swap(__float_as_uint(rm),__float_as_uint(rm),false,false); rm=__builtin_fmaxf(__uint_as_float(rr[0]),__uint_as_float(rr[1])); } \
      resc=false; \
      if(__builtin_expect(__any(rm>(float)THRL),0)){ const float dl=__builtin_fmaxf(rm,0.f); mhat+=dl; \
        _Pragma("unroll") for(int r=0;r<16;++r){C0[r]-=dl;C1[r]-=dl;} \
        const float f=__builtin_amdgcn_exp2f(-dl); l_reg*=f; if(hi==0)wsf[r32]=f; resc=true; } } \
    SBAR(); \
    GAPB(o[0]=__builtin_amdgcn_mfma_f32_32x32x16_bf16(PAF(0),VFR(0),o[0],0,0,0), C0,0); \
    GAPB(o[1]=__builtin_amdgcn_mfma_f32_32x32x16_bf16(PAF(0),VFR(4),o[1],0,0,0), C0,4); \
    KRD(GL,0); GAPB(o[0]=__builtin_amdgcn_mfma_f32_32x32x16_bf16(PAF(1),VFR(1),o[0],0,0,0), C0,8); \
    KRD(GL,1); GAPB(o[1]=__builtin_amdgcn_mfma_f32_32x32x16_bf16(PAF(1),VFR(5),o[1],0,0,0), C0,12); \
    KRD(GL,2); GAPB(o[0]=__builtin_amdgcn_mfma_f32_32x32x16_bf16(PAF(2),VFR(2),o[0],0,0,0), C1,0); \
    KRD(GL,3); GAPB(o[1]=__builtin_amdgcn_mfma_f32_32x32x16_bf16(PAF(2),VFR(6),o[1],0,0,0), C1,4); \
    GAPB(o[0]=__builtin_amdgcn_mfma_f32_32x32x16_bf16(PAF(3),VFR(3),o[0],0,0,0), C1,8); \
    GAPB(o[1]=__builtin_amdgcn_mfma_f32_32x32x16_bf16(PAF(3),VFR(7),o[1],0,0,0), C1,12); \
    }while(0)
  int t=1;
  #undef CMASK
  #define CMASK(P0,P1,t) do{}while(0)
  for(;t+5<NT;t+=2){
    STEP(pB0,pB1,pA0,pA1,t,true,true,true);     WAIT_BAR(2); RESC(); ROT();
    STEP(pA0,pA1,pB0,pB1,t+1,true,true,true);   WAIT_BAR(2); RESC(); ROT();
  }
  #undef CMASK
  #define CMASK(P0,P1,t) do{int jb_=(t)-(NT-4); if(jb_>=0)cmask(P0,P1,jb_,qrel,hi);}while(0)
  #define ENDW(tt) do{ if((tt)+3<NT){WAIT_BAR(2);} else if((tt)+2<NT){WAIT_BAR(1);} else {WAIT_BAR(0);} }while(0)
  for(;t+1<NT;t+=2){
    STEP(pB0,pB1,pA0,pA1,t,(t+3<NT),(t+1<NT),(t+1<NT));       ENDW(t);   RESC(); ROT();
    STEP(pA0,pA1,pB0,pB1,t+1,(t+4<NT),(t+2<NT),(t+2<NT));     ENDW(t+1); RESC(); ROT();
  }
  STEP(pB0,pB1,pA0,pA1,NT-1,false,false,false); RESC();
  { float sacc=pB0[0]+pB0[1]; _Pragma("unroll") for(int r=2;r<16;++r)sacc+=pB0[r]; _Pragma("unroll") for(int r=0;r<16;++r)sacc+=pB1[r]; l_reg+=sacc;
    pw0=(u32x4){PKW(pB0,0),PKW(pB0,2),PKW(pB0,4),PKW(pB0,6)};pw1=(u32x4){PKW(pB0,8),PKW(pB0,10),PKW(pB0,12),PKW(pB0,14)};pw2=(u32x4){PKW(pB1,0),PKW(pB1,2),PKW(pB1,4),PKW(pB1,6)};pw3=(u32x4){PKW(pB1,8),PKW(pB1,10),PKW(pB1,12),PKW(pB1,14)};
    SBAR(); pv(o,vb0+sl_cur,PAF(0),PAF(1),PAF(2),PAF(3)); }
  #undef PKW
  #undef PAF
  #undef VFR
  #undef PIN
  #undef MX3
  #undef GAPA
  #undef GAPB
  #undef EX
  #undef VRD
  #undef KRD
  #undef STEP
  #undef ENDW
  {auto rr=__builtin_amdgcn_permlane32_swap(__float_as_uint(l_reg),__float_as_uint(l_reg),false,false);l_reg=__uint_as_float(rr[0])+__uint_as_float(rr[1]);}
  if(hi==0)wsf[32+r32]=l_reg;asm volatile("s_waitcnt lgkmcnt(0)":::"memory");
  float rli[16];
  #pragma unroll
  for(int r=0;r<16;++r)rli[r]=__builtin_amdgcn_rcpf(wsf[32+crow(r,hi)]);
  bf16*Ow=O+(rowbase+q0+wid*QBLK)*DM+h*D;
  { bf16*stg=(bf16*)(shm+LDS_OST)+wid*2048;
    #pragma unroll
    for(int r=0;r<16;++r){const int orow=crow(r,hi);
      #pragma unroll
      for(int d0=0;d0<2;++d0)stg[orow*64+d0*32+r32]=__float2bfloat16(o[d0][r]*rli[r]);}
    asm volatile("s_waitcnt lgkmcnt(0)":::"memory");
    #pragma unroll
    for(int i=0;i<4;++i){const int row=i*8+(lane>>3),ch=lane&7; const u32x4 v=*(const u32x4*)(stg+row*64+ch*8); ATTN_STORE16(Ow+(long)row*DM+ch*8,v);} }
  asm volatile("s_waitcnt lgkmcnt(0)\n\ts_barrier":::"memory");
  #undef DMA_K
  #undef DMA_V
  #undef CMASK
  #undef BIASINIT
  #undef START
  #undef RESC
  #undef ROT
}
constexpr int ATTN_LDS_BYTES=LDS_BYTES;
struct AttnTensors { const bf16* Q; const bf16* K; const bf16* V; bf16* O; const float* cl2; };
#undef SBAR
#undef WAIT_BAR
}
#define GEMM_PHASE(...) pg8::gemm_phase<__VA_ARGS__, pg8::StaticOrder, PGA, PGS>(ldsl, g, S, E, wave)
#define GEMM_PHASE_SPLIT() pg8::gemm_phase<pg8::EpiPartial, pg8::SplitOrder, PGA, PGS>(ldsl, g2, S2, E2, wave)
#define GEMM_PHASE_SPLIT_T(NN, NS, KSUB, KSH) pg8::gemm_phase<pg8::EpiPartialT<NN, KSH>, pg8::SplitOrderT<NN, NS, KSUB>, PGA, PGS>(ldsl, g2, S2, E2, wave)
#ifndef PGA
#define PGA true
#endif
#ifndef PGS
#define PGS true
#endif
namespace cg = cooperative_groups;
#define LAS __attribute__((address_space(3)))
typedef unsigned short bf16;
typedef unsigned v4u __attribute__((ext_vector_type(4)));
typedef float f32x4 __attribute__((ext_vector_type(4)));
typedef short bf16x8 __attribute__((ext_vector_type(8)));
typedef float f32x16 __attribute__((ext_vector_type(16)));
constexpr int NWAVES = 8, NTHR = 512, NMODC_ = 9216;
constexpr int MP = 32768, MS = 256, M = MP + MS, DM = 1024, FF = 2816, WA = 512, NIN = 4608, INCOLS = 4616, SEQ = 16384, PAST = 1024, DSEQ = 32, SKEYS = PAST + DSEQ;
constexpr float EPS = 1e-6f, LOG2E = 1.4426950408889634f;
constexpr size_t MiB = 1u << 20;
constexpr size_t WS_CTL = 0, CTL_ZERO_BYTES = 65536;
constexpr size_t WS_MOD = 1 * MiB, WS_CUMP = 2 * MiB, WS_CUMS = 3 * MiB, WS_G2SS = 4 * MiB, WS_QS = 6 * MiB, WS_WSP = 7 * MiB;
constexpr size_t WS_WGU1 = 8 * MiB, WS_WD1 = 19 * MiB, WS_WIN = 25 * MiB, WS_WPA = 34 * MiB, WS_WPB = 35 * MiB, WS_WOUT = 36 * MiB, WS_WGU2 = 38 * MiB, WS_WD2 = 49 * MiB;
constexpr size_t WS_XN = 56 * MiB;
constexpr size_t WS_ACT = 121 * MiB;
constexpr size_t QKV_B = (size_t)M * 512 * 2;
constexpr size_t WS_Q = 121 * MiB, WS_K = WS_Q + QKV_B, WS_V = WS_K + QKV_B, WS_U = WS_V + QKV_B, WS_G2 = WS_U + QKV_B;
constexpr size_t WS_AO = WS_Q;
constexpr size_t WS_T1 = WS_U;
constexpr size_t WS_T2 = WS_K;
constexpr size_t WS_BO = 283 * MiB, WS_PART = 300 * MiB, WS_END = 316 * MiB;
static_assert(WS_XN + (size_t)M * 2048 <= WS_ACT && WS_G2 + QKV_B <= WS_BO && WS_BO + QKV_B <= WS_END && WS_ACT + (size_t)M * FF * 2 <= WS_END, "ws map");
constexpr size_t O_Y = 0, O_KP = (size_t)M * 1024, O_VP = O_KP + (size_t)MP * 512, O_FP = O_VP + (size_t)MP * 512, O_KS = O_FP + (size_t)MP * 8, O_VS = O_KS + (size_t)MS * 512,
                 O_FS = O_VS + (size_t)MS * 512, O_GS = O_FS + (size_t)MS * 8, O_END = O_GS + (size_t)MS * 512;
constexpr int LDS_BYTES = 155648, MISC_OFF = LDS_BYTES - 256;
static_assert(attn_body::LDS_TOTAL <= MISC_OFF && pg8::STAGE_BYTES <= LDS_BYTES, "LDS map");

struct Args { const float* in[28]; float* out; unsigned char* ws; };

__device__ __forceinline__ float wave_sum(float v) {
#pragma unroll
    for (int o = 1; o < 64; o <<= 1) v += __shfl_xor(v, o);
    return v;
}
__device__ __forceinline__ unsigned f2bf(float f) { unsigned u = __builtin_bit_cast(unsigned, f); return (u + 0x7fffu + ((u >> 16) & 1u)) >> 16; }
__device__ __forceinline__ unsigned pk2(float lo, float hi) { return f2bf(lo) | (f2bf(hi) << 16); }
__device__ __forceinline__ float bf2f(unsigned short h) { return __uint_as_float((unsigned)h << 16); }

__device__ __forceinline__ void ada_unit(const Args& a, unsigned char* lds, int cb, int tid) {
    asm volatile("" : "+v"(tid));
    float* SC = (float*)lds; float* RED = (float*)(lds + 40960);
    const float* cp = a.in[2]; const float* cs = a.in[3]; const float* w_ada = a.in[7]; const float* b_ada = a.in[8];
    float* MOD = (float*)(a.ws + WS_MOD);
    for (int i = tid; i < 10240; i += NTHR) { const int r = i >> 10, k = i & 1023; const float c = r < 2 ? cp[r * 1024 + k] : cs[(r - 2) * 1024 + k]; SC[i] = c / (1.0f + expf(-c)); }
    __syncthreads();
    if (tid < 504) {
        const int cgp = tid % 9, ks = tid / 9; f32x4 acc[10];
#pragma unroll
        for (int r = 0; r < 10; ++r) acc[r] = (f32x4){0.f, 0.f, 0.f, 0.f};
        for (int k = ks; k < 1024; k += 56) { const f32x4 w = *(const f32x4*)(w_ada + (size_t)k * NMODC_ + 36 * cb + 4 * cgp);
#pragma unroll
            for (int r = 0; r < 10; ++r) acc[r] += w * SC[r * 1024 + k]; }
#pragma unroll
        for (int r = 0; r < 10; ++r) *(f32x4*)(RED + (size_t)tid * 40 + r * 4) = acc[r];
    }
    __syncthreads();
    if (tid < 360) { const int r = tid / 36, c = tid % 36, cgp = c >> 2, i = c & 3; float s = 0.f;
        for (int ks = 0; ks < 56; ++ks) s += RED[(ks * 9 + cgp) * 40 + r * 4 + i];
        MOD[r * NMODC_ + 36 * cb + c] = s + b_ada[36 * cb + c]; }
    __syncthreads();
}
__device__ __forceinline__ void transpose_item(const float* W, int ld, int c0, int K, bf16* WT, int drow0, int k0, float* scr, int lane) {
#pragma unroll 8
    for (int i = 0; i < 32; ++i) { const int kk = 2 * i + (lane >> 5); scr[kk * 33 + (lane & 31)] = W[(size_t)(k0 + kk) * ld + c0 + (lane & 31)]; }
    asm volatile("s_waitcnt lgkmcnt(0)" ::: "memory");
    const int c = lane & 7;
#pragma unroll
    for (int j = 0; j < 4; ++j) { const int n = (lane >> 3) + 8 * j; const float* s = scr + (8 * c) * 33 + n;
        v4u o; o.x = pk2(s[0 * 33], s[1 * 33]); o.y = pk2(s[2 * 33], s[3 * 33]); o.z = pk2(s[4 * 33], s[5 * 33]); o.w = pk2(s[6 * 33], s[7 * 33]);
        *(v4u*)(WT + (size_t)(drow0 + n) * K + k0 + 8 * c) = o; }
    asm volatile("s_waitcnt lgkmcnt(0)" ::: "memory");
}
struct Seg { int in, ld, c0, ncols, K; size_t dst; int drow, mode; };
__device__ const Seg SEGS[13] = {
        {10, FF, 0, FF, 1024, WS_WGU1, 0, 1}, {11, FF, 0, FF, 1024, WS_WGU1, 0, 2}, {12, 1024, 0, 1024, FF, WS_WD1, 0, 0},
        {14, INCOLS, 0, 512, 1024, WS_WIN, 0, 3}, {14, INCOLS, 512, 512, 1024, WS_WIN, 512, 3}, {14, INCOLS, 1024, 512, 1024, WS_WIN, 1024, 0}, {14, INCOLS, 1544, 3072, 1024, WS_WIN, 1536, 0},
        {21, 1024, 0, 1024, 512, WS_WPA, 0, 0}, {22, 1024, 0, 1024, 512, WS_WPB, 0, 0}, {23, 1024, 0, 1024, 1024, WS_WOUT, 0, 0},
        {25, FF, 0, FF, 1024, WS_WGU2, 0, 1}, {26, FF, 0, FF, 1024, WS_WGU2, 0, 2}, {27, 1024, 0, 1024, FF, WS_WD2, 0, 0}};
__device__ __forceinline__ int seg_drow(const Seg& s, int n) {
    if (s.mode == 0) return s.drow + n;
    if (s.mode == 1) return s.drow + 256 * (n >> 7) + (n & 127);
    if (s.mode == 2) return s.drow + 256 * (n >> 7) + 128 + (n & 127);
    const int gs = (n & 255) >> 5; return s.drow + (n & ~255) + 32 * (4 * (gs & 1) + (gs >> 1));
}
__device__ __forceinline__ void p0_weights(const Args& a, unsigned char* lds, int gw, int NGW, int wave, int lane) {
    asm volatile("" : "+v"(lane));
    float* scr = (float*)(lds + wave * 8704);

    int base = 0;
#pragma unroll 1
    for (int si = 0; si < 13; ++si) {
        const Seg s = SEGS[si]; const int nblk = s.ncols / 32, nitems = (s.K / 64) * nblk;
        int first = (gw - base) % NGW; if (first < 0) first += NGW;
        for (int it = first; it < nitems; it += NGW) { const int kb = it / nblk, nb = it % nblk;
            transpose_item(a.in[s.in], s.ld, s.c0 + 32 * nb, s.K, (bf16*)(a.ws + s.dst), seg_drow(s, 32 * nb), 64 * kb, scr, lane); }
        base = (base + nitems) % NGW;
    }
    const float* wsp = a.in[19]; bf16* WSP = (bf16*)(a.ws + WS_WSP);
    for (int i = gw * 64 + lane; i < 4 * 128 * 128; i += NGW * 64) { const int t = (i >> 7) & 127, s2 = i & 127; WSP[i] = (bf16)f2bf(s2 <= t ? wsp[i] : 0.f); }
}
template <bool LOGF> __device__ __forceinline__ void norm_phase(const Args& a, unsigned char* lds, const float* srcp, const float* srcs, const float* g, int ishift, int iscale,
                                                                 int gw, int NGW, int tid, int lane) {
    asm volatile("" : "+v"(tid), "+v"(lane));
    const float* MOD = (const float*)(a.ws + WS_MOD); bf16* XN = (bf16*)(a.ws + WS_XN);
    float* WFt = (float*)lds;
    if (LOGF) { const float* w_in = a.in[14]; for (int i = tid; i < 8192; i += NTHR) { const int k = i >> 3, j = i & 7; WFt[j * 1024 + k] = w_in[(size_t)k * INCOLS + 1536 + j]; } __syncthreads(); }
    int cur = -1; f32x4 gs[4], shv[4], vn[4], vnn[4];
    if (gw < M) { const float* xrow0 = gw < MP ? srcp + (size_t)gw * 1024 : srcs + (size_t)(gw - MP) * 1024;
#pragma unroll
        for (int j = 0; j < 4; ++j) vn[j] = ((const f32x4*)xrow0 + lane)[64 * j]; }
    if (gw + NGW < M) { const int m1 = gw + NGW; const float* xrow1 = m1 < MP ? srcp + (size_t)m1 * 1024 : srcs + (size_t)(m1 - MP) * 1024;
#pragma unroll
        for (int j = 0; j < 4; ++j) vnn[j] = ((const f32x4*)xrow1 + lane)[64 * j]; }
    for (int m = gw; m < M; m += NGW) {
        const int mr = m < MP ? (m >> 14) : 2 + ((m - MP) >> 5);
        if (mr != cur) { cur = mr; const f32x4* g4 = (const f32x4*)g + lane;
            const f32x4* sh4 = (const f32x4*)(MOD + (size_t)mr * 9216 + ishift * 1024) + lane; const f32x4* sc4 = (const f32x4*)(MOD + (size_t)mr * 9216 + iscale * 1024) + lane;
#pragma unroll
            for (int j = 0; j < 4; ++j) { gs[j] = g4[64 * j] * (sc4[64 * j] + 1.0f); shv[j] = sh4[64 * j]; } }
        f32x4 v[4]; float ss = 0.f;
#pragma unroll
        for (int j = 0; j < 4; ++j) { v[j] = vn[j]; vn[j] = vnn[j]; ss += (v[j].x * v[j].x + v[j].y * v[j].y) + (v[j].z * v[j].z + v[j].w * v[j].w); }
        { const int m2 = m + 2 * NGW; if (m2 < M) { const float* xrow2 = m2 < MP ? srcp + (size_t)m2 * 1024 : srcs + (size_t)(m2 - MP) * 1024;
#pragma unroll
            for (int j = 0; j < 4; ++j) vnn[j] = ((const f32x4*)xrow2 + lane)[64 * j]; } }
        const float rstd = 1.0f / sqrtf(wave_sum(ss) * (1.0f / 1024.0f) + EPS);
        unsigned long long* o8 = (unsigned long long*)(XN + (size_t)m * 1024) + lane;
#pragma unroll
        for (int j = 0; j < 4; ++j) { v[j] = (v[j] * rstd) * gs[j] + shv[j];
            o8[64 * j] = (unsigned long long)pk2(v[j].x, v[j].y) | ((unsigned long long)pk2(v[j].z, v[j].w) << 32); }
        if (LOGF) {
            float f[8];
#pragma unroll
            for (int jj = 0; jj < 8; ++jj) { float s = 0.f;
#pragma unroll
                for (int j = 0; j < 4; ++j) { const f32x4 w = *((const f32x4*)(WFt + jj * 1024) + 64 * j + lane); s += (v[j].x * w.x + v[j].y * w.y) + (v[j].z * w.z + v[j].w * w.w); }
                f[jj] = wave_sum(s); }
            float fj = f[0];
#pragma unroll
            for (int jj = 1; jj < 8; ++jj) fj = (lane == jj) ? f[jj] : fj;
            if (lane < 8) { const float x = fj + a.in[15][lane]; const float lf = (x >= 0.f) ? -log1pf(expf(-x)) : x - log1pf(expf(x));
                float* dst = m < MP ? a.out + O_FP + (size_t)m * 8 : a.out + O_FS + (size_t)(m - MP) * 8; dst[lane] = lf; }
        }
    }
}
__device__ __forceinline__ void scan_unit(const Args& a, unsigned char* lds, int unit, int tid) {
    asm volatile("" : "+v"(tid));
    double* tot = (double*)lds;
    if (unit < 16) {
        const int b = unit >> 3, h = unit & 7; const float* lf = a.out + O_FP + ((size_t)b * SEQ) * 8 + h; float* dst = (float*)(a.ws + WS_CUMP) + (size_t)unit * SEQ;
        float x[32]; double s = 0.0;
#pragma unroll
        for (int i = 0; i < 32; ++i) { x[i] = lf[(size_t)(tid * 32 + i) * 8]; s += (double)x[i]; }
        tot[tid] = s; __syncthreads();
        double pre = 0.0; for (int j = 0; j < tid; ++j) pre += tot[j];
#pragma unroll
        for (int i = 0; i < 32; ++i) { pre += (double)x[i]; dst[tid * 32 + i] = (float)(pre * 1.4426950408889634); }
    } else {
        const int bh = unit - 16, b = bh >> 3, h = bh & 7; const float* lfc = a.in[6] + ((size_t)b * PAST) * 8 + h; const float* lfn = a.out + O_FS + ((size_t)b * DSEQ) * 8 + h;
        float* dst = (float*)(a.ws + WS_CUMS) + (size_t)bh * SKEYS;
        float x[3] = {0.f, 0.f, 0.f}; double s = 0.0;
        if (tid < 352) {
#pragma unroll
            for (int i = 0; i < 3; ++i) { const int p = tid * 3 + i; x[i] = p < PAST ? lfc[(size_t)p * 8] : lfn[(size_t)(p - PAST) * 8]; s += (double)x[i]; } }
        tot[tid] = s; __syncthreads();
        if (tid < 352) { double pre = 0.0; for (int j = 0; j < tid; ++j) pre += tot[j];
#pragma unroll
            for (int i = 0; i < 3; ++i) { pre += (double)x[i]; dst[tid * 3 + i] = (float)(pre * 1.4426950408889634); } }
    }
    __syncthreads();
}
__device__ __forceinline__ void gmlp_unit(const Args& a, unsigned char* lds, int ci, int tid, int wave, int lane) {
    asm volatile("" : "+v"(tid), "+v"(lane));
    constexpr int VP = 136;
    bf16* VT = (bf16*)lds; float* rst = (float*)(lds + 128 * VP * 2);
    const bf16* G2 = (const bf16*)(a.ws + WS_G2); const bf16* U = (const bf16*)(a.ws + WS_U); bf16* BO = (bf16*)(a.ws + WS_BO); const bf16* WSP = (const bf16*)(a.ws + WS_WSP);
    const float* G2SS = (const float*)(a.ws + WS_G2SS); const float* gv = a.in[18]; const float* bsp = a.in[20];
    const size_t R0 = (size_t)ci * 128;
    if (tid < 128) { const f32x4* p = (const f32x4*)(G2SS + (R0 + tid) * 8); const f32x4 s0 = p[0], s1 = p[1]; rst[tid] = 1.0f / sqrtf((((s0.x + s0.y) + (s0.z + s0.w)) + ((s1.x + s1.y) + (s1.z + s1.w))) * (1.0f / 512.0f) + EPS); }
    __syncthreads();
    const int r32 = lane & 31, hi = lane >> 5, tb = wave >> 1, dh = wave & 1;
#pragma unroll 1
    for (int g = 0; g < 4; ++g) {
#pragma unroll
        for (int it = 0; it < 4; ++it) { const int q = tid + NTHR * it, s = q & 127, cch = q >> 7;
            const v4u raw = *(const v4u*)(G2 + (R0 + s) * 512 + g * 128 + 8 * cch); const float rs = rst[s];
            const f32x4 g0 = *(const f32x4*)(gv + g * 128 + 8 * cch), g1 = *(const f32x4*)(gv + g * 128 + 8 * cch + 4);
            bf16* col = VT + (8 * cch) * VP + s;
            col[0 * VP] = (bf16)f2bf(pg8::bf_lo(raw.x) * rs * g0.x); col[1 * VP] = (bf16)f2bf(pg8::bf_hi(raw.x) * rs * g0.y); col[2 * VP] = (bf16)f2bf(pg8::bf_lo(raw.y) * rs * g0.z); col[3 * VP] = (bf16)f2bf(pg8::bf_hi(raw.y) * rs * g0.w);
            col[4 * VP] = (bf16)f2bf(pg8::bf_lo(raw.z) * rs * g1.x); col[5 * VP] = (bf16)f2bf(pg8::bf_hi(raw.z) * rs * g1.y); col[6 * VP] = (bf16)f2bf(pg8::bf_lo(raw.w) * rs * g1.z); col[7 * VP] = (bf16)f2bf(pg8::bf_hi(raw.w) * rs * g1.w); }
        bf16x8 af[8];
#pragma unroll
        for (int ks = 0; ks < 8; ++ks) af[ks] = *(const bf16x8*)(WSP + ((size_t)(g * 128 + 32 * tb + r32)) * 128 + 16 * ks + 8 * hi);
        __syncthreads();
        f32x16 acc[2]; acc[0] = f32x16{}; acc[1] = f32x16{};
#pragma unroll
        for (int ks = 0; ks < 8; ++ks) if (ks <= 2 * tb + 1) {
#pragma unroll
            for (int db = 0; db < 2; ++db) { const bf16x8 bfv = *(const bf16x8*)(VT + (64 * dh + 32 * db + r32) * VP + 16 * ks + 8 * hi); acc[db] = __builtin_amdgcn_mfma_f32_32x32x16_bf16(af[ks], bfv, acc[db], 0, 0, 0); }
        }
        { unsigned short uu[2][16]; float bb[16];
#pragma unroll
          for (int r = 0; r < 16; ++r) { const int t = 32 * tb + (r & 3) + 8 * (r >> 2) + 4 * hi; bb[r] = bsp[g * 128 + t];
#pragma unroll
              for (int db = 0; db < 2; ++db) uu[db][r] = U[(R0 + t) * 512 + g * 128 + 64 * dh + 32 * db + r32]; }
#pragma unroll
          for (int db = 0; db < 2; ++db)
#pragma unroll
              for (int r = 0; r < 16; ++r) { const int t = 32 * tb + (r & 3) + 8 * (r >> 2) + 4 * hi, ch = g * 128 + 64 * dh + 32 * db + r32; const size_t off = (R0 + t) * 512 + ch;
                  BO[off] = (bf16)f2bf(bf2f(uu[db][r]) * (acc[db][r] + bb[r])); } }
        __syncthreads();
    }
}
__device__ __forceinline__ void gmlp_sample_unit(const Args& a, unsigned char* lds, int b, int tid) {
    asm volatile("" : "+v"(tid));
    float* rst = (float*)lds;
    const bf16* G2 = (const bf16*)(a.ws + WS_G2); const bf16* U = (const bf16*)(a.ws + WS_U); bf16* BO = (bf16*)(a.ws + WS_BO);
    const float* G2SS = (const float*)(a.ws + WS_G2SS); const float* wsp = a.in[19]; const float* bsp = a.in[20];
    const size_t R0 = (size_t)MP + b * 32;
    if (tid < 32) { const float* p = G2SS + (R0 + tid) * 8; float s = 0.f; for (int i = 0; i < 8; ++i) s += p[i]; rst[tid] = 1.0f / sqrtf(s * (1.0f / 512.0f) + EPS); }
    __syncthreads();
    const int ch = tid, g = ch >> 7; const float gvv = a.in[18][ch];
    float vb[32];
#pragma unroll
    for (int s = 0; s < 32; ++s) { vb[s] = bf2f(G2[(R0 + s) * 512 + ch]) * rst[s] * gvv; a.out[O_GS + ((size_t)b * 32 + s) * 512 + ch] = vb[s]; }
#pragma unroll
    for (int t = 0; t < 32; ++t) { float mixed = bsp[g * 128 + t]; const float* wrow = wsp + ((size_t)g * 128 + t) * 128;
#pragma unroll
        for (int s = 0; s < 32; ++s) if (s <= t) mixed += wrow[s] * vb[s];
        const size_t off = (R0 + t) * 512 + ch; BO[off] = (bf16)f2bf(bf2f(U[off]) * mixed); }
    __syncthreads();
}
__device__ __forceinline__ void sattn_unit(const Args& a, unsigned char* lds, int unit, int tid, int wave, int lane) {
    asm volatile("" : "+v"(tid), "+v"(lane));
    const int qg = unit & 3, h = (unit >> 2) & 7, b = unit >> 5;
    float* qs = (float*)lds;
    float* S = qs + 512;
    float* red = S + 8 * SKEYS;
    float* inv = red + 4096;
    const float* QS = (const float*)(a.ws + WS_QS); const float* cum = (const float*)(a.ws + WS_CUMS) + (size_t)(b * 8 + h) * SKEYS;
    const float* kc = a.in[4] + ((size_t)b * PAST) * 512 + h * 64; const float* vc = a.in[5] + ((size_t)b * PAST) * 512 + h * 64;
    const float* kn = a.out + O_KS + ((size_t)b * DSEQ) * 512 + h * 64; const float* vn = a.out + O_VS + ((size_t)b * DSEQ) * 512 + h * 64;
    { const int qi = tid >> 6, d = tid & 63; qs[tid] = QS[((size_t)b * 32 + 8 * qg + qi) * 512 + h * 64 + d]; }
    __syncthreads();
    for (int key = wave * 132 + lane; key < wave * 132 + 132; key += 64) {
        const f32x4* kr = (const f32x4*)(key < PAST ? kc + (size_t)key * 512 : kn + (size_t)(key - PAST) * 512);
        f32x4 kv[16];
#pragma unroll
        for (int i = 0; i < 16; ++i) kv[i] = kr[i];
        const float ck = cum[key];
#pragma unroll
        for (int qi = 0; qi < 8; ++qi) { float s = 0.f;
#pragma unroll
            for (int i = 0; i < 16; ++i) { const f32x4 q4 = *(const f32x4*)(qs + qi * 64 + 4 * i); s += (q4.x * kv[i].x + q4.y * kv[i].y) + (q4.z * kv[i].z + q4.w * kv[i].w); }
            const int qpos = PAST + 8 * qg + qi;
            S[qi * SKEYS + key] = (key <= qpos) ? s + (cum[qpos] - ck) : -INFINITY; }
    }
    __syncthreads();
    { float mx = -INFINITY; for (int k = lane; k < SKEYS; k += 64) mx = fmaxf(mx, S[wave * SKEYS + k]);
#pragma unroll
      for (int o = 1; o < 64; o <<= 1) mx = fmaxf(mx, __shfl_xor(mx, o));
      float sum = 0.f; for (int k = lane; k < SKEYS; k += 64) { const float p = exp2f(S[wave * SKEYS + k] - mx); S[wave * SKEYS + k] = p; sum += p; }
      sum = wave_sum(sum); if (lane == 0) inv[wave] = 1.0f / sum; }
    __syncthreads();
    { float acc[8];
#pragma unroll
      for (int qi = 0; qi < 8; ++qi) acc[qi] = 0.f;
#pragma unroll 1
      for (int key0 = wave * 132; key0 < wave * 132 + 132; key0 += 12) {
          float vv[12];
#pragma unroll
          for (int j = 0; j < 12; ++j) { const int key = key0 + j; vv[j] = (key < PAST ? vc + (size_t)key * 512 : vn + (size_t)(key - PAST) * 512)[lane]; }
#pragma unroll
          for (int j = 0; j < 12; ++j)
#pragma unroll
              for (int qi = 0; qi < 8; ++qi) acc[qi] += S[qi * SKEYS + key0 + j] * vv[j]; }
#pragma unroll
      for (int qi = 0; qi < 8; ++qi) red[(wave * 8 + qi) * 64 + lane] = acc[qi]; }
    __syncthreads();
    { const int qi = tid >> 6, d = tid & 63; float s = 0.f;
#pragma unroll
      for (int w = 0; w < 8; ++w) s += red[(w * 8 + qi) * 64 + d];
      bf16* AO = (bf16*)(a.ws + WS_AO); AO[((size_t)MP + b * 32 + 8 * qg + qi) * 512 + h * 64 + d] = (bf16)f2bf(s * inv[qi]); }
    __syncthreads();
}

#define XB_TMO      128
#define XB_XCNT(j)  (256  + 64 * (j))
#define XB_XSUB(j)  (1280 + 64 * (j))
#define XB_XGEN(j)  (2304 + 64 * (j))
#define XB_TOP      3328
#define XB_TOPGEN   3392
#define XCD_BAR_WORDS 3456
#define XB_SPIN_CAP (1u << 18)

__device__ __forceinline__ unsigned xb_ld(unsigned* p)              { return __hip_atomic_load(p, __ATOMIC_RELAXED, __HIP_MEMORY_SCOPE_AGENT); }
__device__ __forceinline__ unsigned xb_add(unsigned* p, unsigned v) { return __hip_atomic_fetch_add(p, v, __ATOMIC_RELAXED, __HIP_MEMORY_SCOPE_AGENT); }
__device__ __forceinline__ unsigned xb_xcc_id() { return (unsigned)__builtin_amdgcn_s_getreg((3 << 11) | 20) & 0xFu; }
#define XB_SPIN(cond, bar) do { unsigned _sp = 0; while (cond) { __builtin_amdgcn_s_sleep(1); \
    if ((++_sp & 255u) == 0u) { if (xb_ld(&(bar)[XB_TMO])) break; if (_sp > XB_SPIN_CAP) { atomicAdd(&(bar)[XB_TMO], 1u); break; } } } } while (0)

struct XcdBarrier {
    unsigned* bar; unsigned x;
    volatile LAS unsigned* st;
};

__device__ __forceinline__ XcdBarrier xcd_barrier_post(unsigned* bar, volatile LAS unsigned* st, int wv) {
    XcdBarrier b; b.bar = bar; b.x = xb_xcc_id(); b.st = st;
    if (wv == 0 && lane_id_() == 0) (void)xb_add(&bar[XB_XCNT(b.x)], 1u);
    return b;
}
__device__ __forceinline__ void xcd_barrier_complete(unsigned* bar, unsigned x, unsigned& nloc, unsigned& nx) {
    const unsigned G = gridDim.x * gridDim.y * gridDim.z;
    unsigned sum, cnt, mine, sp = 0u;
    for (;;) {
        sum = 0u; cnt = 0u; mine = 0u;
#pragma unroll
        for (unsigned j = 0; j < 16; ++j) { const unsigned c = xb_ld(&bar[XB_XCNT(j)]); sum += c; cnt += (c > 0u) ? 1u : 0u; mine = (j == x) ? c : mine; }
        if (sum == G) break;
        __builtin_amdgcn_s_sleep(1);
        if ((++sp & 255u) == 0u) { if (xb_ld(&bar[XB_TMO])) break; if (sp > XB_SPIN_CAP) { atomicAdd(&bar[XB_TMO], 1u); break; } }
    }
    nloc = mine > 0u ? mine : 1u; nx = cnt > 0u ? cnt : 1u;
}

__device__ __forceinline__ void xcd_barrier(const XcdBarrier& b, int wv) {
    asm volatile("s_waitcnt vmcnt(0)" ::: "memory");
    __syncthreads();
    if (wv == 0 && lane_id_() == 0) {
        unsigned* bar = b.bar;
        __builtin_amdgcn_s_waitcnt(0);
        unsigned nloc = b.st[0], nx = b.st[1];
        if (nloc == 0u) { xcd_barrier_complete(bar, b.x, nloc, nx); b.st[0] = nloc; b.st[1] = nx; }
        const unsigned old = xb_add(&bar[XB_XSUB(b.x)], 1u);
        const unsigned gen = old / nloc;
        if (old + 1u == (gen + 1u) * nloc) {
            __builtin_amdgcn_fence(__ATOMIC_RELEASE, "agent");
            asm volatile("s_waitcnt vmcnt(0)" ::: "memory");
            const unsigned og = xb_add(&bar[XB_TOP], 1u);
            const unsigned tg = og / nx;
            if (og + 1u == (tg + 1u) * nx) xb_add(&bar[XB_TOPGEN], 1u);
            else XB_SPIN(xb_ld(&bar[XB_TOPGEN]) == tg, bar);
            __builtin_amdgcn_fence(__ATOMIC_ACQUIRE, "agent");
            xb_add(&bar[XB_XGEN(b.x)], 1u);
            asm volatile("s_waitcnt vmcnt(0)" ::: "memory");
        } else {
            XB_SPIN(xb_ld(&bar[XB_XGEN(b.x)]) == gen, bar);
            __builtin_amdgcn_fence(__ATOMIC_ACQUIRE, "agent");
            asm volatile("s_waitcnt vmcnt(0)" ::: "memory");
        }
    }
    __syncthreads();
}

#ifndef SKIPMASK
#define SKIPMASK 0u
#endif
#define PH(n) (((SKIPMASK) >> (n) & 1u) == 0u)
#define GSYNC() do { XcdBarrier b_; b_.bar = (unsigned*)(a.ws + WS_CTL); b_.x = xbar_x; b_.st = MISC + 8; xcd_barrier(b_, wave); } while (0)
__global__ void __launch_bounds__(NTHR, 2) fox_fwd(Args a) {
    extern __shared__ __attribute__((aligned(16))) unsigned char lds[];
    cg::grid_group grid = cg::this_grid();
    const int wave = __builtin_amdgcn_readfirstlane((int)threadIdx.x >> 6);
#define tid ((wave << 6) | lane_id_())
#define lane (lane_id_())
    const int G = gridDim.x, bx = blockIdx.x; const int vcu = (G % 8 == 0) ? (bx % 8) * (G / 8) + bx / 8 : bx;
    const int gw = vcu * NWAVES + wave, NGW = G * NWAVES;
    LAS unsigned char* ldsl = (LAS unsigned char*)lds;
    float* MOD = (float*)(a.ws + WS_MOD); bf16* XN = (bf16*)(a.ws + WS_XN); bf16* ACT = (bf16*)(a.ws + WS_ACT);
    volatile LAS unsigned* MISC = (volatile LAS unsigned*)((LAS unsigned char*)lds + MISC_OFF);
    for (int i = tid; i < LDS_BYTES / 16; i += NTHR) ((v4u*)lds)[i] = (v4u){0u, 0u, 0u, 0u};
    __syncthreads();
    __builtin_amdgcn_fence(__ATOMIC_SEQ_CST, ""); asm volatile("s_waitcnt vmcnt(0) lgkmcnt(0)" ::: "memory");
    const unsigned xbar_x = xcd_barrier_post((unsigned*)(a.ws + WS_CTL), MISC + 8, wave).x;
    grid.sync();
    float* Y = a.out + O_Y;

#ifndef NPASS
#define NPASS 1
#endif
#pragma unroll 1
    for (int pass = 0; pass < NPASS; ++pass) {
    if (pass) GSYNC();
    if (PH(0)) { for (int cb = bx; cb < 256; cb += G) ada_unit(a, lds, cb, tid);
    p0_weights(a, lds, gw, NGW, wave, lane); }
    GSYNC();
    if (PH(1)) norm_phase<false>(a, lds, a.in[0], a.in[1], a.in[9], 0, 1, gw, NGW, tid, lane);
    GSYNC();
    if (PH(2)) { pg8::Gemm g{XN, (const bf16*)(a.ws + WS_WGU1), M, 2 * FF, 1024, 1024}; pg8::StaticOrder S; S.init(M, 2 * FF, G, bx); pg8::EpiUp E{ACT, FF};
      GEMM_PHASE(pg8::EpiUp); }
    GSYNC();
    if (PH(3)) { pg8::EpiRes E{a.in[0], a.in[1], Y, MOD + 2 * 1024, 0.5f};
      { int ksub_ = 256; asm volatile("" : "+s"(ksub_)); pg8::Gemm g2{ACT + (size_t)MP * FF, (const bf16*)(a.ws + WS_WD1), 256, 1024, ksub_, FF}; pg8::SplitOrder S2; S2.init(G, bx); pg8::EpiPartial E2{(float*)(a.ws + WS_PART), 4, 256}; GEMM_PHASE_SPLIT(); }
      { pg8::Gemm g{ACT, (const bf16*)(a.ws + WS_WD1), MP, 1024, FF, FF}; pg8::StaticOrder S; S.init(MP, 1024, G, bx); GEMM_PHASE(pg8::EpiRes); }
      GSYNC();
      if (bx < 32) pg8::reduce_rowgroup<11>((const float*)(a.ws + WS_PART), bx & 3, bx >> 2, E, wave); }
    GSYNC();
    if (PH(4)) norm_phase<true>(a, lds, Y, Y + (size_t)MP * 1024, a.in[13], 3, 4, gw, NGW, tid, lane);
    GSYNC();
    if (PH(5)) { if (G >= 160) { const int u = G - 1 - bx; if (u < 80) scan_unit(a, lds, u, tid); }
                 else for (int u = bx; u < 80; u += G) scan_unit(a, lds, u, tid); }
    if (PH(6)) { pg8::Gemm g{XN, (const bf16*)(a.ws + WS_WIN), M, 2560, 1024, 1024}; pg8::StaticOrder S; S.init(M, 2560, G, bx);
      pg8::EpiIn E{(bf16*)(a.ws + WS_Q), (bf16*)(a.ws + WS_K), (bf16*)(a.ws + WS_V), (bf16*)(a.ws + WS_U), (bf16*)(a.ws + WS_G2), nullptr, nullptr,
                   (float*)(a.ws + WS_G2SS), (float*)(a.ws + WS_QS), a.out + O_KP, a.out + O_KS, a.out + O_VP, a.out + O_VS, a.in[16], a.in[17], attn_body::C2, EPS};
      GEMM_PHASE(pg8::EpiIn); }
    GSYNC();
    if (PH(7)) { const attn_body::bf16* Qb = (const attn_body::bf16*)(a.ws + WS_Q); const attn_body::bf16* Kb = (const attn_body::bf16*)(a.ws + WS_K); const attn_body::bf16* Vb = (const attn_body::bf16*)(a.ws + WS_V);
      attn_body::bf16* Ob = (attn_body::bf16*)(a.ws + WS_AO); const float* CUMP = (const float*)(a.ws + WS_CUMP);
      const int nun = (G == 256) ? 4 : (1024 - bx + G - 1) / G;
      float B2;
      { float mq = fabsf(a.in[16][lane]), mk = fabsf(a.in[17][lane]);
#pragma unroll
        for (int o = 1; o < 64; o <<= 1) { mq = fmaxf(mq, __shfl_xor(mq, o)); mk = fmaxf(mk, __shfl_xor(mk, o)); }
        B2 = 64.0f * mq * mk * attn_body::C2 * 1.01f + 0.5f; }
#pragma unroll 1
      for (int i = 0; i < nun; ++i) { int bh, qb;
          if (G == 256) { const int s = vcu & 15; bh = vcu >> 4; qb = (i == 0) ? s : (i == 1) ? 31 - s : (i == 2) ? 32 + s : 63 - s; } else { const int idx = bx + i * G; bh = idx >> 6; qb = idx & 63; }
          int ts = 0;
          { const float* cl = CUMP + (size_t)bh * SEQ; const float cref = cl[qb * 256]; const int ncand = 4 * qb;
            float cv[4];
#pragma unroll
            for (int k = 0; k < 4; ++k) { const int j = 64 * k + lane; cv[k] = (j < ncand) ? cl[64 * j + 63] : 0.f; }
#pragma unroll
            for (int k = 0; k < 4; ++k) { const int j = 64 * k + lane; const bool sk = (j < ncand) && (cref - cv[k] + 2.0f * B2 < -152.0f); ts += (int)__popcll(__ballot(sk)); }
            ts = __builtin_amdgcn_readfirstlane(ts) & ~1; }
          attn_body::attn_unit<8>(bh >> 3, bh & 7, qb, ts, CUMP + (size_t)bh * SEQ, Qb, Kb, Vb, Ob, (char*)lds, wave);
          }
      __syncthreads(); }
    if (PH(8)) for (int ci = bx; ci < 256; ci += G) gmlp_unit(a, lds, ci, tid, wave, lane);
    if (PH(9)) for (int u = bx; u < 256; u += G) sattn_unit(a, lds, u, tid, wave, lane);
    if (PH(10)) { if (G == 256) { if ((vcu & 15) == 0 && (vcu >> 4) < 8) gmlp_sample_unit(a, lds, vcu >> 4, tid); } else for (int b = bx; b < 8; b += G) gmlp_sample_unit(a, lds, b, tid); }
    GSYNC();
    if (PH(11)) { bf16* T = (bf16*)(a.ws + WS_T1); bf16* T2 = (bf16*)(a.ws + WS_T2); const bf16* WIN = (const bf16*)(a.ws + WS_WIN);
      bf16* TS = T + (size_t)MP * 1024; bf16* T2S = T2 + (size_t)MP * 1024; const bf16* XS = XN + (size_t)MP * 1024;
      float* PARTA = (float*)(a.ws + 2 * MiB); float* PARTB = (float*)(a.ws + 4 * MiB);
      { pg8::Gemm g{(const bf16*)(a.ws + WS_AO) + (size_t)MP * 512, (const bf16*)(a.ws + WS_WPA), 256, 1024, 512, 512}; pg8::StaticOrder S; S.init(256, 1024, G, bx); pg8::EpiMix<0> E{TS, nullptr}; GEMM_PHASE(pg8::EpiMix<0>); }
      { pg8::Gemm g{(const bf16*)(a.ws + WS_AO), (const bf16*)(a.ws + WS_WPA), MP, 1024, 512, 512}; pg8::StaticOrder S; S.init(MP, 1024, G, bx); pg8::EpiMix<0> E{T, nullptr}; GEMM_PHASE(pg8::EpiMix<0>); }
      { int ksub_ = 512; asm volatile("" : "+s"(ksub_)); pg8::Gemm g2{XS, WIN + (size_t)2560 * 1024, 256, 1024, ksub_, 1024}; pg8::SplitOrderT<4, 2, 512> S2; S2.init(G, (bx + G - 8) % G); pg8::EpiPartialT<4, 9> E2{PARTA}; GEMM_PHASE_SPLIT_T(4, 2, 512, 9); }
      { pg8::Gemm g{XN, WIN + (size_t)2560 * 1024, MP, 1024, 1024, 1024}; pg8::StaticOrder S; S.init(MP, 1024, G, bx); pg8::EpiMix<1> E{T, nullptr}; GEMM_PHASE(pg8::EpiMix<1>); }
      { pg8::Gemm g{(const bf16*)(a.ws + WS_BO) + (size_t)MP * 512, (const bf16*)(a.ws + WS_WPB), 256, 1024, 512, 512}; pg8::StaticOrder S; S.init(256, 1024, G, (bx + G - 16) % G); pg8::EpiMix<0> E{T2S, nullptr}; GEMM_PHASE(pg8::EpiMix<0>); }
      { pg8::Gemm g{(const bf16*)(a.ws + WS_BO), (const bf16*)(a.ws + WS_WPB), MP, 1024, 512, 512}; pg8::StaticOrder S; S.init(MP, 1024, G, bx); pg8::EpiMix<0> E{T2, nullptr}; GEMM_PHASE(pg8::EpiMix<0>); }
      { int ksub_ = 512; asm volatile("" : "+s"(ksub_)); pg8::Gemm g2{XS, WIN + (size_t)3584 * 1024, 256, 1024, ksub_, 1024}; pg8::SplitOrderT<4, 2, 512> S2; S2.init(G, (bx + G - 24) % G); pg8::EpiPartialT<4, 9> E2{PARTB}; GEMM_PHASE_SPLIT_T(4, 2, 512, 9); }
      { pg8::Gemm g{XN, WIN + (size_t)3584 * 1024, MP, 1024, 1024, 1024}; pg8::StaticOrder S; S.init(MP, 1024, G, bx); pg8::EpiMix<2> E{T, T2}; GEMM_PHASE(pg8::EpiMix<2>); }
      GSYNC();
      if (bx < 32) { pg8::EpiMix<1> E1{TS, nullptr}; pg8::reduce_rowgroup<2>(PARTA, bx & 3, bx >> 2, E1, wave);
                     pg8::EpiMix<2> E2{TS, T2S}; pg8::reduce_rowgroup<2>(PARTB, bx & 3, bx >> 2, E2, wave); } }
    GSYNC();
    if (PH(13)) { pg8::EpiRes E{Y, Y + (size_t)MP * 1024, Y, MOD + 5 * 1024, 1.0f}; const bf16* M1 = (const bf16*)(a.ws + WS_T1);
      { int ksub_ = 256; asm volatile("" : "+s"(ksub_)); pg8::Gemm g2{M1 + (size_t)MP * 1024, (const bf16*)(a.ws + WS_WOUT), 256, 1024, ksub_, 1024}; pg8::SplitOrderT<4, 4, 256> S2; S2.init(G, bx); pg8::EpiPartialT<4, 8> E2{(float*)(a.ws + WS_PART)}; GEMM_PHASE_SPLIT_T(4, 4, 256, 8); }
      { pg8::Gemm g{M1, (const bf16*)(a.ws + WS_WOUT), MP, 1024, 1024, 1024}; pg8::StaticOrder S; S.init(MP, 1024, G, bx); GEMM_PHASE(pg8::EpiRes); }
      GSYNC();
      if (bx < 32) pg8::reduce_rowgroup<4>((const float*)(a.ws + WS_PART), bx & 3, bx >> 2, E, wave); }
    GSYNC();
    if (PH(14)) norm_phase<false>(a, lds, Y, Y + (size_t)MP * 1024, a.in[24], 6, 7, gw, NGW, tid, lane);
    GSYNC();
    if (PH(15)) { pg8::Gemm g{XN, (const bf16*)(a.ws + WS_WGU2), M, 2 * FF, 1024, 1024}; pg8::StaticOrder S; S.init(M, 2 * FF, G, bx); pg8::EpiUp E{ACT, FF};
      GEMM_PHASE(pg8::EpiUp); }
    GSYNC();
    if (PH(16)) { pg8::EpiRes E{Y, Y + (size_t)MP * 1024, Y, MOD + 8 * 1024, 0.5f};
      { int ksub_ = 256; asm volatile("" : "+s"(ksub_)); pg8::Gemm g2{ACT + (size_t)MP * FF, (const bf16*)(a.ws + WS_WD2), 256, 1024, ksub_, FF}; pg8::SplitOrder S2; S2.init(G, bx); pg8::EpiPartial E2{(float*)(a.ws + WS_PART), 4, 256}; GEMM_PHASE_SPLIT(); }
      { pg8::Gemm g{ACT, (const bf16*)(a.ws + WS_WD2), MP, 1024, FF, FF}; pg8::StaticOrder S; S.init(MP, 1024, G, bx); GEMM_PHASE(pg8::EpiRes); }
      GSYNC();
      if (bx < 32) pg8::reduce_rowgroup<11>((const float*)(a.ws + WS_PART), bx & 3, bx >> 2, E, wave); }
    }
}


#undef tid
#undef lane
extern "C" void kernel_launch(void* const* d_in, const int* in_sizes, int n_in, void* d_out, int out_size, void* d_ws, size_t ws_size, hipStream_t stream) {
    static int grid = 0;
    if (grid == 0) {
        if (n_in != 28 || (size_t)out_size != O_END || ws_size < WS_END || in_sizes[0] != MP * 1024) { fprintf(stderr, "kernel_launch: unexpected shapes (n_in %d out %d ws %zu)\n", n_in, out_size, ws_size); grid = -1; return; }
        int dev = 0, cus = 0, per_cu = 0;
        hipGetDevice(&dev); hipDeviceGetAttribute(&cus, hipDeviceAttributeMultiprocessorCount, dev);
        if (hipFuncSetAttribute((const void*)fox_fwd, hipFuncAttributeMaxDynamicSharedMemorySize, LDS_BYTES) != hipSuccess) { fprintf(stderr, "kernel_launch: hipFuncSetAttribute failed\n"); grid = -1; return; }
        if (hipOccupancyMaxActiveBlocksPerMultiprocessor(&per_cu, (const void*)fox_fwd, NTHR, LDS_BYTES) != hipSuccess || per_cu < 1) { fprintf(stderr, "kernel_launch: occupancy query says %d\n", per_cu); per_cu = 1; }
        (void)hipGetLastError();
        grid = cus * 1;
    }
    if (grid < 0) return;
    if (hipMemsetAsync((char*)d_ws + WS_CTL, 0, CTL_ZERO_BYTES, stream) != hipSuccess) { fprintf(stderr, "kernel_launch: hipMemsetAsync failed\n"); return; }
    Args a{};
    for (int i = 0; i < 28; ++i) a.in[i] = (const float*)d_in[i];
    a.out = (float*)d_out; a.ws = (unsigned char*)d_ws;
    void* args[] = {&a};
    hipError_t e = hipLaunchCooperativeKernel((const void*)fox_fwd, dim3(grid), dim3(NTHR), args, LDS_BYTES, stream);
    if (e != hipSuccess) fprintf(stderr, "cooperative launch failed: %s (grid %d)\n", hipGetErrorString(e), grid);
}
```

```cpp
#include <hip/hip_runtime.h>
#include <hip/hip_cooperative_groups.h>
#include <cstdio>
#include <cstdint>
__device__ __forceinline__ int lane_id_() { return (int)__builtin_amdgcn_mbcnt_hi(~0u, __builtin_amdgcn_mbcnt_lo(~0u, 0u)); }
namespace pg8 {
#define PG8_LAS __attribute__((address_space(3)))
typedef unsigned short bf16_t;
typedef short bf16x8 __attribute__((ext_vector_type(8)));
typedef float f32x4 __attribute__((ext_vector_type(4)));
typedef unsigned u32x4 __attribute__((ext_vector_type(4)));
constexpr int BM = 256, BK = 64, HALF = 128, HTB = HALF * BK * 2  , STAGE_BYTES = 8 * HTB, NXCD = 8, WGM = 8;

__host__ __device__ __forceinline__ int lds_byte(int r, int c) { const int st = (r >> 4) * 2 + (c >> 5), rr = r & 15, cc = c & 31, ob = rr * 64 + cc * 2; return st * 1024 + (ob ^ (((ob >> 9) & 1) << 5)); }
__host__ __device__ __forceinline__ void stage_rc(int b, int& R, int& C) { const int st = b / 1024, sb = b % 1024, swz = sb ^ (((sb >> 9) & 1) << 5); R = (st >> 1) * 16 + swz / 64; C = (st & 1) * 32 + (swz % 64) / 2; }
__host__ __device__ __forceinline__ int perm32(int rho) { const int n = rho >> 4, i = rho & 15; return 8 * (i >> 2) + 4 * n + (i & 3); }

struct Unit { int pm, pn, koff; };
struct Gemm { const bf16_t* A; const bf16_t* Bt; int M, N, K, Kp; };

struct StaticOrder {
    int nM, nN, nwg, G, c;
    __host__ __device__ void init(int M, int N, int G_, int c_) { nM = M / BM; nN = N / BM; nwg = nM * nN; G = G_; c = c_; }
    __host__ __device__ bool next(int i, Unit& u) const {
        const long L = (long)i * G + c; if (L >= nwg) return false;
        int wgid = (int)L; { const int q = nwg / NXCD, r = nwg % NXCD, xcd = wgid % NXCD, off = wgid / NXCD; wgid = (xcd < r ? xcd * (q + 1) : r * (q + 1) + (xcd - r) * q) + off; }
        const int nig = WGM * nN, gid = wgid / nig, fm = gid * WGM, gsz = (nM - fm) < WGM ? (nM - fm) : WGM;
        u.pm = fm + ((wgid % nig) % gsz); u.pn = (wgid % nig) / gsz; u.koff = 0; return true;
    }
    __device__ __forceinline__ void a_ready(const Unit&) const {}
    __device__ __forceinline__ void done(const Unit&) const {}
};

template <int NN, int NS, int KSUB> struct SplitOrderT {
    int G, c;
    __host__ __device__ void init(int G_, int c_) { G = G_; c = c_; }
    __host__ __device__ bool next(int i, Unit& u) const { const int L = i * G + c; if (L >= NN * NS) return false; u.pm = 0; u.pn = L % NN; u.koff = (L / NN) * KSUB; return true; }
    __device__ __forceinline__ void a_ready(const Unit&) const {}
    __device__ __forceinline__ void done(const Unit&) const {}
};
typedef SplitOrderT<4, 11, 256> SplitOrder;
__device__ __forceinline__ unsigned cvt_pk_bf16(float lo, float hi) { unsigned r; asm volatile("v_cvt_pk_bf16_f32 %0, %1, %2" : "=v"(r) : "v"(lo), "v"(hi)); return r; }
typedef float f32x2 __attribute__((ext_vector_type(2)));
__device__ __forceinline__ f32x2 gelu_pk(f32x2 v) {
    const f32x2 av = __builtin_elementwise_abs(v), d = av * 0.2316418882f + 1.0f;
    f32x2 t; t.x = __builtin_amdgcn_rcpf(d.x); t.y = __builtin_amdgcn_rcpf(d.y);
    f32x2 q = t * 0.5307027145f + (-0.7265760135f); q = q * t + 0.7107068705f; q = q * t + (-0.142248368f); q = q * t + 0.127414796f; q = q * t;
    const f32x2 s = (v * v) * (-0.72134752044f);
    f32x2 e; e.x = __builtin_amdgcn_exp2f(s.x); e.y = __builtin_amdgcn_exp2f(s.y);
    const f32x2 m = v * (q * e), r = v - m;
    f32x2 o; o.x = v.x < 0.f ? m.x : r.x; o.y = v.y < 0.f ? m.y : r.y; return o;
}

constexpr int MPROMPT = 32768;
constexpr int NMODC = 9216;
typedef unsigned u32x2v __attribute__((ext_vector_type(2)));
__device__ __forceinline__ float sigm(float x) { return __builtin_amdgcn_rcpf(1.0f + __builtin_amdgcn_exp2f(-1.4426950408889634f * x)); }
__device__ __forceinline__ float gelu_tanh(float x) { const float y = 1.5957691216057308f * (x + 0.044715f * x * x * x); return x * sigm(y); }
__device__ __forceinline__ float bf_lo(unsigned w) { return __uint_as_float(w << 16); }
__device__ __forceinline__ float bf_hi(unsigned w) { return __uint_as_float(w & 0xffff0000u); }
__device__ __forceinline__ int mod_row(int pm, int rloc) { return pm < 128 ? (pm >> 6) : 2 + (rloc >> 5); }

struct EpiUp {
    static constexpr bool PERM = true, AFTER_DRAIN = false;
    bf16_t* ACT; int ldc;
    __device__ __forceinline__ void operator()(const f32x4 (&acc)[2][2][4][2], const Unit& u, int wr, int wc, int fr, int fq) const {
        int fr_ = fr, fq_ = fq; asm volatile("" : "+v"(fr_), "+v"(fq_));
        const int row0 = u.pm * BM + wr * 64 + fr_, ch0 = u.pn * HALF + wc * 32 + 8 * fq_;
#pragma unroll
        for (int ai = 0; ai < 2; ++ai)
#pragma unroll
            for (int m = 0; m < 4; ++m) {
                float o[8];
#pragma unroll
                for (int n = 0; n < 2; ++n)
#pragma unroll
                    for (int i = 0; i < 4; ++i) { const float g = acc[ai][0][m][n][i], up = acc[ai][1][m][n][i]; o[4 * n + i] = g * sigm(g) * up; }
                u32x4 w; w.x = cvt_pk_bf16(o[0], o[1]); w.y = cvt_pk_bf16(o[2], o[3]); w.z = cvt_pk_bf16(o[4], o[5]); w.w = cvt_pk_bf16(o[6], o[7]);
                *(u32x4*)(ACT + (size_t)(row0 + ai * HALF + m * 16) * ldc + ch0) = w;
            }
    }
};
struct EpiRes {
    static constexpr bool PERM = true, AFTER_DRAIN = false;
    const float* resp; const float* ress; float* out; const float* gate; float fac;
    __device__ __forceinline__ void rowgroup(const f32x4 (&v)[2][2], int pn, int ai, int m, int wr, int wc, int fr, int fq) const {
        const int rl = wr * 64 + fr + ai * HALF + m * 16, col0 = pn * BM + wc * 32 + 8 * fq;
        const float* gp = gate + (size_t)(2 + (rl >> 5)) * NMODC + col0; float* obase = out + (size_t)128 * BM * 1024;
#pragma unroll
        for (int bj = 0; bj < 2; ++bj)
#pragma unroll
            for (int n = 0; n < 2; ++n) { const size_t off = (size_t)rl * 1024 + col0 + bj * HALF + 4 * n;
                const f32x4 gv = *(const f32x4*)(gp + bj * HALF + 4 * n), rv = *(const f32x4*)(ress + off);
                *(f32x4*)(obase + off) = rv + (gv * fac) * v[bj][n]; }
    }
    __device__ __forceinline__ void operator()(const f32x4 (&acc)[2][2][4][2], const Unit& u, int wr, int wc, int fr, int fq) const {
        int fr_ = fr, fq_ = fq; asm volatile("" : "+v"(fr_), "+v"(fq_));
        const int rl0 = wr * 64 + fr_, col0 = u.pn * BM + wc * 32 + 8 * fq_;
        const float* rbase = (u.pm < 128) ? resp + (size_t)u.pm * BM * 1024 : ress;
        float* obase = out + (size_t)u.pm * BM * 1024;
#pragma unroll
        for (int ai = 0; ai < 2; ++ai)
#pragma unroll
            for (int m = 0; m < 4; ++m) {
                const int rl = rl0 + ai * HALF + m * 16; const float* gp = gate + (size_t)mod_row(u.pm, rl) * NMODC + col0;
                f32x4 gv4[2][2], rv4[2][2];
#pragma unroll
                for (int bj = 0; bj < 2; ++bj)
#pragma unroll
                    for (int n = 0; n < 2; ++n) { gv4[bj][n] = *(const f32x4*)(gp + bj * HALF + 4 * n); rv4[bj][n] = *(const f32x4*)(rbase + (size_t)rl * 1024 + col0 + bj * HALF + 4 * n); }
#pragma unroll
                for (int bj = 0; bj < 2; ++bj)
#pragma unroll
                    for (int n = 0; n < 2; ++n) *(f32x4*)(obase + (size_t)rl * 1024 + col0 + bj * HALF + 4 * n) = rv4[bj][n] + (gv4[bj][n] * fac) * acc[ai][bj][m][n];
            }
    }
};
struct EpiIn {
    static constexpr bool PERM = true, AFTER_DRAIN = false;
    bf16_t *Q, *K, *V, *U, *G2, *SGA, *SGB; float* G2SS; float* QS;
    float *kout_p, *kout_s, *vout_p, *vout_s;
    const float *gq, *gk; float qscale, eps;
    __device__ __forceinline__ void operator()(const f32x4 (&acc)[2][2][4][2], const Unit& u, int wr, int wc, int fr, int fq) const {
        int fr_ = fr, fq_ = fq; asm volatile("" : "+v"(fr_), "+v"(fq_));
        const int pn = u.pn, rl0 = wr * 64 + fr_; const size_t rg0 = (size_t)u.pm * BM;
        if (pn < 4) {
            const bool isq = pn < 2; const int head = 4 * (pn & 1) + wc; const float* gsrc = isq ? gq : gk;
            f32x4 gv[2][2];
#pragma unroll
            for (int bj = 0; bj < 2; ++bj)
#pragma unroll
                for (int n = 0; n < 2; ++n) { gv[bj][n] = *(const f32x4*)(gsrc + 32 * bj + 8 * fq_ + 4 * n); if (isq) gv[bj][n] = gv[bj][n] * qscale; }
            bf16_t* dst = isq ? Q : K;
#pragma unroll
            for (int ai = 0; ai < 2; ++ai)
#pragma unroll
                for (int m = 0; m < 4; ++m) {
                    float ss = 0.f;
#pragma unroll
                    for (int bj = 0; bj < 2; ++bj)
#pragma unroll
                        for (int n = 0; n < 2; ++n) { const f32x4 x = acc[ai][bj][m][n]; ss += (x[0] * x[0] + x[1] * x[1]) + (x[2] * x[2] + x[3] * x[3]); }
                    ss += __shfl_xor(ss, 16); ss += __shfl_xor(ss, 32);
                    const float rstd = 1.0f / sqrtf(ss * (1.0f / 64.0f) + eps);
                    const int rl = rl0 + ai * HALF + m * 16; const size_t r = rg0 + rl;
#pragma unroll
                    for (int bj = 0; bj < 2; ++bj) {
                        const f32x4 o0 = acc[ai][bj][m][0] * rstd * gv[bj][0], o1 = acc[ai][bj][m][1] * rstd * gv[bj][1];
                        const int c = head * 64 + 32 * bj + 8 * fq_;
                        u32x4 w; w.x = cvt_pk_bf16(o0[0], o0[1]); w.y = cvt_pk_bf16(o0[2], o0[3]); w.z = cvt_pk_bf16(o1[0], o1[1]); w.w = cvt_pk_bf16(o1[2], o1[3]);
                        *(u32x4*)(dst + r * 512 + c) = w;
                        if (isq) { if (u.pm == 128) { float* qp = QS + (size_t)rl * 512 + c; *(f32x4*)qp = o0; *(f32x4*)(qp + 4) = o1; } }
                        else { float* kp = (u.pm < 128) ? kout_p + r * 512 + c : kout_s + (size_t)rl * 512 + c; *(f32x4*)kp = o0; *(f32x4*)(kp + 4) = o1; }
                    }
                    asm volatile("" ::: "memory");
                }
        } else if (pn < 6) {
            const int c0 = (pn - 4) * BM + wc * 32 + 8 * fq_;
#pragma unroll
            for (int ai = 0; ai < 2; ++ai)
#pragma unroll
                for (int m = 0; m < 4; ++m) { const int rl = rl0 + ai * HALF + m * 16; const size_t r = rg0 + rl;
#pragma unroll
                    for (int bj = 0; bj < 2; ++bj) { const f32x4 o0 = acc[ai][bj][m][0], o1 = acc[ai][bj][m][1]; const int c = c0 + bj * HALF;
                        u32x4 w; w.x = cvt_pk_bf16(o0[0], o0[1]); w.y = cvt_pk_bf16(o0[2], o0[3]); w.z = cvt_pk_bf16(o1[0], o1[1]); w.w = cvt_pk_bf16(o1[2], o1[3]);
                        *(u32x4*)(V + r * 512 + c) = w;
                        float* vp = (u.pm < 128) ? vout_p + r * 512 + c : vout_s + (size_t)rl * 512 + c;
                        { *(f32x4*)vp = o0; *(f32x4*)(vp + 4) = o1; } } asm volatile("" ::: "memory"); }
        } else if (pn < 10) {
            const bool isv = pn >= 8; const int t2 = (pn - 6) & 1; const int c0 = t2 * BM + wc * 32 + 8 * fq_; bf16_t* dst = isv ? G2 : U;
#pragma unroll
            for (int ai = 0; ai < 2; ++ai)
#pragma unroll
                for (int m = 0; m < 4; ++m) { const int rl = rl0 + ai * HALF + m * 16; const size_t r = rg0 + rl; float ss = 0.f;
#pragma unroll
                    for (int bj = 0; bj < 2; ++bj) { float o[8];
#pragma unroll
                        for (int n = 0; n < 2; ++n)
#pragma unroll
                            for (int i = 0; i < 4; ++i) { const float g = gelu_tanh(acc[ai][bj][m][n][i]); o[4 * n + i] = g; ss += g * g; }
                        u32x4 w; w.x = cvt_pk_bf16(o[0], o[1]); w.y = cvt_pk_bf16(o[2], o[3]); w.z = cvt_pk_bf16(o[4], o[5]); w.w = cvt_pk_bf16(o[6], o[7]);
                        *(u32x4*)(dst + r * 512 + c0 + bj * HALF) = w; }
                    if (isv) { ss += __shfl_xor(ss, 16); ss += __shfl_xor(ss, 32); if (fq_ == 0) G2SS[r * 8 + t2 * 4 + wc] = ss; } asm volatile("" ::: "memory"); }
        } else {
            const bool isa = pn < 14; const int c0 = ((pn - 10) & 3) * BM + wc * 32 + 8 * fq_; bf16_t* dst = isa ? SGA : SGB;
#pragma unroll
            for (int ai = 0; ai < 2; ++ai)
#pragma unroll
                for (int m = 0; m < 4; ++m) { const size_t r = rg0 + rl0 + ai * HALF + m * 16;
#pragma unroll
                    for (int bj = 0; bj < 2; ++bj) { float o[8];
#pragma unroll
                        for (int n = 0; n < 2; ++n)
#pragma unroll
                            for (int i = 0; i < 4; ++i) o[4 * n + i] = sigm(acc[ai][bj][m][n][i]);
                        u32x4 w; w.x = cvt_pk_bf16(o[0], o[1]); w.y = cvt_pk_bf16(o[2], o[3]); w.z = cvt_pk_bf16(o[4], o[5]); w.w = cvt_pk_bf16(o[6], o[7]);
                        *(u32x4*)(dst + r * 1024 + c0 + bj * HALF) = w;
                        } asm volatile("" ::: "memory"); }
        }
    }
};
struct EpiPartial {
    static constexpr bool PERM = true, AFTER_DRAIN = false;
    float* PART; int nN, Ksub;
    __device__ __forceinline__ void operator()(const f32x4 (&acc)[2][2][4][2], const Unit& u, int wr, int wc, int fr, int fq) const {
        int tid_ = (wr * 4 + wc) * 64 + fq * 16 + fr; asm volatile("" : "+v"(tid_));
        f32x4* dst = (f32x4*)PART + (size_t)((u.koff >> 8) * 4 + u.pn) * 32 * 512 + tid_;
#pragma unroll
        for (int ai = 0; ai < 2; ++ai)
#pragma unroll
            for (int bj = 0; bj < 2; ++bj)
#pragma unroll
                for (int m = 0; m < 4; ++m)
#pragma unroll
                    for (int n = 0; n < 2; ++n) { *dst = acc[ai][bj][m][n]; dst += 512; asm volatile("" : "+v"(dst) :: "memory"); }
        asm volatile("" ::: "memory");
    }
};
template <int NN, int KSHIFT> struct EpiPartialT {
    static constexpr bool PERM = true, AFTER_DRAIN = false;
    float* PART;
    __device__ __forceinline__ void operator()(const f32x4 (&acc)[2][2][4][2], const Unit& u, int wr, int wc, int fr, int fq) const {
        int tid_ = (wr * 4 + wc) * 64 + fq * 16 + fr; asm volatile("" : "+v"(tid_));
        f32x4* dst = (f32x4*)PART + (size_t)((u.koff >> KSHIFT) * NN + u.pn) * 32 * 512 + tid_;
#pragma unroll
        for (int ai = 0; ai < 2; ++ai)
#pragma unroll
            for (int bj = 0; bj < 2; ++bj)
#pragma unroll
                for (int m = 0; m < 4; ++m)
#pragma unroll
                    for (int n = 0; n < 2; ++n) { *dst = acc[ai][bj][m][n]; dst += 512; asm volatile("" : "+v"(dst) :: "memory"); }
    }
};
template <class Epi> __device__ __forceinline__ void reduce_partials(const float* PART, int nN, int nS, int pn, int pm_out, const Epi& E, int wv) {
    int tid = (wv << 6) | lane_id_(); asm volatile("" : "+v"(tid));
    const int wid = __builtin_amdgcn_readfirstlane(tid >> 6), lane = tid & 63, wr = wid >> 2, wc = wid & 3, fr = lane & 15, fq = lane >> 4;
    f32x4 acc[2][2][4][2];
#pragma unroll
    for (int ai = 0; ai < 2; ++ai)
#pragma unroll
        for (int bj = 0; bj < 2; ++bj)
#pragma unroll
            for (int m = 0; m < 4; ++m)
#pragma unroll
                for (int n = 0; n < 2; ++n) acc[ai][bj][m][n] = (f32x4){0.f, 0.f, 0.f, 0.f};
#pragma unroll 1
    for (int s = 0; s < nS; ++s) { const f32x4* src = (const f32x4*)PART + (size_t)(s * nN + pn) * 32 * 512 + tid;
#pragma unroll
        for (int ai = 0; ai < 2; ++ai) {
            f32x4 t[2][4][2];
#pragma unroll
            for (int bj = 0; bj < 2; ++bj)
#pragma unroll
                for (int m = 0; m < 4; ++m)
#pragma unroll
                    for (int n = 0; n < 2; ++n) { t[bj][m][n] = *src; src += 512; asm volatile("" : "+v"(src)); }
#pragma unroll
            for (int bj = 0; bj < 2; ++bj)
#pragma unroll
                for (int m = 0; m < 4; ++m)
#pragma unroll
                    for (int n = 0; n < 2; ++n) acc[ai][bj][m][n] += t[bj][m][n];
            asm volatile("" ::: "memory"); } }
    Unit u; u.pm = pm_out; u.pn = pn; u.koff = 0;
    E(acc, u, wr, wc, fr, fq);
}
template <int NS, class Epi> __device__ __forceinline__ void reduce_rowgroup(const float* PART, int pn, int rg, const Epi& E, int wv) {
    int tid = (wv << 6) | lane_id_(); asm volatile("" : "+v"(tid));
    const int wid = __builtin_amdgcn_readfirstlane(tid >> 6), lane = tid & 63, wr = wid >> 2, wc = wid & 3, fr = lane & 15, fq = lane >> 4;
    const int ai = rg >> 2, m = rg & 3;
    f32x4 t[NS][2][2];
#pragma unroll
    for (int s = 0; s < NS; ++s)
#pragma unroll
        for (int bj = 0; bj < 2; ++bj)
#pragma unroll
            for (int n = 0; n < 2; ++n) t[s][bj][n] = *((const f32x4*)PART + ((size_t)(s * 4 + pn) * 32 + (((ai * 2 + bj) * 4 + m) * 2 + n)) * 512 + tid);
    f32x4 v[2][2];
#pragma unroll
    for (int bj = 0; bj < 2; ++bj)
#pragma unroll
        for (int n = 0; n < 2; ++n) { v[bj][n] = t[0][bj][n];
#pragma unroll
            for (int s = 1; s < NS; ++s) v[bj][n] += t[s][bj][n]; }
    E.rowgroup(v, pn, ai, m, wr, wc, fr, fq);
}
template <int MODE> struct EpiMix {
    static constexpr bool PERM = true, AFTER_DRAIN = false;
    bf16_t* T; const bf16_t* T2;
    __device__ __forceinline__ void one(size_t off, const f32x4 a0, const f32x4 a1) const {
        float o[8] = {a0[0], a0[1], a0[2], a0[3], a1[0], a1[1], a1[2], a1[3]};
        if (MODE >= 1) {
            const u32x4 t = *(const u32x4*)(T + off);
            const float tv[8] = {bf_lo(t.x), bf_hi(t.x), bf_lo(t.y), bf_hi(t.y), bf_lo(t.z), bf_hi(t.z), bf_lo(t.w), bf_hi(t.w)};
            if (MODE == 1) {
#pragma unroll
                for (int i = 0; i < 8; ++i) o[i] = sigm(o[i]) * tv[i];
            } else {
                const u32x4 s2 = *(const u32x4*)(T2 + off);
                const float sv[8] = {bf_lo(s2.x), bf_hi(s2.x), bf_lo(s2.y), bf_hi(s2.y), bf_lo(s2.z), bf_hi(s2.z), bf_lo(s2.w), bf_hi(s2.w)};
#pragma unroll
                for (int i = 0; i < 8; ++i) o[i] = tv[i] + sigm(o[i]) * sv[i];
            }
        }
        u32x4 w; w.x = cvt_pk_bf16(o[0], o[1]); w.y = cvt_pk_bf16(o[2], o[3]); w.z = cvt_pk_bf16(o[4], o[5]); w.w = cvt_pk_bf16(o[6], o[7]);
        *(u32x4*)(T + off) = w;
    }
    __device__ __forceinline__ void two(size_t off, const f32x4 a0, const f32x4 a1, const u32x4 t, const u32x4 s2) const {
        float o[8] = {a0[0], a0[1], a0[2], a0[3], a1[0], a1[1], a1[2], a1[3]};
        const float tv[8] = {bf_lo(t.x), bf_hi(t.x), bf_lo(t.y), bf_hi(t.y), bf_lo(t.z), bf_hi(t.z), bf_lo(t.w), bf_hi(t.w)};
        if (MODE == 1) {
#pragma unroll
            for (int i = 0; i < 8; ++i) o[i] = sigm(o[i]) * tv[i];
        } else {
            const float sv[8] = {bf_lo(s2.x), bf_hi(s2.x), bf_lo(s2.y), bf_hi(s2.y), bf_lo(s2.z), bf_hi(s2.z), bf_lo(s2.w), bf_hi(s2.w)};
#pragma unroll
            for (int i = 0; i < 8; ++i) o[i] = tv[i] + sigm(o[i]) * sv[i];
        }
        u32x4 w; w.x = cvt_pk_bf16(o[0], o[1]); w.y = cvt_pk_bf16(o[2], o[3]); w.z = cvt_pk_bf16(o[4], o[5]); w.w = cvt_pk_bf16(o[6], o[7]);
        *(u32x4*)(T + off) = w;
    }
    __device__ __forceinline__ void operator()(const f32x4 (&acc)[2][2][4][2], const Unit& u, int wr, int wc, int fr, int fq) const {
        int fr_ = fr, fq_ = fq; asm volatile("" : "+v"(fr_), "+v"(fq_));
        const size_t row0 = (size_t)u.pm * BM + wr * 64 + fr_; const int col0 = u.pn * BM + wc * 32 + 8 * fq_;
#pragma unroll
        for (int ai = 0; ai < 2; ++ai)
#pragma unroll
            for (int m = 0; m < 4; ++m) {
                const size_t off0 = (row0 + ai * HALF + m * 16) * 1024 + col0;
                if (MODE >= 1) {
                    const u32x4 ta = *(const u32x4*)(T + off0), tb = *(const u32x4*)(T + off0 + HALF);
                    u32x4 sa = ta, sb = tb; if (MODE == 2) { sa = *(const u32x4*)(T2 + off0); sb = *(const u32x4*)(T2 + off0 + HALF); }
                    two(off0, acc[ai][0][m][0], acc[ai][0][m][1], ta, sa); two(off0 + HALF, acc[ai][1][m][0], acc[ai][1][m][1], tb, sb);
                } else {
#pragma unroll
                    for (int bj = 0; bj < 2; ++bj) one(off0 + bj * HALF, acc[ai][bj][m][0], acc[ai][bj][m][1]);
                }
                asm volatile("" ::: "memory");
            }
    }
    __device__ __forceinline__ void rowgroup(const f32x4 (&v)[2][2], int pn, int ai, int m, int wr, int wc, int fr, int fq) const {
        const size_t row = (size_t)(wr * 64 + fr + ai * HALF + m * 16); const int col0 = pn * BM + wc * 32 + 8 * fq;
#pragma unroll
        for (int bj = 0; bj < 2; ++bj) one(row * 1024 + col0 + bj * HALF, v[bj][0], v[bj][1]);
    }
};
template <class Epi, class Sched, bool ALIGN_EPI = false, bool SP2 = false>
__device__ __forceinline__ void gemm_phase(PG8_LAS unsigned char* lds, const Gemm g, const Sched& S, const Epi& E, int wv) {
    int tid = (wv << 6) | lane_id_(); asm volatile("" : "+v"(tid));
    const int wid = __builtin_amdgcn_readfirstlane(tid >> 6), lane = tid & 63, wr = wid >> 2, wc = wid & 3, fr = lane & 15, fq = lane >> 4;
    const int K = g.Kp, nt = g.K / BK;
    unsigned voffA[2], voffB[2];
#pragma unroll
    for (int i = 0; i < 2; ++i) { int R, C; stage_rc(tid * 16 + i * 8192, R, C); const int Rb = Epi::PERM ? ((R & ~31) + perm32(R & 31)) : R;
        voffA[i] = (unsigned)(R * K + C) * 2u; voffB[i] = (unsigned)(Rb * K + C) * 2u; }
    const size_t kstep = (size_t)(BK * 2);
    const size_t hstep = (size_t)HALF * K * 2;
    const size_t tstep = 2 * hstep;
    const unsigned ldsw = (unsigned)wid * 1024u;
    const int aoff = lds_byte(wr * 64 + fr, fq * 8), boff = lds_byte(wc * 32 + fr, fq * 8);
#define PG8_SA(b, h) (((b) * 2 + (h)) * HTB)
#define PG8_SB(b, h) ((4 + (b) * 2 + (h)) * HTB)
#define PG8_STAGE(bufoff, gbase, voff) do { _Pragma("unroll") for (int _i = 0; _i < 2; ++_i) \
        __builtin_amdgcn_global_load_lds((const unsigned*)((const char*)(gbase) + (voff)[_i]), (PG8_LAS unsigned*)(lds + (bufoff) + ldsw + _i * 8192), 16, 0, 0); } while (0)
#define PG8_LDA(dst, b, h) do { _Pragma("unroll") for (int m = 0; m < 4; ++m) _Pragma("unroll") for (int k = 0; k < 2; ++k) dst[m][k] = *(const PG8_LAS bf16x8*)(lds + PG8_SA(b, h) + aoff + m * 2048 + k * 1024); } while (0)
#define PG8_LDB(dst, b, h) do { _Pragma("unroll") for (int n = 0; n < 2; ++n) _Pragma("unroll") for (int k = 0; k < 2; ++k) dst[n][k] = *(const PG8_LAS bf16x8*)(lds + PG8_SB(b, h) + boff + n * 2048 + k * 1024); } while (0)
#define PG8_MMA(ai, bj, At, Bt) do { __builtin_amdgcn_s_setprio(1); _Pragma("unroll") for (int m = 0; m < 4; ++m) _Pragma("unroll") for (int n = 0; n < 2; ++n) _Pragma("unroll") for (int k = 0; k < 2; ++k) \
        acc[ai][bj][m][n] = __builtin_amdgcn_mfma_f32_16x16x32_bf16(Bt[n][k], At[m][k], acc[ai][bj][m][n], 0, 0, 0); __builtin_amdgcn_s_setprio(0); } while (0)
#define PG8_WAIT_V(n) asm volatile("s_waitcnt vmcnt(" #n ")" ::: "memory")
#define PG8_WAIT_L(n) asm volatile("s_waitcnt lgkmcnt(" #n ")" ::: "memory")
#define PG8_BAR __builtin_amdgcn_s_barrier()
#define PG8_SCHED __builtin_amdgcn_sched_barrier(0)
    Unit cur, nxt; int ui = 0;
    if (!S.next(0, cur)) return;
    f32x4 acc[2][2][4][2];
#pragma unroll
    for (int a = 0; a < 2; ++a)
#pragma unroll
        for (int b = 0; b < 2; ++b)
#pragma unroll
            for (int m = 0; m < 4; ++m)
#pragma unroll
                for (int n = 0; n < 2; ++n) acc[a][b][m][n] = (f32x4){0.f, 0.f, 0.f, 0.f};
    bf16x8 At[4][2], B0[2][2], B1[2][2];
    const char* cA = (const char*)g.A + (size_t)cur.pm * tstep + (size_t)cur.koff * 2; const char* cB = (const char*)g.Bt + (size_t)cur.pn * tstep + (size_t)cur.koff * 2;
    S.a_ready(cur);
    if constexpr (SP2) {
        PG8_STAGE(PG8_SB(0, 0), cB, voffB); PG8_STAGE(PG8_SB(0, 1), cB + hstep, voffB); PG8_STAGE(PG8_SA(0, 0), cA, voffA); PG8_STAGE(PG8_SA(0, 1), cA + hstep, voffA);
        if (wr == 1) PG8_BAR;
        PG8_WAIT_V(2); PG8_BAR;
        PG8_STAGE(PG8_SB(1, 0), cB + kstep, voffB); PG8_STAGE(PG8_SA(1, 0), cA + kstep, voffA); PG8_STAGE(PG8_SB(1, 1), cB + hstep + kstep, voffB);
        PG8_WAIT_V(6); PG8_BAR;
    } else {
        PG8_STAGE(PG8_SB(0, 0), cB, voffB); PG8_STAGE(PG8_SA(0, 0), cA, voffA); PG8_STAGE(PG8_SB(0, 1), cB + hstep, voffB); PG8_STAGE(PG8_SA(0, 1), cA + hstep, voffA);
        if (wr == 1) PG8_BAR;
        PG8_WAIT_V(4); PG8_BAR;
        PG8_STAGE(PG8_SB(1, 0), cB + kstep, voffB); PG8_STAGE(PG8_SA(1, 0), cA + kstep, voffA); PG8_STAGE(PG8_SB(1, 1), cB + hstep + kstep, voffB);
        PG8_WAIT_V(6); PG8_BAR;
    }
    for (;;) {
        const bool has_next = S.next(ui + 1, nxt);
        const char* nA = has_next ? (const char*)g.A + (size_t)nxt.pm * tstep + (size_t)nxt.koff * 2 : cA; const char* nB = has_next ? (const char*)g.Bt + (size_t)nxt.pn * tstep + (size_t)nxt.koff * 2 : cB;
        for (int t = 0; t < nt; t += 2) {
            const bool last = (t == nt - 2);
            const char* a1 = cA + (size_t)(t + 1) * kstep;
            const char* a2 = last ? nA : cA + (size_t)(t + 2) * kstep; const char* b2 = last ? nB : cB + (size_t)(t + 2) * kstep;
            const char* a3 = a2 + kstep; const char* b3 = b2 + kstep;
            if (last && has_next) S.a_ready(nxt);
            if constexpr (SP2) {
            PG8_LDB(B0, 0, 0); PG8_LDB(B1, 0, 1); PG8_SCHED; PG8_LDA(At, 0, 0); PG8_STAGE(PG8_SA(1, 1), a1 + hstep, voffA);
            PG8_WAIT_V(8); PG8_WAIT_L(0); PG8_BAR; PG8_MMA(0, 0, At, B0); PG8_MMA(0, 1, At, B1); PG8_BAR; PG8_SCHED;
            PG8_LDA(At, 0, 1); PG8_STAGE(PG8_SB(0, 0), b2, voffB); PG8_STAGE(PG8_SB(0, 1), b2 + hstep, voffB); PG8_STAGE(PG8_SA(0, 0), a2, voffA);
            PG8_WAIT_V(8); PG8_WAIT_L(0); PG8_BAR; PG8_MMA(1, 0, At, B0); PG8_MMA(1, 1, At, B1); PG8_BAR; PG8_SCHED;
            PG8_LDB(B0, 1, 0); PG8_LDB(B1, 1, 1); PG8_SCHED; PG8_LDA(At, 1, 0); PG8_STAGE(PG8_SA(0, 1), a2 + hstep, voffA);
            PG8_WAIT_V(8); PG8_WAIT_L(0); PG8_BAR; PG8_MMA(0, 0, At, B0); PG8_MMA(0, 1, At, B1); PG8_BAR; PG8_SCHED;
            PG8_LDA(At, 1, 1); PG8_STAGE(PG8_SB(1, 0), b3, voffB); PG8_STAGE(PG8_SB(1, 1), b3 + hstep, voffB); PG8_STAGE(PG8_SA(1, 0), a3, voffA);
            PG8_WAIT_V(8); PG8_WAIT_L(0); PG8_BAR; PG8_MMA(1, 0, At, B0); PG8_MMA(1, 1, At, B1); PG8_BAR; PG8_SCHED;
            } else {
            PG8_LDB(B0, 0, 0); PG8_SCHED; PG8_LDA(At, 0, 0); PG8_STAGE(PG8_SA(1, 1), a1 + hstep, voffA);
            PG8_WAIT_L(8); PG8_BAR; PG8_WAIT_L(0); PG8_MMA(0, 0, At, B0); PG8_BAR; PG8_SCHED;
            PG8_LDB(B1, 0, 1); PG8_STAGE(PG8_SB(0, 0), b2, voffB);
            PG8_BAR; PG8_WAIT_L(0); PG8_MMA(0, 1, At, B1); PG8_BAR;
            PG8_LDA(At, 0, 1); PG8_STAGE(PG8_SA(0, 0), a2, voffA);
            PG8_BAR; PG8_WAIT_L(0); PG8_MMA(1, 0, At, B0); PG8_BAR; PG8_SCHED;
            PG8_STAGE(PG8_SB(0, 1), b2 + hstep, voffB);
            PG8_WAIT_V(6); PG8_BAR; PG8_MMA(1, 1, At, B1); PG8_BAR;
            PG8_LDB(B0, 1, 0); PG8_SCHED; PG8_LDA(At, 1, 0); PG8_STAGE(PG8_SA(0, 1), a2 + hstep, voffA);
            PG8_WAIT_L(8); PG8_BAR; PG8_WAIT_L(0); PG8_MMA(0, 0, At, B0); PG8_BAR; PG8_SCHED;
            PG8_LDB(B1, 1, 1); PG8_STAGE(PG8_SB(1, 0), b3, voffB);
            PG8_BAR; PG8_WAIT_L(0); PG8_MMA(0, 1, At, B1); PG8_BAR;
            PG8_LDA(At, 1, 1); PG8_STAGE(PG8_SA(1, 0), a3, voffA);
            PG8_BAR; PG8_WAIT_L(0); PG8_MMA(1, 0, At, B0); PG8_BAR; PG8_SCHED;
            PG8_STAGE(PG8_SB(1, 1), b3 + hstep, voffB);
            PG8_WAIT_V(6); PG8_BAR; PG8_MMA(1, 1, At, B1); PG8_BAR;
            }
        }
        if constexpr (ALIGN_EPI) { if (wr == 0) PG8_BAR; }
        if constexpr (!Epi::AFTER_DRAIN) { E(acc, cur, wr, wc, fr, fq); S.done(cur); }
        if (!has_next) break;
#pragma unroll
        for (int a = 0; a < 2; ++a)
#pragma unroll
            for (int b = 0; b < 2; ++b)
#pragma unroll
                for (int m = 0; m < 4; ++m)
#pragma unroll
                    for (int n = 0; n < 2; ++n) acc[a][b][m][n] = (f32x4){0.f, 0.f, 0.f, 0.f};
        cur = nxt; cA = nA; cB = nB; ++ui;
        if constexpr (ALIGN_EPI) { if (wr == 1) PG8_BAR; }
    }
    PG8_WAIT_V(0);
    if constexpr (!ALIGN_EPI) { if (wr == 0) PG8_BAR; }
    PG8_BAR;
    if constexpr (Epi::AFTER_DRAIN) { E.fused(acc, cur, wr, wc, fr, fq, lds, wid, lane); S.done(cur); }
#undef PG8_SA
#undef PG8_SB
#undef PG8_STAGE
#undef PG8_LDA
#undef PG8_LDB
#undef PG8_MMA
#undef PG8_WAIT_V
#undef PG8_WAIT_L
#undef PG8_BAR
#undef PG8_SCHED
}

template <class Epi, class Sched>
__device__ __forceinline__ void naive_phase(const Gemm g, const Sched& S, const Epi& E) {
    int tid = threadIdx.x; asm volatile("" : "+v"(tid));
    const int wid = __builtin_amdgcn_readfirstlane(tid >> 6), lane = tid & 63, wr = wid >> 2, wc = wid & 3, fr = lane & 15, fq = lane >> 4;
    Unit u;
#pragma unroll 1
    for (int ui = 0; S.next(ui, u); ++ui) {
        f32x4 acc[2][2][4][2];
#pragma unroll
        for (int ai = 0; ai < 2; ++ai)
#pragma unroll
            for (int m = 0; m < 4; ++m) {
                const bf16_t* arow = g.A + (size_t)(u.pm * BM + ai * HALF + wr * 64 + m * 16 + fr) * g.Kp;
#pragma unroll
                for (int bj = 0; bj < 2; ++bj)
#pragma unroll
                    for (int n = 0; n < 2; ++n)
#pragma unroll
                        for (int i = 0; i < 4; ++i) {
                            const bf16_t* brow = g.Bt + (size_t)(u.pn * BM + bj * HALF + wc * 32 + 8 * fq + 4 * n + i) * g.Kp;
                            float s = 0.f;
#pragma unroll 1
                            for (int k = 0; k < g.K; k += 8) { const u32x4 a = *(const u32x4*)(arow + k), b = *(const u32x4*)(brow + k);
                                s += bf_lo(a.x) * bf_lo(b.x) + bf_hi(a.x) * bf_hi(b.x) + bf_lo(a.y) * bf_lo(b.y) + bf_hi(a.y) * bf_hi(b.y)
                                   + bf_lo(a.z) * bf_lo(b.z) + bf_hi(a.z) * bf_hi(b.z) + bf_lo(a.w) * bf_lo(b.w) + bf_hi(a.w) * bf_hi(b.w); }
                            acc[ai][bj][m][n][i] = s;
                        }
            }
        E(acc, u, wr, wc, fr, fq);
    }
    __syncthreads();
}
}
#include <hip/hip_bf16.h>
#include <cmath>
namespace attn_body {
using bf16=__hip_bfloat16;
using bf16x8=__attribute__((ext_vector_type(8)))short;
using s16x4=__attribute__((ext_vector_type(4)))short;
using f32x16=__attribute__((ext_vector_type(16)))float;
using u32x4=__attribute__((ext_vector_type(4)))unsigned;
using f32x4_t=__attribute__((ext_vector_type(4)))float;
constexpr int BATCH=2,NHEAD=8,SEQ=16384,D=64,DM=NHEAD*D;
constexpr int NW=8,QBLK=32,QB=QBLK*NW,KVBLK=64,NQB=SEQ/QB;
constexpr int ATTN_PITCH=DM, ATTN_UNIT_ROWS=QB;
__device__ __forceinline__ int crow(int r,int hi){return (r&3)+8*(r>>2)+4*hi;}
#define SBAR() __builtin_amdgcn_sched_barrier(0)
__device__ __forceinline__ void cmask(f32x16&p0,f32x16&p1,int jb,int qrel,int hi){
  const float NEG=-INFINITY; int kb=64*jb+4*hi;
  #pragma unroll
  for(int r=0;r<16;++r){int kv=kb+(r&3)+8*(r>>2); if(kv>qrel)p0[r]=NEG; if(kv+32>qrel)p1[r]=NEG;}
}

constexpr int NSLOT=3, SLOTB=8192;
constexpr int LDS_K=0, LDS_V=NSLOT*SLOTB, LDS_WS=2*NSLOT*SLOTB, LDS_OST=LDS_WS+NW*64*4, LDS_BYTES=LDS_OST+NW*4096, LDS_BIAS=LDS_BYTES, LDS_TOTAL=LDS_BIAS+SEQ*4;
constexpr float C2=0.125f*1.4426950408889634f;
__device__ __forceinline__ void glds16(const void*gsrc,unsigned lds_dst){unsigned keep;
  asm volatile("s_mov_b32 %0, m0\n\ts_mov_b32 m0, %2\n\ts_nop 0\n\tglobal_load_lds_dwordx4 %1, off\n\ts_mov_b32 m0, %0":"=&s"(keep):"v"(gsrc),"s"(lds_dst):"memory");}
__device__ __forceinline__ float max3f(float a,float b,float c){float r;asm("v_max3_f32 %0, %1, %2, %3":"=v"(r):"v"(a),"v"(b),"v"(c));return r;}
__device__ __forceinline__ float max2f(float a,float b){float r;asm("v_max_f32_e32 %0, %1, %2":"=v"(r):"v"(a),"v"(b));return r;}
__device__ __forceinline__ float fadd_s(float a,float b){float r;asm("v_add_f32_e32 %0, %1, %2":"=v"(r):"v"(a),"v"(b));return r;}
__device__ __forceinline__ float fsub_s(float a,float b){float r;asm("v_sub_f32_e32 %0, %1, %2":"=v"(r):"v"(a),"v"(b));return r;}
typedef float f32x2_t __attribute__((ext_vector_type(2))); typedef __bf16 bf16x2_t __attribute__((ext_vector_type(2)));
__device__ __forceinline__ unsigned cvtpk_s(float lo,float hi){f32x2_t v={lo,hi};bf16x2_t b=__builtin_convertvector(v,bf16x2_t);return __builtin_bit_cast(unsigned,b);}
#define WAIT_BAR(N) asm volatile("s_waitcnt vmcnt(" #N ") lgkmcnt(0)\n\ts_barrier":::"memory")

__device__ __forceinline__ void qkt(f32x16&p0,f32x16&p1,const char*Kslot,const bf16x8*qr,int r32,int hi){
  const char*kb=Kslot+hi*1024+r32*16;
  #pragma unroll
  for(int d0=0;d0<4;++d0){
    const bf16x8 b0=*reinterpret_cast<const bf16x8*>(kb+d0*2048);
    const bf16x8 b1=*reinterpret_cast<const bf16x8*>(kb+d0*2048+512);
    p0=__builtin_amdgcn_mfma_f32_32x32x16_bf16(b0,qr[d0],p0,0,0,0);p1=__builtin_amdgcn_mfma_f32_32x32x16_bf16(b1,qr[d0],p1,0,0,0);}
}
typedef __attribute__((address_space(3))) const char* lds_cptr;
typedef short v4i16_t __attribute__((ext_vector_type(4)));
__device__ __forceinline__ void kload8(bf16x8*kf,lds_cptr kp){
  kf[0]=*(const __attribute__((address_space(3))) bf16x8*)(kp);      kf[1]=*(const __attribute__((address_space(3))) bf16x8*)(kp+512);
  kf[2]=*(const __attribute__((address_space(3))) bf16x8*)(kp+2048); kf[3]=*(const __attribute__((address_space(3))) bf16x8*)(kp+2560);
  kf[4]=*(const __attribute__((address_space(3))) bf16x8*)(kp+4096); kf[5]=*(const __attribute__((address_space(3))) bf16x8*)(kp+4608);
  kf[6]=*(const __attribute__((address_space(3))) bf16x8*)(kp+6144); kf[7]=*(const __attribute__((address_space(3))) bf16x8*)(kp+6656);
}
__device__ __forceinline__ void kload2(bf16x8*kf,lds_cptr kp,int j){ kf[2*j]=*(const __attribute__((address_space(3))) bf16x8*)(kp+j*2048); kf[2*j+1]=*(const __attribute__((address_space(3))) bf16x8*)(kp+j*2048+512); }
__device__ __forceinline__ s16x4 vtr(lds_cptr p){ return __builtin_bit_cast(s16x4,__builtin_amdgcn_ds_read_tr16_b64_v4i16((__attribute__((address_space(3))) v4i16_t*)p)); }
__device__ __forceinline__ float rowmax(const f32x16&p0,const f32x16&p1){
  float a=max3f(p0[0],p0[1],p1[0]),b=max3f(p0[2],p0[3],p1[1]);a=max3f(a,p1[2],p1[3]);
  #pragma unroll
  for(int r=4;r<16;r+=4){a=max3f(a,p0[r],p0[r+1]);b=max3f(b,p0[r+2],p0[r+3]);a=max3f(a,p1[r],p1[r+1]);b=max3f(b,p1[r+2],p1[r+3]);}
  const float m=max2f(a,b);
  auto rr=__builtin_amdgcn_permlane32_swap(__float_as_uint(m),__float_as_uint(m),false,false);
  return max2f(__uint_as_float(rr[0]),__uint_as_float(rr[1]));
}
__device__ __forceinline__ void pv(f32x16*o,int vb,bf16x8 pa0,bf16x8 pa1,bf16x8 pa2,bf16x8 pa3){
  #pragma unroll
  for(int d0=0;d0<2;++d0){s16x4 lo[4],hi[4];
    #pragma unroll
    for(int ks=0;ks<4;++ks){
      asm volatile("ds_read_b64_tr_b16 %0,%1 offset:%c2":"=&v"(lo[ks]):"v"(vb),"i"(d0*4096+ks*1024):"memory");
      asm volatile("ds_read_b64_tr_b16 %0,%1 offset:%c2":"=&v"(hi[ks]):"v"(vb),"i"(d0*4096+ks*1024+512):"memory");}
    asm volatile("s_waitcnt lgkmcnt(0)":::"memory");SBAR();
    #define PK(k) (bf16x8){lo[k][0],lo[k][1],lo[k][2],lo[k][3],hi[k][0],hi[k][1],hi[k][2],hi[k][3]}
    o[d0]=__builtin_amdgcn_mfma_f32_32x32x16_bf16(pa0,PK(0),o[d0],0,0,0);
    o[d0]=__builtin_amdgcn_mfma_f32_32x32x16_bf16(pa1,PK(1),o[d0],0,0,0);
    o[d0]=__builtin_amdgcn_mfma_f32_32x32x16_bf16(pa2,PK(2),o[d0],0,0,0);
    o[d0]=__builtin_amdgcn_mfma_f32_32x32x16_bf16(pa3,PK(3),o[d0],0,0,0);
    #undef PK
  }
}

#ifndef ATTN_STORE16
#define ATTN_STORE16(p,v) (*(u32x4*)(p)=(v))
#endif
template<int THRL> __device__ __forceinline__ void attn_unit(int b,int h,int qb,int ts,const float*__restrict__ cl2,const bf16*Q,const bf16*__restrict__ K,const bf16*__restrict__ V,bf16*O,char*shm,int wv){
  int tid=(wv<<6)|lane_id_(); asm volatile("":"+v"(tid)); const int lane=tid&63,r32=lane&31,hi=lane>>5; const int wid=__builtin_amdgcn_readfirstlane(tid>>6);
  const long rowbase=(long)b*SEQ; const int q0=qb*QB;
  const bf16*Qw=Q+(rowbase+q0+wid*QBLK)*DM+h*D;
  const bf16*Kh=K+(rowbase+(long)ts*KVBLK)*DM+h*D,*Vh=V+(rowbase+(long)ts*KVBLK)*DM+h*D;
  const unsigned lds0=(unsigned)(uintptr_t)shm;
  float*wsf=(float*)(shm+LDS_WS)+wid*64;
  const bf16*ksrc=Kh+(long)lane*DM+wid*8;
  const bf16*vsrc=Vh+(long)(16*(wid&3)+(lane>>2))*DM+(wid>>2)*32+(lane&3)*8;
  const unsigned kdst=lds0+LDS_K+wid*1024, vdst=lds0+LDS_V+wid*1024;
  #define DMA_K(t,slot) glds16(ksrc+(long)(t)*KVBLK*DM,(unsigned)__builtin_amdgcn_readfirstlane(kdst+(slot)))
  #define DMA_V(t,slot) glds16(vsrc+(long)(t)*KVBLK*DM,(unsigned)__builtin_amdgcn_readfirstlane(vdst+(slot)))
  const int vb0=(int)(lds0+LDS_V)+((lane>>4)&1)*32+(lane&3)*8+(4*hi+((lane&15)>>2))*64;
  const char*Kbase=shm+LDS_K; bf16x8 kf[8];
  const lds_cptr shm3=(lds_cptr)shm; const lds_cptr kp0=shm3+LDS_K+hi*1024+r32*16; const lds_cptr vp0=shm3+LDS_V+((lane>>4)&1)*32+(lane&3)*8+(4*hi+((lane&15)>>2))*64;
  const int NT=(q0+QB)/KVBLK-ts;
  DMA_K(0,0);DMA_V(0,0);DMA_K(1,SLOTB);
  bf16x8 qr[4];
  #pragma unroll
  for(int d0=0;d0<4;++d0)qr[d0]=*reinterpret_cast<const bf16x8*>(&Qw[(long)r32*DM+d0*16+hi*8]);
  float mhat=0.f,l_reg=0.f;f32x16 o[2];o[0]=f32x16{};o[1]=f32x16{};
  typedef __attribute__((address_space(3))) const f32x4_t* lds_f4p; const lds_f4p biasp=(lds_f4p)((lds_cptr)shm+LDS_BIAS)+hi;
  #define BIASINIT(C0,C1,t) do{ _Pragma("unroll") for(int g_=0;g_<4;++g_){ const f32x4_t b0_=biasp[(t)*16+2*g_], b1_=biasp[(t)*16+8+2*g_]; \
      _Pragma("unroll") for(int i_=0;i_<4;++i_){ C0[4*g_+i_]=b0_[i_]-mhat; C1[4*g_+i_]=b1_[i_]-mhat; } } }while(0)
  const int qrel=wid*QBLK+r32;
  #define CMASK(P0,P1,t) do{int jb_=(t)-(NT-4); if(jb_>=0)cmask(P0,P1,jb_,qrel,hi);}while(0)
  bool resc=false;
  #define START(P0,P1) do{ const float rm=rowmax(P0,P1); resc=false; \
    { const float dl=rm; mhat=fadd_s(mhat,dl); \
      _Pragma("unroll") for(int r=0;r<16;++r){P0[r]=fsub_s(P0[r],dl);P1[r]=fsub_s(P1[r],dl);} } \
    _Pragma("unroll") for(int r=0;r<16;++r)P0[r]=__builtin_amdgcn_exp2f(P0[r]); }while(0)
  #define RESC() do{ if(resc){ asm volatile("s_waitcnt lgkmcnt(0)":::"memory"); \
      _Pragma("unroll") for(int d_=0;d_<2;++d_) _Pragma("unroll") for(int r=0;r<16;++r)o[d_][r]*=wsf[crow(r,hi)]; } }while(0)
  f32x16 pA0,pA1,pB0,pB1;
  int sl_prev=0,sl_cur=0,sl_next=SLOTB;
  #define ROT() do{sl_prev=sl_cur;sl_cur=sl_next;sl_next=(sl_next==(NSLOT-1)*SLOTB)?0:sl_next+SLOTB;}while(0)
  {
    const float cref=cl2[q0]; const f32x4_t*src=(const f32x4_t*)(cl2+ts*KVBLK); __attribute__((address_space(3))) f32x4_t*dst=(__attribute__((address_space(3))) f32x4_t*)((__attribute__((address_space(3))) char*)shm+LDS_BIAS);
    for(int i=tid;i<NT*16;i+=NW*64){ const f32x4_t c4=src[i]; dst[i]=(f32x4_t){cref-c4[0],cref-c4[1],cref-c4[2],cref-c4[3]}; } }
  DMA_K(2,2*SLOTB);
  WAIT_BAR(3);
  BIASINIT(pA0,pA1,0); qkt(pA0,pA1,Kbase,qr,r32,hi);asm volatile("s_nop 15\n\ts_nop 7":"+v"(pA0),"+v"(pA1));CMASK(pA0,pA1,0);
  START(pA0,pA1);
  _Pragma("unroll") for(int r=0;r<16;++r)pA1[r]=__builtin_amdgcn_exp2f(pA1[r]);
  WAIT_BAR(0);
  DMA_K(3,0);DMA_V(1,SLOTB);
  ROT();
  kload8(kf,kp0+sl_cur);
  WAIT_BAR(2);
  s16x4 vlo[8],vhi[8]; u32x4 pw0,pw1,pw2,pw3;
  #define PKW(P,B) cvtpk_s(P[B],P[B+1])
  #define PAF(k) __builtin_bit_cast(bf16x8,pw##k)
  #define VFR(i) (bf16x8){vlo[i][0],vlo[i][1],vlo[i][2],vlo[i][3],vhi[i][0],vhi[i][1],vhi[i][2],vhi[i][3]}
  #define PIN(x) asm volatile("":"+v"(x))
  #define MX3(a,b,c) __builtin_fmaxf(__builtin_fmaxf((a),(b)),(c))
  #define GAPA(MF,A0,A1,A2,A3,W0,W1,PW) do{ MF; sacc+=A0; sacc+=A1; sacc+=A2; sacc+=A3; PIN(sacc); W0; W1; PIN(PW); SBAR(); }while(0)
  #define EX(v) __builtin_amdgcn_exp2f(v)
  #define GAPB(MF,X,B) do{ MF; X[B]=EX(X[B]); X[B+1]=EX(X[B+1]); X[B+2]=EX(X[B+2]); X[B+3]=EX(X[B+3]); PIN(X); SBAR(); }while(0)
  #define VRD(i) do{ vlo[i]=vtr(vp_+(((i)>>2)*4096+((i)&3)*1024)); vhi[i]=vtr(vp_+(((i)>>2)*4096+((i)&3)*1024+512)); }while(0)
  #define KRD(G,j) do{ if(G){ kload2(kf,kp0+sl_next,j); SBAR(); } }while(0)
  #define STEP(C0,C1,P0,P1,t,GK,GV,GL) do{ SBAR(); BIASINIT(C0,C1,t); SBAR(); \
    const lds_cptr vp_=vp0+sl_prev; \
    VRD(0); SBAR(); float sacc=(P0[0]+P0[1]); \
    GAPA(C0=__builtin_amdgcn_mfma_f32_32x32x16_bf16(kf[0],qr[0],C0,0,0,0), P0[2],P0[3],P0[4],P0[5],     pw0[0]=PKW(P0,0), pw0[1]=PKW(P0,2), pw0); \
    VRD(4); SBAR(); GAPA(C1=__builtin_amdgcn_mfma_f32_32x32x16_bf16(kf[1],qr[0],C1,0,0,0), P0[6],P0[7],P0[8],P0[9],     pw0[2]=PKW(P0,4), pw0[3]=PKW(P0,6), pw0); \
    VRD(1); SBAR(); GAPA(C0=__builtin_amdgcn_mfma_f32_32x32x16_bf16(kf[2],qr[1],C0,0,0,0),   P0[10],P0[11],P0[12],P0[13], pw1[0]=PKW(P0,8), pw1[1]=PKW(P0,10), pw1); \
    VRD(5); SBAR(); GAPA(C1=__builtin_amdgcn_mfma_f32_32x32x16_bf16(kf[3],qr[1],C1,0,0,0),   P0[14],P0[15],P1[0],P1[1],   pw1[2]=PKW(P0,12),pw1[3]=PKW(P0,14), pw1); \
    VRD(2); SBAR(); GAPA(C0=__builtin_amdgcn_mfma_f32_32x32x16_bf16(kf[4],qr[2],C0,0,0,0),   P1[2],P1[3],P1[4],P1[5],     pw2[0]=PKW(P1,0), pw2[1]=PKW(P1,2), pw2); \
    VRD(6); SBAR(); GAPA(C1=__builtin_amdgcn_mfma_f32_32x32x16_bf16(kf[5],qr[2],C1,0,0,0),   P1[6],P1[7],P1[8],P1[9],     pw2[2]=PKW(P1,4), pw2[3]=PKW(P1,6), pw2); \
    VRD(3); SBAR(); GAPA(C0=__builtin_amdgcn_mfma_f32_32x32x16_bf16(kf[6],qr[3],C0,0,0,0),   P1[10],P1[11],P1[12],P1[13], pw3[0]=PKW(P1,8), pw3[1]=PKW(P1,10), pw3); \
    VRD(7); SBAR(); GAPA(C1=__builtin_amdgcn_mfma_f32_32x32x16_bf16(kf[7],qr[3],C1,0,0,0),   P1[14],P1[15],0.f,0.f,       pw3[2]=PKW(P1,12),pw3[3]=PKW(P1,14), pw3); \
    l_reg+=sacc; \
    if(GK){DMA_K((t)+3,sl_cur);} if(GV){DMA_V((t)+1,sl_next);} \
    CMASK(C0,C1,t); \
    { float a=MX3(C0[0],C0[1],C1[0]),b=MX3(C0[2],C0[3],C1[1]); a=MX3(a,C1[2],C1[3]); \
      _Pragma("unroll") for(int r=4;r<16;r+=4){a=MX3(a,C0[r],C0[r+1]);b=MX3(b,C0[r+2],C0[r+3]);a=MX3(a,C1[r],C1[r+1]);b=MX3(b,C1[r+2],C1[r+3]);} \
      float rm=__builtin_fmaxf(a,b); { auto rr=__builtin_amdgcn_permlane32_swap(__float_as_uint(rm),__float_as_uint(rm),false,false); rm=__builtin_fmaxf(__uint_as_float(rr[0]),__uint_as_float(rr[1])); } \
      resc=false; \
      if(__builtin_expect(__any(rm>(float)THRL),0)){ const float dl=__builtin_fmaxf(rm,0.f); mhat+=dl; \
        _Pragma("unroll") for(int r=0;r<16;++r){C0[r]-=dl;C1[r]-=dl;} \
        const float f=__builtin_amdgcn_exp2f(-dl); l_reg*=f; if(hi==0)wsf[r32]=f; resc=true; } } \
    SBAR(); \
    GAPB(o[0]=__builtin_amdgcn_mfma_f32_32x32x16_bf16(PAF(0),VFR(0),o[0],0,0,0), C0,0); \
    GAPB(o[1]=__builtin_amdgcn_mfma_f32_32x32x16_bf16(PAF(0),VFR(4),o[1],0,0,0), C0,4); \
    KRD(GL,0); GAPB(o[0]=__builtin_amdgcn_mfma_f32_32x32x16_bf16(PAF(1),VFR(1),o[0],0,0,0), C0,8); \
    KRD(GL,1); GAPB(o[1]=__builtin_amdgcn_mfma_f32_32x32x16_bf16(PAF(1),VFR(5),o[1],0,0,0), C0,12); \
    KRD(GL,2); GAPB(o[0]=__builtin_amdgcn_mfma_f32_32x32x16_bf16(PAF(2),VFR(2),o[0],0,0,0), C1,0); \
    KRD(GL,3); GAPB(o[1]=__builtin_amdgcn_mfma_f32_32x32x16_bf16(PAF(2),VFR(6),o[1],0,0,0), C1,4); \
    GAPB(o[0]=__builtin_amdgcn_mfma_f32_32x32x16_bf16(PAF(3),VFR(3),o[0],0,0,0), C1,8); \
    GAPB(o[1]=__builtin_amdgcn_mfma_f32_32x32x16_bf16(PAF(3),VFR(7),o[1],0,0,0), C1,12); \
    }while(0)
  int t=1;
  #undef CMASK
  #define CMASK(P0,P1,t) do{}while(0)
  for(;t+5<NT;t+=2){
    STEP(pB0,pB1,pA0,pA1,t,true,true,true);     WAIT_BAR(2); RESC(); ROT();
    STEP(pA0,pA1,pB0,pB1,t+1,true,true,true);   WAIT_BAR(2); RESC(); ROT();
  }
  #undef CMASK
  #define CMASK(P0,P1,t) do{int jb_=(t)-(NT-4); if(jb_>=0)cmask(P0,P1,jb_,qrel,hi);}while(0)
  #define ENDW(tt) do{ if((tt)+3<NT){WAIT_BAR(2);} else if((tt)+2<NT){WAIT_BAR(1);} else {WAIT_BAR(0);} }while(0)
  for(;t+1<NT;t+=2){
    STEP(pB0,pB1,pA0,pA1,t,(t+3<NT),(t+1<NT),(t+1<NT));       ENDW(t);   RESC(); ROT();
    STEP(pA0,pA1,pB0,pB1,t+1,(t+4<NT),(t+2<NT),(t+2<NT));     ENDW(t+1); RESC(); ROT();
  }
  STEP(pB0,pB1,pA0,pA1,NT-1,false,false,false); RESC();
  { float sacc=pB0[0]+pB0[1]; _Pragma("unroll") for(int r=2;r<16;++r)sacc+=pB0[r]; _Pragma("unroll") for(int r=0;r<16;++r)sacc+=pB1[r]; l_reg+=sacc;
    pw0=(u32x4){PKW(pB0,0),PKW(pB0,2),PKW(pB0,4),PKW(pB0,6)};pw1=(u32x4){PKW(pB0,8),PKW(pB0,10),PKW(pB0,12),PKW(pB0,14)};pw2=(u32x4){PKW(pB1,0),PKW(pB1,2),PKW(pB1,4),PKW(pB1,6)};pw3=(u32x4){PKW(pB1,8),PKW(pB1,10),PKW(pB1,12),PKW(pB1,14)};
    SBAR(); pv(o,vb0+sl_cur,PAF(0),PAF(1),PAF(2),PAF(3)); }
  #undef PKW
  #undef PAF
  #undef VFR
  #undef PIN
  #undef MX3
  #undef GAPA
  #undef GAPB
  #undef EX
  #undef VRD
  #undef KRD
  #undef STEP
  #undef ENDW
  {auto rr=__builtin_amdgcn_permlane32_swap(__float_as_uint(l_reg),__float_as_uint(l_reg),false,false);l_reg=__uint_as_float(rr[0])+__uint_as_float(rr[1]);}
  if(hi==0)wsf[32+r32]=l_reg;asm volatile("s_waitcnt lgkmcnt(0)":::"memory");
  float rli[16];
  #pragma unroll
  for(int r=0;r<16;++r)rli[r]=__builtin_amdgcn_rcpf(wsf[32+crow(r,hi)]);
  bf16*Ow=O+(rowbase+q0+wid*QBLK)*DM+h*D;
  { bf16*stg=(bf16*)(shm+LDS_OST)+wid*2048;
    #pragma unroll
    for(int r=0;r<16;++r){const int orow=crow(r,hi);
      #pragma unroll
      for(int d0=0;d0<2;++d0)stg[orow*64+d0*32+r32]=__float2bfloat16(o[d0][r]*rli[r]);}
    asm volatile("s_waitcnt lgkmcnt(0)":::"memory");
    #pragma unroll
    for(int i=0;i<4;++i){const int row=i*8+(lane>>3),ch=lane&7; const u32x4 v=*(const u32x4*)(stg+row*64+ch*8); ATTN_STORE16(Ow+(long)row*DM+ch*8,v);} }
  asm volatile("s_waitcnt lgkmcnt(0)\n\ts_barrier":::"memory");
  #undef DMA_K
  #undef DMA_V
  #undef CMASK
  #undef BIASINIT
  #undef START
  #undef RESC
  #undef ROT
}
constexpr int ATTN_LDS_BYTES=LDS_BYTES;
struct AttnTensors { const bf16* Q; const bf16* K; const bf16* V; bf16* O; const float* cl2; };
#undef SBAR
#undef WAIT_BAR
}
#define GEMM_PHASE(...) pg8::gemm_phase<__VA_ARGS__, pg8::StaticOrder, PGA, PGS>(ldsl, g, S, E, wave)
#define GEMM_PHASE_SPLIT() pg8::gemm_phase<pg8::EpiPartial, pg8::SplitOrder, PGA, PGS>(ldsl, g2, S2, E2, wave)
#define GEMM_PHASE_SPLIT_T(NN, NS, KSUB, KSH) pg8::gemm_phase<pg8::EpiPartialT<NN, KSH>, pg8::SplitOrderT<NN, NS, KSUB>, PGA, PGS>(ldsl, g2, S2, E2, wave)
#ifndef PGA
#define PGA true
#endif
#ifndef PGS
#define PGS true
#endif
namespace cg = cooperative_groups;
#define LAS __attribute__((address_space(3)))
typedef unsigned short bf16;
typedef unsigned v4u __attribute__((ext_vector_type(4)));
typedef float f32x4 __attribute__((ext_vector_type(4)));
typedef short bf16x8 __attribute__((ext_vector_type(8)));
typedef float f32x16 __attribute__((ext_vector_type(16)));
constexpr int NWAVES = 8, NTHR = 512, NMODC_ = 9216;
constexpr int MP = 32768, MS = 256, M = MP + MS, DM = 1024, FF = 2816, WA = 512, NIN = 4608, INCOLS = 4616, SEQ = 16384, PAST = 1024, DSEQ = 32, SKEYS = PAST + DSEQ;
constexpr float EPS = 1e-6f, LOG2E = 1.4426950408889634f;
constexpr size_t MiB = 1u << 20;
constexpr size_t WS_CTL = 0, CTL_ZERO_BYTES = 65536;
constexpr size_t WS_MOD = 1 * MiB, WS_CUMP = 2 * MiB, WS_CUMS = 3 * MiB, WS_G2SS = 4 * MiB, WS_QS = 6 * MiB, WS_WSP = 7 * MiB;
constexpr size_t WS_WGU1 = 8 * MiB, WS_WD1 = 19 * MiB, WS_WIN = 25 * MiB, WS_WPA = 34 * MiB, WS_WPB = 35 * MiB, WS_WOUT = 36 * MiB, WS_WGU2 = 38 * MiB, WS_WD2 = 49 * MiB;
constexpr size_t WS_XN = 56 * MiB;
constexpr size_t WS_ACT = 121 * MiB;
constexpr size_t QKV_B = (size_t)M * 512 * 2;
constexpr size_t WS_Q = 121 * MiB, WS_K = WS_Q + QKV_B, WS_V = WS_K + QKV_B, WS_U = WS_V + QKV_B, WS_G2 = WS_U + QKV_B;
constexpr size_t WS_AO = WS_Q;
constexpr size_t WS_T1 = WS_U;
constexpr size_t WS_T2 = WS_K;
constexpr size_t WS_BO = 283 * MiB, WS_PART = 300 * MiB, WS_END = 316 * MiB;
static_assert(WS_XN + (size_t)M * 2048 <= WS_ACT && WS_G2 + QKV_B <= WS_BO && WS_BO + QKV_B <= WS_END && WS_ACT + (size_t)M * FF * 2 <= WS_END, "ws map");
constexpr size_t O_Y = 0, O_KP = (size_t)M * 1024, O_VP = O_KP + (size_t)MP * 512, O_FP = O_VP + (size_t)MP * 512, O_KS = O_FP + (size_t)MP * 8, O_VS = O_KS + (size_t)MS * 512,
                 O_FS = O_VS + (size_t)MS * 512, O_GS = O_FS + (size_t)MS * 8, O_END = O_GS + (size_t)MS * 512;
constexpr int LDS_BYTES = 155648, MISC_OFF = LDS_BYTES - 256;
static_assert(attn_body::LDS_TOTAL <= MISC_OFF && pg8::STAGE_BYTES <= LDS_BYTES, "LDS map");

struct Args { const float* in[28]; float* out; unsigned char* ws; };

__device__ __forceinline__ float wave_sum(float v) {
#pragma unroll
    for (int o = 1; o < 64; o <<= 1) v += __shfl_xor(v, o);
    return v;
}
__device__ __forceinline__ unsigned f2bf(float f) { unsigned u = __builtin_bit_cast(unsigned, f); return (u + 0x7fffu + ((u >> 16) & 1u)) >> 16; }
__device__ __forceinline__ unsigned pk2(float lo, float hi) { return f2bf(lo) | (f2bf(hi) << 16); }
__device__ __forceinline__ float bf2f(unsigned short h) { return __uint_as_float((unsigned)h << 16); }

__device__ __forceinline__ void ada_unit(const Args& a, unsigned char* lds, int cb, int tid) {
    asm volatile("" : "+v"(tid));
    float* SC = (float*)lds; float* RED = (float*)(lds + 40960);
    const float* cp = a.in[2]; const float* cs = a.in[3]; const float* w_ada = a.in[7]; const float* b_ada = a.in[8];
    float* MOD = (float*)(a.ws + WS_MOD);
    for (int i = tid; i < 10240; i += NTHR) { const int r = i >> 10, k = i & 1023; const float c = r < 2 ? cp[r * 1024 + k] : cs[(r - 2) * 1024 + k]; SC[i] = c / (1.0f + expf(-c)); }
    __syncthreads();
    if (tid < 504) {
        const int cgp = tid % 9, ks = tid / 9; f32x4 acc[10];
#pragma unroll
        for (int r = 0; r < 10; ++r) acc[r] = (f32x4){0.f, 0.f, 0.f, 0.f};
        for (int k = ks; k < 1024; k += 56) { const f32x4 w = *(const f32x4*)(w_ada + (size_t)k * NMODC_ + 36 * cb + 4 * cgp);
#pragma unroll
            for (int r = 0; r < 10; ++r) acc[r] += w * SC[r * 1024 + k]; }
#pragma unroll
        for (int r = 0; r < 10; ++r) *(f32x4*)(RED + (size_t)tid * 40 + r * 4) = acc[r];
    }
    __syncthreads();
    if (tid < 360) { const int r = tid / 36, c = tid % 36, cgp = c >> 2, i = c & 3; float s = 0.f;
        for (int ks = 0; ks < 56; ++ks) s += RED[(ks * 9 + cgp) * 40 + r * 4 + i];
        MOD[r * NMODC_ + 36 * cb + c] = s + b_ada[36 * cb + c]; }
    __syncthreads();
}
__device__ __forceinline__ void transpose_item(const float* W, int ld, int c0, int K, bf16* WT, int drow0, int k0, float* scr, int lane) {
#pragma unroll 8
    for (int i = 0; i < 32; ++i) { const int kk = 2 * i + (lane >> 5); scr[kk * 33 + (lane & 31)] = W[(size_t)(k0 + kk) * ld + c0 + (lane & 31)]; }
    asm volatile("s_waitcnt lgkmcnt(0)" ::: "memory");
    const int c = lane & 7;
#pragma unroll
    for (int j = 0; j < 4; ++j) { const int n = (lane >> 3) + 8 * j; const float* s = scr + (8 * c) * 33 + n;
        v4u o; o.x = pk2(s[0 * 33], s[1 * 33]); o.y = pk2(s[2 * 33], s[3 * 33]); o.z = pk2(s[4 * 33], s[5 * 33]); o.w = pk2(s[6 * 33], s[7 * 33]);
        *(v4u*)(WT + (size_t)(drow0 + n) * K + k0 + 8 * c) = o; }
    asm volatile("s_waitcnt lgkmcnt(0)" ::: "memory");
}
struct Seg { int in, ld, c0, ncols, K; size_t dst; int drow, mode; };
__device__ const Seg SEGS[13] = {
        {10, FF, 0, FF, 1024, WS_WGU1, 0, 1}, {11, FF, 0, FF, 1024, WS_WGU1, 0, 2}, {12, 1024, 0, 1024, FF, WS_WD1, 0, 0},
        {14, INCOLS, 0, 512, 1024, WS_WIN, 0, 3}, {14, INCOLS, 512, 512, 1024, WS_WIN, 512, 3}, {14, INCOLS, 1024, 512, 1024, WS_WIN, 1024, 0}, {14, INCOLS, 1544, 3072, 1024, WS_WIN, 1536, 0},
        {21, 1024, 0, 1024, 512, WS_WPA, 0, 0}, {22, 1024, 0, 1024, 512, WS_WPB, 0, 0}, {23, 1024, 0, 1024, 1024, WS_WOUT, 0, 0},
        {25, FF, 0, FF, 1024, WS_WGU2, 0, 1}, {26, FF, 0, FF, 1024, WS_WGU2, 0, 2}, {27, 1024, 0, 1024, FF, WS_WD2, 0, 0}};
__device__ __forceinline__ int seg_drow(const Seg& s, int n) {
    if (s.mode == 0) return s.drow + n;
    if (s.mode == 1) return s.drow + 256 * (n >> 7) + (n & 127);
    if (s.mode == 2) return s.drow + 256 * (n >> 7) + 128 + (n & 127);
    const int gs = (n & 255) >> 5; return s.drow + (n & ~255) + 32 * (4 * (gs & 1) + (gs >> 1));
}
__device__ __forceinline__ void p0_weights(const Args& a, unsigned char* lds, int gw, int NGW, int wave, int lane) {
    asm volatile("" : "+v"(lane));
    float* scr = (float*)(lds + wave * 8704);

    int base = 0;
#pragma unroll 1
    for (int si = 0; si < 13; ++si) {
        const Seg s = SEGS[si]; const int nblk = s.ncols / 32, nitems = (s.K / 64) * nblk;
        int first = (gw - base) % NGW; if (first < 0) first += NGW;
        for (int it = first; it < nitems; it += NGW) { const int kb = it / nblk, nb = it % nblk;
            transpose_item(a.in[s.in], s.ld, s.c0 + 32 * nb, s.K, (bf16*)(a.ws + s.dst), seg_drow(s, 32 * nb), 64 * kb, scr, lane); }
        base = (base + nitems) % NGW;
    }
    const float* wsp = a.in[19]; bf16* WSP = (bf16*)(a.ws + WS_WSP);
    for (int i = gw * 64 + lane; i < 4 * 128 * 128; i += NGW * 64) { const int t = (i >> 7) & 127, s2 = i & 127; WSP[i] = (bf16)f2bf(s2 <= t ? wsp[i] : 0.f); }
}
template <bool LOGF> __device__ __forceinline__ void norm_phase(const Args& a, unsigned char* lds, const float* srcp, const float* srcs, const float* g, int ishift, int iscale,
                                                                 int gw, int NGW, int tid, int lane) {
    asm volatile("" : "+v"(tid), "+v"(lane));
    const float* MOD = (const float*)(a.ws + WS_MOD); bf16* XN = (bf16*)(a.ws + WS_XN);
    float* WFt = (float*)lds;
    if (LOGF) { const float* w_in = a.in[14]; for (int i = tid; i < 8192; i += NTHR) { const int k = i >> 3, j = i & 7; WFt[j * 1024 + k] = w_in[(size_t)k * INCOLS + 1536 + j]; } __syncthreads(); }
    int cur = -1; f32x4 gs[4], shv[4], vn[4], vnn[4];
    if (gw < M) { const float* xrow0 = gw < MP ? srcp + (size_t)gw * 1024 : srcs + (size_t)(gw - MP) * 1024;
#pragma unroll
        for (int j = 0; j < 4; ++j) vn[j] = ((const f32x4*)xrow0 + lane)[64 * j]; }
    if (gw + NGW < M) { const int m1 = gw + NGW; const float* xrow1 = m1 < MP ? srcp + (size_t)m1 * 1024 : srcs + (size_t)(m1 - MP) * 1024;
#pragma unroll
        for (int j = 0; j < 4; ++j) vnn[j] = ((const f32x4*)xrow1 + lane)[64 * j]; }
    for (int m = gw; m < M; m += NGW) {
        const int mr = m < MP ? (m >> 14) : 2 + ((m - MP) >> 5);
        if (mr != cur) { cur = mr; const f32x4* g4 = (const f32x4*)g + lane;
            const f32x4* sh4 = (const f32x4*)(MOD + (size_t)mr * 9216 + ishift * 1024) + lane; const f32x4* sc4 = (const f32x4*)(MOD + (size_t)mr * 9216 + iscale * 1024) + lane;
#pragma unroll
            for (int j = 0; j < 4; ++j) { gs[j] = g4[64 * j] * (sc4[64 * j] + 1.0f); shv[j] = sh4[64 * j]; } }
        f32x4 v[4]; float ss = 0.f;
#pragma unroll
        for (int j = 0; j < 4; ++j) { v[j] = vn[j]; vn[j] = vnn[j]; ss += (v[j].x * v[j].x + v[j].y * v[j].y) + (v[j].z * v[j].z + v[j].w * v[j].w); }
        { const int m2 = m + 2 * NGW; if (m2 < M) { const float* xrow2 = m2 < MP ? srcp + (size_t)m2 * 1024 : srcs + (size_t)(m2 - MP) * 1024;
#pragma unroll
            for (int j = 0; j < 4; ++j) vnn[j] = ((const f32x4*)xrow2 + lane)[64 * j]; } }
        const float rstd = 1.0f / sqrtf(wave_sum(ss) * (1.0f / 1024.0f) + EPS);
        unsigned long long* o8 = (unsigned long long*)(XN + (size_t)m * 1024) + lane;
#pragma unroll
        for (int j = 0; j < 4; ++j) { v[j] = (v[j] * rstd) * gs[j] + shv[j];
            o8[64 * j] = (unsigned long long)pk2(v[j].x, v[j].y) | ((unsigned long long)pk2(v[j].z, v[j].w) << 32); }
        if (LOGF) {
            float f[8];
#pragma unroll
            for (int jj = 0; jj < 8; ++jj) { float s = 0.f;
#pragma unroll
                for (int j = 0; j < 4; ++j) { const f32x4 w = *((const f32x4*)(WFt + jj * 1024) + 64 * j + lane); s += (v[j].x * w.x + v[j].y * w.y) + (v[j].z * w.z + v[j].w * w.w); }
                f[jj] = wave_sum(s); }
            float fj = f[0];
#pragma unroll
            for (int jj = 1; jj < 8; ++jj) fj = (lane == jj) ? f[jj] : fj;
            if (lane < 8) { const float x = fj + a.in[15][lane]; const float lf = (x >= 0.f) ? -log1pf(expf(-x)) : x - log1pf(expf(x));
                float* dst = m < MP ? a.out + O_FP + (size_t)m * 8 : a.out + O_FS + (size_t)(m - MP) * 8; dst[lane] = lf; }
        }
    }
}
__device__ __forceinline__ void scan_unit(const Args& a, unsigned char* lds, int unit, int tid) {
    asm volatile("" : "+v"(tid));
    double* tot = (double*)lds;
    if (unit < 16) {
        const int b = unit >> 3, h = unit & 7; const float* lf = a.out + O_FP + ((size_t)b * SEQ) * 8 + h; float* dst = (float*)(a.ws + WS_CUMP) + (size_t)unit * SEQ;
        float x[32]; double s = 0.0;
#pragma unroll
        for (int i = 0; i < 32; ++i) { x[i] = lf[(size_t)(tid * 32 + i) * 8]; s += (double)x[i]; }
        tot[tid] = s; __syncthreads();
        double pre = 0.0; for (int j = 0; j < tid; ++j) pre += tot[j];
#pragma unroll
        for (int i = 0; i < 32; ++i) { pre += (double)x[i]; dst[tid * 32 + i] = (float)(pre * 1.4426950408889634); }
    } else {
        const int bh = unit - 16, b = bh >> 3, h = bh & 7; const float* lfc = a.in[6] + ((size_t)b * PAST) * 8 + h; const float* lfn = a.out + O_FS + ((size_t)b * DSEQ) * 8 + h;
        float* dst = (float*)(a.ws + WS_CUMS) + (size_t)bh * SKEYS;
        float x[3] = {0.f, 0.f, 0.f}; double s = 0.0;
        if (tid < 352) {
#pragma unroll
            for (int i = 0; i < 3; ++i) { const int p = tid * 3 + i; x[i] = p < PAST ? lfc[(size_t)p * 8] : lfn[(size_t)(p - PAST) * 8]; s += (double)x[i]; } }
        tot[tid] = s; __syncthreads();
        if (tid < 352) { double pre = 0.0; for (int j = 0; j < tid; ++j) pre += tot[j];
#pragma unroll
            for (int i = 0; i < 3; ++i) { pre += (double)x[i]; dst[tid * 3 + i] = (float)(pre * 1.4426950408889634); } }
    }
    __syncthreads();
}
__device__ __forceinline__ void gmlp_unit(const Args& a, unsigned char* lds, int ci, int tid, int wave, int lane) {
    asm volatile("" : "+v"(tid), "+v"(lane));
    constexpr int VP = 136;
    bf16* VT = (bf16*)lds; float* rst = (float*)(lds + 128 * VP * 2);
    const bf16* G2 = (const bf16*)(a.ws + WS_G2); const bf16* U = (const bf16*)(a.ws + WS_U); bf16* BO = (bf16*)(a.ws + WS_BO); const bf16* WSP = (const bf16*)(a.ws + WS_WSP);
    const float* G2SS = (const float*)(a.ws + WS_G2SS); const float* gv = a.in[18]; const float* bsp = a.in[20];
    const size_t R0 = (size_t)ci * 128;
    if (tid < 128) { const f32x4* p = (const f32x4*)(G2SS + (R0 + tid) * 8); const f32x4 s0 = p[0], s1 = p[1]; rst[tid] = 1.0f / sqrtf((((s0.x + s0.y) + (s0.z + s0.w)) + ((s1.x + s1.y) + (s1.z + s1.w))) * (1.0f / 512.0f) + EPS); }
    __syncthreads();
    const int r32 = lane & 31, hi = lane >> 5, tb = wave >> 1, dh = wave & 1;
#pragma unroll 1
    for (int g = 0; g < 4; ++g) {
#pragma unroll
        for (int it = 0; it < 4; ++it) { const int q = tid + NTHR * it, s = q & 127, cch = q >> 7;
            const v4u raw = *(const v4u*)(G2 + (R0 + s) * 512 + g * 128 + 8 * cch); const float rs = rst[s];
            const f32x4 g0 = *(const f32x4*)(gv + g * 128 + 8 * cch), g1 = *(const f32x4*)(gv + g * 128 + 8 * cch + 4);
            bf16* col = VT + (8 * cch) * VP + s;
            col[0 * VP] = (bf16)f2bf(pg8::bf_lo(raw.x) * rs * g0.x); col[1 * VP] = (bf16)f2bf(pg8::bf_hi(raw.x) * rs * g0.y); col[2 * VP] = (bf16)f2bf(pg8::bf_lo(raw.y) * rs * g0.z); col[3 * VP] = (bf16)f2bf(pg8::bf_hi(raw.y) * rs * g0.w);
            col[4 * VP] = (bf16)f2bf(pg8::bf_lo(raw.z) * rs * g1.x); col[5 * VP] = (bf16)f2bf(pg8::bf_hi(raw.z) * rs * g1.y); col[6 * VP] = (bf16)f2bf(pg8::bf_lo(raw.w) * rs * g1.z); col[7 * VP] = (bf16)f2bf(pg8::bf_hi(raw.w) * rs * g1.w); }
        bf16x8 af[8];
#pragma unroll
        for (int ks = 0; ks < 8; ++ks) af[ks] = *(const bf16x8*)(WSP + ((size_t)(g * 128 + 32 * tb + r32)) * 128 + 16 * ks + 8 * hi);
        __syncthreads();
        f32x16 acc[2]; acc[0] = f32x16{}; acc[1] = f32x16{};
#pragma unroll
        for (int ks = 0; ks < 8; ++ks) if (ks <= 2 * tb + 1) {
#pragma unroll
            for (int db = 0; db < 2; ++db) { const bf16x8 bfv = *(const bf16x8*)(VT + (64 * dh + 32 * db + r32) * VP + 16 * ks + 8 * hi); acc[db] = __builtin_amdgcn_mfma_f32_32x32x16_bf16(af[ks], bfv, acc[db], 0, 0, 0); }
        }
        { unsigned short uu[2][16]; float bb[16];
#pragma unroll
          for (int r = 0; r < 16; ++r) { const int t = 32 * tb + (r & 3) + 8 * (r >> 2) + 4 * hi; bb[r] = bsp[g * 128 + t];
#pragma unroll
              for (int db = 0; db < 2; ++db) uu[db][r] = U[(R0 + t) * 512 + g * 128 + 64 * dh + 32 * db + r32]; }
#pragma unroll
          for (int db = 0; db < 2; ++db)
#pragma unroll
              for (int r = 0; r < 16; ++r) { const int t = 32 * tb + (r & 3) + 8 * (r >> 2) + 4 * hi, ch = g * 128 + 64 * dh + 32 * db + r32; const size_t off = (R0 + t) * 512 + ch;
                  BO[off] = (bf16)f2bf(bf2f(uu[db][r]) * (acc[db][r] + bb[r])); } }
        __syncthreads();
    }
}
__device__ __forceinline__ void gmlp_sample_unit(const Args& a, unsigned char* lds, int b, int tid) {
    asm volatile("" : "+v"(tid));
    float* rst = (float*)lds;
    const bf16* G2 = (const bf16*)(a.ws + WS_G2); const bf16* U = (const bf16*)(a.ws + WS_U); bf16* BO = (bf16*)(a.ws + WS_BO);
    const float* G2SS = (const float*)(a.ws + WS_G2SS); const float* wsp = a.in[19]; const float* bsp = a.in[20];
    const size_t R0 = (size_t)MP + b * 32;
    if (tid < 32) { const float* p = G2SS + (R0 + tid) * 8; float s = 0.f; for (int i = 0; i < 8; ++i) s += p[i]; rst[tid] = 1.0f / sqrtf(s * (1.0f / 512.0f) + EPS); }
    __syncthreads();
    const int ch = tid, g = ch >> 7; const float gvv = a.in[18][ch];
    float vb[32];
#pragma unroll
    for (int s = 0; s < 32; ++s) { vb[s] = bf2f(G2[(R0 + s) * 512 + ch]) * rst[s] * gvv; a.out[O_GS + ((size_t)b * 32 + s) * 512 + ch] = vb[s]; }
    unsigned short uu[32];
#pragma unroll
    for (int t = 0; t < 32; ++t) uu[t] = U[(R0 + t) * 512 + ch];
#pragma unroll
    for (int t = 0; t < 32; ++t) { float mixed = bsp[g * 128 + t]; const float* wrow = wsp + ((size_t)g * 128 + t) * 128;
#pragma unroll
        for (int s = 0; s < 32; ++s) if (s <= t) mixed += wrow[s] * vb[s];
        const size_t off = (R0 + t) * 512 + ch; BO[off] = (bf16)f2bf(bf2f(uu[t]) * mixed); }
    __syncthreads();
}
__device__ __forceinline__ void sattn_unit(const Args& a, unsigned char* lds, int unit, int tid, int wave, int lane) {
    asm volatile("" : "+v"(tid), "+v"(lane));
    const int qg = unit & 3, h = (unit >> 2) & 7, b = unit >> 5;
    float* qs = (float*)lds;
    float* S = qs + 512;
    float* red = S + 8 * SKEYS;
    float* inv = red + 4096;
    const float* QS = (const float*)(a.ws + WS_QS); const float* cum = (const float*)(a.ws + WS_CUMS) + (size_t)(b * 8 + h) * SKEYS;
    const float* kc = a.in[4] + ((size_t)b * PAST) * 512 + h * 64; const float* vc = a.in[5] + ((size_t)b * PAST) * 512 + h * 64;
    const float* kn = a.out + O_KS + ((size_t)b * DSEQ) * 512 + h * 64; const float* vn = a.out + O_VS + ((size_t)b * DSEQ) * 512 + h * 64;
    { const int qi = tid >> 6, d = tid & 63; qs[tid] = QS[((size_t)b * 32 + 8 * qg + qi) * 512 + h * 64 + d]; }
    __syncthreads();
    for (int key = wave * 132 + lane; key < wave * 132 + 132; key += 64) {
        const f32x4* kr = (const f32x4*)(key < PAST ? kc + (size_t)key * 512 : kn + (size_t)(key - PAST) * 512);
        f32x4 kv[16];
#pragma unroll
        for (int i = 0; i < 16; ++i) kv[i] = kr[i];
        const float ck = cum[key];
#pragma unroll
        for (int qi = 0; qi < 8; ++qi) { float s = 0.f;
#pragma unroll
            for (int i = 0; i < 16; ++i) { const f32x4 q4 = *(const f32x4*)(qs + qi * 64 + 4 * i); s += (q4.x * kv[i].x + q4.y * kv[i].y) + (q4.z * kv[i].z + q4.w * kv[i].w); }
            const int qpos = PAST + 8 * qg + qi;
            S[qi * SKEYS + key] = (key <= qpos) ? s + (cum[qpos] - ck) : -INFINITY; }
    }
    __syncthreads();
    { float mx = -INFINITY; for (int k = lane; k < SKEYS; k += 64) mx = fmaxf(mx, S[wave * SKEYS + k]);
#pragma unroll
      for (int o = 1; o < 64; o <<= 1) mx = fmaxf(mx, __shfl_xor(mx, o));
      float sum = 0.f; for (int k = lane; k < SKEYS; k += 64) { const float p = exp2f(S[wave * SKEYS + k] - mx); S[wave * SKEYS + k] = p; sum += p; }
      sum = wave_sum(sum); if (lane == 0) inv[wave] = 1.0f / sum; }
    __syncthreads();
    { float acc[8];
#pragma unroll
      for (int qi = 0; qi < 8; ++qi) acc[qi] = 0.f;
#pragma unroll 1
      for (int key0 = wave * 132; key0 < wave * 132 + 132; key0 += 12) {
          float vv[12];
#pragma unroll
          for (int j = 0; j < 12; ++j) { const int key = key0 + j; vv[j] = (key < PAST ? vc + (size_t)key * 512 : vn + (size_t)(key - PAST) * 512)[lane]; }
#pragma unroll
          for (int j = 0; j < 12; ++j)
#pragma unroll
              for (int qi = 0; qi < 8; ++qi) acc[qi] += S[qi * SKEYS + key0 + j] * vv[j]; }
#pragma unroll
      for (int qi = 0; qi < 8; ++qi) red[(wave * 8 + qi) * 64 + lane] = acc[qi]; }
    __syncthreads();
    { const int qi = tid >> 6, d = tid & 63; float s = 0.f;
#pragma unroll
      for (int w = 0; w < 8; ++w) s += red[(w * 8 + qi) * 64 + d];
      bf16* AO = (bf16*)(a.ws + WS_AO); AO[((size_t)MP + b * 32 + 8 * qg + qi) * 512 + h * 64 + d] = (bf16)f2bf(s * inv[qi]); }
    __syncthreads();
}

#define XB_TMO      128
#define XB_XCNT(j)  (256  + 64 * (j))
#define XB_XSUB(j)  (1280 + 64 * (j))
#define XB_XGEN(j)  (2304 + 64 * (j))
#define XB_TOP      3328
#define XB_TOPGEN   3392
#define XCD_BAR_WORDS 3456
#define XB_SPIN_CAP (1u << 18)

__device__ __forceinline__ unsigned xb_ld(unsigned* p)              { return __hip_atomic_load(p, __ATOMIC_RELAXED, __HIP_MEMORY_SCOPE_AGENT); }
__device__ __forceinline__ unsigned xb_add(unsigned* p, unsigned v) { return __hip_atomic_fetch_add(p, v, __ATOMIC_RELAXED, __HIP_MEMORY_SCOPE_AGENT); }
__device__ __forceinline__ unsigned xb_xcc_id() { return (unsigned)__builtin_amdgcn_s_getreg((3 << 11) | 20) & 0xFu; }
#define XB_SPIN(cond, bar) do { unsigned _sp = 0; while (cond) { __builtin_amdgcn_s_sleep(1); \
    if ((++_sp & 255u) == 0u) { if (xb_ld(&(bar)[XB_TMO])) break; if (_sp > XB_SPIN_CAP) { atomicAdd(&(bar)[XB_TMO], 1u); break; } } } } while (0)

struct XcdBarrier {
    unsigned* bar; unsigned x;
    volatile LAS unsigned* st;
};

__device__ __forceinline__ XcdBarrier xcd_barrier_post(unsigned* bar, volatile LAS unsigned* st, int wv) {
    XcdBarrier b; b.bar = bar; b.x = xb_xcc_id(); b.st = st;
    if (wv == 0 && lane_id_() == 0) (void)xb_add(&bar[XB_XCNT(b.x)], 1u);
    return b;
}
__device__ __forceinline__ void xcd_barrier_complete(unsigned* bar, unsigned x, unsigned& nloc, unsigned& nx) {
    const unsigned G = gridDim.x * gridDim.y * gridDim.z;
    unsigned sum, cnt, mine, sp = 0u;
    for (;;) {
        sum = 0u; cnt = 0u; mine = 0u;
#pragma unroll
        for (unsigned j = 0; j < 16; ++j) { const unsigned c = xb_ld(&bar[XB_XCNT(j)]); sum += c; cnt += (c > 0u) ? 1u : 0u; mine = (j == x) ? c : mine; }
        if (sum == G) break;
        __builtin_amdgcn_s_sleep(1);
        if ((++sp & 255u) == 0u) { if (xb_ld(&bar[XB_TMO])) break; if (sp > XB_SPIN_CAP) { atomicAdd(&bar[XB_TMO], 1u); break; } }
    }
    nloc = mine > 0u ? mine : 1u; nx = cnt > 0u ? cnt : 1u;
}

__device__ __forceinline__ void xcd_barrier(const XcdBarrier& b, int wv) {
    asm volatile("s_waitcnt vmcnt(0)" ::: "memory");
    __syncthreads();
    if (wv == 0 && lane_id_() == 0) {
        unsigned* bar = b.bar;
        __builtin_amdgcn_s_waitcnt(0);
        unsigned nloc = b.st[0], nx = b.st[1];
        if (nloc == 0u) { xcd_barrier_complete(bar, b.x, nloc, nx); b.st[0] = nloc; b.st[1] = nx; }
        const unsigned old = xb_add(&bar[XB_XSUB(b.x)], 1u);
        const unsigned gen = old / nloc;
        if (old + 1u == (gen + 1u) * nloc) {
            __builtin_amdgcn_fence(__ATOMIC_RELEASE, "agent");
            asm volatile("s_waitcnt vmcnt(0)" ::: "memory");
            const unsigned og = xb_add(&bar[XB_TOP], 1u);
            const unsigned tg = og / nx;
            if (og + 1u == (tg + 1u) * nx) xb_add(&bar[XB_TOPGEN], 1u);
            else XB_SPIN(xb_ld(&bar[XB_TOPGEN]) == tg, bar);
            __builtin_amdgcn_fence(__ATOMIC_ACQUIRE, "agent");
            xb_add(&bar[XB_XGEN(b.x)], 1u);
            asm volatile("s_waitcnt vmcnt(0)" ::: "memory");
        } else {
            XB_SPIN(xb_ld(&bar[XB_XGEN(b.x)]) == gen, bar);
            __builtin_amdgcn_fence(__ATOMIC_ACQUIRE, "agent");
            asm volatile("s_waitcnt vmcnt(0)" ::: "memory");
        }
    }
    __syncthreads();
}

#ifndef SKIPMASK
#define SKIPMASK 0u
#endif
#define PH(n) (((SKIPMASK) >> (n) & 1u) == 0u)
#define GSYNC() do { XcdBarrier b_; b_.bar = (unsigned*)(a.ws + WS_CTL); b_.x = xbar_x; b_.st = MISC + 8; xcd_barrier(b_, wave); } while (0)
__global__ void __launch_bounds__(NTHR, 2) fox_fwd(Args a) {
    extern __shared__ __attribute__((aligned(16))) unsigned char lds[];
    cg::grid_group grid = cg::this_grid();
    const int wave = __builtin_amdgcn_readfirstlane((int)threadIdx.x >> 6);
#define tid ((wave << 6) | lane_id_())
#define lane (lane_id_())
    const int G = gridDim.x, bx = blockIdx.x; const int vcu = (G % 8 == 0) ? (bx % 8) * (G / 8) + bx / 8 : bx;
    const int gw = vcu * NWAVES + wave, NGW = G * NWAVES;
    LAS unsigned char* ldsl = (LAS unsigned char*)lds;
    float* MOD = (float*)(a.ws + WS_MOD); bf16* XN = (bf16*)(a.ws + WS_XN); bf16* ACT = (bf16*)(a.ws + WS_ACT);
    volatile LAS unsigned* MISC = (volatile LAS unsigned*)((LAS unsigned char*)lds + MISC_OFF);
    for (int i = tid; i < LDS_BYTES / 16; i += NTHR) ((v4u*)lds)[i] = (v4u){0u, 0u, 0u, 0u};
    __syncthreads();
    __builtin_amdgcn_fence(__ATOMIC_SEQ_CST, ""); asm volatile("s_waitcnt vmcnt(0) lgkmcnt(0)" ::: "memory");
    const unsigned xbar_x = xcd_barrier_post((unsigned*)(a.ws + WS_CTL), MISC + 8, wave).x;
    grid.sync();
    float* Y = a.out + O_Y;

#ifndef NPASS
#define NPASS 1
#endif
#pragma unroll 1
    for (int pass = 0; pass < NPASS; ++pass) {
    if (pass) GSYNC();
    if (PH(0)) { for (int cb = bx; cb < 256; cb += G) ada_unit(a, lds, cb, tid);
    p0_weights(a, lds, gw, NGW, wave, lane); }
    GSYNC();
    if (PH(1)) norm_phase<false>(a, lds, a.in[0], a.in[1], a.in[9], 0, 1, gw, NGW, tid, lane);
    GSYNC();
    if (PH(2)) { pg8::Gemm g{XN, (const bf16*)(a.ws + WS_WGU1), M, 2 * FF, 1024, 1024}; pg8::StaticOrder S; S.init(M, 2 * FF, G, bx); pg8::EpiUp E{ACT, FF};
      GEMM_PHASE(pg8::EpiUp); }
    GSYNC();
    if (PH(3)) { pg8::EpiRes E{a.in[0], a.in[1], Y, MOD + 2 * 1024, 0.5f};
      { int ksub_ = 256; asm volatile("" : "+s"(ksub_)); pg8::Gemm g2{ACT + (size_t)MP * FF, (const bf16*)(a.ws + WS_WD1), 256, 1024, ksub_, FF}; pg8::SplitOrder S2; S2.init(G, bx); pg8::EpiPartial E2{(float*)(a.ws + WS_PART), 4, 256}; GEMM_PHASE_SPLIT(); }
      { pg8::Gemm g{ACT, (const bf16*)(a.ws + WS_WD1), MP, 1024, FF, FF}; pg8::StaticOrder S; S.init(MP, 1024, G, bx); GEMM_PHASE(pg8::EpiRes); }
      GSYNC();
      if (bx < 32) pg8::reduce_rowgroup<11>((const float*)(a.ws + WS_PART), bx & 3, bx >> 2, E, wave); }
    GSYNC();
    if (PH(4)) norm_phase<true>(a, lds, Y, Y + (size_t)MP * 1024, a.in[13], 3, 4, gw, NGW, tid, lane);
    GSYNC();
    if (PH(5)) { if (G >= 160) { const int u = G - 1 - bx; if (u < 80) scan_unit(a, lds, u, tid); }
                 else for (int u = bx; u < 80; u += G) scan_unit(a, lds, u, tid); }
    if (PH(6)) { pg8::Gemm g{XN, (const bf16*)(a.ws + WS_WIN), M, 2560, 1024, 1024}; pg8::StaticOrder S; S.init(M, 2560, G, bx);
      pg8::EpiIn E{(bf16*)(a.ws + WS_Q), (bf16*)(a.ws + WS_K), (bf16*)(a.ws + WS_V), (bf16*)(a.ws + WS_U), (bf16*)(a.ws + WS_G2), nullptr, nullptr,
                   (float*)(a.ws + WS_G2SS), (float*)(a.ws + WS_QS), a.out + O_KP, a.out + O_KS, a.out + O_VP, a.out + O_VS, a.in[16], a.in[17], attn_body::C2, EPS};
      GEMM_PHASE(pg8::EpiIn); }
    GSYNC();
    if (PH(7)) { const attn_body::bf16* Qb = (const attn_body::bf16*)(a.ws + WS_Q); const attn_body::bf16* Kb = (const attn_body::bf16*)(a.ws + WS_K); const attn_body::bf16* Vb = (const attn_body::bf16*)(a.ws + WS_V);
      attn_body::bf16* Ob = (attn_body::bf16*)(a.ws + WS_AO); const float* CUMP = (const float*)(a.ws + WS_CUMP);
      const int nun = (G == 256) ? 4 : (1024 - bx + G - 1) / G;
      float B2;
      { float mq = fabsf(a.in[16][lane]), mk = fabsf(a.in[17][lane]);
#pragma unroll
        for (int o = 1; o < 64; o <<= 1) { mq = fmaxf(mq, __shfl_xor(mq, o)); mk = fmaxf(mk, __shfl_xor(mk, o)); }
        B2 = 64.0f * mq * mk * attn_body::C2 * 1.01f + 0.5f; }
#pragma unroll 1
      for (int i = 0; i < nun; ++i) { int bh, qb;
          if (G == 256) { const int s = vcu & 15; bh = vcu >> 4; qb = (i == 0) ? s : (i == 1) ? 31 - s : (i == 2) ? 32 + s : 63 - s; } else { const int idx = bx + i * G; bh = idx >> 6; qb = idx & 63; }
          int ts = 0;
          { const float* cl = CUMP + (size_t)bh * SEQ; const float cref = cl[qb * 256]; const int ncand = 4 * qb;
            float cv[4];
#pragma unroll
            for (int k = 0; k < 4; ++k) { const int j = 64 * k + lane; cv[k] = (j < ncand) ? cl[64 * j + 63] : 0.f; }
#pragma unroll
            for (int k = 0; k < 4; ++k) { const int j = 64 * k + lane; const bool sk = (j < ncand) && (cref - cv[k] + 2.0f * B2 < -152.0f); ts += (int)__popcll(__ballot(sk)); }
            ts = __builtin_amdgcn_readfirstlane(ts) & ~1; }
          attn_body::attn_unit<8>(bh >> 3, bh & 7, qb, ts, CUMP + (size_t)bh * SEQ, Qb, Kb, Vb, Ob, (char*)lds, wave);
          }
      __syncthreads(); }
    if (PH(8)) for (int ci = bx; ci < 256; ci += G) gmlp_unit(a, lds, ci, tid, wave, lane);
    if (PH(9)) for (int u = bx; u < 256; u += G) sattn_unit(a, lds, u, tid, wave, lane);
    if (PH(10)) { if (G == 256) { if ((vcu & 15) == 0 && (vcu >> 4) < 8) gmlp_sample_unit(a, lds, vcu >> 4, tid); } else for (int b = bx; b < 8; b += G) gmlp_sample_unit(a, lds, b, tid); }
    GSYNC();
    if (PH(11)) { bf16* T = (bf16*)(a.ws + WS_T1); bf16* T2 = (bf16*)(a.ws + WS_T2); const bf16* WIN = (const bf16*)(a.ws + WS_WIN);
      bf16* TS = T + (size_t)MP * 1024; bf16* T2S = T2 + (size_t)MP * 1024; const bf16* XS = XN + (size_t)MP * 1024;
      float* PARTA = (float*)(a.ws + 2 * MiB); float* PARTB = (float*)(a.ws + 4 * MiB);
      { pg8::Gemm g{(const bf16*)(a.ws + WS_AO) + (size_t)MP * 512, (const bf16*)(a.ws + WS_WPA), 256, 1024, 512, 512}; pg8::StaticOrder S; S.init(256, 1024, G, bx); pg8::EpiMix<0> E{TS, nullptr}; GEMM_PHASE(pg8::EpiMix<0>); }
      { pg8::Gemm g{(const bf16*)(a.ws + WS_AO), (const bf16*)(a.ws + WS_WPA), MP, 1024, 512, 512}; pg8::StaticOrder S; S.init(MP, 1024, G, bx); pg8::EpiMix<0> E{T, nullptr}; GEMM_PHASE(pg8::EpiMix<0>); }
      { int ksub_ = 512; asm volatile("" : "+s"(ksub_)); pg8::Gemm g2{XS, WIN + (size_t)2560 * 1024, 256, 1024, ksub_, 1024}; pg8::SplitOrderT<4, 2, 512> S2; S2.init(G, (bx + G - 8) % G); pg8::EpiPartialT<4, 9> E2{PARTA}; GEMM_PHASE_SPLIT_T(4, 2, 512, 9); }
      { pg8::Gemm g{XN, WIN + (size_t)2560 * 1024, MP, 1024, 1024, 1024}; pg8::StaticOrder S; S.init(MP, 1024, G, bx); pg8::EpiMix<1> E{T, nullptr}; GEMM_PHASE(pg8::EpiMix<1>); }
      { pg8::Gemm g{(const bf16*)(a.ws + WS_BO) + (size_t)MP * 512, (const bf16*)(a.ws + WS_WPB), 256, 1024, 512, 512}; pg8::StaticOrder S; S.init(256, 1024, G, (bx + G - 16) % G); pg8::EpiMix<0> E{T2S, nullptr}; GEMM_PHASE(pg8::EpiMix<0>); }
      { pg8::Gemm g{(const bf16*)(a.ws + WS_BO), (const bf16*)(a.ws + WS_WPB), MP, 1024, 512, 512}; pg8::StaticOrder S; S.init(MP, 1024, G, bx); pg8::EpiMix<0> E{T2, nullptr}; GEMM_PHASE(pg8::EpiMix<0>); }
      { int ksub_ = 512; asm volatile("" : "+s"(ksub_)); pg8::Gemm g2{XS, WIN + (size_t)3584 * 1024, 256, 1024, ksub_, 1024}; pg8::SplitOrderT<4, 2, 512> S2; S2.init(G, (bx + G - 24) % G); pg8::EpiPartialT<4, 9> E2{PARTB}; GEMM_PHASE_SPLIT_T(4, 2, 512, 9); }
      { pg8::Gemm g{XN, WIN + (size_t)3584 * 1024, MP, 1024, 1024, 1024}; pg8::StaticOrder S; S.init(MP, 1024, G, bx); pg8::EpiMix<2> E{T, T2}; GEMM_PHASE(pg8::EpiMix<2>); }
      GSYNC();
      if (bx < 32) { pg8::EpiMix<1> E1{TS, nullptr}; pg8::reduce_rowgroup<2>(PARTA, bx & 3, bx >> 2, E1, wave);
                     pg8::EpiMix<2> E2{TS, T2S}; pg8::reduce_rowgroup<2>(PARTB, bx & 3, bx >> 2, E2, wave); } }
    GSYNC();
    if (PH(13)) { pg8::EpiRes E{Y, Y + (size_t)MP * 1024, Y, MOD + 5 * 1024, 1.0f}; const bf16* M1 = (const bf16*)(a.ws + WS_T1);
      { int ksub_ = 256; asm volatile("" : "+s"(ksub_)); pg8::Gemm g2{M1 + (size_t)MP * 1024, (const bf16*)(a.ws + WS_WOUT), 256, 1024, ksub_, 1024}; pg8::SplitOrderT<4, 4, 256> S2; S2.init(G, bx); pg8::EpiPartialT<4, 8> E2{(float*)(a.ws + WS_PART)}; GEMM_PHASE_SPLIT_T(4, 4, 256, 8); }
      { pg8::Gemm g{M1, (const bf16*)(a.ws + WS_WOUT), MP, 1024, 1024, 1024}; pg8::StaticOrder S; S.init(MP, 1024, G, bx); GEMM_PHASE(pg8::EpiRes); }
      GSYNC();
      if (bx < 32) pg8::reduce_rowgroup<4>((const float*)(a.ws + WS_PART), bx & 3, bx >> 2, E, wave); }
    GSYNC();
    if (PH(14)) norm_phase<false>(a, lds, Y, Y + (size_t)MP * 1024, a.in[24], 6, 7, gw, NGW, tid, lane);
    GSYNC();
    if (PH(15)) { pg8::Gemm g{XN, (const bf16*)(a.ws + WS_WGU2), M, 2 * FF, 1024, 1024}; pg8::StaticOrder S; S.init(M, 2 * FF, G, bx); pg8::EpiUp E{ACT, FF};
      GEMM_PHASE(pg8::EpiUp); }
    GSYNC();
    if (PH(16)) { pg8::EpiRes E{Y, Y + (size_t)MP * 1024, Y, MOD + 8 * 1024, 0.5f};
      { int ksub_ = 256; asm volatile("" : "+s"(ksub_)); pg8::Gemm g2{ACT + (size_t)MP * FF, (const bf16*)(a.ws + WS_WD2), 256, 1024, ksub_, FF}; pg8::SplitOrder S2; S2.init(G, bx); pg8::EpiPartial E2{(float*)(a.ws + WS_PART), 4, 256}; GEMM_PHASE_SPLIT(); }
      { pg8::Gemm g{ACT, (const bf16*)(a.ws + WS_WD2), MP, 1024, FF, FF}; pg8::StaticOrder S; S.init(MP, 1024, G, bx); GEMM_PHASE(pg8::EpiRes); }
      GSYNC();
      if (bx < 32) pg8::reduce_rowgroup<11>((const float*)(a.ws + WS_PART), bx & 3, bx >> 2, E, wave); }
    }
}


#undef tid
#undef lane
extern "C" void kernel_launch(void* const* d_in, const int* in_sizes, int n_in, void* d_out, int out_size, void* d_ws, size_t ws_size, hipStream_t stream) {
    static int grid = 0;
    if (grid == 0) {
        if (n_in != 28 || (size_t)out_size != O_END || ws_size < WS_END || in_sizes[0] != MP * 1024) { fprintf(stderr, "kernel_launch: unexpected shapes (n_in %d out %d ws %zu)\n", n_in, out_size, ws_size); grid = -1; return; }
        int dev = 0, cus = 0, per_cu = 0;
        hipGetDevice(&dev); hipDeviceGetAttribute(&cus, hipDeviceAttributeMultiprocessorCount, dev);
        if (hipFuncSetAttribute((const void*)fox_fwd, hipFuncAttributeMaxDynamicSharedMemorySize, LDS_BYTES) != hipSuccess) { fprintf(stderr, "kernel_launch: hipFuncSetAttribute failed\n"); grid = -1; return; }
        if (hipOccupancyMaxActiveBlocksPerMultiprocessor(&per_cu, (const void*)fox_fwd, NTHR, LDS_BYTES) != hipSuccess || per_cu < 1) { fprintf(stderr, "kernel_launch: occupancy query says %d\n", per_cu); per_cu = 1; }
        (void)hipGetLastError();
        grid = cus * 1;
    }
    if (grid < 0) return;
    if (hipMemsetAsync((char*)d_ws + WS_CTL, 0, CTL_ZERO_BYTES, stream) != hipSuccess) { fprintf(stderr, "kernel_launch: hipMemsetAsync failed\n"); return; }
    Args a{};
    for (int i = 0; i < 28; ++i) a.in[i] = (const float*)d_in[i];
    a.out = (float*)d_out; a.ws = (unsigned char*)d_ws;
    void* args[] = {&a};
    hipError_t e = hipLaunchCooperativeKernel((const void*)fox_fwd, dim3(grid), dim3(NTHR), args, LDS_BYTES, stream);
    if (e != hipSuccess) fprintf(stderr, "cooperative launch failed: %s (grid %d)\n", hipGetErrorString(e), grid);
}
```
